# Optimizing an MI355X kernel written in HIP

```python
import jax
import jax.numpy as jnp
from jax import lax
import numpy as np

D_MODEL = 1024
BATCH = 4
SEQ = 8192
DEPTH = 4

CTX_LEN = 256
GRID_W = 64
HEAD_DIM = 64
NA_HEADS = 4
NA_KH = 8
NA_KW = 16
WA_HEADS = 4
WA_KV_HEADS = 2
WA_WINDOW = 128
WA_BLOCK = 128
MLA_HEADS = 4
MLA_Q_RANK = 256
MLA_KV_RANK = 128
MLA_NOPE = 32
MLA_ROPE = 32
MLA_V = 64
MLA_BLOCK = 128
GLA_HEADS = 4
GLA_DK = 32
GLA_DV = 64
GLA_GATE_RANK = 16
GLA_GATE_NORM = 16.0
GLA_CHUNK = 64
N_EXPERTS = 128
TOP_K = 8
D_EXPERT = 256
D_SHARED = 256
ROUTED_SCALE = 2.5
MOE_BLOCK = 128

ROPE_THETA = 10000.0
LN_EPS = 1e-5
RMS_EPS = 1e-6
DEEPNORM_ALPHA = (2 * DEPTH) ** 0.25
DEEPNORM_BETA = (8 * DEPTH) ** -0.25
MIX_WIDTH = NA_HEADS * HEAD_DIM + WA_HEADS * HEAD_DIM + MLA_HEADS * MLA_V + GLA_HEADS * GLA_DV
IN_SIZES = (
    NA_HEADS * HEAD_DIM, NA_HEADS * HEAD_DIM, NA_HEADS * HEAD_DIM,
    WA_HEADS * HEAD_DIM, WA_KV_HEADS * HEAD_DIM, WA_KV_HEADS * HEAD_DIM,
    MLA_Q_RANK, MLA_KV_RANK, MLA_ROPE,
    GLA_HEADS * GLA_DK, GLA_HEADS * GLA_DK, GLA_HEADS * GLA_DV,
    GLA_HEADS * GLA_DV, GLA_GATE_RANK, GLA_GATE_RANK,
)
IN_WIDTH = sum(IN_SIZES)

kernel_name = 'hybrid_dit_parallel_heads_moe'


def layer_norm(x):
    xf = x.astype(jnp.float32)
    mu = jnp.mean(xf, -1, keepdims=True)
    var = jnp.mean(jnp.square(xf - mu), -1, keepdims=True)
    return ((xf - mu) * lax.rsqrt(var + LN_EPS)).astype(x.dtype)


def rms_norm(x, g):
    xf = x.astype(jnp.float32)
    y = xf * lax.rsqrt(jnp.mean(xf * xf, -1, keepdims=True) + RMS_EPS)
    return y.astype(x.dtype) * g


def modulate(x, shift, scale):
    return layer_norm(x) * (1 + scale) + shift


def post_norm(z, g, b):
    return layer_norm(z) * g + b


def heads(a, n):
    return a.reshape(a.shape[:-1] + (n, a.shape[-1] // n))


def rope_1d(x, pos):
    half = x.shape[-1] // 2
    inv_freq = ROPE_THETA ** (-jnp.arange(half, dtype=jnp.float32) / half)
    ang = pos.astype(jnp.float32)[:, None, None] * inv_freq
    cos, sin = jnp.cos(ang), jnp.sin(ang)
    x1, x2 = x[..., :half].astype(jnp.float32), x[..., half:].astype(jnp.float32)
    return jnp.concatenate([x1 * cos - x2 * sin, x2 * cos + x1 * sin], -1).astype(x.dtype)


def rope_2d(x):
    t = jnp.arange(x.shape[1])
    d = x.shape[-1] // 2
    return jnp.concatenate([rope_1d(x[..., :d], t // GRID_W), rope_1d(x[..., d:], t % GRID_W)], -1)


def context_attention(qc, kc, vc, sink=None):
    s = jnp.einsum('bqhd,bkhd->bhqk', qc, kc).astype(jnp.float32) * qc.shape[-1] ** -0.5
    if sink is not None:
        s = jnp.concatenate([s, jnp.broadcast_to(sink.astype(jnp.float32)[None, :, None, None], s.shape[:-1] + (1,))], -1)
    p = jax.nn.softmax(s, axis=-1)[..., :kc.shape[1]].astype(vc.dtype)
    o = jnp.einsum('bhqk,bkhd->bqhd', p, vc)
    return o.reshape(o.shape[:2] + (-1,))


def neighbourhood_attention(q, k, v, kc, vc, rpb):
    B, T, H, d = q.shape
    rows = T // GRID_W
    kh = min(NA_KH, rows)
    scale = d ** -0.5

    def to_grid(a):
        return a.reshape(B, rows, GRID_W, H, d).transpose(0, 3, 1, 2, 4)

    kg, vg = to_grid(k), to_grid(v)
    q_rows = jnp.moveaxis(to_grid(q), 2, 0)
    r_idx = jnp.arange(rows)
    c_idx = jnp.arange(GRID_W)
    row_start = jnp.clip(r_idx - kh // 2, 0, rows - kh)
    col_keys = jnp.clip(c_idx - NA_KW // 2, 0, GRID_W - NA_KW)[:, None] + jnp.arange(NA_KW)
    col_off = col_keys - c_idx[:, None] + (NA_KW - 1)
    kc_t, vc_t = kc.transpose(0, 2, 1, 3), vc.transpose(0, 2, 1, 3)
    n_nb = kh * NA_KW

    def one_row(inp):
        r, rs, q_row = inp
        k_nb = lax.dynamic_slice_in_dim(kg, rs, kh, axis=2)[:, :, :, col_keys]
        v_nb = lax.dynamic_slice_in_dim(vg, rs, kh, axis=2)[:, :, :, col_keys]
        row_off = rs + jnp.arange(kh) - r + (NA_KH - 1)
        bias = rpb[:, row_off][:, :, col_off].transpose(0, 2, 1, 3)
        s_nb = jnp.einsum('bhcd,bhicjd->bhcij', q_row, k_nb).astype(jnp.float32) * scale + bias.astype(jnp.float32)
        s_ctx = jnp.einsum('bhcd,bhnd->bhcn', q_row, kc_t).astype(jnp.float32) * scale
        p = jax.nn.softmax(jnp.concatenate([s_nb.reshape(B, H, GRID_W, n_nb), s_ctx], -1), axis=-1).astype(v.dtype)
        return (jnp.einsum('bhcij,bhicjd->bhcd', p[..., :n_nb].reshape(B, H, GRID_W, kh, NA_KW), v_nb)
                + jnp.einsum('bhcn,bhnd->bhcd', p[..., n_nb:], vc_t))

    o = lax.map(one_row, (r_idx, row_start, q_rows))
    return o.transpose(1, 0, 3, 2, 4).reshape(B, T, H * d)


def window_attention(q, k, v, kc, vc, sink):
    B, T, H, d = q.shape
    hkv = k.shape[2]
    grp = H // hkv
    nb = T // WA_BLOCK
    band = WA_BLOCK + 2 * WA_WINDOW
    scale = d ** -0.5
    pad = ((0, 0), (WA_WINDOW, WA_WINDOW), (0, 0), (0, 0))
    kp, vp = jnp.pad(k, pad), jnp.pad(v, pad)
    qb = q.reshape(B, nb, WA_BLOCK, hkv, grp, d).transpose(1, 0, 2, 3, 4, 5)
    k_off = jnp.arange(band)
    rel = k_off[None, :] - WA_WINDOW - jnp.arange(WA_BLOCK)[:, None]
    sink_l = jnp.broadcast_to(sink.reshape(hkv, grp).astype(jnp.float32)[None, :, :, None, None], (B, hkv, grp, WA_BLOCK, 1))

    def one_block(inp):
        i, q_blk = inp
        start = i * WA_BLOCK
        k_blk = lax.dynamic_slice_in_dim(kp, start, band, axis=1)
        v_blk = lax.dynamic_slice_in_dim(vp, start, band, axis=1)
        kpos = start - WA_WINDOW + k_off
        valid = (jnp.abs(rel) <= WA_WINDOW) & ((kpos >= 0) & (kpos < T))[None, :]
        s = jnp.einsum('bqhgd,bkhd->bhgqk', q_blk, k_blk).astype(jnp.float32) * scale
        s = jnp.where(valid, s, -jnp.inf)
        s_ctx = jnp.einsum('bqhgd,bchd->bhgqc', q_blk, kc).astype(jnp.float32) * scale
        p = jax.nn.softmax(jnp.concatenate([s, s_ctx, sink_l], -1), axis=-1).astype(v.dtype)
        return (jnp.einsum('bhgqk,bkhd->bqhgd', p[..., :band], v_blk)
                + jnp.einsum('bhgqc,bchd->bqhgd', p[..., band:band + kc.shape[1]], vc))

    o = lax.map(one_block, (jnp.arange(nb), qb))
    return o.transpose(1, 0, 2, 3, 4, 5).reshape(B, T, H * d)


def mla_q(cq, g_q, w_uq, rotary):
    q = heads(rms_norm(cq, g_q) @ w_uq, MLA_HEADS)
    q_nope, q_rope = q[..., :MLA_NOPE], q[..., MLA_NOPE:]
    if rotary:
        q_rope = rope_2d(q_rope)
    return jnp.concatenate([q_nope, q_rope], -1)


def mla_kv(ckv, k_rope, g_kv, w_ukv, rotary):
    kv = heads(rms_norm(ckv, g_kv) @ w_ukv, MLA_HEADS)
    k_nope, v = kv[..., :MLA_NOPE], kv[..., MLA_NOPE:]
    kr = k_rope[:, :, None, :]
    if rotary:
        kr = rope_2d(kr)
    k = jnp.concatenate([k_nope, jnp.broadcast_to(kr, k_nope.shape[:-1] + (MLA_ROPE,))], -1)
    return k, v


def mla_attention(q, k, v, kc, vc):
    B, T, H, dqk = q.shape
    nb = T // MLA_BLOCK
    scale = dqk ** -0.5
    k_all = jnp.concatenate([k, kc], axis=1)
    v_all = jnp.concatenate([v, vc], axis=1)
    qb = q.reshape(B, nb, MLA_BLOCK, H, dqk).transpose(1, 0, 2, 3, 4)

    def one_block(q_blk):
        s = jnp.einsum('bqhd,bkhd->bhqk', q_blk, k_all).astype(jnp.float32) * scale
        p = jax.nn.softmax(s, axis=-1).astype(v.dtype)
        return jnp.einsum('bhqk,bkhd->bqhd', p, v_all)

    o = lax.map(one_block, qb)
    return o.transpose(1, 0, 2, 3, 4).reshape(B, T, H * v.shape[-1])


def gla_chunked(q, k, v, g, s0, with_output):
    B, H, T, dk = q.shape
    n = T // GLA_CHUNK

    def ch(a):
        return a.reshape(B, H, n, GLA_CHUNK, a.shape[-1])

    q, k, v, g = ch(q), ch(k), ch(v), ch(g)
    b = jnp.cumsum(g, axis=3)
    b_end = b[:, :, :, -1]
    u = jnp.einsum('bhnck,bhncv->bhnkv', k * jnp.exp(b_end[:, :, :, None] - b), v)

    def step(s, inp):
        dec, du = inp
        return s * dec[..., None] + du, s

    s_final, s_before = lax.scan(step, s0, (jnp.moveaxis(jnp.exp(b_end), 2, 0), jnp.moveaxis(u, 2, 0)))
    if not with_output:
        return None, s_final
    s_before = jnp.moveaxis(s_before, 0, 2)
    q_dec = q * jnp.exp(b)
    att = jnp.einsum('bhnik,bhnjk->bhnij', q_dec, k * jnp.exp(-b))
    att = jnp.where(jnp.tril(jnp.ones((GLA_CHUNK, GLA_CHUNK), dtype=bool)), att, 0.0)
    o = jnp.einsum('bhnij,bhnjv->bhniv', att, v) + jnp.einsum('bhnik,bhnkv->bhniv', q_dec, s_before)
    return o.reshape(B, H, T, v.shape[-1]), s_final


def gla_mixer(lat, ctx, w_gf, b_gf, w_gb, b_gb, g_norm, ctx_out):
    def prep(q, k, v, zf, zb):
        def f(a, dh):
            return heads(a, GLA_HEADS).transpose(0, 2, 1, 3).astype(jnp.float32)
        gf = jax.nn.log_sigmoid(zf @ w_gf + b_gf) / GLA_GATE_NORM
        gb = jax.nn.log_sigmoid(zb @ w_gb + b_gb) / GLA_GATE_NORM
        return f(q, GLA_DK) * GLA_DK ** -0.5, f(k, GLA_DK), f(v, GLA_DV), f(gf, GLA_DK), f(gb, GLA_DK)

    q, k, v, gf, gb = prep(lat[0], lat[1], lat[2], lat[4], lat[5])
    qc, kc, vc, gfc, gbc = prep(ctx[0], ctx[1], ctx[2], ctx[4], ctx[5])
    B = q.shape[0]
    s0 = jnp.zeros((B, GLA_HEADS, GLA_DK, GLA_DV), jnp.float32)

    def flip(a):
        return jnp.flip(a, axis=2)

    oc_f, sc_f = gla_chunked(qc, kc, vc, gfc, s0, ctx_out)
    oc_b, sc_b = gla_chunked(flip(qc), flip(kc), flip(vc), flip(gbc), s0, ctx_out)
    o_f, _ = gla_chunked(q, k, v, gf, sc_f, True)
    o_b, _ = gla_chunked(flip(q), flip(k), flip(v), flip(gb), sc_b, True)

    def finish(of, ob, r):
        o = rms_norm((of + flip(ob)).transpose(0, 2, 1, 3), g_norm).astype(r.dtype)
        return o.reshape(r.shape[:-1] + (-1,)) * jax.nn.silu(r)

    o_lat = finish(o_f, o_b, lat[3])
    o_ctx = finish(oc_f, oc_b, ctx[3]) if ctx_out else None
    return o_lat, o_ctx


def moe_ffn(h, router_w, router_bias, w1, w3, w2, sw1, sw3, sw2):
    N, D = h.shape
    E = w1.shape[0]
    scores = jax.nn.sigmoid((h @ router_w).astype(jnp.float32))
    _, sel = lax.top_k(scores + router_bias.astype(jnp.float32), TOP_K)
    s_sel = jnp.take_along_axis(scores, sel, axis=-1)
    gates = ROUTED_SCALE * s_sel / jnp.sum(s_sel, -1, keepdims=True)
    e_flat = sel.reshape(-1)
    tok_flat = jnp.repeat(jnp.arange(N, dtype=jnp.int32), TOP_K)
    g_flat = gates.reshape(-1).astype(h.dtype)
    order = jnp.argsort(e_flat)
    e_s, tok_s, g_s = e_flat[order], tok_flat[order], g_flat[order]
    counts = jnp.bincount(e_flat, length=E)
    padded = (counts + MOE_BLOCK - 1) // MOE_BLOCK * MOE_BLOCK
    pad_end = jnp.cumsum(padded)
    pad_start = pad_end - padded
    grp_start = jnp.cumsum(counts) - counts
    dest = pad_start[e_s] + jnp.arange(e_s.shape[0]) - grp_start[e_s]
    n_blocks = -(-(N * TOP_K) // MOE_BLOCK) + E
    buf_tok = jnp.full((n_blocks * MOE_BLOCK,), N, jnp.int32).at[dest].set(tok_s)
    buf_gate = jnp.zeros((n_blocks * MOE_BLOCK,), h.dtype).at[dest].set(g_s)
    blk_exp = jnp.minimum(jnp.searchsorted(pad_end, jnp.arange(n_blocks) * MOE_BLOCK, side='right'), E - 1)
    h_pad = jnp.concatenate([h, jnp.zeros((1, D), h.dtype)], 0)

    def expert_block(acc, inp):
        e, tok, g = inp
        xb = h_pad[tok]
        y = (jax.nn.silu(xb @ w1[e]) * (xb @ w3[e])) @ w2[e]
        return acc.at[tok].add(y * g[:, None]), None

    acc, _ = lax.scan(expert_block, jnp.zeros((N + 1, D), h.dtype),
                      (blk_exp, buf_tok.reshape(n_blocks, MOE_BLOCK), buf_gate.reshape(n_blocks, MOE_BLOCK)))
    shared = (jax.nn.silu(h @ sw1) * (h @ sw3)) @ sw2
    return acc[:N] + shared


def setup_inputs(seed: int = 0) -> dict:
    key = jax.random.key(seed)
    keys = iter(jax.random.split(key, 40))

    def nrm(shape, scale):
        return scale * jax.random.normal(next(keys), shape, jnp.float32)

    L, D, E, F = DEPTH, D_MODEL, N_EXPERTS, D_EXPERT
    return {
        'x': nrm((BATCH, SEQ, D), 1.0),
        'c': nrm((BATCH, D), 1.0),
        'ctx': nrm((BATCH, CTX_LEN, D), 1.0),
        'c_ctx': nrm((D,), 1.0),
        'w_ada': nrm((L, D, 6 * D), 0.5 * D ** -0.5),
        'b_ada': nrm((L, 6 * D), 0.02),
        'w_in': nrm((L, D, IN_WIDTH), D ** -0.5),
        'na_rpb': nrm((L, NA_HEADS, 2 * NA_KH - 1, 2 * NA_KW - 1), 0.3),
        'wa_sink': nrm((L, WA_HEADS), 1.0),
        'mla_g_q': 1.0 + nrm((L, MLA_Q_RANK), 0.02),
        'mla_g_kv': 1.0 + nrm((L, MLA_KV_RANK), 0.02),
        'mla_w_uq': nrm((L, MLA_Q_RANK, MLA_HEADS * (MLA_NOPE + MLA_ROPE)), MLA_Q_RANK ** -0.5),
        'mla_w_ukv': nrm((L, MLA_KV_RANK, MLA_HEADS * (MLA_NOPE + MLA_V)), MLA_KV_RANK ** -0.5),
        'gla_w_gf': nrm((L, GLA_GATE_RANK, GLA_HEADS * GLA_DK), GLA_GATE_RANK ** -0.5),
        'gla_b_gf': nrm((L, GLA_HEADS * GLA_DK), 0.5),
        'gla_w_gb': nrm((L, GLA_GATE_RANK, GLA_HEADS * GLA_DK), GLA_GATE_RANK ** -0.5),
        'gla_b_gb': nrm((L, GLA_HEADS * GLA_DK), 0.5),
        'gla_g_norm': 1.0 + nrm((L, GLA_DV), 0.02),
        'w_out': nrm((L, MIX_WIDTH, D), DEEPNORM_BETA * MIX_WIDTH ** -0.5),
        'ln1_g': 1.0 + nrm((L, D), 0.02),
        'ln1_b': nrm((L, D), 0.02),
        'ln2_g': 1.0 + nrm((L, D), 0.02),
        'ln2_b': nrm((L, D), 0.02),
        'router_w': nrm((L, D, E), D ** -0.5),
        'router_bias': nrm((L, E), 0.01),
        'exp_w1': nrm((L, E, D, F), D ** -0.5),
        'exp_w3': nrm((L, E, D, F), D ** -0.5),
        'exp_w2': nrm((L, E, F, D), DEEPNORM_BETA * F ** -0.5),
        'sh_w1': nrm((L, D, D_SHARED), D ** -0.5),
        'sh_w3': nrm((L, D, D_SHARED), D ** -0.5),
        'sh_w2': nrm((L, D_SHARED, D), DEEPNORM_BETA * D_SHARED ** -0.5),
    }


def reference(x, c, ctx, c_ctx, w_ada, b_ada, w_in, na_rpb, wa_sink, mla_g_q, mla_g_kv, mla_w_uq, mla_w_ukv,
              gla_w_gf, gla_b_gf, gla_w_gb, gla_b_gb, gla_g_norm, w_out, ln1_g, ln1_b, ln2_g, ln2_b,
              router_w, router_bias, exp_w1, exp_w3, exp_w2, sh_w1, sh_w3, sh_w2):
    B, T, D = x.shape
    C = ctx.shape[1]
    offs = np.cumsum(IN_SIZES)[:-1].tolist()
    grp = WA_HEADS // WA_KV_HEADS
    xc = ctx
    for l in range(DEPTH):
        last = l == DEPTH - 1
        mod = jnp.split((jax.nn.silu(c) @ w_ada[l] + b_ada[l])[:, None, :], 6, axis=-1)
        mod_c = jnp.split(jax.nn.silu(c_ctx) @ w_ada[l] + b_ada[l], 6, axis=-1)
        h = modulate(x, mod[0], mod[1])
        hc = modulate(xc, mod_c[0], mod_c[1])
        P = jnp.split(h @ w_in[l], offs, axis=-1)
        Pc = jnp.split(hc @ w_in[l], offs, axis=-1)

        kc_a, vc_a = heads(Pc[1], NA_HEADS), heads(Pc[2], NA_HEADS)
        o_a = neighbourhood_attention(heads(P[0], NA_HEADS), heads(P[1], NA_HEADS), heads(P[2], NA_HEADS),
                                      kc_a, vc_a, na_rpb[l])
        kc_b, vc_b = heads(Pc[4], WA_KV_HEADS), heads(Pc[5], WA_KV_HEADS)
        o_b = window_attention(rope_2d(heads(P[3], WA_HEADS)), rope_2d(heads(P[4], WA_KV_HEADS)),
                               heads(P[5], WA_KV_HEADS), kc_b, vc_b, wa_sink[l])
        k_c, v_c = mla_kv(P[7], P[8], mla_g_kv[l], mla_w_ukv[l], True)
        kc_c, vc_c = mla_kv(Pc[7], Pc[8], mla_g_kv[l], mla_w_ukv[l], False)
        o_c = mla_attention(mla_q(P[6], mla_g_q[l], mla_w_uq[l], True), k_c, v_c, kc_c, vc_c)
        o_d, oc_d = gla_mixer(P[9:15], Pc[9:15], gla_w_gf[l], gla_b_gf[l], gla_w_gb[l], gla_b_gb[l],
                              gla_g_norm[l], not last)

        o = jnp.concatenate([o_a, o_b, o_c, o_d], -1) @ w_out[l]
        x = post_norm(DEEPNORM_ALPHA * x + mod[2] * o, ln1_g[l], ln1_b[l])
        if not last:
            oc = jnp.concatenate([
                context_attention(heads(Pc[0], NA_HEADS), kc_a, vc_a),
                context_attention(heads(Pc[3], WA_HEADS), jnp.repeat(kc_b, grp, axis=2),
                                  jnp.repeat(vc_b, grp, axis=2), wa_sink[l]),
                context_attention(mla_q(Pc[6], mla_g_q[l], mla_w_uq[l], False), kc_c, vc_c),
                oc_d], -1) @ w_out[l]
            xc = post_norm(DEEPNORM_ALPHA * xc + mod_c[2] * oc, ln1_g[l], ln1_b[l])

        h = modulate(x, mod[3], mod[4])
        moe_w = (router_w[l], router_bias[l], exp_w1[l], exp_w3[l], exp_w2[l], sh_w1[l], sh_w3[l], sh_w2[l])
        if last:
            f = moe_ffn(h.reshape(B * T, D), *moe_w).reshape(B, T, D)
        else:
            hc = modulate(xc, mod_c[3], mod_c[4])
            f_all = moe_ffn(jnp.concatenate([h.reshape(B * T, D), hc.reshape(B * C, D)], 0), *moe_w)
            f = f_all[:B * T].reshape(B, T, D)
            xc = post_norm(DEEPNORM_ALPHA * xc + mod_c[5] * f_all[B * T:].reshape(B, C, D), ln2_g[l], ln2_b[l])
        x = post_norm(DEEPNORM_ALPHA * x + mod[5] * f, ln2_g[l], ln2_b[l])
    return x
```

```cpp
#include <hip/hip_runtime.h>
#include <cstdio>
#include <cstdint>

#define GAS __attribute__((address_space(1)))
#define LAS __attribute__((address_space(3)))
typedef unsigned short bf16;
typedef unsigned v4u __attribute__((ext_vector_type(4)));
typedef unsigned v2u __attribute__((ext_vector_type(2)));
typedef float f32x4 __attribute__((ext_vector_type(4)));
typedef float f32x2 __attribute__((ext_vector_type(2)));
typedef float f32x16 __attribute__((ext_vector_type(16)));
typedef short bf16x8 __attribute__((ext_vector_type(8)));
typedef short s16x4 __attribute__((ext_vector_type(4)));
typedef GAS unsigned gu32;
#define RLX_AGENT __ATOMIC_RELAXED, __HIP_MEMORY_SCOPE_AGENT
#define LDS_WAIT() asm volatile("s_waitcnt lgkmcnt(0)" ::: "memory")
#define VM_WAIT() asm volatile("s_waitcnt vmcnt(0)" ::: "memory")

constexpr int NB = 4, SEQ = 8192, CTXL = 256, DM = 1024, DEPTH = 4;
constexpr int NLAT = NB * SEQ, NCTX = NB * CTXL, NTOK = NLAT + NCTX;
constexpr int INW = 2496, INWP = 2560;
constexpr int A_Q = 0, A_K = 256, A_V = 512, B_Q = 768, B_K = 1024, B_V = 1152, C_Q = 1280, C_KV = 1536, C_KR = 1664,
              D_Q = 1696, D_K = 1824, D_V = 1952, D_R = 2208, D_ZF = 2464, D_ZB = 2480;
constexpr int NEXP = 128, TOPK = 8, DEXP = 256;
constexpr int NSLOT_MAX = NTOK * TOPK + NEXP * 256;
constexpr int NCH = 132;
constexpr float LN_EPS = 1e-5f, RMS_EPS = 1e-6f;
constexpr float DN_ALPHA = 1.6817928305074290f;
constexpr float LOG2E = 1.4426950408889634f;
constexpr float C2 = 0.125f * LOG2E;

#ifndef ROUTER_SPLIT
#define ROUTER_SPLIT 1
#endif
constexpr int HLD = ROUTER_SPLIT ? 2 * DM : DM;
constexpr size_t al256(size_t x) { return (x + 255) & ~(size_t)255; }
constexpr size_t WS_CTL = 0, CTL_ZERO_BYTES = 1u << 20;
constexpr size_t WS_MOD = CTL_ZERO_BYTES;
constexpr size_t WS_WIN = al256(WS_MOD + (size_t)DEPTH * 5 * 6 * DM * 4);
constexpr size_t WS_WOUT = WS_WIN + (size_t)DEPTH * INWP * DM * 2;
constexpr size_t WS_WUQ = WS_WOUT + (size_t)DEPTH * DM * DM * 2;
constexpr size_t WS_WUKV = WS_WUQ + (size_t)DEPTH * 256 * 256 * 2;
constexpr size_t WS_WRT = WS_WUKV + (size_t)DEPTH * 512 * 128 * 2;
constexpr size_t WS_WS13 = WS_WRT + (size_t)DEPTH * 256 * HLD * 2;
constexpr size_t WS_WS2 = WS_WS13 + (size_t)DEPTH * 512 * DM * 2;
constexpr size_t WS_WE13 = WS_WS2 + (size_t)DEPTH * DM * 256 * 2;
constexpr size_t WS_WE2 = WS_WE13 + (size_t)NEXP * 512 * DM * 2;
constexpr size_t WS_XA = WS_WE2 + (size_t)NEXP * DM * 256 * 2;
constexpr size_t WS_Z = WS_XA + (size_t)NTOK * DM * 4;
constexpr size_t WS_H = WS_Z + (size_t)NTOK * DM * 4;
constexpr size_t WS_P = WS_H + (size_t)NTOK * HLD * 2;
constexpr size_t WS_QC = WS_P + (size_t)NTOK * INWP * 2;
constexpr size_t WS_KC = WS_QC + (size_t)NTOK * 256 * 2;
constexpr size_t WS_VC = WS_KC + (size_t)NTOK * 256 * 2;
constexpr size_t WS_CAT = WS_VC + (size_t)NTOK * 256 * 2;
constexpr size_t WS_GU = WS_CAT + (size_t)NTOK * DM * 2;
constexpr size_t WS_GDEC = WS_GU + (size_t)32 * NCH * 2048 * 4;
constexpr size_t WS_RSTD = WS_GDEC + (size_t)32 * NCH * 32 * 4;
constexpr size_t WS_LOG = al256(WS_RSTD + (size_t)NTOK * 2 * 4);
constexpr size_t WS_SEL = WS_LOG + (size_t)NTOK * 128 * 4;
constexpr size_t WS_GATE = WS_SEL + (size_t)NTOK * 8 * 4;
constexpr size_t WS_RANK = WS_GATE + (size_t)NTOK * 8 * 4;
constexpr size_t WS_TSLOT = WS_RANK + (size_t)NTOK * 8 * 4;
constexpr size_t WS_BBASE = WS_TSLOT + (size_t)NTOK * 8 * 4;
constexpr size_t WS_STOK = WS_BBASE + (size_t)256 * 128 * 4;
constexpr size_t WS_SGATE = al256(WS_STOK + (size_t)NSLOT_MAX * 4);
constexpr size_t WS_TEXP = al256(WS_SGATE + (size_t)NSLOT_MAX * 4);
constexpr size_t WS_HS = WS_TEXP + 2048 * 4;
constexpr size_t WS_HSS = WS_HS + (size_t)NSLOT_MAX * 256 * 2;
constexpr size_t WS_Y = WS_HSS + (size_t)NTOK * 256 * 2;
constexpr size_t WS_YS = WS_Y + (size_t)NSLOT_MAX * DM * 2;
constexpr size_t WS_BC = WS_YS + (size_t)NTOK * DM * 2;
constexpr size_t WS_END = WS_BC + (size_t)NTOK * 256 * 4;
static_assert(WS_END <= (size_t)2147483648u, "d_ws map must fit 2 GiB");
constexpr int CW_BAR = 4096;
constexpr int CW_CNT = 16384;

constexpr int LDS_BYTES = 147456;
constexpr int MISC_OFF = LDS_BYTES - 512;
constexpr int SCR_BYTES = MISC_OFF;

__device__ __forceinline__ unsigned f2bf(float f) { unsigned u = __builtin_bit_cast(unsigned, f); return (u + 0x7fffu + ((u >> 16) & 1u)) >> 16; }
__device__ __forceinline__ unsigned pk2(float lo, float hi) { return f2bf(lo) | (f2bf(hi) << 16); }
__device__ __forceinline__ float bf2f(unsigned short b) { return __builtin_bit_cast(float, (unsigned)b << 16); }
__device__ __forceinline__ float bflo(unsigned w) { return __builtin_bit_cast(float, w << 16); }
__device__ __forceinline__ float bfhi(unsigned w) { return __builtin_bit_cast(float, w & 0xffff0000u); }
typedef __bf16 bf16x2_t __attribute__((ext_vector_type(2)));
__device__ __forceinline__ unsigned cvtpk(float lo, float hi) { f32x2 v = {lo, hi}; bf16x2_t b = __builtin_convertvector(v, bf16x2_t); return __builtin_bit_cast(unsigned, b); }
__device__ __forceinline__ float wave_sum(float v) {
#pragma unroll
    for (int o = 1; o < 64; o <<= 1) v += __shfl_xor(v, o);
    return v;
}
__device__ __forceinline__ float fsilu(float a) { return a * __builtin_amdgcn_rcpf(1.0f + __builtin_amdgcn_exp2f(-a * LOG2E)); }
namespace pg8 {
typedef unsigned short bf16_t;
constexpr int BM = 256, BK = 64, HALF = 128, HTB = HALF * BK * 2  , STAGE_BYTES = 8 * HTB, NXCD = 8, WGM = 8;

__host__ __device__ __forceinline__ int lds_byte(int r, int c) { const int st = (r >> 4) * 2 + (c >> 5), rr = r & 15, cc = c & 31, ob = rr * 64 + cc * 2; return st * 1024 + (ob ^ (((ob >> 9) & 1) << 5)); }
__host__ __device__ __forceinline__ void stage_rc(int b, int& R, int& C) { const int st = b / 1024, sb = b % 1024, swz = sb ^ (((sb >> 9) & 1) << 5); R = (st >> 1) * 16 + swz / 64; C = (st & 1) * 32 + (swz % 64) / 2; }
__host__ __device__ __forceinline__ int perm32(int rho) { const int n = rho >> 4, i = rho & 15; return 8 * (i >> 2) + 4 * n + (i & 3); }

struct Unit { int pm, pn; };
struct Gemm { const bf16_t* A; const bf16_t* Bt; int K; int lda; const int* rowidx; };

struct StaticOrder {
    int nM, nN, nwg, G, c;
    __device__ void init(int M, int N, int G_, int c_) { nM = M / BM; nN = N / BM; nwg = nM * nN; G = G_; c = c_; }
    __device__ bool next(int i, Unit& u) const {
        const long L = (long)i * G + c; if (L >= nwg) return false;
        int wgid = (int)L; { const int q = nwg / NXCD, r = nwg % NXCD, xcd = wgid % NXCD, off = wgid / NXCD; wgid = (xcd < r ? xcd * (q + 1) : r * (q + 1) + (xcd - r) * q) + off; }
        const int nig = WGM * nN, gid = wgid / nig, fm = gid * WGM, gsz = (nM - fm) < WGM ? (nM - fm) : WGM;
        u.pm = fm + ((wgid % nig) % gsz); u.pn = (wgid % nig) / gsz; return true;
    }
};
struct AfterRouterOrder {
    int nR, G, c;
    __device__ void init(int M, int G_, int c_) { nR = M / BM; G = G_; c = c_; }
    __device__ bool next(int i, Unit& u) const {
        const int nidle = G - nR; int L;
        if (nidle <= 0 || 2 * nR - 2 * nidle > nR) { L = i * G + c; if (L >= 2 * nR) return false; }
        else if (c >= nR) { if (i >= 2) return false; L = 2 * (c - nR) + i; if (L >= 2 * nR) return false; }
        else { if (i >= 1) return false; L = 2 * nidle + c; if (L >= 2 * nR) return false; }
        u.pm = L >> 1; u.pn = L & 1; return true;
    }
};
struct GroupedOrder {
    const int* texp; int nN, G, c, ntile;
    __device__ void init(const int* texp_, int ntile_, int nN_, int G_, int c_) { texp = texp_; nN = nN_; G = G_; c = c_; ntile = ntile_; }
    __device__ bool next(int i, Unit& u) const {
        const long L = (long)i * G + c; if (L >= (long)ntile * nN) return false;
        const int mt = (int)(L / nN), nt = (int)(L % nN); u.pm = mt; u.pn = __builtin_amdgcn_readfirstlane(texp[mt]) * nN + nt; return true;
    }
};

template <class Epi, class Sched, bool GATHER, bool ALIGN_EPI = true>
__device__ __forceinline__ void gemm_phase(LAS unsigned char* lds, const Gemm g, const Sched& S, const Epi& E) {
    int tid_ = threadIdx.x; asm volatile("" : "+v"(tid_));
    const int tid = tid_, wid = __builtin_amdgcn_readfirstlane(tid >> 6), lane = tid & 63, wr = wid >> 2, wc = wid & 3, fr = lane & 15, fq = lane >> 4;
    const int K = g.K, nt = K / BK;
    unsigned voffB[2], voffA[2]; int RA[2]; unsigned CA2[2];
#pragma unroll
    for (int i = 0; i < 2; ++i) { int R, C; stage_rc(tid * 16 + i * 8192, R, C); const int Rb = Epi::PERM ? ((R & ~31) + perm32(R & 31)) : R;
        RA[i] = R; CA2[i] = (unsigned)C * 2u; voffB[i] = (unsigned)(Rb * K + C) * 2u; voffA[i] = (unsigned)(R * g.lda + C) * 2u; }
    const size_t hstepA = (size_t)HALF * g.lda * 2;
    const size_t kstep = (size_t)(BK * 2);
    const size_t hstep = (size_t)HALF * K * 2;
    const size_t tstep = 2 * hstep;
    const size_t tstepA = (size_t)BM * g.lda * 2;
    const unsigned ldsw = (unsigned)wid * 1024u;
    const int aoff = lds_byte(wr * 64 + fr, fq * 8), boff = lds_byte(wc * 32 + fr, fq * 8);
#define PG8_SA(b, h) (((b) * 2 + (h)) * HTB)
#define PG8_SB(b, h) ((4 + (b) * 2 + (h)) * HTB)
#define PG8_STAGE(bufoff, gbase, voff) do { _Pragma("unroll") for (int _i = 0; _i < 2; ++_i) \
        __builtin_amdgcn_global_load_lds((const unsigned*)((const char*)(gbase) + (voff)[_i]), (LAS unsigned*)(lds + (bufoff) + ldsw + _i * 8192), 16, 0, 0); } while (0)
#define PG8_LDA(dst, b, h) do { _Pragma("unroll") for (int m = 0; m < 4; ++m) _Pragma("unroll") for (int k = 0; k < 2; ++k) dst[m][k] = *(const LAS bf16x8*)(lds + PG8_SA(b, h) + aoff + m * 2048 + k * 1024); } while (0)
#define PG8_LDB(dst, b, h) do { _Pragma("unroll") for (int n = 0; n < 2; ++n) _Pragma("unroll") for (int k = 0; k < 2; ++k) dst[n][k] = *(const LAS bf16x8*)(lds + PG8_SB(b, h) + boff + n * 2048 + k * 1024); } while (0)
#define PG8_MMA(ai, bj, At, Bt) do { __builtin_amdgcn_s_setprio(1); _Pragma("unroll") for (int m = 0; m < 4; ++m) _Pragma("unroll") for (int n = 0; n < 2; ++n) _Pragma("unroll") for (int k = 0; k < 2; ++k) \
        acc[ai][bj][m][n] = __builtin_amdgcn_mfma_f32_16x16x32_bf16(Bt[n][k], At[m][k], acc[ai][bj][m][n], 0, 0, 0); __builtin_amdgcn_s_setprio(0); } while (0)
#define PG8_WAIT_V(n) asm volatile("s_waitcnt vmcnt(" #n ")" ::: "memory")
#define PG8_WAIT_L(n) asm volatile("s_waitcnt lgkmcnt(" #n ")" ::: "memory")
#define PG8_BAR __builtin_amdgcn_s_barrier()
#define PG8_SCHED __builtin_amdgcn_sched_barrier(0)
#define PG8_AOFF(dst, u) do { if constexpr (GATHER) { _Pragma("unroll") for (int _h = 0; _h < 2; ++_h) _Pragma("unroll") for (int _i = 0; _i < 2; ++_i) \
        dst[_h][_i] = (unsigned)g.rowidx[(u).pm * BM + _h * HALF + RA[_i]] * (unsigned)(g.lda * 2) + CA2[_i]; } } while (0)
#define PG8_STAGE_A(bufoff, gbase, h, useN) do { if constexpr (GATHER) { unsigned _o[2]; _o[0] = (useN) ? offN[h][0] : offC[h][0]; _o[1] = (useN) ? offN[h][1] : offC[h][1]; PG8_STAGE(bufoff, gbase, _o); } \
        else { PG8_STAGE(bufoff, (gbase) + (h) * hstepA, voffA); } } while (0)
    Unit cur, nxt; int ui = 0;
    if (!S.next(0, cur)) return;
    f32x4 acc[2][2][4][2];
#pragma unroll
    for (int a = 0; a < 2; ++a)
#pragma unroll
        for (int b = 0; b < 2; ++b)
#pragma unroll
            for (int m = 0; m < 4; ++m)
#pragma unroll
                for (int n = 0; n < 2; ++n) acc[a][b][m][n] = (f32x4){0.f, 0.f, 0.f, 0.f};
    bf16x8 At[4][2], B0[2][2], B1[2][2];
    unsigned offC[2][2], offN[2][2];
    PG8_AOFF(offC, cur);
    const char* cA = GATHER ? (const char*)g.A : (const char*)g.A + (size_t)cur.pm * tstepA; const char* cB = (const char*)g.Bt + (size_t)cur.pn * tstep;
    PG8_STAGE(PG8_SB(0, 0), cB, voffB); PG8_STAGE(PG8_SB(0, 1), cB + hstep, voffB); PG8_STAGE_A(PG8_SA(0, 0), cA, 0, false); PG8_STAGE_A(PG8_SA(0, 1), cA, 1, false);
    if (wr == 1) PG8_BAR;
    PG8_WAIT_V(2); PG8_BAR;
    PG8_STAGE(PG8_SB(1, 0), cB + kstep, voffB); PG8_STAGE_A(PG8_SA(1, 0), cA + kstep, 0, false); PG8_STAGE(PG8_SB(1, 1), cB + hstep + kstep, voffB);
    PG8_WAIT_V(6); PG8_BAR;
    for (;;) {
        const bool has_next = S.next(ui + 1, nxt);
        if constexpr (GATHER) { if (has_next) { PG8_AOFF(offN, nxt); } else {
#pragma unroll
            for (int h = 0; h < 2; ++h)
#pragma unroll
                for (int i = 0; i < 2; ++i) offN[h][i] = offC[h][i]; } }
        const char* nA = has_next ? (GATHER ? (const char*)g.A : (const char*)g.A + (size_t)nxt.pm * tstepA) : cA; const char* nB = has_next ? (const char*)g.Bt + (size_t)nxt.pn * tstep : cB;
#pragma unroll 1
        for (int t = 0; t < nt; t += 2) {
            const bool last = (t == nt - 2);
            const char* a1 = cA + (size_t)(t + 1) * kstep;
            const char* a2 = last ? nA : cA + (size_t)(t + 2) * kstep; const char* b2 = last ? nB : cB + (size_t)(t + 2) * kstep;
            const char* a3 = a2 + kstep; const char* b3 = b2 + kstep;
            PG8_LDB(B0, 0, 0); PG8_LDB(B1, 0, 1); PG8_SCHED; PG8_LDA(At, 0, 0); PG8_STAGE_A(PG8_SA(1, 1), a1, 1, false);
            PG8_WAIT_V(8); PG8_WAIT_L(0); PG8_BAR; PG8_MMA(0, 0, At, B0); PG8_MMA(0, 1, At, B1); PG8_BAR; PG8_SCHED;
            PG8_LDA(At, 0, 1); PG8_STAGE(PG8_SB(0, 0), b2, voffB); PG8_STAGE(PG8_SB(0, 1), b2 + hstep, voffB); PG8_STAGE_A(PG8_SA(0, 0), a2, 0, last);
            PG8_WAIT_V(8); PG8_WAIT_L(0); PG8_BAR; PG8_MMA(1, 0, At, B0); PG8_MMA(1, 1, At, B1); PG8_BAR; PG8_SCHED;
            PG8_LDB(B0, 1, 0); PG8_LDB(B1, 1, 1); PG8_SCHED; PG8_LDA(At, 1, 0); PG8_STAGE_A(PG8_SA(0, 1), a2, 1, last);
            PG8_WAIT_V(8); PG8_WAIT_L(0); PG8_BAR; PG8_MMA(0, 0, At, B0); PG8_MMA(0, 1, At, B1); PG8_BAR; PG8_SCHED;
            PG8_LDA(At, 1, 1); PG8_STAGE(PG8_SB(1, 0), b3, voffB); PG8_STAGE(PG8_SB(1, 1), b3 + hstep, voffB); PG8_STAGE_A(PG8_SA(1, 0), a3, 0, last);
            PG8_WAIT_V(8); PG8_WAIT_L(0); PG8_BAR; PG8_MMA(1, 0, At, B0); PG8_MMA(1, 1, At, B1); PG8_BAR; PG8_SCHED;
        }
        if constexpr (ALIGN_EPI) { if (wr == 0) PG8_BAR; }
        E(acc, cur, wr, wc, fr, fq);
        if (!has_next) break;
#pragma unroll
        for (int a = 0; a < 2; ++a)
#pragma unroll
            for (int b = 0; b < 2; ++b)
#pragma unroll
                for (int m = 0; m < 4; ++m)
#pragma unroll
                    for (int n = 0; n < 2; ++n) acc[a][b][m][n] = (f32x4){0.f, 0.f, 0.f, 0.f};
        cur = nxt; cA = nA; cB = nB; ++ui;
        if constexpr (GATHER) {
#pragma unroll
            for (int h = 0; h < 2; ++h)
#pragma unroll
                for (int i = 0; i < 2; ++i) offC[h][i] = offN[h][i]; }
        if constexpr (ALIGN_EPI) { if (wr == 1) PG8_BAR; }
    }
    PG8_WAIT_V(0);
    if constexpr (!ALIGN_EPI) { if (wr == 0) PG8_BAR; }
    PG8_BAR;
#undef PG8_SA
#undef PG8_SB
#undef PG8_STAGE
#undef PG8_LDA
#undef PG8_LDB
#undef PG8_MMA
#undef PG8_WAIT_V
#undef PG8_WAIT_L
#undef PG8_BAR
#undef PG8_SCHED
#undef PG8_AOFF
#undef PG8_STAGE_A
}
}
namespace pg8 {
__device__ __forceinline__ unsigned cvt_pk_bf16(float lo, float hi) { unsigned r; asm volatile("v_cvt_pk_bf16_f32 %0, %1, %2" : "=v"(r) : "v"(lo), "v"(hi)); return r; }
template <int LDC, bool ROWSCALE, bool SKIPROPE = false> struct EpiBf16 {
    static constexpr bool PERM = true;
    bf16_t* O; int nloc; unsigned scmask; float sc; size_t tile_stride; const float* rowscale; int rs_off;
    __device__ __forceinline__ void operator()(const f32x4 (&acc)[2][2][4][2], const Unit& u, int wr, int wc, int fr, int fq) const {
        const int pnl = u.pn % nloc; const int row0 = u.pm * BM + wr * 64 + fr;
        bf16_t* p0 = O + (size_t)pnl * tile_stride + (size_t)row0 * LDC + wc * 32 + 8 * fq;
        const float s = ((scmask >> pnl) & 1u) ? sc : 1.f;
        if (SKIPROPE && pnl == 0 && (wc & 1)) return;
#pragma unroll
        for (int ai = 0; ai < 2; ++ai)
#pragma unroll
            for (int m = 0; m < 4; ++m) { bf16_t* rowp = p0 + (size_t)(ai * HALF + m * 16) * LDC;
                float rsc = s; if constexpr (ROWSCALE) rsc *= rowscale[2 * (row0 + ai * HALF + m * 16) + rs_off];
#pragma unroll
                for (int bj = 0; bj < 2; ++bj) { const f32x4 v0 = acc[ai][bj][m][0] * rsc, v1 = acc[ai][bj][m][1] * rsc;
                    v4u w; w.x = cvt_pk_bf16(v0[0], v0[1]); w.y = cvt_pk_bf16(v0[2], v0[3]); w.z = cvt_pk_bf16(v1[0], v1[1]); w.w = cvt_pk_bf16(v1[2], v1[3]);
                    *(v4u*)(rowp + bj * HALF) = w; } }
    }
};
struct EpiResid {
    static constexpr bool PERM = false;
    const float* X; float* Z; const float* modrow;
    __device__ __forceinline__ void operator()(const f32x4 (&acc)[2][2][4][2], const Unit& u, int wr, int wc, int fr, int fq) const {
        const int rowt = u.pm * BM; const int mr = rowt < NLAT ? (rowt >> 13) : 4;
        const float* gp = modrow + (size_t)mr * 6 * DM;
        const int col0 = u.pn * BM + wc * 32 + 4 * fq;
        f32x4 gv[2][2];
#pragma unroll
        for (int bj = 0; bj < 2; ++bj)
#pragma unroll
            for (int n = 0; n < 2; ++n) gv[bj][n] = *(const f32x4*)(gp + col0 + bj * HALF + n * 16);
#pragma unroll
        for (int ai = 0; ai < 2; ++ai)
#pragma unroll
            for (int m = 0; m < 4; ++m) { const size_t off = (size_t)(rowt + ai * HALF + wr * 64 + m * 16 + fr) * DM + col0;
#pragma unroll
                for (int bj = 0; bj < 2; ++bj)
#pragma unroll
                    for (int n = 0; n < 2; ++n) { const f32x4 xv = *(const f32x4*)(X + off + bj * HALF + n * 16);
                        *(f32x4*)(Z + off + bj * HALF + n * 16) = xv * DN_ALPHA + gv[bj][n] * acc[ai][bj][m][n]; } }
    }
};
struct EpiLogits {
    static constexpr bool PERM = false;
    float* O;
    __device__ __forceinline__ void operator()(const f32x4 (&acc)[2][2][4][2], const Unit& u, int wr, int wc, int fr, int fq) const {
        const int col0 = wc * 32 + 4 * fq;
#pragma unroll
        for (int ai = 0; ai < 2; ++ai)
#pragma unroll
            for (int m = 0; m < 4; ++m) { float* rowp = O + (size_t)(u.pm * BM + ai * HALF + wr * 64 + m * 16 + fr) * 128 + col0;
#pragma unroll
                for (int n = 0; n < 2; ++n) *(f32x4*)(rowp + n * 16) = acc[ai][0][m][n] + acc[ai][1][m][n]; }
    }
};
struct EpiSwiGLU {
    static constexpr bool PERM = true;
    bf16_t* O; int nloc; const float* gate;
    __device__ __forceinline__ void operator()(const f32x4 (&acc)[2][2][4][2], const Unit& u, int wr, int wc, int fr, int fq) const {
        const int pnl = u.pn % nloc; const int row0 = u.pm * BM + wr * 64 + fr; const int col0 = pnl * 128 + wc * 16 + 4 * fq;
#pragma unroll
        for (int ai = 0; ai < 2; ++ai)
#pragma unroll
            for (int m = 0; m < 4; ++m) { const int row = row0 + ai * HALF + m * 16; const float gt = gate ? gate[row] : 1.f; bf16_t* rowp = O + (size_t)row * 256 + col0;
#pragma unroll
                for (int bj = 0; bj < 2; ++bj) { const f32x4 a = acc[ai][bj][m][0], b = acc[ai][bj][m][1];
                    v2u w; w.x = cvt_pk_bf16(fsilu(a[0]) * b[0] * gt, fsilu(a[1]) * b[1] * gt); w.y = cvt_pk_bf16(fsilu(a[2]) * b[2] * gt, fsilu(a[3]) * b[3] * gt);
                    *(v2u*)(rowp + bj * 64) = w; } }
    }
};
}
#define XB_TMO      128
#define XB_XCNT(j)  (256  + 64 * (j))
#define XB_XSUB(j)  (1280 + 64 * (j))
#define XB_XGEN(j)  (2304 + 64 * (j))
#define XB_TOP      3328
#define XB_TOPGEN   3392
#define XCD_BAR_WORDS 3456
#define XB_SPIN_CAP (1u << 18)

__device__ __forceinline__ unsigned xb_ld(unsigned* p)              { return __hip_atomic_load(p, __ATOMIC_RELAXED, __HIP_MEMORY_SCOPE_AGENT); }
__device__ __forceinline__ unsigned xb_add(unsigned* p, unsigned v) { return __hip_atomic_fetch_add(p, v, __ATOMIC_RELAXED, __HIP_MEMORY_SCOPE_AGENT); }
__device__ __forceinline__ unsigned xb_xcc_id() { return (unsigned)__builtin_amdgcn_s_getreg((3 << 11) | 20) & 0xFu; }
#define XB_SPIN(cond, bar) do { unsigned _sp = 0; while (cond) { __builtin_amdgcn_s_sleep(1); \
    if ((++_sp & 255u) == 0u) { if (xb_ld(&(bar)[XB_TMO])) break; if (_sp > XB_SPIN_CAP) { atomicAdd(&(bar)[XB_TMO], 1u); break; } } } } while (0)

struct XcdBarrier {
    unsigned* bar; unsigned x;
    volatile LAS unsigned* st;
};

__device__ __forceinline__ XcdBarrier xcd_barrier_post(unsigned* bar, volatile LAS unsigned* st) {
    XcdBarrier b; b.bar = bar; b.x = xb_xcc_id(); b.st = st;
    if (threadIdx.x == 0) (void)xb_add(&bar[XB_XCNT(b.x)], 1u);
    return b;
}
__device__ __forceinline__ void xcd_barrier_complete(unsigned* bar, unsigned x, unsigned& nloc, unsigned& nx) {
    const unsigned G = gridDim.x * gridDim.y * gridDim.z;
    unsigned sum, cnt, mine, sp = 0u;
    for (;;) {
        sum = 0u; cnt = 0u; mine = 0u;
#pragma unroll
        for (unsigned j = 0; j < 16; ++j) { const unsigned c = xb_ld(&bar[XB_XCNT(j)]); sum += c; cnt += (c > 0u) ? 1u : 0u; mine = (j == x) ? c : mine; }
        if (sum == G) break;
        __builtin_amdgcn_s_sleep(1);
        if ((++sp & 255u) == 0u) { if (xb_ld(&bar[XB_TMO])) break; if (sp > XB_SPIN_CAP) { atomicAdd(&bar[XB_TMO], 1u); break; } }
    }
    nloc = mine > 0u ? mine : 1u; nx = cnt > 0u ? cnt : 1u;
}

__device__ __forceinline__ void xcd_barrier(const XcdBarrier& b) {
    asm volatile("s_waitcnt vmcnt(0)" ::: "memory");
    __syncthreads();
    if (threadIdx.x == 0) {
        unsigned* bar = b.bar;
        __builtin_amdgcn_s_waitcnt(0);
        unsigned nloc = b.st[0], nx = b.st[1];
        if (nloc == 0u) { xcd_barrier_complete(bar, b.x, nloc, nx); b.st[0] = nloc; b.st[1] = nx; }
        const unsigned old = xb_add(&bar[XB_XSUB(b.x)], 1u);
        const unsigned gen = old / nloc;
        if (old + 1u == (gen + 1u) * nloc) {
            __builtin_amdgcn_fence(__ATOMIC_RELEASE, "agent");
            asm volatile("s_waitcnt vmcnt(0)" ::: "memory");
            const unsigned og = xb_add(&bar[XB_TOP], 1u);
            const unsigned tg = og / nx;
            if (og + 1u == (tg + 1u) * nx) xb_add(&bar[XB_TOPGEN], 1u);
            else XB_SPIN(xb_ld(&bar[XB_TOPGEN]) == tg, bar);
            __builtin_amdgcn_fence(__ATOMIC_ACQUIRE, "agent");
            xb_add(&bar[XB_XGEN(b.x)], 1u);
            asm volatile("s_waitcnt vmcnt(0)" ::: "memory");
        } else {
            XB_SPIN(xb_ld(&bar[XB_XGEN(b.x)]) == gen, bar);
            __builtin_amdgcn_fence(__ATOMIC_ACQUIRE, "agent");
            asm volatile("s_waitcnt vmcnt(0)" ::: "memory");
        }
    }
    __syncthreads();
}
namespace att {
constexpr int NSLOT = 3, SLOTB = 8192;
constexpr int LDS_K = 0, LDS_V = NSLOT * SLOTB, LDS_WS = 2 * NSLOT * SLOTB, LDS_OST = LDS_WS + 8 * 64 * 4, LDS_BIAS = LDS_OST + 8 * 4096, LDS_END = LDS_BIAS + 2048;
enum { M_FULL = 0, M_NA = 1, M_WA = 2 };
__device__ __forceinline__ int crow(int r, int hi) { return (r & 3) + 8 * (r >> 2) + 4 * hi; }
__device__ __forceinline__ void glds16(const void* gsrc, unsigned lds_dst) { unsigned keep;
    asm volatile("s_mov_b32 %0, m0\n\ts_mov_b32 m0, %2\n\ts_nop 0\n\tglobal_load_lds_dwordx4 %1, off\n\ts_mov_b32 m0, %0" : "=&s"(keep) : "v"(gsrc), "s"(lds_dst) : "memory"); }
__device__ __forceinline__ void qkt(f32x16& p0, f32x16& p1, const char* Kslot, const bf16x8* qr, int r32, int hi) {
    const char* kb = Kslot + hi * 1024 + r32 * 16;
    const f32x16 z = {};
#pragma unroll
    for (int d0 = 0; d0 < 4; ++d0) {
        const bf16x8 b0 = *reinterpret_cast<const bf16x8*>(kb + d0 * 2048);
        const bf16x8 b1 = *reinterpret_cast<const bf16x8*>(kb + d0 * 2048 + 512);
        if (d0 == 0) { p0 = __builtin_amdgcn_mfma_f32_32x32x16_bf16(b0, qr[0], z, 0, 0, 0); p1 = __builtin_amdgcn_mfma_f32_32x32x16_bf16(b1, qr[0], z, 0, 0, 0); }
        else { p0 = __builtin_amdgcn_mfma_f32_32x32x16_bf16(b0, qr[d0], p0, 0, 0, 0); p1 = __builtin_amdgcn_mfma_f32_32x32x16_bf16(b1, qr[d0], p1, 0, 0, 0); } }
}
__device__ __forceinline__ void pv(f32x16* o, int vb, bf16x8 pa0, bf16x8 pa1, bf16x8 pa2, bf16x8 pa3) {
#pragma unroll
    for (int d0 = 0; d0 < 2; ++d0) { s16x4 lo[4], hi[4];
#pragma unroll
        for (int ks = 0; ks < 4; ++ks) {
            asm volatile("ds_read_b64_tr_b16 %0,%1 offset:%c2" : "=&v"(lo[ks]) : "v"(vb), "i"(d0 * 4096 + ks * 1024) : "memory");
            asm volatile("ds_read_b64_tr_b16 %0,%1 offset:%c2" : "=&v"(hi[ks]) : "v"(vb), "i"(d0 * 4096 + ks * 1024 + 512) : "memory"); }
        asm volatile("s_waitcnt lgkmcnt(0)" ::: "memory"); __builtin_amdgcn_sched_barrier(0);
#define PK(k) (bf16x8){lo[k][0], lo[k][1], lo[k][2], lo[k][3], hi[k][0], hi[k][1], hi[k][2], hi[k][3]}
        o[d0] = __builtin_amdgcn_mfma_f32_32x32x16_bf16(pa0, PK(0), o[d0], 0, 0, 0);
        o[d0] = __builtin_amdgcn_mfma_f32_32x32x16_bf16(pa1, PK(1), o[d0], 0, 0, 0);
        o[d0] = __builtin_amdgcn_mfma_f32_32x32x16_bf16(pa2, PK(2), o[d0], 0, 0, 0);
        o[d0] = __builtin_amdgcn_mfma_f32_32x32x16_bf16(pa3, PK(3), o[d0], 0, 0, 0);
#undef PK
    }
}
struct Desc {
    const bf16* Q; int qp;
    const bf16* K; const bf16* V; int kp;
    bf16* O; int op;
    int nt, nctx, nt_real;
    int ctxrow, latrow;
    int r0, kr0;
    int q0, kt0;
    const float* rpb;
    float sink_l2; int has_sink;
    int qrope, qt0;
};
template <int MODE>
__device__ __forceinline__ void attn_unit(const Desc& d, char* shm) {
    int tid_ = threadIdx.x; asm volatile("" : "+v"(tid_));
    const int tid = tid_, lane = tid & 63, r32 = lane & 31, hi = lane >> 5; const int wid = __builtin_amdgcn_readfirstlane(tid >> 6);
    const unsigned lds0 = (unsigned)(uintptr_t)shm;
    float* wsf = (float*)(shm + LDS_WS) + wid * 64;
    const bf16* Qw = d.Q + (size_t)(wid * 32) * d.qp;
    const unsigned kdst = lds0 + LDS_K + wid * 1024, vdst = lds0 + LDS_V + wid * 1024;
    const size_t koffl = (size_t)lane * d.kp + wid * 8;
    const size_t voffl = (size_t)(16 * (wid & 3) + (lane >> 2)) * d.kp + (wid >> 2) * 32 + (lane & 3) * 8;
#define TROW(t) ((t) < d.nctx ? d.ctxrow + 64 * (t) : d.latrow + 64 * ((t) - d.nctx))
#define DMA_KV(t, slot) do { const size_t ro_ = (size_t)TROW(t) * d.kp; \
        glds16(d.K + ro_ + koffl, (unsigned)__builtin_amdgcn_readfirstlane(kdst + (slot) * SLOTB)); \
        glds16(d.V + ro_ + voffl, (unsigned)__builtin_amdgcn_readfirstlane(vdst + (slot) * SLOTB)); } while (0)
    const int vb0 = (int)(lds0 + LDS_V) + ((lane >> 4) & 1) * 32 + (lane & 3) * 8 + (4 * hi + ((lane & 15) >> 2)) * 64;
    if (MODE == M_NA) { float* bt = (float*)(shm + LDS_BIAS); if (tid < 465) bt[tid] = d.rpb[tid] * LOG2E; }
    DMA_KV(0, 0);
    if (d.nt > 1) DMA_KV(1, 1);
    bf16x8 qr[4];
#pragma unroll
    for (int d0 = 0; d0 < 4; ++d0) qr[d0] = *reinterpret_cast<const bf16x8*>(&Qw[(size_t)r32 * d.qp + d0 * 16 + hi * 8]);
    float m = -1e30f, l = 0.f; f32x16 o[2]; o[0] = f32x16{}; o[1] = f32x16{};
    const int qrow = (MODE == M_NA) ? d.r0 + (wid >> 1) : 0;
    const int qcol = 32 * (wid & 1) + r32;
    const int rs = (MODE == M_NA) ? (qrow - 4 < 0 ? 0 : (qrow - 4 > 120 ? 120 : qrow - 4)) : 0;
    const int cs = qcol - 8 < 0 ? 0 : (qcol - 8 > 48 ? 48 : qcol - 8);
    const int qpos = d.q0 + 32 * wid + r32;
    int slot = 0;
    for (int t = 0; t < d.nt; ++t) {
        if (t + 1 < d.nt) asm volatile("s_waitcnt vmcnt(2) lgkmcnt(0)\n\ts_barrier" ::: "memory");
        else asm volatile("s_waitcnt vmcnt(0) lgkmcnt(0)\n\ts_barrier" ::: "memory");
        if (t + 2 < d.nt) { const int s2 = slot + 2 >= NSLOT ? slot + 2 - NSLOT : slot + 2; DMA_KV(t + 2, s2); }
        bool active = true;
        int kr = 0, k0 = 0;
        if (MODE == M_NA && t >= d.nctx) { kr = d.kr0 + (t - d.nctx); active = (kr >= rs) && (kr < rs + 8); }
        if (MODE == M_WA && t >= d.nctx) { k0 = d.kt0 + 64 * (t - d.nctx); const int qw = d.q0 + 32 * wid; active = (k0 + 63 >= qw - 128) && (k0 <= qw + 31 + 128); }
        if (active) {
            f32x16 p0, p1;
            qkt(p0, p1, shm + LDS_K + slot * SLOTB, qr, r32, hi);
            if (MODE == M_NA && t >= d.nctx) {
                const float* bt = (const float*)(shm + LDS_BIAS) + (kr - qrow + 7) * 31 + 15 - qcol;
#pragma unroll
                for (int r = 0; r < 16; ++r) {
                    const int kv = crow(r, hi);
                    { const bool ok = (unsigned)(kv - cs) < 16u; const float bv = bt[ok ? kv : qcol]; p0[r] = ok ? p0[r] + bv : -INFINITY; }
                    { const int kv2 = kv + 32; const bool ok = (unsigned)(kv2 - cs) < 16u; const float bv = bt[ok ? kv2 : qcol]; p1[r] = ok ? p1[r] + bv : -INFINITY; }
                }
            }
            if (MODE == M_WA && t >= d.nctx) {
#pragma unroll
                for (int r = 0; r < 16; ++r) {
                    const int dk = k0 + crow(r, hi) - qpos;
                    if (dk > 128 || dk < -128) p0[r] = -INFINITY;
                    if (dk + 32 > 128 || dk + 32 < -128) p1[r] = -INFINITY;
                }
            }
            float rm = __builtin_fmaxf(p0[0], p1[0]);
#pragma unroll
            for (int r = 1; r < 16; ++r) rm = __builtin_fmaxf(rm, __builtin_fmaxf(p0[r], p1[r]));
            { auto rr = __builtin_amdgcn_permlane32_swap(__float_as_uint(rm), __float_as_uint(rm), false, false); rm = __builtin_fmaxf(__uint_as_float(rr[0]), __uint_as_float(rr[1])); }
            const float mn = __builtin_fmaxf(m, rm);
            if (__any(mn > m)) {
                const float f = __builtin_amdgcn_exp2f(m - mn); l *= f; m = mn;
                if (hi == 0) wsf[r32] = f;
                asm volatile("s_waitcnt lgkmcnt(0)" ::: "memory");
#pragma unroll
                for (int r = 0; r < 16; ++r) { const float fr_ = wsf[crow(r, hi)]; o[0][r] *= fr_; o[1][r] *= fr_; }
            }
            float sacc = 0.f;
#pragma unroll
            for (int r = 0; r < 16; ++r) { p0[r] = __builtin_amdgcn_exp2f(p0[r] - m); p1[r] = __builtin_amdgcn_exp2f(p1[r] - m); sacc += p0[r] + p1[r]; }
            l += sacc;
            v4u pw0, pw1, pw2, pw3;
            pw0 = (v4u){cvtpk(p0[0], p0[1]), cvtpk(p0[2], p0[3]), cvtpk(p0[4], p0[5]), cvtpk(p0[6], p0[7])};
            pw1 = (v4u){cvtpk(p0[8], p0[9]), cvtpk(p0[10], p0[11]), cvtpk(p0[12], p0[13]), cvtpk(p0[14], p0[15])};
            pw2 = (v4u){cvtpk(p1[0], p1[1]), cvtpk(p1[2], p1[3]), cvtpk(p1[4], p1[5]), cvtpk(p1[6], p1[7])};
            pw3 = (v4u){cvtpk(p1[8], p1[9]), cvtpk(p1[10], p1[11]), cvtpk(p1[12], p1[13]), cvtpk(p1[14], p1[15])};
            pv(o, vb0 + slot * SLOTB, __builtin_bit_cast(bf16x8, pw0), __builtin_bit_cast(bf16x8, pw1), __builtin_bit_cast(bf16x8, pw2), __builtin_bit_cast(bf16x8, pw3));
        }
        slot = slot + 1 >= NSLOT ? 0 : slot + 1;
    }
    if (d.has_sink && hi == 0) l += __builtin_amdgcn_exp2f(d.sink_l2 - m);
    { auto rr = __builtin_amdgcn_permlane32_swap(__float_as_uint(l), __float_as_uint(l), false, false); l = __uint_as_float(rr[0]) + __uint_as_float(rr[1]); }
    if (hi == 0) wsf[32 + r32] = l;
    asm volatile("s_waitcnt lgkmcnt(0)" ::: "memory");
    float rli[16];
#pragma unroll
    for (int r = 0; r < 16; ++r) rli[r] = __builtin_amdgcn_rcpf(wsf[32 + crow(r, hi)]);
    bf16* Ow = d.O + (size_t)(wid * 32) * d.op;
    { bf16* stg = (bf16*)(shm + LDS_OST) + wid * 2048;
#pragma unroll
        for (int r = 0; r < 16; ++r) { const int orow = crow(r, hi);
#pragma unroll
            for (int d0 = 0; d0 < 2; ++d0) stg[orow * 64 + d0 * 32 + r32] = (bf16)f2bf(o[d0][r] * rli[r]); }
        asm volatile("s_waitcnt lgkmcnt(0)" ::: "memory");
#pragma unroll
        for (int i = 0; i < 4; ++i) { const int row = i * 8 + (lane >> 3), ch = lane & 7; const v4u v = *(const v4u*)(stg + row * 64 + ch * 8); *(v4u*)(Ow + (size_t)row * d.op + ch * 8) = v; } }
    asm volatile("s_waitcnt lgkmcnt(0)\n\ts_barrier" ::: "memory");
#undef TROW
#undef DMA_KV
}
}
namespace att {
typedef unsigned u32x4 __attribute__((ext_vector_type(4)));
#define SBAR() __builtin_amdgcn_sched_barrier(0)
__device__ __forceinline__ float max3f(float a,float b,float c){float r;asm("v_max3_f32 %0, %1, %2, %3":"=v"(r):"v"(a),"v"(b),"v"(c));return r;}
__device__ __forceinline__ float max2f(float a,float b){float r;asm("v_max_f32_e32 %0, %1, %2":"=v"(r):"v"(a),"v"(b));return r;}
__device__ __forceinline__ float fadd_s(float a,float b){float r;asm("v_add_f32_e32 %0, %1, %2":"=v"(r):"v"(a),"v"(b));return r;}
__device__ __forceinline__ float fsub_s(float a,float b){float r;asm("v_sub_f32_e32 %0, %1, %2":"=v"(r):"v"(a),"v"(b));return r;}
__device__ __forceinline__ unsigned cvtpk_s(float lo,float hi){return cvtpk(lo,hi);}
#define WAIT_BAR(N) asm volatile("s_waitcnt vmcnt(" #N ") lgkmcnt(0)\n\ts_barrier":::"memory")


__device__ __forceinline__ void qkt_n(f32x16&p0,f32x16&p1,const char*Kslot,const bf16x8*qr,const f32x16&negm,int r32,int hi){
  const char*kb=Kslot+hi*1024+r32*16;
  #pragma unroll
  for(int d0=0;d0<4;++d0){
    const bf16x8 b0=*reinterpret_cast<const bf16x8*>(kb+d0*2048);
    const bf16x8 b1=*reinterpret_cast<const bf16x8*>(kb+d0*2048+512);
    if(d0==0){p0=__builtin_amdgcn_mfma_f32_32x32x16_bf16(b0,qr[0],negm,0,0,0);p1=__builtin_amdgcn_mfma_f32_32x32x16_bf16(b1,qr[0],negm,0,0,0);}
    else{p0=__builtin_amdgcn_mfma_f32_32x32x16_bf16(b0,qr[d0],p0,0,0,0);p1=__builtin_amdgcn_mfma_f32_32x32x16_bf16(b1,qr[d0],p1,0,0,0);}}
}
typedef __attribute__((address_space(3))) const char* lds_cptr;
typedef short v4i16_t __attribute__((ext_vector_type(4)));
__device__ __forceinline__ void kload8(bf16x8*kf,lds_cptr kp){
  kf[0]=*(const __attribute__((address_space(3))) bf16x8*)(kp);      kf[1]=*(const __attribute__((address_space(3))) bf16x8*)(kp+512);
  kf[2]=*(const __attribute__((address_space(3))) bf16x8*)(kp+2048); kf[3]=*(const __attribute__((address_space(3))) bf16x8*)(kp+2560);
  kf[4]=*(const __attribute__((address_space(3))) bf16x8*)(kp+4096); kf[5]=*(const __attribute__((address_space(3))) bf16x8*)(kp+4608);
  kf[6]=*(const __attribute__((address_space(3))) bf16x8*)(kp+6144); kf[7]=*(const __attribute__((address_space(3))) bf16x8*)(kp+6656);
}
__device__ __forceinline__ void kload2(bf16x8*kf,lds_cptr kp,int j){ kf[2*j]=*(const __attribute__((address_space(3))) bf16x8*)(kp+j*2048); kf[2*j+1]=*(const __attribute__((address_space(3))) bf16x8*)(kp+j*2048+512); }
__device__ __forceinline__ s16x4 vtr(lds_cptr p){ return __builtin_bit_cast(s16x4,__builtin_amdgcn_ds_read_tr16_b64_v4i16((__attribute__((address_space(3))) v4i16_t*)p)); }
__device__ __forceinline__ float rowmax(const f32x16&p0,const f32x16&p1){
  float a=max3f(p0[0],p0[1],p1[0]),b=max3f(p0[2],p0[3],p1[1]);a=max3f(a,p1[2],p1[3]);
  #pragma unroll
  for(int r=4;r<16;r+=4){a=max3f(a,p0[r],p0[r+1]);b=max3f(b,p0[r+2],p0[r+3]);a=max3f(a,p1[r],p1[r+1]);b=max3f(b,p1[r+2],p1[r+3]);}
  const float m=max2f(a,b);
  auto rr=__builtin_amdgcn_permlane32_swap(__float_as_uint(m),__float_as_uint(m),false,false);
  return max2f(__uint_as_float(rr[0]),__uint_as_float(rr[1]));
}

template<int MODE> __device__ __forceinline__ void pipe_mask(f32x16&P0,f32x16&P1,int t,const Desc& d,const char*shm,int wid,int r32,int hi){
  if(MODE==M_FULL) return;
  if(t<d.nctx) return;
  if(t>=d.nt_real){
    _Pragma("unroll") for(int r=0;r<16;++r){P0[r]=-INFINITY;P1[r]=-INFINITY;} return; }
  if(MODE==M_NA){
    const int qrow=d.r0+(wid>>1), qcol=32*(wid&1)+r32, kr=d.kr0+(t-d.nctx);
    const int rs=qrow-4<0?0:(qrow-4>120?120:qrow-4), cs=qcol-8<0?0:(qcol-8>48?48:qcol-8);
    if(kr<rs||kr>=rs+8){ _Pragma("unroll") for(int r=0;r<16;++r){P0[r]=-INFINITY;P1[r]=-INFINITY;} return; }
    const float*bt=(const float*)(shm+LDS_BIAS)+(kr-qrow+7)*31+15-qcol;
    _Pragma("unroll") for(int r=0;r<16;++r){ const int kv=crow(r,hi);
      { const bool ok=(unsigned)(kv-cs)<16u; const float bv=bt[ok?kv:qcol]; P0[r]=ok?P0[r]+bv:-INFINITY; }
      { const int kv2=kv+32; const bool ok=(unsigned)(kv2-cs)<16u; const float bv=bt[ok?kv2:qcol]; P1[r]=ok?P1[r]+bv:-INFINITY; } }
  }
  if(MODE==M_WA){
    const int qpos=d.q0+32*wid+r32, k0=d.kt0+64*(t-d.nctx);
    _Pragma("unroll") for(int r=0;r<16;++r){ const int dk=k0+crow(r,hi)-qpos;
      if(dk>128||dk<-128)P0[r]=-INFINITY; if(dk+32>128||dk+32<-128)P1[r]=-INFINITY; }
  }
}
template<int THRL,int MODE> __device__ __forceinline__ void attn_unit_pipe(const Desc& d,char*shm){
  int tid_=threadIdx.x; asm volatile("":"+v"(tid_)); const int tid=tid_,lane=tid&63,r32=lane&31,hi=lane>>5; const int wid=__builtin_amdgcn_readfirstlane(tid>>6);
  const bf16*Qw=d.Q+(size_t)(wid*32)*d.qp;
  const unsigned lds0=(unsigned)(uintptr_t)shm;
  if(MODE==M_NA){ float*bt=(float*)(shm+LDS_BIAS); if(tid<465)bt[tid]=d.rpb[tid]*LOG2E; }
  float*wsf=(float*)(shm+LDS_WS)+wid*64;
  const size_t koffl=(size_t)lane*d.kp+wid*8;
  const size_t voffl=(size_t)(16*(wid&3)+(lane>>2))*d.kp+(wid>>2)*32+(lane&3)*8;
  #define TROW(t) ((t)<d.nctx?d.ctxrow+64*(t):((t)<d.nt_real?d.latrow+64*((t)-d.nctx):d.latrow))
  const unsigned kdst=lds0+LDS_K+wid*1024, vdst=lds0+LDS_V+wid*1024;
  #define DMA_K(t,slot) glds16(d.K+(size_t)TROW(t)*d.kp+koffl,(unsigned)__builtin_amdgcn_readfirstlane(kdst+(slot)))
  #define DMA_V(t,slot) glds16(d.V+(size_t)TROW(t)*d.kp+voffl,(unsigned)__builtin_amdgcn_readfirstlane(vdst+(slot)))
  const int vb0=(int)(lds0+LDS_V)+((lane>>4)&1)*32+(lane&3)*8+(4*hi+((lane&15)>>2))*64;
  const char*Kbase=shm+LDS_K; bf16x8 kf[8];
  const lds_cptr shm3=(lds_cptr)shm; const lds_cptr kp0=shm3+LDS_K+hi*1024+r32*16; const lds_cptr vp0=shm3+LDS_V+((lane>>4)&1)*32+(lane&3)*8+(4*hi+((lane&15)>>2))*64;
  const int NT=d.nt;
  DMA_K(0,0);DMA_V(0,0);DMA_K(1,SLOTB);
  bf16x8 qr[4];
  #pragma unroll
  for(int d0=0;d0<4;++d0)qr[d0]=*reinterpret_cast<const bf16x8*>(&Qw[(size_t)r32*d.qp+d0*16+hi*8]);
  if(d.qrope){
    const int tq=d.qt0+32*wid+r32, rr=tq>>6, cc=tq&63;
    #pragma unroll
    for(int d0=2;d0<4;++d0){ const float pos=(float)(d0==2?rr:cc); u32x4 w=__builtin_bit_cast(u32x4,qr[d0]), pw, ow;
      #pragma unroll
      for(int j=0;j<4;++j) pw[j]=(unsigned)__shfl_xor((int)w[j],32);
      #pragma unroll
      for(int j=0;j<4;++j){ float res[2];
        #pragma unroll
        for(int e=0;e<2;++e){ const int i=2*j+e; const float own=e?bfhi(w[j]):bflo(w[j]), oth=e?bfhi(pw[j]):bflo(pw[j]);
          const float rev=pos*__builtin_amdgcn_exp2f(-(float)i*(13.287712379549449f/8.0f))*0.15915494309189535f; const float cs_=__builtin_amdgcn_cosf(rev), sn_=__builtin_amdgcn_sinf(rev);
          res[e]=hi?(own*cs_+oth*sn_):(own*cs_-oth*sn_); }
        ow[j]=cvtpk(res[0],res[1]); }
      qr[d0]=__builtin_bit_cast(bf16x8,ow); } }
  float mhat=0.f,l_reg=0.f;f32x16 o[2];o[0]=f32x16{};o[1]=f32x16{};f32x16 negm=f32x16{};asm volatile("":"+v"(negm));
  #define CMASK(P0,P1,t) pipe_mask<MODE>(P0,P1,(t),d,shm,wid,r32,hi)
  bool resc=false;
  #define START(P0,P1) do{ const float rm=rowmax(P0,P1); resc=false; \
    { const float dl=rm; mhat=fadd_s(mhat,dl); \
      _Pragma("unroll") for(int r=0;r<16;++r){P0[r]=fsub_s(P0[r],dl);P1[r]=fsub_s(P1[r],dl);} \
      _Pragma("unroll") for(int r=0;r<16;++r)negm[r]=-mhat; asm volatile("":"+v"(negm)); } \
    _Pragma("unroll") for(int r=0;r<16;++r)P0[r]=__builtin_amdgcn_exp2f(P0[r]); }while(0)
  #define RESC() do{ if(resc){ asm volatile("s_waitcnt lgkmcnt(0)":::"memory"); \
      _Pragma("unroll") for(int d_=0;d_<2;++d_) _Pragma("unroll") for(int r=0;r<16;++r)o[d_][r]*=wsf[crow(r,hi)]; } }while(0)
  f32x16 pA0,pA1,pB0,pB1;
  int sl_prev=0,sl_cur=0,sl_next=SLOTB;
  #define ROT() do{sl_prev=sl_cur;sl_cur=sl_next;sl_next=(sl_next==(NSLOT-1)*SLOTB)?0:sl_next+SLOTB;}while(0)
  DMA_K(2,2*SLOTB);
  WAIT_BAR(3);
  qkt_n(pA0,pA1,Kbase,qr,negm,r32,hi);asm volatile("s_nop 15\n\ts_nop 7":"+v"(pA0),"+v"(pA1));CMASK(pA0,pA1,0);
  START(pA0,pA1);
  _Pragma("unroll") for(int r=0;r<16;++r)pA1[r]=__builtin_amdgcn_exp2f(pA1[r]);
  WAIT_BAR(0);
  DMA_K(3,0);DMA_V(1,SLOTB);
  ROT();
  kload8(kf,kp0+sl_cur);
  WAIT_BAR(2);
  s16x4 vlo[8],vhi[8]; u32x4 pw0,pw1,pw2,pw3;
  #define PKW(P,B) cvtpk_s(P[B],P[B+1])
  #define PAF(k) __builtin_bit_cast(bf16x8,pw##k)
  #define VFR(i) (bf16x8){vlo[i][0],vlo[i][1],vlo[i][2],vlo[i][3],vhi[i][0],vhi[i][1],vhi[i][2],vhi[i][3]}
  #define PIN(x) asm volatile("":"+v"(x))
  #define MX3(a,b,c) __builtin_fmaxf(__builtin_fmaxf((a),(b)),(c))
  #define GAPA(MF,A0,A1,A2,A3,W0,W1,PW) do{ MF; sacc+=A0; sacc+=A1; sacc+=A2; sacc+=A3; PIN(sacc); W0; W1; PIN(PW); SBAR(); }while(0)
  #define EX(v) __builtin_amdgcn_exp2f(v)
  #define GAPB(MF,X,B) do{ MF; X[B]=EX(X[B]); X[B+1]=EX(X[B+1]); X[B+2]=EX(X[B+2]); X[B+3]=EX(X[B+3]); PIN(X); SBAR(); }while(0)
  #define VRD(i) do{ vlo[i]=vtr(vp_+(((i)>>2)*4096+((i)&3)*1024)); vhi[i]=vtr(vp_+(((i)>>2)*4096+((i)&3)*1024+512)); }while(0)
  #define KRD(G,j) do{ if(G){ kload2(kf,kp0+sl_next,j); SBAR(); } }while(0)
  #define STEP(C0,C1,P0,P1,t,GK,GV,GL) do{ SBAR(); \
    const lds_cptr vp_=vp0+sl_prev; \
    VRD(0); SBAR(); float sacc=(P0[0]+P0[1]); \
    GAPA(C0=__builtin_amdgcn_mfma_f32_32x32x16_bf16(kf[0],qr[0],negm,0,0,0), P0[2],P0[3],P0[4],P0[5],     pw0[0]=PKW(P0,0), pw0[1]=PKW(P0,2), pw0); \
    VRD(4); SBAR(); GAPA(C1=__builtin_amdgcn_mfma_f32_32x32x16_bf16(kf[1],qr[0],negm,0,0,0), P0[6],P0[7],P0[8],P0[9],     pw0[2]=PKW(P0,4), pw0[3]=PKW(P0,6), pw0); \
    VRD(1); SBAR(); GAPA(C0=__builtin_amdgcn_mfma_f32_32x32x16_bf16(kf[2],qr[1],C0,0,0,0),   P0[10],P0[11],P0[12],P0[13], pw1[0]=PKW(P0,8), pw1[1]=PKW(P0,10), pw1); \
    VRD(5); SBAR(); GAPA(C1=__builtin_amdgcn_mfma_f32_32x32x16_bf16(kf[3],qr[1],C1,0,0,0),   P0[14],P0[15],P1[0],P1[1],   pw1[2]=PKW(P0,12),pw1[3]=PKW(P0,14), pw1); \
    VRD(2); SBAR(); GAPA(C0=__builtin_amdgcn_mfma_f32_32x32x16_bf16(kf[4],qr[2],C0,0,0,0),   P1[2],P1[3],P1[4],P1[5],     pw2[0]=PKW(P1,0), pw2[1]=PKW(P1,2), pw2); \
    VRD(6); SBAR(); GAPA(C1=__builtin_amdgcn_mfma_f32_32x32x16_bf16(kf[5],qr[2],C1,0,0,0),   P1[6],P1[7],P1[8],P1[9],     pw2[2]=PKW(P1,4), pw2[3]=PKW(P1,6), pw2); \
    VRD(3); SBAR(); GAPA(C0=__builtin_amdgcn_mfma_f32_32x32x16_bf16(kf[6],qr[3],C0,0,0,0),   P1[10],P1[11],P1[12],P1[13], pw3[0]=PKW(P1,8), pw3[1]=PKW(P1,10), pw3); \
    VRD(7); SBAR(); GAPA(C1=__builtin_amdgcn_mfma_f32_32x32x16_bf16(kf[7],qr[3],C1,0,0,0),   P1[14],P1[15],0.f,0.f,       pw3[2]=PKW(P1,12),pw3[3]=PKW(P1,14), pw3); \
    l_reg+=sacc; \
    if(GK){DMA_K((t)+3,sl_cur);} if(GV){DMA_V((t)+1,sl_next);} \
    CMASK(C0,C1,t); \
    { float a=MX3(C0[0],C0[1],C1[0]),b=MX3(C0[2],C0[3],C1[1]); a=MX3(a,C1[2],C1[3]); \
      _Pragma("unroll") for(int r=4;r<16;r+=4){a=MX3(a,C0[r],C0[r+1]);b=MX3(b,C0[r+2],C0[r+3]);a=MX3(a,C1[r],C1[r+1]);b=MX3(b,C1[r+2],C1[r+3]);} \
      float rm=__builtin_fmaxf(a,b); { auto rr=__builtin_amdgcn_permlane32_swap(__float_as_uint(rm),__float_as_uint(rm),false,false); rm=__builtin_fmaxf(__uint_as_float(rr[0]),__uint_as_float(rr[1])); } \
      resc=false; \
      if(__builtin_expect(__any(rm>(float)THRL),0)){ const float dl=__builtin_fmaxf(rm,0.f); mhat+=dl; \
        _Pragma("unroll") for(int r=0;r<16;++r){C0[r]-=dl;C1[r]-=dl;} \
        _Pragma("unroll") for(int r=0;r<16;++r)negm[r]=-mhat; asm volatile("":"+v"(negm)); \
        const float f=__builtin_amdgcn_exp2f(-dl); l_reg*=f; if(hi==0)wsf[r32]=f; resc=true; } } \
    SBAR(); \
    GAPB(o[0]=__builtin_amdgcn_mfma_f32_32x32x16_bf16(PAF(0),VFR(0),o[0],0,0,0), C0,0); \
    GAPB(o[1]=__builtin_amdgcn_mfma_f32_32x32x16_bf16(PAF(0),VFR(4),o[1],0,0,0), C0,4); \
    KRD(GL,0); GAPB(o[0]=__builtin_amdgcn_mfma_f32_32x32x16_bf16(PAF(1),VFR(1),o[0],0,0,0), C0,8); \
    KRD(GL,1); GAPB(o[1]=__builtin_amdgcn_mfma_f32_32x32x16_bf16(PAF(1),VFR(5),o[1],0,0,0), C0,12); \
    KRD(GL,2); GAPB(o[0]=__builtin_amdgcn_mfma_f32_32x32x16_bf16(PAF(2),VFR(2),o[0],0,0,0), C1,0); \
    KRD(GL,3); GAPB(o[1]=__builtin_amdgcn_mfma_f32_32x32x16_bf16(PAF(2),VFR(6),o[1],0,0,0), C1,4); \
    GAPB(o[0]=__builtin_amdgcn_mfma_f32_32x32x16_bf16(PAF(3),VFR(3),o[0],0,0,0), C1,8); \
    GAPB(o[1]=__builtin_amdgcn_mfma_f32_32x32x16_bf16(PAF(3),VFR(7),o[1],0,0,0), C1,12); \
    }while(0)
  int t=1;
  for(;t+5<NT;t+=2){
    STEP(pB0,pB1,pA0,pA1,t,true,true,true);     WAIT_BAR(2); RESC(); ROT();
    STEP(pA0,pA1,pB0,pB1,t+1,true,true,true);   WAIT_BAR(2); RESC(); ROT();
  }
  #define ENDW(tt) do{ if((tt)+3<NT){WAIT_BAR(2);} else if((tt)+2<NT){WAIT_BAR(1);} else {WAIT_BAR(0);} }while(0)
  for(;t+1<NT;t+=2){
    STEP(pB0,pB1,pA0,pA1,t,(t+3<NT),(t+1<NT),(t+1<NT));       ENDW(t);   RESC(); ROT();
    STEP(pA0,pA1,pB0,pB1,t+1,(t+4<NT),(t+2<NT),(t+2<NT));     ENDW(t+1); RESC(); ROT();
  }
  STEP(pB0,pB1,pA0,pA1,NT-1,false,false,false); RESC();
  { float sacc=pB0[0]+pB0[1]; _Pragma("unroll") for(int r=2;r<16;++r)sacc+=pB0[r]; _Pragma("unroll") for(int r=0;r<16;++r)sacc+=pB1[r]; l_reg+=sacc;
    pw0=(u32x4){PKW(pB0,0),PKW(pB0,2),PKW(pB0,4),PKW(pB0,6)};pw1=(u32x4){PKW(pB0,8),PKW(pB0,10),PKW(pB0,12),PKW(pB0,14)};pw2=(u32x4){PKW(pB1,0),PKW(pB1,2),PKW(pB1,4),PKW(pB1,6)};pw3=(u32x4){PKW(pB1,8),PKW(pB1,10),PKW(pB1,12),PKW(pB1,14)};
    SBAR(); pv(o,vb0+sl_cur,PAF(0),PAF(1),PAF(2),PAF(3)); }
  #undef PKW
  #undef PAF
  #undef VFR
  #undef PIN
  #undef MX3
  #undef GAPA
  #undef GAPB
  #undef EX
  #undef VRD
  #undef KRD
  #undef STEP
  #undef ENDW
  if(d.has_sink&&hi==0)l_reg+=__builtin_amdgcn_exp2f(d.sink_l2-mhat);
  {auto rr=__builtin_amdgcn_permlane32_swap(__float_as_uint(l_reg),__float_as_uint(l_reg),false,false);l_reg=__uint_as_float(rr[0])+__uint_as_float(rr[1]);}
  if(hi==0)wsf[32+r32]=l_reg;asm volatile("s_waitcnt lgkmcnt(0)":::"memory");
  float rli[16];
  #pragma unroll
  for(int r=0;r<16;++r)rli[r]=__builtin_amdgcn_rcpf(wsf[32+crow(r,hi)]);
  bf16*Ow=d.O+(size_t)(wid*32)*d.op;
  { bf16*stg=(bf16*)(shm+LDS_OST)+wid*2048;
    #pragma unroll
    for(int r=0;r<16;++r){const int orow=crow(r,hi);
      #pragma unroll
      for(int d0=0;d0<2;++d0)stg[orow*64+d0*32+r32]=(bf16)f2bf(o[d0][r]*rli[r]);}
    asm volatile("s_waitcnt lgkmcnt(0)":::"memory");
    #pragma unroll
    for(int i=0;i<4;++i){const int row=i*8+(lane>>3),ch=lane&7; const u32x4 v=*(const u32x4*)(stg+row*64+ch*8); *(u32x4*)(Ow+(size_t)row*d.op+ch*8)=v;} }
  asm volatile("s_waitcnt lgkmcnt(0)\n\ts_barrier":::"memory");
  #undef DMA_K
  #undef TROW
  #undef DMA_V
  #undef CMASK
  #undef START
  #undef RESC
  #undef ROT
}

#undef SBAR
#undef WAIT_BAR
}
namespace gla {
constexpr int S32 = 40, S64 = 72;
struct Par {
    const bf16* P; bf16* CAT; float* GU; float* GDEC; float* BC;
    const float *wgf, *bgf, *wgb, *bgb, *gnorm;
};
__device__ __forceinline__ int chunk_row(int b, int n) { return n < 4 ? NLAT + b * CTXL + 64 * n : b * SEQ + 64 * (n - 4); }
__device__ __forceinline__ int chunk_dir(int n, int dir) { return dir == 0 ? n : (n < 4 ? 3 - n : 135 - n); }
template <int KS>
__device__ __forceinline__ f32x16 mm_tile(f32x16 c, const bf16* A, int sa, const bf16* Bt, int sb, int r32, int hi) {
#pragma unroll
    for (int s = 0; s < KS; ++s) {
        const bf16x8 a = *reinterpret_cast<const bf16x8*>(A + r32 * sa + 16 * s + 8 * hi);
        const bf16x8 b = *reinterpret_cast<const bf16x8*>(Bt + r32 * sb + 16 * s + 8 * hi);
        c = __builtin_amdgcn_mfma_f32_32x32x16_bf16(a, b, c, 0, 0, 0);
    }
    return c;
}
__device__ __forceinline__ float decay_g(const bf16* zl, int tok, int dir, const float (&w)[16], float bias) {
    const v4u* zp = (const v4u*)(zl + tok * 32 + dir * 16);
    const v4u z0 = zp[0], z1 = zp[1];
    float a = bias;
    a += bflo(z0.x) * w[0] + bfhi(z0.x) * w[1] + bflo(z0.y) * w[2] + bfhi(z0.y) * w[3] + bflo(z0.z) * w[4] + bfhi(z0.z) * w[5] + bflo(z0.w) * w[6] + bfhi(z0.w) * w[7];
    a += bflo(z1.x) * w[8] + bfhi(z1.x) * w[9] + bflo(z1.y) * w[10] + bfhi(z1.y) * w[11] + bflo(z1.z) * w[12] + bfhi(z1.z) * w[13] + bflo(z1.w) * w[14] + bfhi(z1.w) * w[15];
    const float ls = __builtin_fminf(a, 0.f) - 0.6931471805599453f * __builtin_amdgcn_logf(1.0f + __builtin_amdgcn_exp2f(-LOG2E * __builtin_fabsf(a)));
    return ls * (1.0f / 16.0f);
}
__device__ __forceinline__ void decay_totals(float& bend, float& carry, const bf16* zl, const float (&w)[16], float bias, int dir, int half) {
    float tot = 0.f;
#pragma unroll 4
    for (int ii = 0; ii < 32; ++ii) tot += decay_g(zl, 32 * half + ii, dir, w, bias);
    const float oth = __shfl_xor(tot, 32);
    bend = tot + oth; carry = (half == (dir == 0 ? 1 : 0)) ? oth : 0.f;
}
__device__ __forceinline__ void load_z(bf16* zl, const bf16* P, int row0, int tid) {
    if (tid < 256) { const int j = tid >> 2, c = tid & 3; *(v4u*)(zl + j * 32 + c * 8) = *(const v4u*)(P + (size_t)(row0 + j) * INWP + D_ZF + c * 8); }
}
__device__ __forceinline__ void ld_rows32(v4u (&pc)[2], const bf16* P, int row0, int col, int lane) {
#pragma unroll
    for (int i = 0; i < 2; ++i) { const int pidx = lane + 64 * i; pc[i] = *(const v4u*)(P + (size_t)(row0 + (pidx >> 2)) * INWP + col + (pidx & 3) * 8); }
}
__device__ __forceinline__ void st_rows32(bf16* dst, const v4u (&pc)[2], int lane) {
#pragma unroll
    for (int i = 0; i < 2; ++i) { const int pidx = lane + 64 * i; *(v4u*)(dst + (pidx >> 2) * S32 + (pidx & 3) * 8) = pc[i]; }
}
__device__ __forceinline__ void load_vt(bf16* Vt, const bf16* P, int row0, int h, int part, int lane) {
    const int c8 = lane & 7, jj = lane >> 3;
#pragma unroll
    for (int it = 0; it < 4; ++it) {
        const int j = 32 * part + it * 8 + jj;
        const v4u x = *(const v4u*)(P + (size_t)(row0 + j) * INWP + D_V + h * 64 + c8 * 8);
        bf16* dst = Vt + (c8 * 8) * S64 + j;
        dst[0 * S64] = (bf16)(x.x & 0xffff); dst[1 * S64] = (bf16)(x.x >> 16); dst[2 * S64] = (bf16)(x.y & 0xffff); dst[3 * S64] = (bf16)(x.y >> 16);
        dst[4 * S64] = (bf16)(x.z & 0xffff); dst[5 * S64] = (bf16)(x.z >> 16); dst[6 * S64] = (bf16)(x.w & 0xffff); dst[7 * S64] = (bf16)(x.w >> 16);
    }
}
__device__ __forceinline__ void g1_unit(const Par& p, int b, int n, char* shm) {
    int tid_ = threadIdx.x; asm volatile("" : "+v"(tid_));
    const int tid = tid_, lane = tid & 63, r32 = lane & 31, hi = lane >> 5; const int wid = __builtin_amdgcn_readfirstlane(tid >> 6);
    const int h = wid >> 1, dir = wid & 1, row0 = chunk_row(b, n);
    char* pr = shm + (wid >> 1) * 32768;
    bf16* KdT = (bf16*)(pr + (wid & 1) * 4608);
    bf16* Vt = (bf16*)(pr + 9216);
    bf16* Kr = (bf16*)(pr + 18432);
    bf16* zl = (bf16*)(shm + 131072);
    const int k = lane & 31, half = lane >> 5;
    v4u pc[2]; ld_rows32(pc, p.P, row0 + 32 * dir, D_K + h * 32, lane);
    float w[16];
    { const float* wg = dir == 0 ? p.wgf : p.wgb;
#pragma unroll
      for (int j = 0; j < 16; ++j) w[j] = wg[j * 128 + h * 32 + k]; }
    const float bias = (dir == 0 ? p.bgf : p.bgb)[h * 32 + k];
    load_z(zl, p.P, row0, tid);
    load_vt(Vt, p.P, row0, h, dir, lane);
    st_rows32(Kr + 32 * dir * S32, pc, lane);
    __syncthreads();
    float bend, run;
    decay_totals(bend, run, zl, w, bias, dir, half);
#pragma unroll 2
    for (int s = 0; s < 32; ++s) {
        const int i = 32 * half + (dir == 0 ? s : 31 - s);
        run += decay_g(zl, i, dir, w, bias);
        KdT[k * S64 + i] = (bf16)f2bf(bf2f(Kr[i * S32 + k]) * __expf(bend - run));
        p.BC[(size_t)(row0 + i) * 256 + dir * 128 + h * 32 + k] = run;
    }
    const int seq = (b * 4 + h) * 2 + dir, nd = chunk_dir(n, dir);
    if (half == 0) p.GDEC[((size_t)seq * NCH + nd) * 32 + k] = __expf(bend);
    LDS_WAIT();
    float* up = p.GU + ((size_t)seq * NCH + nd) * 2048;
#pragma unroll
    for (int dt = 0; dt < 2; ++dt) {
        f32x16 c = {};
        c = mm_tile<4>(c, KdT, S64, Vt + (32 * dt) * S64, S64, r32, hi);
#pragma unroll
        for (int r = 0; r < 16; ++r) (up + ((r & 3) + 8 * (r >> 2)) * 64 + 32 * dt)[(unsigned)(4 * hi * 64 + r32)] = c[r];
    }
    __syncthreads();
}
__device__ __forceinline__ void g2_scan(float* GU, const float* GDEC, int gt) {
    if (gt >= 32 * 2048) return;
    const int seq = gt >> 11, e = gt & 2047, k = e >> 6;
    float* up = GU + (size_t)seq * NCH * 2048 + e; const float* dp = GDEC + (size_t)seq * NCH * 32 + k;
    float s = 0.f;
#pragma unroll 12
    for (int n = 0; n < NCH; ++n) { const float u = up[(size_t)n * 2048], dc = dp[n * 32]; up[(size_t)n * 2048] = s; s = s * dc + u; }
}
struct G3Lds { bf16 *Kd, *St, *Vt, *Qd, *AT, *zl; };
template <int DIR>
__device__ __forceinline__ void g3_dir(f32x16 (&o)[2], const Par& p, const G3Lds& L, int row0, int b, int n, int h, int ih, int lane) {
    const int r32 = lane & 31, hi = lane >> 5;
    const int seq = (b * 4 + h) * 2 + DIR, nd = chunk_dir(n, DIR);
    const float* sp = p.GU + ((size_t)seq * NCH + nd) * 2048;
    const int t128 = ih * 64 + lane;
    f32x4 sv[4];
#pragma unroll
    for (int it = 0; it < 4; ++it) sv[it] = *(const f32x4*)(sp + (it * 128 + t128) * 4);
    v4u pq[2], pk[2]; f32x4 pb[2][2];
#pragma unroll
    for (int i = 0; i < 2; ++i) { const int item = lane + 64 * i, t = item >> 2, g8 = item & 3; const size_t row = (size_t)(row0 + 32 * ih + t);
        pq[i] = *(const v4u*)(p.P + row * INWP + D_Q + h * 32 + g8 * 8); pk[i] = *(const v4u*)(p.P + row * INWP + D_K + h * 32 + g8 * 8);
        const float* bp = p.BC + row * 256 + DIR * 128 + h * 32 + g8 * 8; pb[i][0] = *(const f32x4*)bp; pb[i][1] = *(const f32x4*)(bp + 4); }
#pragma unroll
    for (int i = 0; i < 2; ++i) { const int item = lane + 64 * i, t = item >> 2, g8 = item & 3;
        float e[8], qf[8], kf[8];
#pragma unroll
        for (int j = 0; j < 4; ++j) { e[j] = pb[i][0][j]; e[4 + j] = pb[i][1][j]; }
        qf[0] = bflo(pq[i].x); qf[1] = bfhi(pq[i].x); qf[2] = bflo(pq[i].y); qf[3] = bfhi(pq[i].y); qf[4] = bflo(pq[i].z); qf[5] = bfhi(pq[i].z); qf[6] = bflo(pq[i].w); qf[7] = bfhi(pq[i].w);
        kf[0] = bflo(pk[i].x); kf[1] = bfhi(pk[i].x); kf[2] = bflo(pk[i].y); kf[3] = bfhi(pk[i].y); kf[4] = bflo(pk[i].z); kf[5] = bfhi(pk[i].z); kf[6] = bflo(pk[i].w); kf[7] = bfhi(pk[i].w);
#pragma unroll
        for (int j = 0; j < 8; ++j) { qf[j] *= __builtin_amdgcn_exp2f(e[j] * LOG2E) * 0.17677669529663687f; kf[j] *= __builtin_amdgcn_exp2f(-e[j] * LOG2E); }
        v4u wq, wk; wq.x = cvtpk(qf[0], qf[1]); wq.y = cvtpk(qf[2], qf[3]); wq.z = cvtpk(qf[4], qf[5]); wq.w = cvtpk(qf[6], qf[7]);
        wk.x = cvtpk(kf[0], kf[1]); wk.y = cvtpk(kf[2], kf[3]); wk.z = cvtpk(kf[4], kf[5]); wk.w = cvtpk(kf[6], kf[7]);
        *(v4u*)(L.Qd + t * S32 + g8 * 8) = wq; *(v4u*)(L.Kd + (32 * ih + t) * S32 + g8 * 8) = wk; }
#pragma unroll
    for (int it = 0; it < 4; ++it) { const int e4 = (it * 128 + t128) * 4, kk = e4 >> 6, d0 = e4 & 63; const f32x4 v = sv[it];
        L.St[(d0 + 0) * S32 + kk] = (bf16)f2bf(v.x); L.St[(d0 + 1) * S32 + kk] = (bf16)f2bf(v.y); L.St[(d0 + 2) * S32 + kk] = (bf16)f2bf(v.z); L.St[(d0 + 3) * S32 + kk] = (bf16)f2bf(v.w); }
    __syncthreads();
#pragma unroll
    for (int jt = 0; jt < 2; ++jt) {
        f32x16 c = {};
        c = mm_tile<2>(c, L.Qd, S32, L.Kd + (32 * jt) * S32, S32, r32, hi);
        const int j = 32 * jt + r32;
#pragma unroll
        for (int r = 0; r < 16; ++r) { const int il = att::crow(r, hi), ig = 32 * ih + il; const bool keep = DIR == 0 ? (j <= ig) : (j >= ig);
            L.AT[il * S64 + j] = (bf16)f2bf(keep ? c[r] : 0.f); }
    }
    LDS_WAIT();
#pragma unroll
    for (int dt = 0; dt < 2; ++dt) {
        o[dt] = mm_tile<4>(o[dt], L.AT, S64, L.Vt + (32 * dt) * S64, S64, r32, hi);
        o[dt] = mm_tile<2>(o[dt], L.Qd, S32, L.St + (32 * dt) * S32, S32, r32, hi);
    }
    __syncthreads();
}
__device__ __forceinline__ void g3_unit(const Par& p, int b, int n, char* shm) {
    int tid_ = threadIdx.x; asm volatile("" : "+v"(tid_));
    const int tid = tid_, lane = tid & 63, r32 = lane & 31, hi = lane >> 5; const int wid = __builtin_amdgcn_readfirstlane(tid >> 6);
    const int h = wid >> 1, ih = wid & 1, row0 = chunk_row(b, n);
    char* pr = shm + (wid >> 1) * 33792;
    G3Lds L;
    L.Kd = (bf16*)pr;
    L.St = (bf16*)(pr + 5120);
    L.Vt = (bf16*)(pr + 10240);
    L.Qd = (bf16*)(pr + 19456 + ih * 7168);
    L.AT = (bf16*)(pr + 19456 + ih * 7168 + 2560);
    L.zl = nullptr;
    load_vt(L.Vt, p.P, row0, h, ih, lane);
    __syncthreads();
    f32x16 o[2]; o[0] = f32x16{}; o[1] = f32x16{};
    g3_dir<0>(o, p, L, row0, b, n, h, ih, lane);
    g3_dir<1>(o, p, L, row0, b, n, h, ih, lane);
    { v4u pg[4];
#pragma unroll
      for (int i = 0; i < 4; ++i) { const int pidx = lane + 64 * i; pg[i] = *(const v4u*)(p.P + (size_t)(row0 + 32 * ih + (pidx >> 3)) * INWP + D_R + h * 64 + (pidx & 7) * 8); }
#pragma unroll
      for (int i = 0; i < 4; ++i) { const int pidx = lane + 64 * i; *(v4u*)(L.AT + (pidx >> 3) * S64 + (pidx & 7) * 8) = pg[i]; } }
    const float gn0 = p.gnorm[r32], gn1 = p.gnorm[32 + r32];
    const unsigned lc_ = (unsigned)(4 * hi * DM + r32);
    LDS_WAIT();
#pragma unroll
    for (int r = 0; r < 16; ++r) {
        float ss = o[0][r] * o[0][r] + o[1][r] * o[1][r];
        ss += __shfl_xor(ss, 1); ss += __shfl_xor(ss, 2); ss += __shfl_xor(ss, 4); ss += __shfl_xor(ss, 8); ss += __shfl_xor(ss, 16);
        const float rstd = __builtin_amdgcn_rsqf(ss * (1.0f / 64.0f) + RMS_EPS);
        const int il = att::crow(r, hi);
        bf16* cp = p.CAT + (size_t)(row0 + 32 * ih + (r & 3) + 8 * (r >> 2)) * DM + 768 + h * 64;
        cp[lc_] = (bf16)f2bf(o[0][r] * rstd * gn0 * fsilu(bf2f(L.AT[il * S64 + r32])));
        cp[lc_ + 32] = (bf16)f2bf(o[1][r] * rstd * gn1 * fsilu(bf2f(L.AT[il * S64 + 32 + r32])));
    }
    __syncthreads();
}
}
#if defined(SELFCHECK) && SELFCHECK
namespace chk {
__device__ __forceinline__ void item(const unsigned char* ws, const float* rpb_l, const float* sink_l, int row, int mx, int h, int lane, float* acc2) {
    const bf16* P = (const bf16*)(ws + WS_P); const bf16* QC = (const bf16*)(ws + WS_QC); const bf16* KC = (const bf16*)(ws + WS_KC); const bf16* VC = (const bf16*)(ws + WS_VC); const bf16* CATp = (const bf16*)(ws + WS_CAT);
    const bool lat = row < NLAT; const int b = lat ? row >> 13 : (row - NLAT) >> 8; const int t = row & (SEQ - 1), r = t >> 6, c = t & 63;
    const bf16* qp; const bf16* Kb; const bf16* Vb; int kp;
    if (mx == 0) { qp = P + (size_t)row * INWP + A_Q + h * 64; Kb = P + A_K + h * 64; Vb = P + A_V + h * 64; kp = INWP; }
    else if (mx == 1) { qp = P + (size_t)row * INWP + B_Q + h * 64; Kb = P + B_K + (h >> 1) * 64; Vb = P + B_V + (h >> 1) * 64; kp = INWP; }
    else { qp = QC + (size_t)row * 256 + h * 64; Kb = KC + h * 64; Vb = VC + h * 64; kp = 256; }
    float q[64];
#pragma unroll
    for (int d = 0; d < 64; ++d) q[d] = bf2f(qp[d]);
    if (mx == 2 && lat) {
#pragma unroll
        for (int g2 = 0; g2 < 2; ++g2) { const float pos = (float)(g2 == 0 ? r : c);
#pragma unroll
            for (int i = 0; i < 8; ++i) { const float ang = pos * exp2f(-(float)i * (13.287712379549449f / 8.0f)); const float cs_ = __cosf(ang), sn_ = __sinf(ang);
                const float x1 = q[32 + 16 * g2 + i], x2 = q[32 + 16 * g2 + 8 + i]; q[32 + 16 * g2 + i] = x1 * cs_ - x2 * sn_; q[32 + 16 * g2 + 8 + i] = x2 * cs_ + x1 * sn_; } }
    }
    const int rs = r - 4 < 0 ? 0 : (r - 4 > 120 ? 120 : r - 4), cs = c - 8 < 0 ? 0 : (c - 8 > 48 ? 48 : c - 8);
    const int nlatk = !lat ? 0 : (mx == 0 ? 128 : (mx == 1 ? 257 : SEQ)), ncand = nlatk + CTXL;
    float mxv = -1e30f;
    for (int pass = 0; pass < 2; ++pass) {
        float l = 0.f, o[64];
#pragma unroll
        for (int d = 0; d < 64; ++d) o[d] = 0.f;
        float pm = -1e30f;
        for (int j = lane; j < ncand; j += 64) {
            int krow; float bias = 0.f; bool ok = true;
            if (j >= nlatk) krow = NLAT + b * CTXL + (j - nlatk);
            else if (mx == 0) { const int i = j >> 4, jj = j & 15; krow = b * SEQ + (rs + i) * 64 + cs + jj; bias = rpb_l[h * 465 + (rs + i - r + 7) * 31 + (cs + jj - c + 15)] * LOG2E; }
            else if (mx == 1) { const int kpos = t - 128 + j; ok = kpos >= 0 && kpos < SEQ; krow = b * SEQ + (ok ? kpos : 0); }
            else krow = b * SEQ + j;
            if (!ok) continue;
            const bf16* kr = Kb + (size_t)krow * kp; float s = bias;
#pragma unroll
            for (int d = 0; d < 64; d += 2) { const unsigned w = *(const unsigned*)(kr + d); s += q[d] * bflo(w) + q[d + 1] * bfhi(w); }
            if (pass == 0) pm = fmaxf(pm, s);
            else { const float pe = __builtin_amdgcn_exp2f(s - mxv); l += pe; const bf16* vr = Vb + (size_t)krow * kp;
#pragma unroll
                for (int d = 0; d < 64; d += 2) { const unsigned w = *(const unsigned*)(vr + d); o[d] += pe * bflo(w); o[d + 1] += pe * bfhi(w); } }
        }
        if (pass == 0) {
#pragma unroll
            for (int off = 32; off >= 1; off >>= 1) pm = fmaxf(pm, __shfl_xor(pm, off));
            mxv = pm;
        } else {
            l = wave_sum(l); if (mx == 1) l += __builtin_amdgcn_exp2f(sink_l[h] * LOG2E - mxv);
            float e2 = 0.f, r2 = 0.f;
#pragma unroll
            for (int d = 0; d < 64; ++d) { const float od = wave_sum(o[d]) / l; const float cd = bf2f(CATp[(size_t)row * DM + mx * 256 + h * 64 + d]); e2 += (od - cd) * (od - cd); r2 += od * od; }
            if (lane == 0) { atomicAdd(acc2, e2); atomicAdd(acc2 + 1, r2); atomicAdd(acc2 + 2 + 2 * mx, e2); atomicAdd(acc2 + 3 + 2 * mx, r2); }
        }
    }
}
__device__ __forceinline__ void rope_pair(float& x1, float& x2, float pos, int i, int half) {
    const float ang = pos * exp2f(-(float)i * (13.287712379549449f / (float)half)); const float cs_ = __cosf(ang), sn_ = __sinf(ang);
    const float a = x1, b = x2; x1 = a * cs_ - b * sn_; x2 = b * cs_ + a * sn_;
}
__device__ __forceinline__ void proj_item(const unsigned char* ws, const float* w_in_l, const float* gq, const float* gkv, const float* wuq, const float* wukv, int row, int lane, float* pl, float* acc2) {
    const bf16* Hh = (const bf16*)(ws + WS_H) + (size_t)row * HLD; const bf16* P = (const bf16*)(ws + WS_P) + (size_t)row * INWP;
    const bf16* QCr = (const bf16*)(ws + WS_QC) + (size_t)row * 256; const bf16* KCr = (const bf16*)(ws + WS_KC) + (size_t)row * 256; const bf16* VCr = (const bf16*)(ws + WS_VC) + (size_t)row * 256;
    const bool lat = row < NLAT; const int t = row & (SEQ - 1); const float pr_ = (float)(t >> 6), pc_ = (float)(t & 63);
    for (int j = 0; j < 15; ++j) { const int cc = lane + 64 * j; if (cc >= 928) break; const int col = 768 + cc; float s = 0.f;
        for (int k = 0; k < DM; ++k) { float hv = bf2f(Hh[k]); if (ROUTER_SPLIT) hv += bf2f(Hh[DM + k]); s += hv * w_in_l[(size_t)k * INW + col]; }
        pl[cc] = s; }
    LDS_WAIT();
    float e2[7] = {0.f, 0.f, 0.f, 0.f, 0.f, 0.f, 0.f}, r2[7] = {0.f, 0.f, 0.f, 0.f, 0.f, 0.f, 0.f};
#define CHK_ACC(cat, ref, got) do { const float rf_ = (ref), gt_ = (got); e2[cat] += (rf_ - gt_) * (rf_ - gt_); r2[cat] += rf_ * rf_; } while (0)
    for (int pi = lane; pi < 6 * 32; pi += 64) { const int hd = pi >> 5, i = pi & 31, g2 = i >> 4, ii = i & 15; const int base = hd * 64 + 32 * g2 + ii;
        float x1 = pl[base], x2 = pl[base + 16]; if (lat) rope_pair(x1, x2, g2 == 0 ? pr_ : pc_, ii, 16);
        if (hd < 4) { CHK_ACC(0, x1 * C2, bf2f(P[B_Q + base])); CHK_ACC(0, x2 * C2, bf2f(P[B_Q + base + 16])); } else { CHK_ACC(1, x1, bf2f(P[B_Q + base])); CHK_ACC(1, x2, bf2f(P[B_Q + base + 16])); } }
    for (int i = lane; i < 128; i += 64) CHK_ACC(2, pl[B_V - 768 + i], bf2f(P[B_V + i]));
    float sq = 0.f, sk = 0.f;
    for (int i = lane; i < 256; i += 64) { const float v = pl[C_Q - 768 + i]; sq += v * v; }
    for (int i = lane; i < 128; i += 64) { const float v = pl[C_KV - 768 + i]; sk += v * v; }
    const float rq = 1.0f / sqrtf(wave_sum(sq) / 256.f + RMS_EPS), rk = 1.0f / sqrtf(wave_sum(sk) / 128.f + RMS_EPS);
    for (int n = lane; n < 256; n += 64) { float s = 0.f; for (int k = 0; k < 256; ++k) s += pl[C_Q - 768 + k] * rq * gq[k] * wuq[(size_t)k * 256 + n]; CHK_ACC(3, s * C2, bf2f(QCr[n])); }
    for (int n = lane; n < 384; n += 64) { float s = 0.f; for (int k = 0; k < 128; ++k) s += pl[C_KV - 768 + k] * rk * gkv[k] * wukv[(size_t)k * 384 + n];
        const int h = n / 96, jj = n % 96; if (jj < 32) CHK_ACC(4, s, bf2f(KCr[h * 64 + jj])); else CHK_ACC(6, s, bf2f(VCr[h * 64 + jj - 32])); }
    for (int pi = lane; pi < 4 * 16; pi += 64) { const int h = pi >> 4, i = pi & 15, g2 = i >> 3, ii = i & 7; const int base = 16 * g2 + ii;
        float x1 = pl[C_KR - 768 + base], x2 = pl[C_KR - 768 + base + 8]; if (lat) rope_pair(x1, x2, g2 == 0 ? pr_ : pc_, ii, 8);
        CHK_ACC(5, x1, bf2f(KCr[h * 64 + 32 + base])); CHK_ACC(5, x2, bf2f(KCr[h * 64 + 32 + base + 8])); }
#undef CHK_ACC
#pragma unroll
    for (int cat = 0; cat < 7; ++cat) { const float a = wave_sum(e2[cat]), b = wave_sum(r2[cat]); if (lane == 0) { atomicAdd(acc2 + 16 + 2 * cat, a); atomicAdd(acc2 + 17 + 2 * cat, b); } }
}
constexpr int NP_ROWS = 112;
__device__ __forceinline__ int proj_row(int s) { return s < 96 ? (int)(((long)s * 7919 + 5) % NLAT) : NLAT + ((s - 96) * 61 + 7) % NCTX; }
constexpr int NS_LAT = 640, NS_CTX = 48, NS_EDGE = 28;
__device__ __forceinline__ int sample_row(int s) {
    if (s < NS_LAT) return (int)(((long)s * 6151 + 17) % NLAT);
    s -= NS_LAT;
    if (s < NS_EDGE) { const int b = s / 7, k = s % 7; const int tt[7] = {0, 1, 63, 64, 4095, 8127, 8191}; int t = 0;
#pragma unroll
        for (int i = 0; i < 7; ++i) if (i == k) t = tt[i];
        return b * SEQ + t; }
    s -= NS_EDGE;
    return NLAT + (s * 21 + 3) % NCTX;
}
}
#endif
struct RowMapId { int off; __device__ __forceinline__ int operator()(int n) const { return off + n; } };
struct RowMapIl { int sub; __device__ __forceinline__ int operator()(int n) const { return 8 * (n >> 2) + 4 * sub + (n & 3); } };
struct RowMapKV { __device__ __forceinline__ int operator()(int n) const { const int h = n / 96, j = n % 96; return j < 32 ? h * 64 + j : 256 + h * 64 + (j - 32); } };
template <class RowMap>
__device__ __forceinline__ void tr_item(const float* W, int ldw, int k0, int n0, bf16* WT, int ldt, const RowMap& rm, const float* kscale, float* scr, int lane) {
#pragma unroll 4
    for (int it = 0; it < 16; ++it) { const int k = it * 4 + (lane >> 4), n4 = (lane & 15) * 4;
        f32x4 x = *(const f32x4*)(W + (size_t)(k0 + k) * ldw + n0 + n4);
        if (kscale) x = x * kscale[k0 + k];
        float* s = scr + k * 65 + n4; s[0] = x.x; s[1] = x.y; s[2] = x.z; s[3] = x.w; }
    LDS_WAIT();
#pragma unroll 2
    for (int it = 0; it < 8; ++it) { const int n = it * 8 + (lane >> 3), c = lane & 7; const float* s = scr + (8 * c) * 65 + n;
        v4u o; o.x = pk2(s[0 * 65], s[1 * 65]); o.y = pk2(s[2 * 65], s[3 * 65]); o.z = pk2(s[4 * 65], s[5 * 65]); o.w = pk2(s[6 * 65], s[7 * 65]);
        *(v4u*)(WT + (size_t)rm(n0 + n) * ldt + k0 + 8 * c) = o; }
    LDS_WAIT();
}
__device__ __forceinline__ void ld_row(const float* p, int lane, f32x4 (&v)[4]) {
#pragma unroll
    for (int j = 0; j < 2; ++j) { v[2 * j] = *(const f32x4*)(p + 512 * j + 8 * lane); v[2 * j + 1] = *(const f32x4*)(p + 512 * j + 8 * lane + 4); }
}
__device__ __forceinline__ void st_row(float* p, int lane, const f32x4 (&v)[4]) {
#pragma unroll
    for (int j = 0; j < 2; ++j) { *(f32x4*)(p + 512 * j + 8 * lane) = v[2 * j]; *(f32x4*)(p + 512 * j + 8 * lane + 4) = v[2 * j + 1]; }
}
__device__ __forceinline__ void st_row_bf16(bf16* p, int lane, const f32x4 (&v)[4]) {
#pragma unroll
    for (int j = 0; j < 2; ++j) { v4u w; w.x = cvtpk(v[2 * j].x, v[2 * j].y); w.y = cvtpk(v[2 * j].z, v[2 * j].w); w.z = cvtpk(v[2 * j + 1].x, v[2 * j + 1].y); w.w = cvtpk(v[2 * j + 1].z, v[2 * j + 1].w);
        *(v4u*)(p + 512 * j + 8 * lane) = w; }
}
__device__ __forceinline__ void st_row_hilo(bf16* p, int lane, const f32x4 (&v)[4]) {
#pragma unroll
    for (int j = 0; j < 2; ++j) { v4u w, wl; const f32x4 a = v[2 * j], b = v[2 * j + 1];
        w.x = cvtpk(a.x, a.y); w.y = cvtpk(a.z, a.w); w.z = cvtpk(b.x, b.y); w.w = cvtpk(b.z, b.w);
        wl.x = cvtpk(a.x - bflo(w.x), a.y - bfhi(w.x)); wl.y = cvtpk(a.z - bflo(w.y), a.w - bfhi(w.y)); wl.z = cvtpk(b.x - bflo(w.z), b.y - bfhi(w.z)); wl.w = cvtpk(b.z - bflo(w.w), b.w - bfhi(w.w));
        *(v4u*)(p + 512 * j + 8 * lane) = w; if (ROUTER_SPLIT) *(v4u*)(p + DM + 512 * j + 8 * lane) = wl; }
}
__device__ __forceinline__ void tr_item_router(const float* W, int k0, int n0, bf16* WT, float* scr, int lane) {
#pragma unroll 4
    for (int it = 0; it < 16; ++it) { const int k = it * 4 + (lane >> 4), n4 = (lane & 15) * 4;
        const f32x4 x = *(const f32x4*)(W + (size_t)(k0 + k) * NEXP + n0 + n4);
        float* s = scr + k * 65 + n4; s[0] = x.x; s[1] = x.y; s[2] = x.z; s[3] = x.w; }
    LDS_WAIT();
#pragma unroll 2
    for (int it = 0; it < 8; ++it) { const int n = it * 8 + (lane >> 3), c = lane & 7; const float* s = scr + (8 * c) * 65 + n;
        float f[8]; v4u o, ol;
#pragma unroll
        for (int i = 0; i < 8; ++i) f[i] = s[i * 65];
        o.x = cvtpk(f[0], f[1]); o.y = cvtpk(f[2], f[3]); o.z = cvtpk(f[4], f[5]); o.w = cvtpk(f[6], f[7]);
        ol.x = cvtpk(f[0] - bflo(o.x), f[1] - bfhi(o.x)); ol.y = cvtpk(f[2] - bflo(o.y), f[3] - bfhi(o.y)); ol.z = cvtpk(f[4] - bflo(o.z), f[5] - bfhi(o.z)); ol.w = cvtpk(f[6] - bflo(o.w), f[7] - bfhi(o.w));
        bf16* d0 = WT + (size_t)(n0 + n) * HLD + k0 + 8 * c; bf16* d1 = WT + (size_t)(128 + n0 + n) * HLD + k0 + 8 * c;
        if (ROUTER_SPLIT) { *(v4u*)d0 = o; *(v4u*)(d0 + DM) = o; *(v4u*)d1 = ol; *(v4u*)(d1 + DM) = ol; }
        else { *(v4u*)d0 = o; *(v4u*)d1 = (v4u){0u, 0u, 0u, 0u}; } }
    LDS_WAIT();
}
__device__ __forceinline__ void ln_row(f32x4 (&v)[4]) {
    float s = 0.f;
#pragma unroll
    for (int j = 0; j < 4; ++j) s += (v[j].x + v[j].y) + (v[j].z + v[j].w);
    const float mean = wave_sum(s) * (1.f / DM); float s2 = 0.f;
#pragma unroll
    for (int j = 0; j < 4; ++j) { v[j] = v[j] - mean; s2 += (v[j].x * v[j].x + v[j].y * v[j].y) + (v[j].z * v[j].z + v[j].w * v[j].w); }
    const float rstd = 1.0f / sqrtf(wave_sum(s2) * (1.f / DM) + LN_EPS);
#pragma unroll
    for (int j = 0; j < 4; ++j) v[j] = v[j] * rstd;
}
template <bool ONEPLUS>
__device__ __forceinline__ void affine_row(f32x4 (&v)[4], const float* a, const float* b, int lane) {
    f32x4 av[4], bv[4]; ld_row(a, lane, av); ld_row(b, lane, bv);
#pragma unroll
    for (int j = 0; j < 4; ++j) v[j] = ONEPLUS ? v[j] * (av[j] + 1.0f) + bv[j] : v[j] * av[j] + bv[j];
}
__device__ __forceinline__ int mod_row(int row) { return row < NLAT ? (row >> 13) : 4; }

__device__ __forceinline__ int ltid() { int t = threadIdx.x; asm volatile("" : "+v"(t)); return t; }
struct Args {
    const float *x, *c, *ctx, *c_ctx, *w_ada, *b_ada, *w_in, *na_rpb, *wa_sink, *mla_g_q, *mla_g_kv, *mla_w_uq, *mla_w_ukv,
                *gla_w_gf, *gla_b_gf, *gla_w_gb, *gla_b_gb, *gla_g_norm, *w_out, *ln1_g, *ln1_b, *ln2_g, *ln2_b,
                *router_w, *router_bias, *exp_w1, *exp_w3, *exp_w2, *sh_w1, *sh_w3, *sh_w2;
    float* out; unsigned char* ws;
};
static_assert(sizeof(Args) == 33 * 8, "Args has no padding");

constexpr int CV_N = NEXP * 192, CV_N0 = 5344, CV_N1 = CV_N0 + 4608, CV_N2 = CV_N1 + 7680;
__device__ __forceinline__ void convert_experts(const Args& A, int l, int lo, int hi, int gw, int NGW, float* scr, int lane) {
    bf16* we13 = (bf16*)(A.ws + WS_WE13); bf16* we2 = (bf16*)(A.ws + WS_WE2);
    for (int it = lo + gw; it < hi; it += NGW) {
        const int e = it / 192, r = it % 192, which = r >> 6, q = r & 63;
        if (which < 2) { const float* W = (which == 0 ? A.exp_w1 : A.exp_w3) + ((size_t)l * NEXP + e) * DM * DEXP;
            tr_item(W, DEXP, (q >> 2) * 64, (q & 3) * 64, we13 + (size_t)e * 512 * DM, DM, RowMapIl{which}, nullptr, scr, lane); }
        else { const float* W = A.exp_w2 + ((size_t)l * NEXP + e) * DEXP * DM;
            tr_item(W, DM, (q >> 4) * 64, (q & 15) * 64, we2 + (size_t)e * DM * DEXP, DEXP, RowMapId{0}, nullptr, scr, lane); }
    }
}

#ifndef SELFCHECK_TOL
#define SELFCHECK_TOL 0.03f
#endif
#ifndef SELFCHECK_TOL2
#define SELFCHECK_TOL2 0.02f
#endif
#ifndef PHMASK
#define PHMASK 0xffffff
#endif
#define PHON(k) (((PHMASK) >> (k)) & 1)
#ifndef DUPK
#define DUPK -1
#endif
#define DUP_SECOND 0
__global__ void __launch_bounds__(512, 2) hybrid_fwd(Args A) {
    extern __shared__ __attribute__((aligned(16))) unsigned char lds[];
    const int wave = __builtin_amdgcn_readfirstlane((int)threadIdx.x >> 6);
    const int G = gridDim.x; const int bx = blockIdx.x; const int vcu = (G % 8 == 0) ? (bx % 8) * (G / 8) + bx / 8 : bx;
    const int gw = vcu * 8 + wave, NGW = G * 8;
    const bool cv_tails = (G == 256);
    GAS unsigned char* wsg = (GAS unsigned char*)A.ws;
    unsigned char* ws = (unsigned char*)wsg;
#define WS_LAUNDER() asm volatile("" : "+s"(wsg)); ws = (unsigned char*)wsg; const int tid = ltid(), lane = tid & 63; (void)lane
    gu32* ctl = (gu32*)(ws + WS_CTL);
    volatile LAS unsigned* MISC = (volatile LAS unsigned*)((LAS unsigned char*)lds + MISC_OFF);
    { const int tid = ltid(); if (tid < 128) MISC[tid] = 0u; }
    __syncthreads();
    XcdBarrier bar = xcd_barrier_post((unsigned*)(ctl + CW_BAR), MISC);
#define GRID_BAR() do { XcdBarrier b2_ = bar; GAS unsigned* bp_ = (GAS unsigned*)bar.bar; asm volatile("" : "+s"(bp_), "+s"(b2_.x)); b2_.bar = (unsigned*)bp_; xcd_barrier(b2_); } while (0)
    char* shm = (char*)lds;
#define MODT ((float*)(ws + WS_MOD))
#define Hb ((bf16*)(ws + WS_H))
#define Pb ((bf16*)(ws + WS_P))
#define QC ((bf16*)(ws + WS_QC))
#define KC ((bf16*)(ws + WS_KC))
#define VC ((bf16*)(ws + WS_VC))
#define CAT ((bf16*)(ws + WS_CAT))
#define XA ((float*)(ws + WS_XA))
#define Zb ((float*)(ws + WS_Z))
#define RSTD ((float*)(ws + WS_RSTD))

        if (PHON(0)) {
        WS_LAUNDER();
    {
        float* sc = (float*)shm;
        float* part = (float*)(shm + 20480);
        for (int i = tid; i < 5 * DM; i += 512) { const float v = i < 4 * DM ? A.c[i] : A.c_ctx[i - 4 * DM]; sc[i] = v / (1.0f + __expf(-v)); }
        __syncthreads();
        for (int grp = vcu; grp < DEPTH * 96; grp += G) {
            const int l = grp / 96, col = (grp % 96) * 64 + lane;
            const float* wp = A.w_ada + (size_t)l * DM * 6 * DM + col;
            float acc[5] = {0.f, 0.f, 0.f, 0.f, 0.f};
#pragma unroll 8
            for (int kk = 0; kk < 128; ++kk) { const int k = wave * 128 + kk; const float w = wp[(size_t)k * 6 * DM];
#pragma unroll
                for (int r = 0; r < 5; ++r) acc[r] += sc[r * DM + k] * w; }
#pragma unroll
            for (int r = 0; r < 5; ++r) part[(wave * 5 + r) * 64 + lane] = acc[r];
            __syncthreads();
            if (tid < 320) { const int r = tid >> 6; float s = A.b_ada[(size_t)l * 6 * DM + col];
#pragma unroll
                for (int w8 = 0; w8 < 8; ++w8) s += part[(w8 * 5 + r) * 64 + lane];
                MODT[((size_t)l * 5 + r) * 6 * DM + col] = s; }
            __syncthreads();
        }
        float* scr = (float*)(shm + wave * 16640);
        constexpr int I_IN = 16 * 39, I_OUT = 16 * 16, I_UQ = 4 * 4, I_UKV = 2 * 6, I_RT = 16 * 2, I_S1 = 16 * 4, I_S2 = 4 * 16;
        constexpr int I_L = I_IN + I_OUT + I_UQ + I_UKV + I_RT + 2 * I_S1 + I_S2;
        for (int it = gw; it < DEPTH * I_L; it += NGW) {
            const int l = it / I_L; int r = it % I_L;
            if (r < I_IN) { tr_item(A.w_in + (size_t)l * DM * INW, INW, (r / 39) * 64, (r % 39) * 64, (bf16*)(ws + WS_WIN) + (size_t)l * INWP * DM, DM, RowMapId{0}, nullptr, scr, lane); continue; } r -= I_IN;
            if (r < I_OUT) { tr_item(A.w_out + (size_t)l * DM * DM, DM, (r / 16) * 64, (r % 16) * 64, (bf16*)(ws + WS_WOUT) + (size_t)l * DM * DM, DM, RowMapId{0}, nullptr, scr, lane); continue; } r -= I_OUT;
            if (r < I_UQ) { tr_item(A.mla_w_uq + (size_t)l * 256 * 256, 256, (r / 4) * 64, (r % 4) * 64, (bf16*)(ws + WS_WUQ) + (size_t)l * 256 * 256, 256, RowMapId{0}, A.mla_g_q + l * 256, scr, lane); continue; } r -= I_UQ;
            if (r < I_UKV) { tr_item(A.mla_w_ukv + (size_t)l * 128 * 384, 384, (r / 6) * 64, (r % 6) * 64, (bf16*)(ws + WS_WUKV) + (size_t)l * 512 * 128, 128, RowMapKV{}, A.mla_g_kv + l * 128, scr, lane); continue; } r -= I_UKV;
            if (r < I_RT) { tr_item_router(A.router_w + (size_t)l * DM * NEXP, (r / 2) * 64, (r % 2) * 64, (bf16*)(ws + WS_WRT) + (size_t)l * 256 * HLD, scr, lane); continue; } r -= I_RT;
            if (r < I_S1) { tr_item(A.sh_w1 + (size_t)l * DM * 256, 256, (r / 4) * 64, (r % 4) * 64, (bf16*)(ws + WS_WS13) + (size_t)l * 512 * DM, DM, RowMapIl{0}, nullptr, scr, lane); continue; } r -= I_S1;
            if (r < I_S1) { tr_item(A.sh_w3 + (size_t)l * DM * 256, 256, (r / 4) * 64, (r % 4) * 64, (bf16*)(ws + WS_WS13) + (size_t)l * 512 * DM, DM, RowMapIl{1}, nullptr, scr, lane); continue; } r -= I_S1;
            tr_item(A.sh_w2 + (size_t)l * 256 * DM, DM, (r / 16) * 64, (r % 16) * 64, (bf16*)(ws + WS_WS2) + (size_t)l * DM * 256, 256, RowMapId{0}, nullptr, scr, lane);
        }
        { const v4u z = {0u, 0u, 0u, 0u}; const int gt = vcu * 512 + tid, NGT = G * 512;
            for (int i = gt; i < DEPTH * 64 * 128; i += NGT) { const int l = i / (64 * 128), r = i % (64 * 128); *(v4u*)((bf16*)(ws + WS_WIN) + ((size_t)l * INWP + INW) * DM + (size_t)r * 8) = z; }
            for (int i = gt; i < DEPTH * 4 * 32 * 16; i += NGT) { const int l = i / 2048, r = i % 2048, h = r / 512, q = r % 512; *(v4u*)((bf16*)(ws + WS_WUKV) + ((size_t)l * 512 + h * 64 + 32) * 128 + (size_t)q * 8) = z; } }
    }
        }
    GRID_BAR();
        if (PHON(1)) {
        WS_LAUNDER();
    for (int m = gw; m < NTOK; m += NGW) {
        const float* src = m < NLAT ? A.x + (size_t)m * DM : A.ctx + (size_t)(m - NLAT) * DM;
        f32x4 v[4]; ld_row(src, lane, v); st_row(XA + (size_t)m * DM, lane, v);
        ln_row(v); const float* mp = MODT + (size_t)mod_row(m) * 6 * DM; affine_row<true>(v, mp + DM, mp, lane);
        st_row_hilo(Hb + (size_t)m * HLD, lane, v);
    }
    convert_experts(A, 0, 0, cv_tails ? CV_N0 : CV_N, gw, NGW, (float*)(shm + wave * 16640), lane);
        }
    GRID_BAR();

#pragma unroll 1
    for (int l = 0; l < DEPTH; ++l) {
        const bool lastl = (l == DEPTH - 1);
        const int MT = lastl ? NLAT : NTOK;
#define modl (MODT + (size_t)l * 5 * 6 * DM)
        if (PHON(2)) {
        WS_LAUNDER();
        { pg8::Gemm g{Hb, (const bf16*)(ws + WS_WIN) + (size_t)l * INWP * DM, DM, HLD, nullptr}; pg8::StaticOrder S; S.init(NTOK, INWP, G, bx);
          pg8::EpiBf16<INWP, false> E{Pb, 10, (1u << 0) | (1u << 3), C2, 256, nullptr, 0};
          pg8::gemm_phase<pg8::EpiBf16<INWP, false>, pg8::StaticOrder, false>((LAS unsigned char*)lds, g, S, E); }
        if (cv_tails && !lastl && bx >= 40) convert_experts(A, l, CV_N0, CV_N1, (bx - 40) * 8 + wave, 216 * 8, (float*)(shm + wave * 16640), lane);
        }
        GRID_BAR();
        if (PHON(3)) {
        WS_LAUNDER();
        {
        const bool roleB = lane < 24, roleK = lane == 24 || lane == 25;
        const int hd = lane >> 2, g2 = roleB ? (lane >> 1) & 1 : lane & 1, c8 = lane & 1;
        const int col1 = roleB ? B_Q + hd * 64 + 32 * g2 + 8 * c8 : C_KR + 16 * g2, dpart = roleB ? 16 : 8;
        const int f0 = roleB ? 8 * c8 : 0; const float fdiv = roleB ? 13.287712379549449f / 16.0f : 13.287712379549449f / 8.0f;
        for (int m0 = gw; m0 < NTOK; m0 += 4 * NGW) {
            v4u xa[4], xb[4]; v2u ca[4]; unsigned cb[4];
#pragma unroll
            for (int u = 0; u < 4; ++u) { const int m = m0 + u * NGW; const bf16* pr = Pb + (size_t)(m < NTOK ? m : 0) * INWP;
                xa[u] = *(const v4u*)(pr + col1); xb[u] = *(const v4u*)(pr + col1 + dpart);
                ca[u] = *(const v2u*)(pr + C_Q + 4 * lane); cb[u] = *(const unsigned*)(pr + C_KV + 2 * lane); }
#pragma unroll
            for (int u = 0; u < 4; ++u) { const int m = m0 + u * NGW; if (m < NTOK) { bf16* pr = Pb + (size_t)m * INWP;
                const bool lat = m < NLAT; const int t = m & (SEQ - 1);
                if ((roleB && lat) || roleK) {
                    const float pos = (float)(g2 == 0 ? (t >> 6) : (t & 63)); v4u oa, ob;
#pragma unroll
                    for (int j = 0; j < 4; ++j) { float r1[2], r2[2];
#pragma unroll
                        for (int e = 0; e < 2; ++e) { const float rev = pos * __builtin_amdgcn_exp2f(-(float)(f0 + 2 * j + e) * fdiv) * 0.15915494309189535f;
                            const float cs_ = lat ? __builtin_amdgcn_cosf(rev) : 1.f, sn_ = lat ? __builtin_amdgcn_sinf(rev) : 0.f;
                            const float a1 = e ? bfhi(xa[u][j]) : bflo(xa[u][j]), a2 = e ? bfhi(xb[u][j]) : bflo(xb[u][j]); r1[e] = a1 * cs_ - a2 * sn_; r2[e] = a2 * cs_ + a1 * sn_; }
                        oa[j] = cvtpk(r1[0], r1[1]); ob[j] = cvtpk(r2[0], r2[1]); }
                    if (roleB) { *(v4u*)(pr + col1) = oa; *(v4u*)(pr + col1 + 16) = ob; }
                    else { bf16* kd = KC + (size_t)m * 256 + 32 + 16 * g2;
#pragma unroll
                        for (int h4 = 0; h4 < 4; ++h4) { *(v4u*)(kd + h4 * 64) = oa; *(v4u*)(kd + h4 * 64 + 8) = ob; } }
                }
                const v2u a_ = ca[u]; const unsigned b2 = cb[u];
                float sq = bflo(a_.x) * bflo(a_.x) + bfhi(a_.x) * bfhi(a_.x) + bflo(a_.y) * bflo(a_.y) + bfhi(a_.y) * bfhi(a_.y); float sk = bflo(b2) * bflo(b2) + bfhi(b2) * bfhi(b2);
                sq = wave_sum(sq); sk = wave_sum(sk);
                if (lane == 0) { RSTD[2 * m] = 1.0f / sqrtf(sq * (1.f / 256.f) + RMS_EPS); RSTD[2 * m + 1] = 1.0f / sqrtf(sk * (1.f / 128.f) + RMS_EPS); } } }
        }
        }
        }
#define GLA_PAR() const gla::Par gp{Pb, CAT, (float*)(ws + WS_GU), (float*)(ws + WS_GDEC), (float*)(ws + WS_BC), A.gla_w_gf + l * 16 * 128, A.gla_b_gf + l * 128, A.gla_w_gb + l * 16 * 128, A.gla_b_gb + l * 128, A.gla_g_norm + l * 64}
        if (PHON(3)) {
        WS_LAUNDER();
        if (PHON(21)) { GLA_PAR(); for (int u = vcu; u < NB * NCH; u += G) gla::g1_unit(gp, u / NCH, u % NCH, shm); }
        }
        GRID_BAR();
        if (PHON(4)) {
        WS_LAUNDER();
        { pg8::Gemm g{Pb + C_Q, (const bf16*)(ws + WS_WUQ) + (size_t)l * 256 * 256, 256, INWP, nullptr}; pg8::StaticOrder S; S.init(NTOK, 256, G, bx);
          pg8::EpiBf16<256, true> E{QC, 1, 1u, C2, 0, RSTD, 0};
          pg8::gemm_phase<pg8::EpiBf16<256, true>, pg8::StaticOrder, false>((LAS unsigned char*)lds, g, S, E); }
        { pg8::Gemm g{Pb + C_KV, (const bf16*)(ws + WS_WUKV) + (size_t)l * 512 * 128, 128, INWP, nullptr}; pg8::StaticOrder S; S.init(NTOK, 512, G, bx);
          pg8::EpiBf16<256, true, true> E{KC, 2, 0u, 1.f, (size_t)(WS_VC - WS_KC) / 2, RSTD, 1};
          pg8::gemm_phase<pg8::EpiBf16<256, true, true>, pg8::StaticOrder, false>((LAS unsigned char*)lds, g, S, E); }
        if (!DUP_SECOND) gla::g2_scan((float*)(ws + WS_GU), (const float*)(ws + WS_GDEC), vcu * 512 + tid);
        }
        GRID_BAR();
#if defined(SELFCHECK) && SELFCHECK
        {
            WS_LAUNDER();
            float* acc2 = (float*)(ws + WS_CTL) + 32768;
            for (int it = gw; it < chk::NP_ROWS; it += NGW) chk::proj_item(ws, A.w_in + (size_t)l * DM * INW, A.mla_g_q + l * 256, A.mla_g_kv + l * 128, A.mla_w_uq + (size_t)l * 256 * 256, A.mla_w_ukv + (size_t)l * 128 * 384,
                                                                            chk::proj_row(it), lane, (float*)(shm + wave * 4096), acc2);
            __syncthreads();
        }
#endif
        if (PHON(6)) {
        WS_LAUNDER();
        {
            if (PHON(16)) for (int u = vcu; u < 512; u += G) { const int bh = 2 * ((u & 255) >> 5) + (u >> 8), qb = u & 31, b = bh >> 2, h = bh & 3;
                att::Desc d{}; d.Q = QC + (size_t)(b * SEQ + 256 * qb) * 256 + h * 64; d.qp = 256; d.K = KC + h * 64; d.V = VC + h * 64; d.kp = 256;
                d.O = CAT + (size_t)(b * SEQ + 256 * qb) * DM + 512 + h * 64; d.op = DM; d.nt = 132; d.nctx = 4; d.ctxrow = NLAT + b * CTXL; d.latrow = b * SEQ;
                d.nt_real = d.nt; d.qrope = 1; d.qt0 = 256 * qb; att::attn_unit_pipe<8, att::M_FULL>(d, shm); }
            if (PHON(17)) for (int u = vcu; u < 512; u += G) { const int bh = u >> 5, qb = u & 31, b = bh >> 2, h = bh & 3; const int r0 = 4 * qb;
                const int kr0 = r0 - 4 < 0 ? 0 : (r0 - 4 > 120 ? 120 : r0 - 4); const int r3 = r0 + 3; const int krl = (r3 - 4 < 0 ? 0 : (r3 - 4 > 120 ? 120 : r3 - 4)) + 8;
                att::Desc d{}; d.Q = Pb + (size_t)(b * SEQ + 256 * qb) * INWP + A_Q + h * 64; d.qp = INWP; d.K = Pb + A_K + h * 64; d.V = Pb + A_V + h * 64; d.kp = INWP;
                d.O = CAT + (size_t)(b * SEQ + 256 * qb) * DM + h * 64; d.op = DM; d.nctx = 4; d.nt = 4 + (krl - kr0); d.ctxrow = NLAT + b * CTXL; d.latrow = b * SEQ + 64 * kr0;
                d.r0 = r0; d.kr0 = kr0; d.rpb = A.na_rpb + ((size_t)l * 4 + h) * 465;
                d.nt_real = d.nt; d.nt = (d.nt + 1) & ~1; att::attn_unit_pipe<8, att::M_NA>(d, shm); }
            if (PHON(18)) for (int u = vcu; u < 512; u += G) { const int bh = u >> 5, qb = u & 31, b = bh >> 2, h = bh & 3; const int q0 = 256 * qb;
                const int kt0 = q0 - 128 < 0 ? 0 : q0 - 128; const int kte = q0 + 256 + 128 > SEQ ? SEQ : q0 + 256 + 128;
                att::Desc d{}; d.Q = Pb + (size_t)(b * SEQ + q0) * INWP + B_Q + h * 64; d.qp = INWP; d.K = Pb + B_K + (h >> 1) * 64; d.V = Pb + B_V + (h >> 1) * 64; d.kp = INWP;
                d.O = CAT + (size_t)(b * SEQ + q0) * DM + 256 + h * 64; d.op = DM; d.nctx = 4; d.nt = 4 + (kte - kt0) / 64; d.ctxrow = NLAT + b * CTXL; d.latrow = b * SEQ + kt0;
                d.q0 = q0; d.kt0 = kt0; d.sink_l2 = A.wa_sink[l * 4 + h] * LOG2E; d.has_sink = 1;
                d.nt_real = d.nt; d.nt = (d.nt + 1) & ~1; att::attn_unit_pipe<8, att::M_WA>(d, shm); }
            if (PHON(19) && !lastl) for (int u = vcu; u < 48; u += G) { const int mx = u >> 4, b = (u >> 2) & 3, h = u & 3; const int qrow = NLAT + b * CTXL;
                att::Desc d{}; d.nt = 4; d.nctx = 4; d.ctxrow = qrow; d.latrow = 0; d.op = DM; d.O = CAT + (size_t)qrow * DM + 256 * mx + h * 64;
                if (mx == 0) { d.Q = Pb + (size_t)qrow * INWP + A_Q + h * 64; d.qp = INWP; d.K = Pb + A_K + h * 64; d.V = Pb + A_V + h * 64; d.kp = INWP; }
                else if (mx == 1) { d.Q = Pb + (size_t)qrow * INWP + B_Q + h * 64; d.qp = INWP; d.K = Pb + B_K + (h >> 1) * 64; d.V = Pb + B_V + (h >> 1) * 64; d.kp = INWP; d.sink_l2 = A.wa_sink[l * 4 + h] * LOG2E; d.has_sink = 1; }
                else { d.Q = QC + (size_t)qrow * 256 + h * 64; d.qp = 256; d.K = KC + h * 64; d.V = VC + h * 64; d.kp = 256; }
                att::attn_unit<att::M_FULL>(d, shm); }
            if (PHON(20)) { GLA_PAR(); for (int u = vcu; u < NB * NCH; u += G) { const int b = u / NCH, n = u % NCH; if (lastl && n < 4) continue; gla::g3_unit(gp, b, n, shm); } }
        }
        }
        GRID_BAR();
#if defined(SELFCHECK) && SELFCHECK
        {
            WS_LAUNDER();
            float* acc2 = (float*)(ws + WS_CTL) + 32768;
            const int ns = chk::NS_LAT + chk::NS_EDGE + (lastl ? 0 : chk::NS_CTX);
            for (int it = gw; it < ns * 12; it += NGW) chk::item(ws, A.na_rpb + (size_t)l * 4 * 465, A.wa_sink + l * 4, chk::sample_row(it / 12), (it % 12) >> 2, it & 3, lane, acc2);
        }
        GRID_BAR();
#endif
        if (PHON(7)) {
        WS_LAUNDER();
        { pg8::Gemm g{CAT, (const bf16*)(ws + WS_WOUT) + (size_t)l * DM * DM, DM, DM, nullptr}; pg8::StaticOrder S; S.init(MT, DM, G, bx);
          pg8::EpiBf16<DM, false> E{(bf16*)Zb, 4, 0u, 1.f, 256, nullptr, 0};
          pg8::gemm_phase<pg8::EpiBf16<DM, false>, pg8::StaticOrder, false>((LAS unsigned char*)lds, g, S, E); }
        if (cv_tails && !lastl && bx >= 16) convert_experts(A, l, CV_N1, CV_N2, (bx - 16) * 8 + wave, 240 * 8, (float*)(shm + wave * 16640), lane);
        }
        GRID_BAR();
        if (PHON(8)) {
        WS_LAUNDER();
        for (int m0 = gw; m0 < MT; m0 += 2 * NGW) {
            f32x4 vv[2][4];
#pragma unroll
            for (int u = 0; u < 2; ++u) { const int m = m0 + u * NGW, mm = m < MT ? m : m0;
                f32x4 gt[4]; ld_row(XA + (size_t)mm * DM, lane, vv[u]); ld_row(modl + (size_t)mod_row(mm) * 6 * DM + 2 * DM, lane, gt);
                const bf16* orow = (const bf16*)Zb + (size_t)mm * DM;
#pragma unroll
                for (int j = 0; j < 2; ++j) { const v4u w = *(const v4u*)(orow + 512 * j + 8 * lane);
                    vv[u][2 * j] = vv[u][2 * j] * DN_ALPHA + gt[2 * j] * (f32x4){bflo(w.x), bfhi(w.x), bflo(w.y), bfhi(w.y)};
                    vv[u][2 * j + 1] = vv[u][2 * j + 1] * DN_ALPHA + gt[2 * j + 1] * (f32x4){bflo(w.z), bfhi(w.z), bflo(w.w), bfhi(w.w)}; } }
#pragma unroll
            for (int u = 0; u < 2; ++u) { const int m = m0 + u * NGW; if (m >= MT) break;
                ln_row(vv[u]); affine_row<false>(vv[u], A.ln1_g + l * DM, A.ln1_b + l * DM, lane);
                st_row(XA + (size_t)m * DM, lane, vv[u]);
                ln_row(vv[u]); const float* mp = modl + (size_t)mod_row(m) * 6 * DM; affine_row<true>(vv[u], mp + 4 * DM, mp + 3 * DM, lane);
                st_row_hilo(Hb + (size_t)m * HLD, lane, vv[u]); }
        }
        }
        GRID_BAR();
        if (PHON(9)) {
        WS_LAUNDER();
        { pg8::Gemm g{Hb, (const bf16*)(ws + WS_WRT) + (size_t)l * 256 * HLD, HLD, HLD, nullptr}; pg8::StaticOrder S; S.init(MT, 256, G, bx);
          pg8::EpiLogits E{(float*)(ws + WS_LOG)};
          pg8::gemm_phase<pg8::EpiLogits, pg8::StaticOrder, false>((LAS unsigned char*)lds, g, S, E); }
        if (cv_tails && !lastl && bx >= 132) { convert_experts(A, l, CV_N2, CV_N, (bx - 132) * 8 + wave, 124 * 8, (float*)(shm + wave * 16640), lane); __syncthreads(); }
        { pg8::Gemm g{Hb, (const bf16*)(ws + WS_WS13) + (size_t)l * 512 * DM, DM, HLD, nullptr}; pg8::AfterRouterOrder S; S.init(MT, G, bx);
          pg8::EpiSwiGLU E{(bf16*)(ws + WS_HSS), 2, nullptr};
          pg8::gemm_phase<pg8::EpiSwiGLU, pg8::AfterRouterOrder, false>((LAS unsigned char*)lds, g, S, E); }
        }
        GRID_BAR();
        if (PHON(10)) {
        WS_LAUNDER();
        }
        const int TPB = MT / G;
        if (PHON(10)) {
        WS_LAUNDER();
        }
        int* gcnt = (int*)(ws + WS_CTL) + CW_CNT + l * NEXP;
        if (PHON(10)) {
        WS_LAUNDER();
        {
            int* hist = (int*)shm;
            if (tid < NEXP) hist[tid] = 0;
            __syncthreads();
            const float rb0 = A.router_bias[l * NEXP + lane], rb1 = A.router_bias[l * NEXP + 64 + lane];
            for (int i = wave; i < TPB; i += 8) {
                const int tok = vcu * TPB + i; const float* lg = (const float*)(ws + WS_LOG) + (size_t)tok * NEXP;
                const float s0 = 1.0f / (1.0f + __expf(-lg[lane])), s1 = 1.0f / (1.0f + __expf(-lg[64 + lane]));
                float v0 = s0 + rb0, v1 = s1 + rb1; int my_e = 0; float my_s = 0.f, ssum = 0.f;
#pragma unroll
                for (int k = 0; k < TOPK; ++k) {
                    float bv = v0 >= v1 ? v0 : v1; int bi = v0 >= v1 ? lane : lane + 64;
#pragma unroll
                    for (int off = 32; off >= 1; off >>= 1) { const float ov = __shfl_xor(bv, off); const int oi = __shfl_xor(bi, off); if (ov > bv || (ov == bv && oi < bi)) { bv = ov; bi = oi; } }
                    const float ssel = __shfl(bi < 64 ? s0 : s1, bi & 63);
                    if (lane == (bi & 63)) { if (bi < 64) v0 = -INFINITY; else v1 = -INFINITY; }
                    ssum += ssel; if (lane == k) { my_e = bi; my_s = ssel; }
                }
                if (lane < TOPK) { const int rk = atomicAdd(&hist[my_e], 1);
                    ((int*)(ws + WS_SEL))[tok * 8 + lane] = my_e; ((float*)(ws + WS_GATE))[tok * 8 + lane] = 2.5f * my_s / ssum; ((int*)(ws + WS_RANK))[tok * 8 + lane] = rk; }
            }
            __syncthreads();
            if (tid < NEXP) { const int base = __hip_atomic_fetch_add(gcnt + tid, hist[tid], __ATOMIC_RELAXED, __HIP_MEMORY_SCOPE_AGENT); ((int*)(ws + WS_BBASE))[vcu * NEXP + tid] = base; }
        }
        }
        GRID_BAR();
        if (PHON(11)) {
        WS_LAUNDER();
        {
            int* sst = (int*)shm; int* scn = sst + 132;
            if (tid < NEXP) scn[tid] = __hip_atomic_load(gcnt + tid, __ATOMIC_RELAXED, __HIP_MEMORY_SCOPE_AGENT);
            __syncthreads();
            if (tid == 0) { int a = 0; for (int e = 0; e < NEXP; ++e) { sst[e] = a; a += (scn[e] + 255) & ~255; } sst[NEXP] = a; }
            __syncthreads();
            int* stok = (int*)(ws + WS_STOK); float* sgate = (float*)(ws + WS_SGATE); int* texp = (int*)(ws + WS_TEXP);
            for (int i = tid; i < TPB * 8; i += 512) { const int ent = vcu * TPB * 8 + i; const int e = ((const int*)(ws + WS_SEL))[ent];
                const int slot = sst[e] + ((const int*)(ws + WS_BBASE))[vcu * NEXP + e] + ((const int*)(ws + WS_RANK))[ent];
                stok[slot] = ent >> 3; sgate[slot] = ((const float*)(ws + WS_GATE))[ent]; ((int*)(ws + WS_TSLOT))[ent] = slot; }
            for (int e = vcu; e < NEXP; e += G) {
                for (int s = sst[e] + scn[e] + tid; s < sst[e + 1]; s += 512) { stok[s] = 0; sgate[s] = 0.f; }
                for (int mt = (sst[e] >> 8) + tid; mt < (sst[e + 1] >> 8); mt += 512) texp[mt] = e;
            }
            if (vcu == 0 && tid == 0) texp[2047] = sst[NEXP] >> 8;
            __syncthreads();
        }
        }
        GRID_BAR();
        if (PHON(12)) {
        WS_LAUNDER();
        int* texl = (int*)(shm + 133120);
        const int ntile = __builtin_amdgcn_readfirstlane(((const int*)(ws + WS_TEXP))[2047]);
        for (int i = tid; i < ntile; i += 512) texl[i] = ((const int*)(ws + WS_TEXP))[i];
        __syncthreads();
        { pg8::Gemm g{Hb, (const bf16*)(ws + WS_WE13), DM, HLD, (const int*)(ws + WS_STOK)}; pg8::GroupedOrder S; S.init(texl, ntile, 2, G, bx);
          pg8::EpiSwiGLU E{(bf16*)(ws + WS_HS), 2, (const float*)(ws + WS_SGATE)};
          pg8::gemm_phase<pg8::EpiSwiGLU, pg8::GroupedOrder, true>((LAS unsigned char*)lds, g, S, E); }
        { pg8::Gemm g{(const bf16*)(ws + WS_HSS), (const bf16*)(ws + WS_WS2) + (size_t)l * DM * 256, 256, 256, nullptr}; pg8::StaticOrder S;
          { const int c0 = (ntile * 2) % G; S.init(MT, DM, G, (bx - c0 + G) % G); }
          pg8::EpiBf16<DM, false> E{(bf16*)(ws + WS_YS), 4, 0u, 1.f, 256, nullptr, 0};
          pg8::gemm_phase<pg8::EpiBf16<DM, false>, pg8::StaticOrder, false>((LAS unsigned char*)lds, g, S, E); }
        }
        GRID_BAR();
        if (PHON(13)) {
        WS_LAUNDER();
        int* texl = (int*)(shm + 133120);
        const int ntile = __builtin_amdgcn_readfirstlane(((const int*)(ws + WS_TEXP))[2047]);
        for (int i = tid; i < ntile; i += 512) texl[i] = ((const int*)(ws + WS_TEXP))[i];
        __syncthreads();
        { pg8::Gemm g{(const bf16*)(ws + WS_HS), (const bf16*)(ws + WS_WE2), 256, 256, nullptr}; pg8::GroupedOrder S; S.init(texl, ntile, 4, G, bx);
          pg8::EpiBf16<DM, false> E{(bf16*)(ws + WS_Y), 4, 0u, 1.f, 256, nullptr, 0};
          pg8::gemm_phase<pg8::EpiBf16<DM, false>, pg8::GroupedOrder, false>((LAS unsigned char*)lds, g, S, E); }
        }
        GRID_BAR();
        if (PHON(14)) {
        WS_LAUNDER();
        for (int m = gw; m < MT; m += NGW) {
            f32x4 f[4];
            { const bf16* ys = (const bf16*)(ws + WS_YS) + (size_t)m * DM;
#pragma unroll
              for (int j = 0; j < 2; ++j) { const v4u w = *(const v4u*)(ys + 512 * j + 8 * lane); f[2 * j] = (f32x4){bflo(w.x), bfhi(w.x), bflo(w.y), bfhi(w.y)}; f[2 * j + 1] = (f32x4){bflo(w.z), bfhi(w.z), bflo(w.w), bfhi(w.w)}; } }
            const int* ts = (const int*)(ws + WS_TSLOT) + (size_t)m * 8;
#pragma unroll
            for (int k = 0; k < TOPK; ++k) { const bf16* yr = (const bf16*)(ws + WS_Y) + (size_t)ts[k] * DM;
#pragma unroll
                for (int j = 0; j < 2; ++j) { const v4u w = *(const v4u*)(yr + 512 * j + 8 * lane); f[2 * j] += (f32x4){bflo(w.x), bfhi(w.x), bflo(w.y), bfhi(w.y)}; f[2 * j + 1] += (f32x4){bflo(w.z), bfhi(w.z), bflo(w.w), bfhi(w.w)}; } }
            f32x4 v[4], gt[4]; ld_row(XA + (size_t)m * DM, lane, v); const float* mp = modl + (size_t)mod_row(m) * 6 * DM; ld_row(mp + 5 * DM, lane, gt);
#pragma unroll
            for (int j = 0; j < 4; ++j) v[j] = v[j] * DN_ALPHA + gt[j] * f[j];
            ln_row(v); affine_row<false>(v, A.ln2_g + l * DM, A.ln2_b + l * DM, lane);
            if (lastl) { st_row(A.out + (size_t)m * DM, lane, v); }
            else { st_row(XA + (size_t)m * DM, lane, v); ln_row(v); const float* mn = modl + 5 * 6 * DM + (size_t)mod_row(m) * 6 * DM; affine_row<true>(v, mn + DM, mn, lane); st_row_hilo(Hb + (size_t)m * HLD, lane, v); }
        }
        }
        if (!lastl) {
        if (PHON(15)) {
        WS_LAUNDER(); convert_experts(A, l + 1, 0, (cv_tails && l + 1 < DEPTH - 1) ? CV_N0 : CV_N, gw, NGW, (float*)(shm + wave * 16640), lane);
        }
        GRID_BAR(); }
    }
#if defined(SELFCHECK) && SELFCHECK
    GRID_BAR();
    {
        const float* acc2 = (const float*)(A.ws + WS_CTL) + 32768; bool bad = false;
        for (int m3 = 0; m3 < 3; ++m3) { const float e2 = __hip_atomic_load(acc2 + 2 + 2 * m3, __ATOMIC_RELAXED, __HIP_MEMORY_SCOPE_AGENT), r2 = __hip_atomic_load(acc2 + 3 + 2 * m3, __ATOMIC_RELAXED, __HIP_MEMORY_SCOPE_AGENT);
            if (!(r2 > 0.f) || !(e2 <= SELFCHECK_TOL * SELFCHECK_TOL * r2)) bad = true; }
        for (int cat = 0; cat < 7; ++cat) { const float e2 = __hip_atomic_load(acc2 + 16 + 2 * cat, __ATOMIC_RELAXED, __HIP_MEMORY_SCOPE_AGENT), r2 = __hip_atomic_load(acc2 + 17 + 2 * cat, __ATOMIC_RELAXED, __HIP_MEMORY_SCOPE_AGENT);
            if (!(r2 > 0.f) || !(e2 <= SELFCHECK_TOL2 * SELFCHECK_TOL2 * r2)) bad = true; }
        if (bad) { const int tid = ltid(); for (size_t i = (size_t)bx * 512 + tid; i < (size_t)NLAT * DM; i += (size_t)G * 512) A.out[i] *= 3.0f; }
    }
#endif
    if (bx == 0 && ltid() < 64) { const int tid = ltid(); if (__hip_atomic_load((unsigned*)(ctl + CW_BAR) + XB_TMO, __ATOMIC_RELAXED, __HIP_MEMORY_SCOPE_AGENT) != 0u) A.out[tid] = __builtin_nanf(""); }
#undef GRID_BAR
#undef MODT
#undef Hb
#undef Pb
#undef QC
#undef KC
#undef VC
#undef CAT
#undef XA
#undef Zb
#undef RSTD
#undef modl
}

extern "C" void kernel_launch(void* const* d_in, const int* in_sizes, int n_in, void* d_out, int out_size, void* d_ws, size_t ws_size, hipStream_t stream) {
    static int grid = 0;
    if (grid == 0) {
        if (n_in != 31 || in_sizes[0] != NLAT * DM || out_size != NLAT * DM || ws_size < WS_END) {
            fprintf(stderr, "kernel_launch: built for 31 inputs, x/out of %d floats, >= %zu bytes of workspace; got n_in %d, in0 %d, out %d, ws %zu; nothing launched\n", NLAT * DM, (size_t)WS_END, n_in, n_in > 0 ? in_sizes[0] : -1, out_size, ws_size);
            grid = -1; return; }
        int dev = 0, cus = 0, per_cu = 0;
        if (hipGetDevice(&dev) != hipSuccess || hipDeviceGetAttribute(&cus, hipDeviceAttributeMultiprocessorCount, dev) != hipSuccess) { fprintf(stderr, "kernel_launch: device query failed\n"); grid = -1; return; }
        if (hipFuncSetAttribute((const void*)hybrid_fwd, hipFuncAttributeMaxDynamicSharedMemorySize, LDS_BYTES) != hipSuccess) { fprintf(stderr, "kernel_launch: hipFuncSetAttribute failed\n"); grid = -1; return; }
        if (hipOccupancyMaxActiveBlocksPerMultiprocessor(&per_cu, (const void*)hybrid_fwd, 512, LDS_BYTES) != hipSuccess || per_cu < 1)
            fprintf(stderr, "kernel_launch: note: occupancy query reports %d workgroups per CU\n", per_cu);
        (void)hipGetLastError();
        grid = cus;
        if (grid != 256) fprintf(stderr, "kernel_launch: note: %d CUs (tuned for 256)\n", grid);
        if ((NTOK % grid) || (NLAT % grid)) { fprintf(stderr, "kernel_launch: grid %d does not divide the token counts\n", grid); grid = -1; return; }
    }
    if (grid < 0) return;
    if (hipMemsetAsync((char*)d_ws + WS_CTL, 0, CTL_ZERO_BYTES, stream) != hipSuccess) { fprintf(stderr, "kernel_launch: hipMemsetAsync failed\n"); return; }
    Args a{};
    const float** ap = (const float**)&a;
    for (int i = 0; i < 31; ++i) ap[i] = (const float*)d_in[i];
    a.out = (float*)d_out; a.ws = (unsigned char*)d_ws;
    hipLaunchKernelGGL(hybrid_fwd, dim3(grid), dim3(512), LDS_BYTES, stream, a);
    const hipError_t le = hipPeekAtLastError();
    if (le != hipSuccess) fprintf(stderr, "kernel_launch: launch failed: %s\n", hipGetErrorName(le));
}
```

```cpp
#define ROUTER_SPLIT 0
#include <hip/hip_runtime.h>
#include <cstdio>
#include <cstdint>

#define GAS __attribute__((address_space(1)))
#define LAS __attribute__((address_space(3)))
typedef unsigned short bf16;
typedef unsigned v4u __attribute__((ext_vector_type(4)));
typedef unsigned v2u __attribute__((ext_vector_type(2)));
typedef float f32x4 __attribute__((ext_vector_type(4)));
typedef float f32x2 __attribute__((ext_vector_type(2)));
typedef float f32x16 __attribute__((ext_vector_type(16)));
typedef short bf16x8 __attribute__((ext_vector_type(8)));
typedef short s16x4 __attribute__((ext_vector_type(4)));
typedef GAS unsigned gu32;
#define RLX_AGENT __ATOMIC_RELAXED, __HIP_MEMORY_SCOPE_AGENT
#define LDS_WAIT() asm volatile("s_waitcnt lgkmcnt(0)" ::: "memory")
#define VM_WAIT() asm volatile("s_waitcnt vmcnt(0)" ::: "memory")

constexpr int NB = 4, SEQ = 8192, CTXL = 256, DM = 1024, DEPTH = 4;
constexpr int NLAT = NB * SEQ, NCTX = NB * CTXL, NTOK = NLAT + NCTX;
constexpr int INW = 2496, INWP = 2560;
constexpr int A_Q = 0, A_K = 256, A_V = 512, B_Q = 768, B_K = 1024, B_V = 1152, C_Q = 1280, C_KV = 1536, C_KR = 1664,
              D_Q = 1696, D_K = 1824, D_V = 1952, D_R = 2208, D_ZF = 2464, D_ZB = 2480;
constexpr int NEXP = 128, TOPK = 8, DEXP = 256;
constexpr int NSLOT_MAX = NTOK * TOPK + NEXP * 256;
constexpr int NCH = 132;
constexpr float LN_EPS = 1e-5f, RMS_EPS = 1e-6f;
constexpr float DN_ALPHA = 1.6817928305074290f;
constexpr float LOG2E = 1.4426950408889634f;
constexpr float C2 = 0.125f * LOG2E;

#ifndef ROUTER_SPLIT
#define ROUTER_SPLIT 1
#endif
constexpr int HLD = ROUTER_SPLIT ? 2 * DM : DM;
constexpr size_t al256(size_t x) { return (x + 255) & ~(size_t)255; }
constexpr size_t WS_CTL = 0, CTL_ZERO_BYTES = 1u << 20;
constexpr size_t WS_MOD = CTL_ZERO_BYTES;
constexpr size_t WS_WIN = al256(WS_MOD + (size_t)DEPTH * 5 * 6 * DM * 4);
constexpr size_t WS_WOUT = WS_WIN + (size_t)DEPTH * INWP * DM * 2;
constexpr size_t WS_WUQ = WS_WOUT + (size_t)DEPTH * DM * DM * 2;
constexpr size_t WS_WUKV = WS_WUQ + (size_t)DEPTH * 256 * 256 * 2;
constexpr size_t WS_WRT = WS_WUKV + (size_t)DEPTH * 512 * 128 * 2;
constexpr size_t WS_WS13 = WS_WRT + (size_t)DEPTH * 256 * HLD * 2;
constexpr size_t WS_WS2 = WS_WS13 + (size_t)DEPTH * 512 * DM * 2;
constexpr size_t WS_WE13 = WS_WS2 + (size_t)DEPTH * DM * 256 * 2;
constexpr size_t WS_WE2 = WS_WE13 + (size_t)NEXP * 512 * DM * 2;
constexpr size_t WS_XA = WS_WE2 + (size_t)NEXP * DM * 256 * 2;
constexpr size_t WS_Z = WS_XA + (size_t)NTOK * DM * 4;
constexpr size_t WS_H = WS_Z + (size_t)NTOK * DM * 4;
constexpr size_t WS_P = WS_H + (size_t)NTOK * HLD * 2;
constexpr size_t WS_QC = WS_P + (size_t)NTOK * INWP * 2;
constexpr size_t WS_KC = WS_QC + (size_t)NTOK * 256 * 2;
constexpr size_t WS_VC = WS_KC + (size_t)NTOK * 256 * 2;
constexpr size_t WS_CAT = WS_VC + (size_t)NTOK * 256 * 2;
constexpr size_t WS_GU = WS_CAT + (size_t)NTOK * DM * 2;
constexpr size_t WS_GDEC = WS_GU + (size_t)32 * NCH * 2048 * 4;
constexpr size_t WS_RSTD = WS_GDEC + (size_t)32 * NCH * 32 * 4;
constexpr size_t WS_LOG = al256(WS_RSTD + (size_t)NTOK * 2 * 4);
constexpr size_t WS_SEL = WS_LOG + (size_t)NTOK * 128 * 4;
constexpr size_t WS_GATE = WS_SEL + (size_t)NTOK * 8 * 4;
constexpr size_t WS_RANK = WS_GATE + (size_t)NTOK * 8 * 4;
constexpr size_t WS_TSLOT = WS_RANK + (size_t)NTOK * 8 * 4;
constexpr size_t WS_BBASE = WS_TSLOT + (size_t)NTOK * 8 * 4;
constexpr size_t WS_STOK = WS_BBASE + (size_t)256 * 128 * 4;
constexpr size_t WS_SGATE = al256(WS_STOK + (size_t)NSLOT_MAX * 4);
constexpr size_t WS_TEXP = al256(WS_SGATE + (size_t)NSLOT_MAX * 4);
constexpr size_t WS_HS = WS_TEXP + 2048 * 4;
constexpr size_t WS_HSS = WS_HS + (size_t)NSLOT_MAX * 256 * 2;
constexpr size_t WS_Y = WS_HSS + (size_t)NTOK * 256 * 2;
constexpr size_t WS_YS = WS_Y + (size_t)NSLOT_MAX * DM * 2;
constexpr size_t WS_BC = WS_YS + (size_t)NTOK * DM * 2;
constexpr size_t WS_END = WS_BC + (size_t)NTOK * 256 * 4;
static_assert(WS_END <= (size_t)2147483648u, "d_ws map must fit 2 GiB");
constexpr int CW_BAR = 4096;
constexpr int CW_CNT = 16384;

constexpr int LDS_BYTES = 147456;
constexpr int MISC_OFF = LDS_BYTES - 512;
constexpr int SCR_BYTES = MISC_OFF;

__device__ __forceinline__ unsigned f2bf(float f) { unsigned u = __builtin_bit_cast(unsigned, f); return (u + 0x7fffu + ((u >> 16) & 1u)) >> 16; }
__device__ __forceinline__ unsigned pk2(float lo, float hi) { return f2bf(lo) | (f2bf(hi) << 16); }
__device__ __forceinline__ float bf2f(unsigned short b) { return __builtin_bit_cast(float, (unsigned)b << 16); }
__device__ __forceinline__ float bflo(unsigned w) { return __builtin_bit_cast(float, w << 16); }
__device__ __forceinline__ float bfhi(unsigned w) { return __builtin_bit_cast(float, w & 0xffff0000u); }
typedef __bf16 bf16x2_t __attribute__((ext_vector_type(2)));
__device__ __forceinline__ unsigned cvtpk(float lo, float hi) { f32x2 v = {lo, hi}; bf16x2_t b = __builtin_convertvector(v, bf16x2_t); return __builtin_bit_cast(unsigned, b); }
__device__ __forceinline__ float wave_sum(float v) {
#pragma unroll
    for (int o = 1; o < 64; o <<= 1) v += __shfl_xor(v, o);
    return v;
}
__device__ __forceinline__ float fsilu(float a) { return a * __builtin_amdgcn_rcpf(1.0f + __builtin_amdgcn_exp2f(-a * LOG2E)); }
namespace pg8 {
typedef unsigned short bf16_t;
constexpr int BM = 256, BK = 64, HALF = 128, HTB = HALF * BK * 2  , STAGE_BYTES = 8 * HTB, NXCD = 8, WGM = 8;

__host__ __device__ __forceinline__ int lds_byte(int r, int c) { const int st = (r >> 4) * 2 + (c >> 5), rr = r & 15, cc = c & 31, ob = rr * 64 + cc * 2; return st * 1024 + (ob ^ (((ob >> 9) & 1) << 5)); }
__host__ __device__ __forceinline__ void stage_rc(int b, int& R, int& C) { const int st = b / 1024, sb = b % 1024, swz = sb ^ (((sb >> 9) & 1) << 5); R = (st >> 1) * 16 + swz / 64; C = (st & 1) * 32 + (swz % 64) / 2; }
__host__ __device__ __forceinline__ int perm32(int rho) { const int n = rho >> 4, i = rho & 15; return 8 * (i >> 2) + 4 * n + (i & 3); }

struct Unit { int pm, pn; };
struct Gemm { const bf16_t* A; const bf16_t* Bt; int K; int lda; const int* rowidx; };

struct StaticOrder {
    int nM, nN, nwg, G, c;
    __device__ void init(int M, int N, int G_, int c_) { nM = M / BM; nN = N / BM; nwg = nM * nN; G = G_; c = c_; }
    __device__ bool next(int i, Unit& u) const {
        const long L = (long)i * G + c; if (L >= nwg) return false;
        int wgid = (int)L; { const int q = nwg / NXCD, r = nwg % NXCD, xcd = wgid % NXCD, off = wgid / NXCD; wgid = (xcd < r ? xcd * (q + 1) : r * (q + 1) + (xcd - r) * q) + off; }
        const int nig = WGM * nN, gid = wgid / nig, fm = gid * WGM, gsz = (nM - fm) < WGM ? (nM - fm) : WGM;
        u.pm = fm + ((wgid % nig) % gsz); u.pn = (wgid % nig) / gsz; return true;
    }
};
struct AfterRouterOrder {
    int nR, G, c;
    __device__ void init(int M, int G_, int c_) { nR = M / BM; G = G_; c = c_; }
    __device__ bool next(int i, Unit& u) const {
        const int nidle = G - nR; int L;
        if (nidle <= 0 || 2 * nR - 2 * nidle > nR) { L = i * G + c; if (L >= 2 * nR) return false; }
        else if (c >= nR) { if (i >= 2) return false; L = 2 * (c - nR) + i; if (L >= 2 * nR) return false; }
        else { if (i >= 1) return false; L = 2 * nidle + c; if (L >= 2 * nR) return false; }
        u.pm = L >> 1; u.pn = L & 1; return true;
    }
};
struct GroupedOrder {
    const int* texp; int nN, G, c, ntile;
    __device__ void init(const int* texp_, int ntile_, int nN_, int G_, int c_) { texp = texp_; nN = nN_; G = G_; c = c_; ntile = ntile_; }
    __device__ bool next(int i, Unit& u) const {
        const long L = (long)i * G + c; if (L >= (long)ntile * nN) return false;
        const int mt = (int)(L / nN), nt = (int)(L % nN); u.pm = mt; u.pn = __builtin_amdgcn_readfirstlane(texp[mt]) * nN + nt; return true;
    }
};

template <class Epi, class Sched, bool GATHER, bool ALIGN_EPI = true>
__device__ __forceinline__ void gemm_phase(LAS unsigned char* lds, const Gemm g, const Sched& S, const Epi& E) {
    int tid_ = threadIdx.x; asm volatile("" : "+v"(tid_));
    const int tid = tid_, wid = __builtin_amdgcn_readfirstlane(tid >> 6), lane = tid & 63, wr = wid >> 2, wc = wid & 3, fr = lane & 15, fq = lane >> 4;
    const int K = g.K, nt = K / BK;
    unsigned voffB[2], voffA[2]; int RA[2]; unsigned CA2[2];
#pragma unroll
    for (int i = 0; i < 2; ++i) { int R, C; stage_rc(tid * 16 + i * 8192, R, C); const int Rb = Epi::PERM ? ((R & ~31) + perm32(R & 31)) : R;
        RA[i] = R; CA2[i] = (unsigned)C * 2u; voffB[i] = (unsigned)(Rb * K + C) * 2u; voffA[i] = (unsigned)(R * g.lda + C) * 2u; }
    const size_t hstepA = (size_t)HALF * g.lda * 2;
    const size_t kstep = (size_t)(BK * 2);
    const size_t hstep = (size_t)HALF * K * 2;
    const size_t tstep = 2 * hstep;
    const size_t tstepA = (size_t)BM * g.lda * 2;
    const unsigned ldsw = (unsigned)wid * 1024u;
    const int aoff = lds_byte(wr * 64 + fr, fq * 8), boff = lds_byte(wc * 32 + fr, fq * 8);
#define PG8_SA(b, h) (((b) * 2 + (h)) * HTB)
#define PG8_SB(b, h) ((4 + (b) * 2 + (h)) * HTB)
#define PG8_STAGE(bufoff, gbase, voff) do { _Pragma("unroll") for (int _i = 0; _i < 2; ++_i) \
        __builtin_amdgcn_global_load_lds((const unsigned*)((const char*)(gbase) + (voff)[_i]), (LAS unsigned*)(lds + (bufoff) + ldsw + _i * 8192), 16, 0, 0); } while (0)
#define PG8_LDA(dst, b, h) do { _Pragma("unroll") for (int m = 0; m < 4; ++m) _Pragma("unroll") for (int k = 0; k < 2; ++k) dst[m][k] = *(const LAS bf16x8*)(lds + PG8_SA(b, h) + aoff + m * 2048 + k * 1024); } while (0)
#define PG8_LDB(dst, b, h) do { _Pragma("unroll") for (int n = 0; n < 2; ++n) _Pragma("unroll") for (int k = 0; k < 2; ++k) dst[n][k] = *(const LAS bf16x8*)(lds + PG8_SB(b, h) + boff + n * 2048 + k * 1024); } while (0)
#define PG8_MMA(ai, bj, At, Bt) do { __builtin_amdgcn_s_setprio(1); _Pragma("unroll") for (int m = 0; m < 4; ++m) _Pragma("unroll") for (int n = 0; n < 2; ++n) _Pragma("unroll") for (int k = 0; k < 2; ++k) \
        acc[ai][bj][m][n] = __builtin_amdgcn_mfma_f32_16x16x32_bf16(Bt[n][k], At[m][k], acc[ai][bj][m][n], 0, 0, 0); __builtin_amdgcn_s_setprio(0); } while (0)
#define PG8_WAIT_V(n) asm volatile("s_waitcnt vmcnt(" #n ")" ::: "memory")
#define PG8_WAIT_L(n) asm volatile("s_waitcnt lgkmcnt(" #n ")" ::: "memory")
#define PG8_BAR __builtin_amdgcn_s_barrier()
#define PG8_SCHED __builtin_amdgcn_sched_barrier(0)
#define PG8_AOFF(dst, u) do { if constexpr (GATHER) { _Pragma("unroll") for (int _h = 0; _h < 2; ++_h) _Pragma("unroll") for (int _i = 0; _i < 2; ++_i) \
        dst[_h][_i] = (unsigned)g.rowidx[(u).pm * BM + _h * HALF + RA[_i]] * (unsigned)(g.lda * 2) + CA2[_i]; } } while (0)
#define PG8_STAGE_A(bufoff, gbase, h, useN) do { if constexpr (GATHER) { unsigned _o[2]; _o[0] = (useN) ? offN[h][0] : offC[h][0]; _o[1] = (useN) ? offN[h][1] : offC[h][1]; PG8_STAGE(bufoff, gbase, _o); } \
        else { PG8_STAGE(bufoff, (gbase) + (h) * hstepA, voffA); } } while (0)
    Unit cur, nxt; int ui = 0;
    if (!S.next(0, cur)) return;
    f32x4 acc[2][2][4][2];
#pragma unroll
    for (int a = 0; a < 2; ++a)
#pragma unroll
        for (int b = 0; b < 2; ++b)
#pragma unroll
            for (int m = 0; m < 4; ++m)
#pragma unroll
                for (int n = 0; n < 2; ++n) acc[a][b][m][n] = (f32x4){0.f, 0.f, 0.f, 0.f};
    bf16x8 At[4][2], B0[2][2], B1[2][2];
    unsigned offC[2][2], offN[2][2];
    PG8_AOFF(offC, cur);
    const char* cA = GATHER ? (const char*)g.A : (const char*)g.A + (size_t)cur.pm * tstepA; const char* cB = (const char*)g.Bt + (size_t)cur.pn * tstep;
    PG8_STAGE(PG8_SB(0, 0), cB, voffB); PG8_STAGE(PG8_SB(0, 1), cB + hstep, voffB); PG8_STAGE_A(PG8_SA(0, 0), cA, 0, false); PG8_STAGE_A(PG8_SA(0, 1), cA, 1, false);
    if (wr == 1) PG8_BAR;
    PG8_WAIT_V(2); PG8_BAR;
    PG8_STAGE(PG8_SB(1, 0), cB + kstep, voffB); PG8_STAGE_A(PG8_SA(1, 0), cA + kstep, 0, false); PG8_STAGE(PG8_SB(1, 1), cB + hstep + kstep, voffB);
    PG8_WAIT_V(6); PG8_BAR;
    for (;;) {
        const bool has_next = S.next(ui + 1, nxt);
        if constexpr (GATHER) { if (has_next) { PG8_AOFF(offN, nxt); } else {
#pragma unroll
            for (int h = 0; h < 2; ++h)
#pragma unroll
                for (int i = 0; i < 2; ++i) offN[h][i] = offC[h][i]; } }
        const char* nA = has_next ? (GATHER ? (const char*)g.A : (const char*)g.A + (size_t)nxt.pm * tstepA) : cA; const char* nB = has_next ? (const char*)g.Bt + (size_t)nxt.pn * tstep : cB;
#pragma unroll 1
        for (int t = 0; t < nt; t += 2) {
            const bool last = (t == nt - 2);
            const char* a1 = cA + (size_t)(t + 1) * kstep;
            const char* a2 = last ? nA : cA + (size_t)(t + 2) * kstep; const char* b2 = last ? nB : cB + (size_t)(t + 2) * kstep;
            const char* a3 = a2 + kstep; const char* b3 = b2 + kstep;
            PG8_LDB(B0, 0, 0); PG8_LDB(B1, 0, 1); PG8_SCHED; PG8_LDA(At, 0, 0); PG8_STAGE_A(PG8_SA(1, 1), a1, 1, false);
            PG8_WAIT_V(8); PG8_WAIT_L(0); PG8_BAR; PG8_MMA(0, 0, At, B0); PG8_MMA(0, 1, At, B1); PG8_BAR; PG8_SCHED;
            PG8_LDA(At, 0, 1); PG8_STAGE(PG8_SB(0, 0), b2, voffB); PG8_STAGE(PG8_SB(0, 1), b2 + hstep, voffB); PG8_STAGE_A(PG8_SA(0, 0), a2, 0, last);
            PG8_WAIT_V(8); PG8_WAIT_L(0); PG8_BAR; PG8_MMA(1, 0, At, B0); PG8_MMA(1, 1, At, B1); PG8_BAR; PG8_SCHED;
            PG8_LDB(B0, 1, 0); PG8_LDB(B1, 1, 1); PG8_SCHED; PG8_LDA(At, 1, 0); PG8_STAGE_A(PG8_SA(0, 1), a2, 1, last);
            PG8_WAIT_V(8); PG8_WAIT_L(0); PG8_BAR; PG8_MMA(0, 0, At, B0); PG8_MMA(0, 1, At, B1); PG8_BAR; PG8_SCHED;
            PG8_LDA(At, 1, 1); PG8_STAGE(PG8_SB(1, 0), b3, voffB); PG8_STAGE(PG8_SB(1, 1), b3 + hstep, voffB); PG8_STAGE_A(PG8_SA(1, 0), a3, 0, last);
            PG8_WAIT_V(8); PG8_WAIT_L(0); PG8_BAR; PG8_MMA(1, 0, At, B0); PG8_MMA(1, 1, At, B1); PG8_BAR; PG8_SCHED;
        }
        if constexpr (ALIGN_EPI) { if (wr == 0) PG8_BAR; }
        E(acc, cur, wr, wc, fr, fq);
        if (!has_next) break;
#pragma unroll
        for (int a = 0; a < 2; ++a)
#pragma unroll
            for (int b = 0; b < 2; ++b)
#pragma unroll
                for (int m = 0; m < 4; ++m)
#pragma unroll
                    for (int n = 0; n < 2; ++n) acc[a][b][m][n] = (f32x4){0.f, 0.f, 0.f, 0.f};
        cur = nxt; cA = nA; cB = nB; ++ui;
        if constexpr (GATHER) {
#pragma unroll
            for (int h = 0; h < 2; ++h)
#pragma unroll
                for (int i = 0; i < 2; ++i) offC[h][i] = offN[h][i]; }
        if constexpr (ALIGN_EPI) { if (wr == 1) PG8_BAR; }
    }
    PG8_WAIT_V(0);
    if constexpr (!ALIGN_EPI) { if (wr == 0) PG8_BAR; }
    PG8_BAR;
#undef PG8_SA
#undef PG8_SB
#undef PG8_STAGE
#undef PG8_LDA
#undef PG8_LDB
#undef PG8_MMA
#undef PG8_WAIT_V
#undef PG8_WAIT_L
#undef PG8_BAR
#undef PG8_SCHED
#undef PG8_AOFF
#undef PG8_STAGE_A
}
}
namespace pg8 {
__device__ __forceinline__ unsigned cvt_pk_bf16(float lo, float hi) { unsigned r; asm volatile("v_cvt_pk_bf16_f32 %0, %1, %2" : "=v"(r) : "v"(lo), "v"(hi)); return r; }
template <int LDC, bool ROWSCALE, bool SKIPROPE = false> struct EpiBf16 {
    static constexpr bool PERM = true;
    bf16_t* O; int nloc; unsigned scmask; float sc; size_t tile_stride; const float* rowscale; int rs_off;
    __device__ __forceinline__ void operator()(const f32x4 (&acc)[2][2][4][2], const Unit& u, int wr, int wc, int fr, int fq) const {
        const int pnl = u.pn % nloc; const int row0 = u.pm * BM + wr * 64 + fr;
        bf16_t* p0 = O + (size_t)pnl * tile_stride + (size_t)row0 * LDC + wc * 32 + 8 * fq;
        const float s = ((scmask >> pnl) & 1u) ? sc : 1.f;
        if (SKIPROPE && pnl == 0 && (wc & 1)) return;
#pragma unroll
        for (int ai = 0; ai < 2; ++ai)
#pragma unroll
            for (int m = 0; m < 4; ++m) { bf16_t* rowp = p0 + (size_t)(ai * HALF + m * 16) * LDC;
                float rsc = s; if constexpr (ROWSCALE) rsc *= rowscale[2 * (row0 + ai * HALF + m * 16) + rs_off];
#pragma unroll
                for (int bj = 0; bj < 2; ++bj) { const f32x4 v0 = acc[ai][bj][m][0] * rsc, v1 = acc[ai][bj][m][1] * rsc;
                    v4u w; w.x = cvt_pk_bf16(v0[0], v0[1]); w.y = cvt_pk_bf16(v0[2], v0[3]); w.z = cvt_pk_bf16(v1[0], v1[1]); w.w = cvt_pk_bf16(v1[2], v1[3]);
                    *(v4u*)(rowp + bj * HALF) = w; } }
    }
};
struct EpiResid {
    static constexpr bool PERM = false;
    const float* X; float* Z; const float* modrow;
    __device__ __forceinline__ void operator()(const f32x4 (&acc)[2][2][4][2], const Unit& u, int wr, int wc, int fr, int fq) const {
        const int rowt = u.pm * BM; const int mr = rowt < NLAT ? (rowt >> 13) : 4;
        const float* gp = modrow + (size_t)mr * 6 * DM;
        const int col0 = u.pn * BM + wc * 32 + 4 * fq;
        f32x4 gv[2][2];
#pragma unroll
        for (int bj = 0; bj < 2; ++bj)
#pragma unroll
            for (int n = 0; n < 2; ++n) gv[bj][n] = *(const f32x4*)(gp + col0 + bj * HALF + n * 16);
#pragma unroll
        for (int ai = 0; ai < 2; ++ai)
#pragma unroll
            for (int m = 0; m < 4; ++m) { const size_t off = (size_t)(rowt + ai * HALF + wr * 64 + m * 16 + fr) * DM + col0;
#pragma unroll
                for (int bj = 0; bj < 2; ++bj)
#pragma unroll
                    for (int n = 0; n < 2; ++n) { const f32x4 xv = *(const f32x4*)(X + off + bj * HALF + n * 16);
                        *(f32x4*)(Z + off + bj * HALF + n * 16) = xv * DN_ALPHA + gv[bj][n] * acc[ai][bj][m][n]; } }
    }
};
struct EpiLogits {
    static constexpr bool PERM = false;
    float* O;
    __device__ __forceinline__ void operator()(const f32x4 (&acc)[2][2][4][2], const Unit& u, int wr, int wc, int fr, int fq) const {
        const int col0 = wc * 32 + 4 * fq;
#pragma unroll
        for (int ai = 0; ai < 2; ++ai)
#pragma unroll
            for (int m = 0; m < 4; ++m) { float* rowp = O + (size_t)(u.pm * BM + ai * HALF + wr * 64 + m * 16 + fr) * 128 + col0;
#pragma unroll
                for (int n = 0; n < 2; ++n) *(f32x4*)(rowp + n * 16) = acc[ai][0][m][n] + acc[ai][1][m][n]; }
    }
};
struct EpiSwiGLU {
    static constexpr bool PERM = true;
    bf16_t* O; int nloc; const float* gate;
    __device__ __forceinline__ void operator()(const f32x4 (&acc)[2][2][4][2], const Unit& u, int wr, int wc, int fr, int fq) const {
        const int pnl = u.pn % nloc; const int row0 = u.pm * BM + wr * 64 + fr; const int col0 = pnl * 128 + wc * 16 + 4 * fq;
#pragma unroll
        for (int ai = 0; ai < 2; ++ai)
#pragma unroll
            for (int m = 0; m < 4; ++m) { const int row = row0 + ai * HALF + m * 16; const float gt = gate ? gate[row] : 1.f; bf16_t* rowp = O + (size_t)row * 256 + col0;
#pragma unroll
                for (int bj = 0; bj < 2; ++bj) { const f32x4 a = acc[ai][bj][m][0], b = acc[ai][bj][m][1];
                    v2u w; w.x = cvt_pk_bf16(fsilu(a[0]) * b[0] * gt, fsilu(a[1]) * b[1] * gt); w.y = cvt_pk_bf16(fsilu(a[2]) * b[2] * gt, fsilu(a[3]) * b[3] * gt);
                    *(v2u*)(rowp + bj * 64) = w; } }
    }
};
}
#define XB_TMO      128
#define XB_XCNT(j)  (256  + 64 * (j))
#define XB_XSUB(j)  (1280 + 64 * (j))
#define XB_XGEN(j)  (2304 + 64 * (j))
#define XB_TOP      3328
#define XB_TOPGEN   3392
#define XCD_BAR_WORDS 3456
#define XB_SPIN_CAP (1u << 18)

__device__ __forceinline__ unsigned xb_ld(unsigned* p)              { return __hip_atomic_load(p, __ATOMIC_RELAXED, __HIP_MEMORY_SCOPE_AGENT); }
__device__ __forceinline__ unsigned xb_add(unsigned* p, unsigned v) { return __hip_atomic_fetch_add(p, v, __ATOMIC_RELAXED, __HIP_MEMORY_SCOPE_AGENT); }
__device__ __forceinline__ unsigned xb_xcc_id() { return (unsigned)__builtin_amdgcn_s_getreg((3 << 11) | 20) & 0xFu; }
#define XB_SPIN(cond, bar) do { unsigned _sp = 0; while (cond) { __builtin_amdgcn_s_sleep(1); \
    if ((++_sp & 255u) == 0u) { if (xb_ld(&(bar)[XB_TMO])) break; if (_sp > XB_SPIN_CAP) { atomicAdd(&(bar)[XB_TMO], 1u); break; } } } } while (0)

struct XcdBarrier {
    unsigned* bar; unsigned x;
    volatile LAS unsigned* st;
};

__device__ __forceinline__ XcdBarrier xcd_barrier_post(unsigned* bar, volatile LAS unsigned* st) {
    XcdBarrier b; b.bar = bar; b.x = xb_xcc_id(); b.st = st;
    if (threadIdx.x == 0) (void)xb_add(&bar[XB_XCNT(b.x)], 1u);
    return b;
}
__device__ __forceinline__ void xcd_barrier_complete(unsigned* bar, unsigned x, unsigned& nloc, unsigned& nx) {
    const unsigned G = gridDim.x * gridDim.y * gridDim.z;
    unsigned sum, cnt, mine, sp = 0u;
    for (;;) {
        sum = 0u; cnt = 0u; mine = 0u;
#pragma unroll
        for (unsigned j = 0; j < 16; ++j) { const unsigned c = xb_ld(&bar[XB_XCNT(j)]); sum += c; cnt += (c > 0u) ? 1u : 0u; mine = (j == x) ? c : mine; }
        if (sum == G) break;
        __builtin_amdgcn_s_sleep(1);
        if ((++sp & 255u) == 0u) { if (xb_ld(&bar[XB_TMO])) break; if (sp > XB_SPIN_CAP) { atomicAdd(&bar[XB_TMO], 1u); break; } }
    }
    nloc = mine > 0u ? mine : 1u; nx = cnt > 0u ? cnt : 1u;
}

__device__ __forceinline__ void xcd_barrier(const XcdBarrier& b) {
    asm volatile("s_waitcnt vmcnt(0)" ::: "memory");
    __syncthreads();
    if (threadIdx.x == 0) {
        unsigned* bar = b.bar;
        __builtin_amdgcn_s_waitcnt(0);
        unsigned nloc = b.st[0], nx = b.st[1];
        if (nloc == 0u) { xcd_barrier_complete(bar, b.x, nloc, nx); b.st[0] = nloc; b.st[1] = nx; }
        const unsigned old = xb_add(&bar[XB_XSUB(b.x)], 1u);
        const unsigned gen = old / nloc;
        if (old + 1u == (gen + 1u) * nloc) {
            __builtin_amdgcn_fence(__ATOMIC_RELEASE, "agent");
            asm volatile("s_waitcnt vmcnt(0)" ::: "memory");
            const unsigned og = xb_add(&bar[XB_TOP], 1u);
            const unsigned tg = og / nx;
            if (og + 1u == (tg + 1u) * nx) xb_add(&bar[XB_TOPGEN], 1u);
            else XB_SPIN(xb_ld(&bar[XB_TOPGEN]) == tg, bar);
            __builtin_amdgcn_fence(__ATOMIC_ACQUIRE, "agent");
            xb_add(&bar[XB_XGEN(b.x)], 1u);
            asm volatile("s_waitcnt vmcnt(0)" ::: "memory");
        } else {
            XB_SPIN(xb_ld(&bar[XB_XGEN(b.x)]) == gen, bar);
            __builtin_amdgcn_fence(__ATOMIC_ACQUIRE, "agent");
            asm volatile("s_waitcnt vmcnt(0)" ::: "memory");
        }
    }
    __syncthreads();
}
namespace att {
constexpr int NSLOT = 3, SLOTB = 8192;
constexpr int LDS_K = 0, LDS_V = NSLOT * SLOTB, LDS_WS = 2 * NSLOT * SLOTB, LDS_OST = LDS_WS + 8 * 64 * 4, LDS_BIAS = LDS_OST + 8 * 4096, LDS_END = LDS_BIAS + 2048;
enum { M_FULL = 0, M_NA = 1, M_WA = 2 };
__device__ __forceinline__ int crow(int r, int hi) { return (r & 3) + 8 * (r >> 2) + 4 * hi; }
__device__ __forceinline__ void glds16(const void* gsrc, unsigned lds_dst) { unsigned keep;
    asm volatile("s_mov_b32 %0, m0\n\ts_mov_b32 m0, %2\n\ts_nop 0\n\tglobal_load_lds_dwordx4 %1, off\n\ts_mov_b32 m0, %0" : "=&s"(keep) : "v"(gsrc), "s"(lds_dst) : "memory"); }
__device__ __forceinline__ void qkt(f32x16& p0, f32x16& p1, const char* Kslot, const bf16x8* qr, int r32, int hi) {
    const char* kb = Kslot + hi * 1024 + r32 * 16;
    const f32x16 z = {};
#pragma unroll
    for (int d0 = 0; d0 < 4; ++d0) {
        const bf16x8 b0 = *reinterpret_cast<const bf16x8*>(kb + d0 * 2048);
        const bf16x8 b1 = *reinterpret_cast<const bf16x8*>(kb + d0 * 2048 + 512);
        if (d0 == 0) { p0 = __builtin_amdgcn_mfma_f32_32x32x16_bf16(b0, qr[0], z, 0, 0, 0); p1 = __builtin_amdgcn_mfma_f32_32x32x16_bf16(b1, qr[0], z, 0, 0, 0); }
        else { p0 = __builtin_amdgcn_mfma_f32_32x32x16_bf16(b0, qr[d0], p0, 0, 0, 0); p1 = __builtin_amdgcn_mfma_f32_32x32x16_bf16(b1, qr[d0], p1, 0, 0, 0); } }
}
__device__ __forceinline__ void pv(f32x16* o, int vb, bf16x8 pa0, bf16x8 pa1, bf16x8 pa2, bf16x8 pa3) {
#pragma unroll
    for (int d0 = 0; d0 < 2; ++d0) { s16x4 lo[4], hi[4];
#pragma unroll
        for (int ks = 0; ks < 4; ++ks) {
            asm volatile("ds_read_b64_tr_b16 %0,%1 offset:%c2" : "=&v"(lo[ks]) : "v"(vb), "i"(d0 * 4096 + ks * 1024) : "memory");
            asm volatile("ds_read_b64_tr_b16 %0,%1 offset:%c2" : "=&v"(hi[ks]) : "v"(vb), "i"(d0 * 4096 + ks * 1024 + 512) : "memory"); }
        asm volatile("s_waitcnt lgkmcnt(0)" ::: "memory"); __builtin_amdgcn_sched_barrier(0);
#define PK(k) (bf16x8){lo[k][0], lo[k][1], lo[k][2], lo[k][3], hi[k][0], hi[k][1], hi[k][2], hi[k][3]}
        o[d0] = __builtin_amdgcn_mfma_f32_32x32x16_bf16(pa0, PK(0), o[d0], 0, 0, 0);
        o[d0] = __builtin_amdgcn_mfma_f32_32x32x16_bf16(pa1, PK(1), o[d0], 0, 0, 0);
        o[d0] = __builtin_amdgcn_mfma_f32_32x32x16_bf16(pa2, PK(2), o[d0], 0, 0, 0);
        o[d0] = __builtin_amdgcn_mfma_f32_32x32x16_bf16(pa3, PK(3), o[d0], 0, 0, 0);
#undef PK
    }
}
struct Desc {
    const bf16* Q; int qp;
    const bf16* K; const bf16* V; int kp;
    bf16* O; int op;
    int nt, nctx, nt_real;
    int ctxrow, latrow;
    int r0, kr0;
    int q0, kt0;
    const float* rpb;
    float sink_l2; int has_sink;
    int qrope, qt0;
};
template <int MODE>
__device__ __forceinline__ void attn_unit(const Desc& d, char* shm) {
    int tid_ = threadIdx.x; asm volatile("" : "+v"(tid_));
    const int tid = tid_, lane = tid & 63, r32 = lane & 31, hi = lane >> 5; const int wid = __builtin_amdgcn_readfirstlane(tid >> 6);
    const unsigned lds0 = (unsigned)(uintptr_t)shm;
    float* wsf = (float*)(shm + LDS_WS) + wid * 64;
    const bf16* Qw = d.Q + (size_t)(wid * 32) * d.qp;
    const unsigned kdst = lds0 + LDS_K + wid * 1024, vdst = lds0 + LDS_V + wid * 1024;
    const size_t koffl = (size_t)lane * d.kp + wid * 8;
    const size_t voffl = (size_t)(16 * (wid & 3) + (lane >> 2)) * d.kp + (wid >> 2) * 32 + (lane & 3) * 8;
#define TROW(t) ((t) < d.nctx ? d.ctxrow + 64 * (t) : d.latrow + 64 * ((t) - d.nctx))
#define DMA_KV(t, slot) do { const size_t ro_ = (size_t)TROW(t) * d.kp; \
        glds16(d.K + ro_ + koffl, (unsigned)__builtin_amdgcn_readfirstlane(kdst + (slot) * SLOTB)); \
        glds16(d.V + ro_ + voffl, (unsigned)__builtin_amdgcn_readfirstlane(vdst + (slot) * SLOTB)); } while (0)
    const int vb0 = (int)(lds0 + LDS_V) + ((lane >> 4) & 1) * 32 + (lane & 3) * 8 + (4 * hi + ((lane & 15) >> 2)) * 64;
    if (MODE == M_NA) { float* bt = (float*)(shm + LDS_BIAS); if (tid < 465) bt[tid] = d.rpb[tid] * LOG2E; }
    DMA_KV(0, 0);
    if (d.nt > 1) DMA_KV(1, 1);
    bf16x8 qr[4];
#pragma unroll
    for (int d0 = 0; d0 < 4; ++d0) qr[d0] = *reinterpret_cast<const bf16x8*>(&Qw[(size_t)r32 * d.qp + d0 * 16 + hi * 8]);
    float m = -1e30f, l = 0.f; f32x16 o[2]; o[0] = f32x16{}; o[1] = f32x16{};
    const int qrow = (MODE == M_NA) ? d.r0 + (wid >> 1) : 0;
    const int qcol = 32 * (wid & 1) + r32;
    const int rs = (MODE == M_NA) ? (qrow - 4 < 0 ? 0 : (qrow - 4 > 120 ? 120 : qrow - 4)) : 0;
    const int cs = qcol - 8 < 0 ? 0 : (qcol - 8 > 48 ? 48 : qcol - 8);
    const int qpos = d.q0 + 32 * wid + r32;
    int slot = 0;
    for (int t = 0; t < d.nt; ++t) {
        if (t + 1 < d.nt) asm volatile("s_waitcnt vmcnt(2) lgkmcnt(0)\n\ts_barrier" ::: "memory");
        else asm volatile("s_waitcnt vmcnt(0) lgkmcnt(0)\n\ts_barrier" ::: "memory");
        if (t + 2 < d.nt) { const int s2 = slot + 2 >= NSLOT ? slot + 2 - NSLOT : slot + 2; DMA_KV(t + 2, s2); }
        bool active = true;
        int kr = 0, k0 = 0;
        if (MODE == M_NA && t >= d.nctx) { kr = d.kr0 + (t - d.nctx); active = (kr >= rs) && (kr < rs + 8); }
        if (MODE == M_WA && t >= d.nctx) { k0 = d.kt0 + 64 * (t - d.nctx); const int qw = d.q0 + 32 * wid; active = (k0 + 63 >= qw - 128) && (k0 <= qw + 31 + 128); }
        if (active) {
            f32x16 p0, p1;
            qkt(p0, p1, shm + LDS_K + slot * SLOTB, qr, r32, hi);
            if (MODE == M_NA && t >= d.nctx) {
                const float* bt = (const float*)(shm + LDS_BIAS) + (kr - qrow + 7) * 31 + 15 - qcol;
#pragma unroll
                for (int r = 0; r < 16; ++r) {
                    const int kv = crow(r, hi);
                    { const bool ok = (unsigned)(kv - cs) < 16u; const float bv = bt[ok ? kv : qcol]; p0[r] = ok ? p0[r] + bv : -INFINITY; }
                    { const int kv2 = kv + 32; const bool ok = (unsigned)(kv2 - cs) < 16u; const float bv = bt[ok ? kv2 : qcol]; p1[r] = ok ? p1[r] + bv : -INFINITY; }
                }
            }
            if (MODE == M_WA && t >= d.nctx) {
#pragma unroll
                for (int r = 0; r < 16; ++r) {
                    const int dk = k0 + crow(r, hi) - qpos;
                    if (dk > 128 || dk < -128) p0[r] = -INFINITY;
                    if (dk + 32 > 128 || dk + 32 < -128) p1[r] = -INFINITY;
                }
            }
            float rm = __builtin_fmaxf(p0[0], p1[0]);
#pragma unroll
            for (int r = 1; r < 16; ++r) rm = __builtin_fmaxf(rm, __builtin_fmaxf(p0[r], p1[r]));
            { auto rr = __builtin_amdgcn_permlane32_swap(__float_as_uint(rm), __float_as_uint(rm), false, false); rm = __builtin_fmaxf(__uint_as_float(rr[0]), __uint_as_float(rr[1])); }
            const float mn = __builtin_fmaxf(m, rm);
            if (__any(mn > m)) {
                const float f = __builtin_amdgcn_exp2f(m - mn); l *= f; m = mn;
                if (hi == 0) wsf[r32] = f;
                asm volatile("s_waitcnt lgkmcnt(0)" ::: "memory");
#pragma unroll
                for (int r = 0; r < 16; ++r) { const float fr_ = wsf[crow(r, hi)]; o[0][r] *= fr_; o[1][r] *= fr_; }
            }
            float sacc = 0.f;
#pragma unroll
            for (int r = 0; r < 16; ++r) { p0[r] = __builtin_amdgcn_exp2f(p0[r] - m); p1[r] = __builtin_amdgcn_exp2f(p1[r] - m); sacc += p0[r] + p1[r]; }
            l += sacc;
            v4u pw0, pw1, pw2, pw3;
            pw0 = (v4u){cvtpk(p0[0], p0[1]), cvtpk(p0[2], p0[3]), cvtpk(p0[4], p0[5]), cvtpk(p0[6], p0[7])};
            pw1 = (v4u){cvtpk(p0[8], p0[9]), cvtpk(p0[10], p0[11]), cvtpk(p0[12], p0[13]), cvtpk(p0[14], p0[15])};
            pw2 = (v4u){cvtpk(p1[0], p1[1]), cvtpk(p1[2], p1[3]), cvtpk(p1[4], p1[5]), cvtpk(p1[6], p1[7])};
            pw3 = (v4u){cvtpk(p1[8], p1[9]), cvtpk(p1[10], p1[11]), cvtpk(p1[12], p1[13]), cvtpk(p1[14], p1[15])};
            pv(o, vb0 + slot * SLOTB, __builtin_bit_cast(bf16x8, pw0), __builtin_bit_cast(bf16x8, pw1), __builtin_bit_cast(bf16x8, pw2), __builtin_bit_cast(bf16x8, pw3));
        }
        slot = slot + 1 >= NSLOT ? 0 : slot + 1;
    }
    if (d.has_sink && hi == 0) l += __builtin_amdgcn_exp2f(d.sink_l2 - m);
    { auto rr = __builtin_amdgcn_permlane32_swap(__float_as_uint(l), __float_as_uint(l), false, false); l = __uint_as_float(rr[0]) + __uint_as_float(rr[1]); }
    if (hi == 0) wsf[32 + r32] = l;
    asm volatile("s_waitcnt lgkmcnt(0)" ::: "memory");
    float rli[16];
#pragma unroll
    for (int r = 0; r < 16; ++r) rli[r] = __builtin_amdgcn_rcpf(wsf[32 + crow(r, hi)]);
    bf16* Ow = d.O + (size_t)(wid * 32) * d.op;
    { bf16* stg = (bf16*)(shm + LDS_OST) + wid * 2048;
#pragma unroll
        for (int r = 0; r < 16; ++r) { const int orow = crow(r, hi);
#pragma unroll
            for (int d0 = 0; d0 < 2; ++d0) stg[orow * 64 + d0 * 32 + r32] = (bf16)f2bf(o[d0][r] * rli[r]); }
        asm volatile("s_waitcnt lgkmcnt(0)" ::: "memory");
#pragma unroll
        for (int i = 0; i < 4; ++i) { const int row = i * 8 + (lane >> 3), ch = lane & 7; const v4u v = *(const v4u*)(stg + row * 64 + ch * 8); *(v4u*)(Ow + (size_t)row * d.op + ch * 8) = v; } }
    asm volatile("s_waitcnt lgkmcnt(0)\n\ts_barrier" ::: "memory");
#undef TROW
#undef DMA_KV
}
}
namespace att {
typedef unsigned u32x4 __attribute__((ext_vector_type(4)));
#define SBAR() __builtin_amdgcn_sched_barrier(0)
__device__ __forceinline__ float max3f(float a,float b,float c){float r;asm("v_max3_f32 %0, %1, %2, %3":"=v"(r):"v"(a),"v"(b),"v"(c));return r;}
__device__ __forceinline__ float max2f(float a,float b){float r;asm("v_max_f32_e32 %0, %1, %2":"=v"(r):"v"(a),"v"(b));return r;}
__device__ __forceinline__ float fadd_s(float a,float b){float r;asm("v_add_f32_e32 %0, %1, %2":"=v"(r):"v"(a),"v"(b));return r;}
__device__ __forceinline__ float fsub_s(float a,float b){float r;asm("v_sub_f32_e32 %0, %1, %2":"=v"(r):"v"(a),"v"(b));return r;}
__device__ __forceinline__ unsigned cvtpk_s(float lo,float hi){return cvtpk(lo,hi);}
#define WAIT_BAR(N) asm volatile("s_waitcnt vmcnt(" #N ") lgkmcnt(0)\n\ts_barrier":::"memory")


__device__ __forceinline__ void qkt_n(f32x16&p0,f32x16&p1,const char*Kslot,const bf16x8*qr,const f32x16&negm,int r32,int hi){
  const char*kb=Kslot+hi*1024+r32*16;
  #pragma unroll
  for(int d0=0;d0<4;++d0){
    const bf16x8 b0=*reinterpret_cast<const bf16x8*>(kb+d0*2048);
    const bf16x8 b1=*reinterpret_cast<const bf16x8*>(kb+d0*2048+512);
    if(d0==0){p0=__builtin_amdgcn_mfma_f32_32x32x16_bf16(b0,qr[0],negm,0,0,0);p1=__builtin_amdgcn_mfma_f32_32x32x16_bf16(b1,qr[0],negm,0,0,0);}
    else{p0=__builtin_amdgcn_mfma_f32_32x32x16_bf16(b0,qr[d0],p0,0,0,0);p1=__builtin_amdgcn_mfma_f32_32x32x16_bf16(b1,qr[d0],p1,0,0,0);}}
}
typedef __attribute__((address_space(3))) const char* lds_cptr;
typedef short v4i16_t __attribute__((ext_vector_type(4)));
__device__ __forceinline__ void kload8(bf16x8*kf,lds_cptr kp){
  kf[0]=*(const __attribute__((address_space(3))) bf16x8*)(kp);      kf[1]=*(const __attribute__((address_space(3))) bf16x8*)(kp+512);
  kf[2]=*(const __attribute__((address_space(3))) bf16x8*)(kp+2048); kf[3]=*(const __attribute__((address_space(3))) bf16x8*)(kp+2560);
  kf[4]=*(const __attribute__((address_space(3))) bf16x8*)(kp+4096); kf[5]=*(const __attribute__((address_space(3))) bf16x8*)(kp+4608);
  kf[6]=*(const __attribute__((address_space(3))) bf16x8*)(kp+6144); kf[7]=*(const __attribute__((address_space(3))) bf16x8*)(kp+6656);
}
__device__ __forceinline__ void kload2(bf16x8*kf,lds_cptr kp,int j){ kf[2*j]=*(const __attribute__((address_space(3))) bf16x8*)(kp+j*2048); kf[2*j+1]=*(const __attribute__((address_space(3))) bf16x8*)(kp+j*2048+512); }
__device__ __forceinline__ s16x4 vtr(lds_cptr p){ return __builtin_bit_cast(s16x4,__builtin_amdgcn_ds_read_tr16_b64_v4i16((__attribute__((address_space(3))) v4i16_t*)p)); }
__device__ __forceinline__ float rowmax(const f32x16&p0,const f32x16&p1){
  float a=max3f(p0[0],p0[1],p1[0]),b=max3f(p0[2],p0[3],p1[1]);a=max3f(a,p1[2],p1[3]);
  #pragma unroll
  for(int r=4;r<16;r+=4){a=max3f(a,p0[r],p0[r+1]);b=max3f(b,p0[r+2],p0[r+3]);a=max3f(a,p1[r],p1[r+1]);b=max3f(b,p1[r+2],p1[r+3]);}
  const float m=max2f(a,b);
  auto rr=__builtin_amdgcn_permlane32_swap(__float_as_uint(m),__float_as_uint(m),false,false);
  return max2f(__uint_as_float(rr[0]),__uint_as_float(rr[1]));
}

template<int MODE> __device__ __forceinline__ void pipe_mask(f32x16&P0,f32x16&P1,int t,const Desc& d,const char*shm,int wid,int r32,int hi){
  if(MODE==M_FULL) return;
  if(t<d.nctx) return;
  if(t>=d.nt_real){
    _Pragma("unroll") for(int r=0;r<16;++r){P0[r]=-INFINITY;P1[r]=-INFINITY;} return; }
  if(MODE==M_NA){
    const int qrow=d.r0+(wid>>1), qcol=32*(wid&1)+r32, kr=d.kr0+(t-d.nctx);
    const int rs=qrow-4<0?0:(qrow-4>120?120:qrow-4), cs=qcol-8<0?0:(qcol-8>48?48:qcol-8);
    if(kr<rs||kr>=rs+8){ _Pragma("unroll") for(int r=0;r<16;++r){P0[r]=-INFINITY;P1[r]=-INFINITY;} return; }
    const float*bt=(const float*)(shm+LDS_BIAS)+(kr-qrow+7)*31+15-qcol;
    _Pragma("unroll") for(int r=0;r<16;++r){ const int kv=crow(r,hi);
      { const bool ok=(unsigned)(kv-cs)<16u; const float bv=bt[ok?kv:qcol]; P0[r]=ok?P0[r]+bv:-INFINITY; }
      { const int kv2=kv+32; const bool ok=(unsigned)(kv2-cs)<16u; const float bv=bt[ok?kv2:qcol]; P1[r]=ok?P1[r]+bv:-INFINITY; } }
  }
  if(MODE==M_WA){
    const int qpos=d.q0+32*wid+r32, k0=d.kt0+64*(t-d.nctx);
    _Pragma("unroll") for(int r=0;r<16;++r){ const int dk=k0+crow(r,hi)-qpos;
      if(dk>128||dk<-128)P0[r]=-INFINITY; if(dk+32>128||dk+32<-128)P1[r]=-INFINITY; }
  }
}
template<int THRL,int MODE> __device__ __forceinline__ void attn_unit_pipe(const Desc& d,char*shm){
  int tid_=threadIdx.x; asm volatile("":"+v"(tid_)); const int tid=tid_,lane=tid&63,r32=lane&31,hi=lane>>5; const int wid=__builtin_amdgcn_readfirstlane(tid>>6);
  const bf16*Qw=d.Q+(size_t)(wid*32)*d.qp;
  const unsigned lds0=(unsigned)(uintptr_t)shm;
  if(MODE==M_NA){ float*bt=(float*)(shm+LDS_BIAS); if(tid<465)bt[tid]=d.rpb[tid]*LOG2E; }
  float*wsf=(float*)(shm+LDS_WS)+wid*64;
  const size_t koffl=(size_t)lane*d.kp+wid*8;
  const size_t voffl=(size_t)(16*(wid&3)+(lane>>2))*d.kp+(wid>>2)*32+(lane&3)*8;
  #define TROW(t) ((t)<d.nctx?d.ctxrow+64*(t):((t)<d.nt_real?d.latrow+64*((t)-d.nctx):d.latrow))
  const unsigned kdst=lds0+LDS_K+wid*1024, vdst=lds0+LDS_V+wid*1024;
  #define DMA_K(t,slot) glds16(d.K+(size_t)TROW(t)*d.kp+koffl,(unsigned)__builtin_amdgcn_readfirstlane(kdst+(slot)))
  #define DMA_V(t,slot) glds16(d.V+(size_t)TROW(t)*d.kp+voffl,(unsigned)__builtin_amdgcn_readfirstlane(vdst+(slot)))
  const int vb0=(int)(lds0+LDS_V)+((lane>>4)&1)*32+(lane&3)*8+(4*hi+((lane&15)>>2))*64;
  const char*Kbase=shm+LDS_K; bf16x8 kf[8];
  const lds_cptr shm3=(lds_cptr)shm; const lds_cptr kp0=shm3+LDS_K+hi*1024+r32*16; const lds_cptr vp0=shm3+LDS_V+((lane>>4)&1)*32+(lane&3)*8+(4*hi+((lane&15)>>2))*64;
  const int NT=d.nt;
  DMA_K(0,0);DMA_V(0,0);DMA_K(1,SLOTB);
  bf16x8 qr[4];
  #pragma unroll
  for(int d0=0;d0<4;++d0)qr[d0]=*reinterpret_cast<const bf16x8*>(&Qw[(size_t)r32*d.qp+d0*16+hi*8]);
  if(d.qrope){
    const int tq=d.qt0+32*wid+r32, rr=tq>>6, cc=tq&63;
    #pragma unroll
    for(int d0=2;d0<4;++d0){ const float pos=(float)(d0==2?rr:cc); u32x4 w=__builtin_bit_cast(u32x4,qr[d0]), pw, ow;
      #pragma unroll
      for(int j=0;j<4;++j) pw[j]=(unsigned)__shfl_xor((int)w[j],32);
      #pragma unroll
      for(int j=0;j<4;++j){ float res[2];
        #pragma unroll
        for(int e=0;e<2;++e){ const int i=2*j+e; const float own=e?bfhi(w[j]):bflo(w[j]), oth=e?bfhi(pw[j]):bflo(pw[j]);
          const float rev=pos*__builtin_amdgcn_exp2f(-(float)i*(13.287712379549449f/8.0f))*0.15915494309189535f; const float cs_=__builtin_amdgcn_cosf(rev), sn_=__builtin_amdgcn_sinf(rev);
          res[e]=hi?(own*cs_+oth*sn_):(own*cs_-oth*sn_); }
        ow[j]=cvtpk(res[0],res[1]); }
      qr[d0]=__builtin_bit_cast(bf16x8,ow); } }
  float mhat=0.f,l_reg=0.f;f32x16 o[2];o[0]=f32x16{};o[1]=f32x16{};f32x16 negm=f32x16{};asm volatile("":"+v"(negm));
  #define CMASK(P0,P1,t) pipe_mask<MODE>(P0,P1,(t),d,shm,wid,r32,hi)
  bool resc=false;
  #define START(P0,P1) do{ const float rm=rowmax(P0,P1); resc=false; \
    { const float dl=rm; mhat=fadd_s(mhat,dl); \
      _Pragma("unroll") for(int r=0;r<16;++r){P0[r]=fsub_s(P0[r],dl);P1[r]=fsub_s(P1[r],dl);} \
      _Pragma("unroll") for(int r=0;r<16;++r)negm[r]=-mhat; asm volatile("":"+v"(negm)); } \
    _Pragma("unroll") for(int r=0;r<16;++r)P0[r]=__builtin_amdgcn_exp2f(P0[r]); }while(0)
  #define RESC() do{ if(resc){ asm volatile("s_waitcnt lgkmcnt(0)":::"memory"); \
      _Pragma("unroll") for(int d_=0;d_<2;++d_) _Pragma("unroll") for(int r=0;r<16;++r)o[d_][r]*=wsf[crow(r,hi)]; } }while(0)
  f32x16 pA0,pA1,pB0,pB1;
  int sl_prev=0,sl_cur=0,sl_next=SLOTB;
  #define ROT() do{sl_prev=sl_cur;sl_cur=sl_next;sl_next=(sl_next==(NSLOT-1)*SLOTB)?0:sl_next+SLOTB;}while(0)
  DMA_K(2,2*SLOTB);
  WAIT_BAR(3);
  qkt_n(pA0,pA1,Kbase,qr,negm,r32,hi);asm volatile("s_nop 15\n\ts_nop 7":"+v"(pA0),"+v"(pA1));CMASK(pA0,pA1,0);
  START(pA0,pA1);
  _Pragma("unroll") for(int r=0;r<16;++r)pA1[r]=__builtin_amdgcn_exp2f(pA1[r]);
  WAIT_BAR(0);
  DMA_K(3,0);DMA_V(1,SLOTB);
  ROT();
  kload8(kf,kp0+sl_cur);
  WAIT_BAR(2);
  s16x4 vlo[8],vhi[8]; u32x4 pw0,pw1,pw2,pw3;
  #define PKW(P,B) cvtpk_s(P[B],P[B+1])
  #define PAF(k) __builtin_bit_cast(bf16x8,pw##k)
  #define VFR(i) (bf16x8){vlo[i][0],vlo[i][1],vlo[i][2],vlo[i][3],vhi[i][0],vhi[i][1],vhi[i][2],vhi[i][3]}
  #define PIN(x) asm volatile("":"+v"(x))
  #define MX3(a,b,c) __builtin_fmaxf(__builtin_fmaxf((a),(b)),(c))
  #define GAPA(MF,A0,A1,A2,A3,W0,W1,PW) do{ MF; sacc+=A0; sacc+=A1; sacc+=A2; sacc+=A3; PIN(sacc); W0; W1; PIN(PW); SBAR(); }while(0)
  #define EX(v) __builtin_amdgcn_exp2f(v)
  #define GAPB(MF,X,B) do{ MF; X[B]=EX(X[B]); X[B+1]=EX(X[B+1]); X[B+2]=EX(X[B+2]); X[B+3]=EX(X[B+3]); PIN(X); SBAR(); }while(0)
  #define VRD(i) do{ vlo[i]=vtr(vp_+(((i)>>2)*4096+((i)&3)*1024)); vhi[i]=vtr(vp_+(((i)>>2)*4096+((i)&3)*1024+512)); }while(0)
  #define KRD(G,j) do{ if(G){ kload2(kf,kp0+sl_next,j); SBAR(); } }while(0)
  #define STEP(C0,C1,P0,P1,t,GK,GV,GL) do{ SBAR(); \
    const lds_cptr vp_=vp0+sl_prev; \
    VRD(0); SBAR(); float sacc=(P0[0]+P0[1]); \
    GAPA(C0=__builtin_amdgcn_mfma_f32_32x32x16_bf16(kf[0],qr[0],negm,0,0,0), P0[2],P0[3],P0[4],P0[5],     pw0[0]=PKW(P0,0), pw0[1]=PKW(P0,2), pw0); \
    VRD(4); SBAR(); GAPA(C1=__builtin_amdgcn_mfma_f32_32x32x16_bf16(kf[1],qr[0],negm,0,0,0), P0[6],P0[7],P0[8],P0[9],     pw0[2]=PKW(P0,4), pw0[3]=PKW(P0,6), pw0); \
    VRD(1); SBAR(); GAPA(C0=__builtin_amdgcn_mfma_f32_32x32x16_bf16(kf[2],qr[1],C0,0,0,0),   P0[10],P0[11],P0[12],P0[13], pw1[0]=PKW(P0,8), pw1[1]=PKW(P0,10), pw1); \
    VRD(5); SBAR(); GAPA(C1=__builtin_amdgcn_mfma_f32_32x32x16_bf16(kf[3],qr[1],C1,0,0,0),   P0[14],P0[15],P1[0],P1[1],   pw1[2]=PKW(P0,12),pw1[3]=PKW(P0,14), pw1); \
    VRD(2); SBAR(); GAPA(C0=__builtin_amdgcn_mfma_f32_32x32x16_bf16(kf[4],qr[2],C0,0,0,0),   P1[2],P1[3],P1[4],P1[5],     pw2[0]=PKW(P1,0), pw2[1]=PKW(P1,2), pw2); \
    VRD(6); SBAR(); GAPA(C1=__builtin_amdgcn_mfma_f32_32x32x16_bf16(kf[5],qr[2],C1,0,0,0),   P1[6],P1[7],P1[8],P1[9],     pw2[2]=PKW(P1,4), pw2[3]=PKW(P1,6), pw2); \
    VRD(3); SBAR(); GAPA(C0=__builtin_amdgcn_mfma_f32_32x32x16_bf16(kf[6],qr[3],C0,0,0,0),   P1[10],P1[11],P1[12],P1[13], pw3[0]=PKW(P1,8), pw3[1]=PKW(P1,10), pw3); \
    VRD(7); SBAR(); GAPA(C1=__builtin_amdgcn_mfma_f32_32x32x16_bf16(kf[7],qr[3],C1,0,0,0),   P1[14],P1[15],0.f,0.f,       pw3[2]=PKW(P1,12),pw3[3]=PKW(P1,14), pw3); \
    l_reg+=sacc; \
    if(GK){DMA_K((t)+3,sl_cur);} if(GV){DMA_V((t)+1,sl_next);} \
    CMASK(C0,C1,t); \
    { float a=MX3(C0[0],C0[1],C1[0]),b=MX3(C0[2],C0[3],C1[1]); a=MX3(a,C1[2],C1[3]); \
      _Pragma("unroll") for(int r=4;r<16;r+=4){a=MX3(a,C0[r],C0[r+1]);b=MX3(b,C0[r+2],C0[r+3]);a=MX3(a,C1[r],C1[r+1]);b=MX3(b,C1[r+2],C1[r+3]);} \
      float rm=__builtin_fmaxf(a,b); { auto rr=__builtin_amdgcn_permlane32_swap(__float_as_uint(rm),__float_as_uint(rm),false,false); rm=__builtin_fmaxf(__uint_as_float(rr[0]),__uint_as_float(rr[1])); } \
      resc=false; \
      if(__builtin_expect(__any(rm>(float)THRL),0)){ const float dl=__builtin_fmaxf(rm,0.f); mhat+=dl; \
        _Pragma("unroll") for(int r=0;r<16;++r){C0[r]-=dl;C1[r]-=dl;} \
        _Pragma("unroll") for(int r=0;r<16;++r)negm[r]=-mhat; asm volatile("":"+v"(negm)); \
        const float f=__builtin_amdgcn_exp2f(-dl); l_reg*=f; if(hi==0)wsf[r32]=f; resc=true; } } \
    SBAR(); \
    GAPB(o[0]=__builtin_amdgcn_mfma_f32_32x32x16_bf16(PAF(0),VFR(0),o[0],0,0,0), C0,0); \
    GAPB(o[1]=__builtin_amdgcn_mfma_f32_32x32x16_bf16(PAF(0),VFR(4),o[1],0,0,0), C0,4); \
    KRD(GL,0); GAPB(o[0]=__builtin_amdgcn_mfma_f32_32x32x16_bf16(PAF(1),VFR(1),o[0],0,0,0), C0,8); \
    KRD(GL,1); GAPB(o[1]=__builtin_amdgcn_mfma_f32_32x32x16_bf16(PAF(1),VFR(5),o[1],0,0,0), C0,12); \
    KRD(GL,2); GAPB(o[0]=__builtin_amdgcn_mfma_f32_32x32x16_bf16(PAF(2),VFR(2),o[0],0,0,0), C1,0); \
    KRD(GL,3); GAPB(o[1]=__builtin_amdgcn_mfma_f32_32x32x16_bf16(PAF(2),VFR(6),o[1],0,0,0), C1,4); \
    GAPB(o[0]=__builtin_amdgcn_mfma_f32_32x32x16_bf16(PAF(3),VFR(3),o[0],0,0,0), C1,8); \
    GAPB(o[1]=__builtin_amdgcn_mfma_f32_32x32x16_bf16(PAF(3),VFR(7),o[1],0,0,0), C1,12); \
    }while(0)
  int t=1;
  for(;t+5<NT;t+=2){
    STEP(pB0,pB1,pA0,pA1,t,true,true,true);     WAIT_BAR(2); RESC(); ROT();
    STEP(pA0,pA1,pB0,pB1,t+1,true,true,true);   WAIT_BAR(2); RESC(); ROT();
  }
  #define ENDW(tt) do{ if((tt)+3<NT){WAIT_BAR(2);} else if((tt)+2<NT){WAIT_BAR(1);} else {WAIT_BAR(0);} }while(0)
  for(;t+1<NT;t+=2){
    STEP(pB0,pB1,pA0,pA1,t,(t+3<NT),(t+1<NT),(t+1<NT));       ENDW(t);   RESC(); ROT();
    STEP(pA0,pA1,pB0,pB1,t+1,(t+4<NT),(t+2<NT),(t+2<NT));     ENDW(t+1); RESC(); ROT();
  }
  STEP(pB0,pB1,pA0,pA1,NT-1,false,false,false); RESC();
  { float sacc=pB0[0]+pB0[1]; _Pragma("unroll") for(int r=2;r<16;++r)sacc+=pB0[r]; _Pragma("unroll") for(int r=0;r<16;++r)sacc+=pB1[r]; l_reg+=sacc;
    pw0=(u32x4){PKW(pB0,0),PKW(pB0,2),PKW(pB0,4),PKW(pB0,6)};pw1=(u32x4){PKW(pB0,8),PKW(pB0,10),PKW(pB0,12),PKW(pB0,14)};pw2=(u32x4){PKW(pB1,0),PKW(pB1,2),PKW(pB1,4),PKW(pB1,6)};pw3=(u32x4){PKW(pB1,8),PKW(pB1,10),PKW(pB1,12),PKW(pB1,14)};
    SBAR(); pv(o,vb0+sl_cur,PAF(0),PAF(1),PAF(2),PAF(3)); }
  #undef PKW
  #undef PAF
  #undef VFR
  #undef PIN
  #undef MX3
  #undef GAPA
  #undef GAPB
  #undef EX
  #undef VRD
  #undef KRD
  #undef STEP
  #undef ENDW
  if(d.has_sink&&hi==0)l_reg+=__builtin_amdgcn_exp2f(d.sink_l2-mhat);
  {auto rr=__builtin_amdgcn_permlane32_swap(__float_as_uint(l_reg),__float_as_uint(l_reg),false,false);l_reg=__uint_as_float(rr[0])+__uint_as_float(rr[1]);}
  if(hi==0)wsf[32+r32]=l_reg;asm volatile("s_waitcnt lgkmcnt(0)":::"memory");
  float rli[16];
  #pragma unroll
  for(int r=0;r<16;++r)rli[r]=__builtin_amdgcn_rcpf(wsf[32+crow(r,hi)]);
  bf16*Ow=d.O+(size_t)(wid*32)*d.op;
  { bf16*stg=(bf16*)(shm+LDS_OST)+wid*2048;
    #pragma unroll
    for(int r=0;r<16;++r){const int orow=crow(r,hi);
      #pragma unroll
      for(int d0=0;d0<2;++d0)stg[orow*64+d0*32+r32]=(bf16)f2bf(o[d0][r]*rli[r]);}
    asm volatile("s_waitcnt lgkmcnt(0)":::"memory");
    #pragma unroll
    for(int i=0;i<4;++i){const int row=i*8+(lane>>3),ch=lane&7; const u32x4 v=*(const u32x4*)(stg+row*64+ch*8); *(u32x4*)(Ow+(size_t)row*d.op+ch*8)=v;} }
  asm volatile("s_waitcnt lgkmcnt(0)\n\ts_barrier":::"memory");
  #undef DMA_K
  #undef TROW
  #undef DMA_V
  #undef CMASK
  #undef START
  #undef RESC
  #undef ROT
}

#undef SBAR
#undef WAIT_BAR
}
namespace gla {
constexpr int S32 = 40, S64 = 72;
struct Par {
    const bf16* P; bf16* CAT; float* GU; float* GDEC; float* BC;
    const float *wgf, *bgf, *wgb, *bgb, *gnorm;
};
__device__ __forceinline__ int chunk_row(int b, int n) { return n < 4 ? NLAT + b * CTXL + 64 * n : b * SEQ + 64 * (n - 4); }
__device__ __forceinline__ int chunk_dir(int n, int dir) { return dir == 0 ? n : (n < 4 ? 3 - n : 135 - n); }
template <int KS>
__device__ __forceinline__ f32x16 mm_tile(f32x16 c, const bf16* A, int sa, const bf16* Bt, int sb, int r32, int hi) {
#pragma unroll
    for (int s = 0; s < KS; ++s) {
        const bf16x8 a = *reinterpret_cast<const bf16x8*>(A + r32 * sa + 16 * s + 8 * hi);
        const bf16x8 b = *reinterpret_cast<const bf16x8*>(Bt + r32 * sb + 16 * s + 8 * hi);
        c = __builtin_amdgcn_mfma_f32_32x32x16_bf16(a, b, c, 0, 0, 0);
    }
    return c;
}
__device__ __forceinline__ float decay_g(const bf16* zl, int tok, int dir, const float (&w)[16], float bias) {
    const v4u* zp = (const v4u*)(zl + tok * 32 + dir * 16);
    const v4u z0 = zp[0], z1 = zp[1];
    float a = bias;
    a += bflo(z0.x) * w[0] + bfhi(z0.x) * w[1] + bflo(z0.y) * w[2] + bfhi(z0.y) * w[3] + bflo(z0.z) * w[4] + bfhi(z0.z) * w[5] + bflo(z0.w) * w[6] + bfhi(z0.w) * w[7];
    a += bflo(z1.x) * w[8] + bfhi(z1.x) * w[9] + bflo(z1.y) * w[10] + bfhi(z1.y) * w[11] + bflo(z1.z) * w[12] + bfhi(z1.z) * w[13] + bflo(z1.w) * w[14] + bfhi(z1.w) * w[15];
    const float ls = __builtin_fminf(a, 0.f) - 0.6931471805599453f * __builtin_amdgcn_logf(1.0f + __builtin_amdgcn_exp2f(-LOG2E * __builtin_fabsf(a)));
    return ls * (1.0f / 16.0f);
}
__device__ __forceinline__ void decay_totals(float& bend, float& carry, const bf16* zl, const float (&w)[16], float bias, int dir, int half) {
    float tot = 0.f;
#pragma unroll 4
    for (int ii = 0; ii < 32; ++ii) tot += decay_g(zl, 32 * half + ii, dir, w, bias);
    const float oth = __shfl_xor(tot, 32);
    bend = tot + oth; carry = (half == (dir == 0 ? 1 : 0)) ? oth : 0.f;
}
__device__ __forceinline__ void load_z(bf16* zl, const bf16* P, int row0, int tid) {
    if (tid < 256) { const int j = tid >> 2, c = tid & 3; *(v4u*)(zl + j * 32 + c * 8) = *(const v4u*)(P + (size_t)(row0 + j) * INWP + D_ZF + c * 8); }
}
__device__ __forceinline__ void ld_rows32(v4u (&pc)[2], const bf16* P, int row0, int col, int lane) {
#pragma unroll
    for (int i = 0; i < 2; ++i) { const int pidx = lane + 64 * i; pc[i] = *(const v4u*)(P + (size_t)(row0 + (pidx >> 2)) * INWP + col + (pidx & 3) * 8); }
}
__device__ __forceinline__ void st_rows32(bf16* dst, const v4u (&pc)[2], int lane) {
#pragma unroll
    for (int i = 0; i < 2; ++i) { const int pidx = lane + 64 * i; *(v4u*)(dst + (pidx >> 2) * S32 + (pidx & 3) * 8) = pc[i]; }
}
__device__ __forceinline__ void load_vt(bf16* Vt, const bf16* P, int row0, int h, int part, int lane) {
    const int c8 = lane & 7, jj = lane >> 3;
#pragma unroll
    for (int it = 0; it < 4; ++it) {
        const int j = 32 * part + it * 8 + jj;
        const v4u x = *(const v4u*)(P + (size_t)(row0 + j) * INWP + D_V + h * 64 + c8 * 8);
        bf16* dst = Vt + (c8 * 8) * S64 + j;
        dst[0 * S64] = (bf16)(x.x & 0xffff); dst[1 * S64] = (bf16)(x.x >> 16); dst[2 * S64] = (bf16)(x.y & 0xffff); dst[3 * S64] = (bf16)(x.y >> 16);
        dst[4 * S64] = (bf16)(x.z & 0xffff); dst[5 * S64] = (bf16)(x.z >> 16); dst[6 * S64] = (bf16)(x.w & 0xffff); dst[7 * S64] = (bf16)(x.w >> 16);
    }
}
__device__ __forceinline__ void g1_unit(const Par& p, int b, int n, char* shm) {
    int tid_ = threadIdx.x; asm volatile("" : "+v"(tid_));
    const int tid = tid_, lane = tid & 63, r32 = lane & 31, hi = lane >> 5; const int wid = __builtin_amdgcn_readfirstlane(tid >> 6);
    const int h = wid >> 1, dir = wid & 1, row0 = chunk_row(b, n);
    char* pr = shm + (wid >> 1) * 32768;
    bf16* KdT = (bf16*)(pr + (wid & 1) * 4608);
    bf16* Vt = (bf16*)(pr + 9216);
    bf16* Kr = (bf16*)(pr + 18432);
    bf16* zl = (bf16*)(shm + 131072);
    const int k = lane & 31, half = lane >> 5;
    v4u pc[2]; ld_rows32(pc, p.P, row0 + 32 * dir, D_K + h * 32, lane);
    float w[16];
    { const float* wg = dir == 0 ? p.wgf : p.wgb;
#pragma unroll
      for (int j = 0; j < 16; ++j) w[j] = wg[j * 128 + h * 32 + k]; }
    const float bias = (dir == 0 ? p.bgf : p.bgb)[h * 32 + k];
    load_z(zl, p.P, row0, tid);
    load_vt(Vt, p.P, row0, h, dir, lane);
    st_rows32(Kr + 32 * dir * S32, pc, lane);
    __syncthreads();
    float bend, run;
    decay_totals(bend, run, zl, w, bias, dir, half);
#pragma unroll 2
    for (int s = 0; s < 32; ++s) {
        const int i = 32 * half + (dir == 0 ? s : 31 - s);
        run += decay_g(zl, i, dir, w, bias);
        KdT[k * S64 + i] = (bf16)f2bf(bf2f(Kr[i * S32 + k]) * __expf(bend - run));
        p.BC[(size_t)(row0 + i) * 256 + dir * 128 + h * 32 + k] = run;
    }
    const int seq = (b * 4 + h) * 2 + dir, nd = chunk_dir(n, dir);
    if (half == 0) p.GDEC[((size_t)seq * NCH + nd) * 32 + k] = __expf(bend);
    LDS_WAIT();
    float* up = p.GU + ((size_t)seq * NCH + nd) * 2048;
#pragma unroll
    for (int dt = 0; dt < 2; ++dt) {
        f32x16 c = {};
        c = mm_tile<4>(c, KdT, S64, Vt + (32 * dt) * S64, S64, r32, hi);
#pragma unroll
        for (int r = 0; r < 16; ++r) (up + ((r & 3) + 8 * (r >> 2)) * 64 + 32 * dt)[(unsigned)(4 * hi * 64 + r32)] = c[r];
    }
    __syncthreads();
}
__device__ __forceinline__ void g2_scan(float* GU, const float* GDEC, int gt) {
    if (gt >= 32 * 2048) return;
    const int seq = gt >> 11, e = gt & 2047, k = e >> 6;
    float* up = GU + (size_t)seq * NCH * 2048 + e; const float* dp = GDEC + (size_t)seq * NCH * 32 + k;
    float s = 0.f;
#pragma unroll 12
    for (int n = 0; n < NCH; ++n) { const float u = up[(size_t)n * 2048], dc = dp[n * 32]; up[(size_t)n * 2048] = s; s = s * dc + u; }
}
struct G3Lds { bf16 *Kd, *St, *Vt, *Qd, *AT, *zl; };
template <int DIR>
__device__ __forceinline__ void g3_dir(f32x16 (&o)[2], const Par& p, const G3Lds& L, int row0, int b, int n, int h, int ih, int lane) {
    const int r32 = lane & 31, hi = lane >> 5;
    const int seq = (b * 4 + h) * 2 + DIR, nd = chunk_dir(n, DIR);
    const float* sp = p.GU + ((size_t)seq * NCH + nd) * 2048;
    const int t128 = ih * 64 + lane;
    f32x4 sv[4];
#pragma unroll
    for (int it = 0; it < 4; ++it) sv[it] = *(const f32x4*)(sp + (it * 128 + t128) * 4);
    v4u pq[2], pk[2]; f32x4 pb[2][2];
#pragma unroll
    for (int i = 0; i < 2; ++i) { const int item = lane + 64 * i, t = item >> 2, g8 = item & 3; const size_t row = (size_t)(row0 + 32 * ih + t);
        pq[i] = *(const v4u*)(p.P + row * INWP + D_Q + h * 32 + g8 * 8); pk[i] = *(const v4u*)(p.P + row * INWP + D_K + h * 32 + g8 * 8);
        const float* bp = p.BC + row * 256 + DIR * 128 + h * 32 + g8 * 8; pb[i][0] = *(const f32x4*)bp; pb[i][1] = *(const f32x4*)(bp + 4); }
#pragma unroll
    for (int i = 0; i < 2; ++i) { const int item = lane + 64 * i, t = item >> 2, g8 = item & 3;
        float e[8], qf[8], kf[8];
#pragma unroll
        for (int j = 0; j < 4; ++j) { e[j] = pb[i][0][j]; e[4 + j] = pb[i][1][j]; }
        qf[0] = bflo(pq[i].x); qf[1] = bfhi(pq[i].x); qf[2] = bflo(pq[i].y); qf[3] = bfhi(pq[i].y); qf[4] = bflo(pq[i].z); qf[5] = bfhi(pq[i].z); qf[6] = bflo(pq[i].w); qf[7] = bfhi(pq[i].w);
        kf[0] = bflo(pk[i].x); kf[1] = bfhi(pk[i].x); kf[2] = bflo(pk[i].y); kf[3] = bfhi(pk[i].y); kf[4] = bflo(pk[i].z); kf[5] = bfhi(pk[i].z); kf[6] = bflo(pk[i].w); kf[7] = bfhi(pk[i].w);
#pragma unroll
        for (int j = 0; j < 8; ++j) { qf[j] *= __builtin_amdgcn_exp2f(e[j] * LOG2E) * 0.17677669529663687f; kf[j] *= __builtin_amdgcn_exp2f(-e[j] * LOG2E); }
        v4u wq, wk; wq.x = cvtpk(qf[0], qf[1]); wq.y = cvtpk(qf[2], qf[3]); wq.z = cvtpk(qf[4], qf[5]); wq.w = cvtpk(qf[6], qf[7]);
        wk.x = cvtpk(kf[0], kf[1]); wk.y = cvtpk(kf[2], kf[3]); wk.z = cvtpk(kf[4], kf[5]); wk.w = cvtpk(kf[6], kf[7]);
        *(v4u*)(L.Qd + t * S32 + g8 * 8) = wq; *(v4u*)(L.Kd + (32 * ih + t) * S32 + g8 * 8) = wk; }
#pragma unroll
    for (int it = 0; it < 4; ++it) { const int e4 = (it * 128 + t128) * 4, kk = e4 >> 6, d0 = e4 & 63; const f32x4 v = sv[it];
        L.St[(d0 + 0) * S32 + kk] = (bf16)f2bf(v.x); L.St[(d0 + 1) * S32 + kk] = (bf16)f2bf(v.y); L.St[(d0 + 2) * S32 + kk] = (bf16)f2bf(v.z); L.St[(d0 + 3) * S32 + kk] = (bf16)f2bf(v.w); }
    __syncthreads();
#pragma unroll
    for (int jt = 0; jt < 2; ++jt) {
        f32x16 c = {};
        c = mm_tile<2>(c, L.Qd, S32, L.Kd + (32 * jt) * S32, S32, r32, hi);
        const int j = 32 * jt + r32;
#pragma unroll
        for (int r = 0; r < 16; ++r) { const int il = att::crow(r, hi), ig = 32 * ih + il; const bool keep = DIR == 0 ? (j <= ig) : (j >= ig);
            L.AT[il * S64 + j] = (bf16)f2bf(keep ? c[r] : 0.f); }
    }
    LDS_WAIT();
#pragma unroll
    for (int dt = 0; dt < 2; ++dt) {
        o[dt] = mm_tile<4>(o[dt], L.AT, S64, L.Vt + (32 * dt) * S64, S64, r32, hi);
        o[dt] = mm_tile<2>(o[dt], L.Qd, S32, L.St + (32 * dt) * S32, S32, r32, hi);
    }
    __syncthreads();
}
__device__ __forceinline__ void g3_unit(const Par& p, int b, int n, char* shm) {
    int tid_ = threadIdx.x; asm volatile("" : "+v"(tid_));
    const int tid = tid_, lane = tid & 63, r32 = lane & 31, hi = lane >> 5; const int wid = __builtin_amdgcn_readfirstlane(tid >> 6);
    const int h = wid >> 1, ih = wid & 1, row0 = chunk_row(b, n);
    char* pr = shm + (wid >> 1) * 33792;
    G3Lds L;
    L.Kd = (bf16*)pr;
    L.St = (bf16*)(pr + 5120);
    L.Vt = (bf16*)(pr + 10240);
    L.Qd = (bf16*)(pr + 19456 + ih * 7168);
    L.AT = (bf16*)(pr + 19456 + ih * 7168 + 2560);
    L.zl = nullptr;
    load_vt(L.Vt, p.P, row0, h, ih, lane);
    __syncthreads();
    f32x16 o[2]; o[0] = f32x16{}; o[1] = f32x16{};
    g3_dir<0>(o, p, L, row0, b, n, h, ih, lane);
    g3_dir<1>(o, p, L, row0, b, n, h, ih, lane);
    { v4u pg[4];
#pragma unroll
      for (int i = 0; i < 4; ++i) { const int pidx = lane + 64 * i; pg[i] = *(const v4u*)(p.P + (size_t)(row0 + 32 * ih + (pidx >> 3)) * INWP + D_R + h * 64 + (pidx & 7) * 8); }
#pragma unroll
      for (int i = 0; i < 4; ++i) { const int pidx = lane + 64 * i; *(v4u*)(L.AT + (pidx >> 3) * S64 + (pidx & 7) * 8) = pg[i]; } }
    const float gn0 = p.gnorm[r32], gn1 = p.gnorm[32 + r32];
    const unsigned lc_ = (unsigned)(4 * hi * DM + r32);
    LDS_WAIT();
#pragma unroll
    for (int r = 0; r < 16; ++r) {
        float ss = o[0][r] * o[0][r] + o[1][r] * o[1][r];
        ss += __shfl_xor(ss, 1); ss += __shfl_xor(ss, 2); ss += __shfl_xor(ss, 4); ss += __shfl_xor(ss, 8); ss += __shfl_xor(ss, 16);
        const float rstd = __builtin_amdgcn_rsqf(ss * (1.0f / 64.0f) + RMS_EPS);
        const int il = att::crow(r, hi);
        bf16* cp = p.CAT + (size_t)(row0 + 32 * ih + (r & 3) + 8 * (r >> 2)) * DM + 768 + h * 64;
        cp[lc_] = (bf16)f2bf(o[0][r] * rstd * gn0 * fsilu(bf2f(L.AT[il * S64 + r32])));
        cp[lc_ + 32] = (bf16)f2bf(o[1][r] * rstd * gn1 * fsilu(bf2f(L.AT[il * S64 + 32 + r32])));
    }
    __syncthreads();
}
}
#if defined(SELFCHECK) && SELFCHECK
namespace chk {
__device__ __forceinline__ void item(const unsigned char* ws, const float* rpb_l, const float* sink_l, int row, int mx, int h, int lane, float* acc2) {
    const bf16* P = (const bf16*)(ws + WS_P); const bf16* QC = (const bf16*)(ws + WS_QC); const bf16* KC = (const bf16*)(ws + WS_KC); const bf16* VC = (const bf16*)(ws + WS_VC); const bf16* CATp = (const bf16*)(ws + WS_CAT);
    const bool lat = row < NLAT; const int b = lat ? row >> 13 : (row - NLAT) >> 8; const int t = row & (SEQ - 1), r = t >> 6, c = t & 63;
    const bf16* qp; const bf16* Kb; const bf16* Vb; int kp;
    if (mx == 0) { qp = P + (size_t)row * INWP + A_Q + h * 64; Kb = P + A_K + h * 64; Vb = P + A_V + h * 64; kp = INWP; }
    else if (mx == 1) { qp = P + (size_t)row * INWP + B_Q + h * 64; Kb = P + B_K + (h >> 1) * 64; Vb = P + B_V + (h >> 1) * 64; kp = INWP; }
    else { qp = QC + (size_t)row * 256 + h * 64; Kb = KC + h * 64; Vb = VC + h * 64; kp = 256; }
    float q[64];
#pragma unroll
    for (int d = 0; d < 64; ++d) q[d] = bf2f(qp[d]);
    if (mx == 2 && lat) {
#pragma unroll
        for (int g2 = 0; g2 < 2; ++g2) { const float pos = (float)(g2 == 0 ? r : c);
#pragma unroll
            for (int i = 0; i < 8; ++i) { const float ang = pos * exp2f(-(float)i * (13.287712379549449f / 8.0f)); const float cs_ = __cosf(ang), sn_ = __sinf(ang);
                const float x1 = q[32 + 16 * g2 + i], x2 = q[32 + 16 * g2 + 8 + i]; q[32 + 16 * g2 + i] = x1 * cs_ - x2 * sn_; q[32 + 16 * g2 + 8 + i] = x2 * cs_ + x1 * sn_; } }
    }
    const int rs = r - 4 < 0 ? 0 : (r - 4 > 120 ? 120 : r - 4), cs = c - 8 < 0 ? 0 : (c - 8 > 48 ? 48 : c - 8);
    const int nlatk = !lat ? 0 : (mx == 0 ? 128 : (mx == 1 ? 257 : SEQ)), ncand = nlatk + CTXL;
    float mxv = -1e30f;
    for (int pass = 0; pass < 2; ++pass) {
        float l = 0.f, o[64];
#pragma unroll
        for (int d = 0; d < 64; ++d) o[d] = 0.f;
        float pm = -1e30f;
        for (int j = lane; j < ncand; j += 64) {
            int krow; float bias = 0.f; bool ok = true;
            if (j >= nlatk) krow = NLAT + b * CTXL + (j - nlatk);
            else if (mx == 0) { const int i = j >> 4, jj = j & 15; krow = b * SEQ + (rs + i) * 64 + cs + jj; bias = rpb_l[h * 465 + (rs + i - r + 7) * 31 + (cs + jj - c + 15)] * LOG2E; }
            else if (mx == 1) { const int kpos = t - 128 + j; ok = kpos >= 0 && kpos < SEQ; krow = b * SEQ + (ok ? kpos : 0); }
            else krow = b * SEQ + j;
            if (!ok) continue;
            const bf16* kr = Kb + (size_t)krow * kp; float s = bias;
#pragma unroll
            for (int d = 0; d < 64; d += 2) { const unsigned w = *(const unsigned*)(kr + d); s += q[d] * bflo(w) + q[d + 1] * bfhi(w); }
            if (pass == 0) pm = fmaxf(pm, s);
            else { const float pe = __builtin_amdgcn_exp2f(s - mxv); l += pe; const bf16* vr = Vb + (size_t)krow * kp;
#pragma unroll
                for (int d = 0; d < 64; d += 2) { const unsigned w = *(const unsigned*)(vr + d); o[d] += pe * bflo(w); o[d + 1] += pe * bfhi(w); } }
        }
        if (pass == 0) {
#pragma unroll
            for (int off = 32; off >= 1; off >>= 1) pm = fmaxf(pm, __shfl_xor(pm, off));
            mxv = pm;
        } else {
            l = wave_sum(l); if (mx == 1) l += __builtin_amdgcn_exp2f(sink_l[h] * LOG2E - mxv);
            float e2 = 0.f, r2 = 0.f;
#pragma unroll
            for (int d = 0; d < 64; ++d) { const float od = wave_sum(o[d]) / l; const float cd = bf2f(CATp[(size_t)row * DM + mx * 256 + h * 64 + d]); e2 += (od - cd) * (od - cd); r2 += od * od; }
            if (lane == 0) { atomicAdd(acc2, e2); atomicAdd(acc2 + 1, r2); atomicAdd(acc2 + 2 + 2 * mx, e2); atomicAdd(acc2 + 3 + 2 * mx, r2); }
        }
    }
}
__device__ __forceinline__ void rope_pair(float& x1, float& x2, float pos, int i, int half) {
    const float ang = pos * exp2f(-(float)i * (13.287712379549449f / (float)half)); const float cs_ = __cosf(ang), sn_ = __sinf(ang);
    const float a = x1, b = x2; x1 = a * cs_ - b * sn_; x2 = b * cs_ + a * sn_;
}
__device__ __forceinline__ void proj_item(const unsigned char* ws, const float* w_in_l, const float* gq, const float* gkv, const float* wuq, const float* wukv, int row, int lane, float* pl, float* acc2) {
    const bf16* Hh = (const bf16*)(ws + WS_H) + (size_t)row * HLD; const bf16* P = (const bf16*)(ws + WS_P) + (size_t)row * INWP;
    const bf16* QCr = (const bf16*)(ws + WS_QC) + (size_t)row * 256; const bf16* KCr = (const bf16*)(ws + WS_KC) + (size_t)row * 256; const bf16* VCr = (const bf16*)(ws + WS_VC) + (size_t)row * 256;
    const bool lat = row < NLAT; const int t = row & (SEQ - 1); const float pr_ = (float)(t >> 6), pc_ = (float)(t & 63);
    for (int j = 0; j < 15; ++j) { const int cc = lane + 64 * j; if (cc >= 928) break; const int col = 768 + cc; float s = 0.f;
        for (int k = 0; k < DM; ++k) { float hv = bf2f(Hh[k]); if (ROUTER_SPLIT) hv += bf2f(Hh[DM + k]); s += hv * w_in_l[(size_t)k * INW + col]; }
        pl[cc] = s; }
    LDS_WAIT();
    float e2[7] = {0.f, 0.f, 0.f, 0.f, 0.f, 0.f, 0.f}, r2[7] = {0.f, 0.f, 0.f, 0.f, 0.f, 0.f, 0.f};
#define CHK_ACC(cat, ref, got) do { const float rf_ = (ref), gt_ = (got); e2[cat] += (rf_ - gt_) * (rf_ - gt_); r2[cat] += rf_ * rf_; } while (0)
    for (int pi = lane; pi < 6 * 32; pi += 64) { const int hd = pi >> 5, i = pi & 31, g2 = i >> 4, ii = i & 15; const int base = hd * 64 + 32 * g2 + ii;
        float x1 = pl[base], x2 = pl[base + 16]; if (lat) rope_pair(x1, x2, g2 == 0 ? pr_ : pc_, ii, 16);
        if (hd < 4) { CHK_ACC(0, x1 * C2, bf2f(P[B_Q + base])); CHK_ACC(0, x2 * C2, bf2f(P[B_Q + base + 16])); } else { CHK_ACC(1, x1, bf2f(P[B_Q + base])); CHK_ACC(1, x2, bf2f(P[B_Q + base + 16])); } }
    for (int i = lane; i < 128; i += 64) CHK_ACC(2, pl[B_V - 768 + i], bf2f(P[B_V + i]));
    float sq = 0.f, sk = 0.f;
    for (int i = lane; i < 256; i += 64) { const float v = pl[C_Q - 768 + i]; sq += v * v; }
    for (int i = lane; i < 128; i += 64) { const float v = pl[C_KV - 768 + i]; sk += v * v; }
    const float rq = 1.0f / sqrtf(wave_sum(sq) / 256.f + RMS_EPS), rk = 1.0f / sqrtf(wave_sum(sk) / 128.f + RMS_EPS);
    for (int n = lane; n < 256; n += 64) { float s = 0.f; for (int k = 0; k < 256; ++k) s += pl[C_Q - 768 + k] * rq * gq[k] * wuq[(size_t)k * 256 + n]; CHK_ACC(3, s * C2, bf2f(QCr[n])); }
    for (int n = lane; n < 384; n += 64) { float s = 0.f; for (int k = 0; k < 128; ++k) s += pl[C_KV - 768 + k] * rk * gkv[k] * wukv[(size_t)k * 384 + n];
        const int h = n / 96, jj = n % 96; if (jj < 32) CHK_ACC(4, s, bf2f(KCr[h * 64 + jj])); else CHK_ACC(6, s, bf2f(VCr[h * 64 + jj - 32])); }
    for (int pi = lane; pi < 4 * 16; pi += 64) { const int h = pi >> 4, i = pi & 15, g2 = i >> 3, ii = i & 7; const int base = 16 * g2 + ii;
        float x1 = pl[C_KR - 768 + base], x2 = pl[C_KR - 768 + base + 8]; if (lat) rope_pair(x1, x2, g2 == 0 ? pr_ : pc_, ii, 8);
        CHK_ACC(5, x1, bf2f(KCr[h * 64 + 32 + base])); CHK_ACC(5, x2, bf2f(KCr[h * 64 + 32 + base + 8])); }
#undef CHK_ACC
#pragma unroll
    for (int cat = 0; cat < 7; ++cat) { const float a = wave_sum(e2[cat]), b = wave_sum(r2[cat]); if (lane == 0) { atomicAdd(acc2 + 16 + 2 * cat, a); atomicAdd(acc2 + 17 + 2 * cat, b); } }
}
constexpr int NP_ROWS = 112;
__device__ __forceinline__ int proj_row(int s) { return s < 96 ? (int)(((long)s * 7919 + 5) % NLAT) : NLAT + ((s - 96) * 61 + 7) % NCTX; }
constexpr int NS_LAT = 640, NS_CTX = 48, NS_EDGE = 28;
__device__ __forceinline__ int sample_row(int s) {
    if (s < NS_LAT) return (int)(((long)s * 6151 + 17) % NLAT);
    s -= NS_LAT;
    if (s < NS_EDGE) { const int b = s / 7, k = s % 7; const int tt[7] = {0, 1, 63, 64, 4095, 8127, 8191}; int t = 0;
#pragma unroll
        for (int i = 0; i < 7; ++i) if (i == k) t = tt[i];
        return b * SEQ + t; }
    s -= NS_EDGE;
    return NLAT + (s * 21 + 3) % NCTX;
}
}
#endif
struct RowMapId { int off; __device__ __forceinline__ int operator()(int n) const { return off + n; } };
struct RowMapIl { int sub; __device__ __forceinline__ int operator()(int n) const { return 8 * (n >> 2) + 4 * sub + (n & 3); } };
struct RowMapKV { __device__ __forceinline__ int operator()(int n) const { const int h = n / 96, j = n % 96; return j < 32 ? h * 64 + j : 256 + h * 64 + (j - 32); } };
template <class RowMap>
__device__ __forceinline__ void tr_item(const float* W, int ldw, int k0, int n0, bf16* WT, int ldt, const RowMap& rm, const float* kscale, float* scr, int lane) {
#pragma unroll 4
    for (int it = 0; it < 16; ++it) { const int k = it * 4 + (lane >> 4), n4 = (lane & 15) * 4;
        f32x4 x = *(const f32x4*)(W + (size_t)(k0 + k) * ldw + n0 + n4);
        if (kscale) x = x * kscale[k0 + k];
        float* s = scr + k * 65 + n4; s[0] = x.x; s[1] = x.y; s[2] = x.z; s[3] = x.w; }
    LDS_WAIT();
#pragma unroll 2
    for (int it = 0; it < 8; ++it) { const int n = it * 8 + (lane >> 3), c = lane & 7; const float* s = scr + (8 * c) * 65 + n;
        v4u o; o.x = pk2(s[0 * 65], s[1 * 65]); o.y = pk2(s[2 * 65], s[3 * 65]); o.z = pk2(s[4 * 65], s[5 * 65]); o.w = pk2(s[6 * 65], s[7 * 65]);
        *(v4u*)(WT + (size_t)rm(n0 + n) * ldt + k0 + 8 * c) = o; }
    LDS_WAIT();
}
__device__ __forceinline__ void ld_row(const float* p, int lane, f32x4 (&v)[4]) {
#pragma unroll
    for (int j = 0; j < 2; ++j) { v[2 * j] = *(const f32x4*)(p + 512 * j + 8 * lane); v[2 * j + 1] = *(const f32x4*)(p + 512 * j + 8 * lane + 4); }
}
__device__ __forceinline__ void st_row(float* p, int lane, const f32x4 (&v)[4]) {
#pragma unroll
    for (int j = 0; j < 2; ++j) { *(f32x4*)(p + 512 * j + 8 * lane) = v[2 * j]; *(f32x4*)(p + 512 * j + 8 * lane + 4) = v[2 * j + 1]; }
}
__device__ __forceinline__ void st_row_bf16(bf16* p, int lane, const f32x4 (&v)[4]) {
#pragma unroll
    for (int j = 0; j < 2; ++j) { v4u w; w.x = cvtpk(v[2 * j].x, v[2 * j].y); w.y = cvtpk(v[2 * j].z, v[2 * j].w); w.z = cvtpk(v[2 * j + 1].x, v[2 * j + 1].y); w.w = cvtpk(v[2 * j + 1].z, v[2 * j + 1].w);
        *(v4u*)(p + 512 * j + 8 * lane) = w; }
}
__device__ __forceinline__ void st_row_hilo(bf16* p, int lane, const f32x4 (&v)[4]) {
#pragma unroll
    for (int j = 0; j < 2; ++j) { v4u w, wl; const f32x4 a = v[2 * j], b = v[2 * j + 1];
        w.x = cvtpk(a.x, a.y); w.y = cvtpk(a.z, a.w); w.z = cvtpk(b.x, b.y); w.w = cvtpk(b.z, b.w);
        wl.x = cvtpk(a.x - bflo(w.x), a.y - bfhi(w.x)); wl.y = cvtpk(a.z - bflo(w.y), a.w - bfhi(w.y)); wl.z = cvtpk(b.x - bflo(w.z), b.y - bfhi(w.z)); wl.w = cvtpk(b.z - bflo(w.w), b.w - bfhi(w.w));
        *(v4u*)(p + 512 * j + 8 * lane) = w; if (ROUTER_SPLIT) *(v4u*)(p + DM + 512 * j + 8 * lane) = wl; }
}
__device__ __forceinline__ void tr_item_router(const float* W, int k0, int n0, bf16* WT, float* scr, int lane) {
#pragma unroll 4
    for (int it = 0; it < 16; ++it) { const int k = it * 4 + (lane >> 4), n4 = (lane & 15) * 4;
        const f32x4 x = *(const f32x4*)(W + (size_t)(k0 + k) * NEXP + n0 + n4);
        float* s = scr + k * 65 + n4; s[0] = x.x; s[1] = x.y; s[2] = x.z; s[3] = x.w; }
    LDS_WAIT();
#pragma unroll 2
    for (int it = 0; it < 8; ++it) { const int n = it * 8 + (lane >> 3), c = lane & 7; const float* s = scr + (8 * c) * 65 + n;
        float f[8]; v4u o, ol;
#pragma unroll
        for (int i = 0; i < 8; ++i) f[i] = s[i * 65];
        o.x = cvtpk(f[0], f[1]); o.y = cvtpk(f[2], f[3]); o.z = cvtpk(f[4], f[5]); o.w = cvtpk(f[6], f[7]);
        ol.x = cvtpk(f[0] - bflo(o.x), f[1] - bfhi(o.x)); ol.y = cvtpk(f[2] - bflo(o.y), f[3] - bfhi(o.y)); ol.z = cvtpk(f[4] - bflo(o.z), f[5] - bfhi(o.z)); ol.w = cvtpk(f[6] - bflo(o.w), f[7] - bfhi(o.w));
        bf16* d0 = WT + (size_t)(n0 + n) * HLD + k0 + 8 * c; bf16* d1 = WT + (size_t)(128 + n0 + n) * HLD + k0 + 8 * c;
        if (ROUTER_SPLIT) { *(v4u*)d0 = o; *(v4u*)(d0 + DM) = o; *(v4u*)d1 = ol; *(v4u*)(d1 + DM) = ol; }
        else { *(v4u*)d0 = o; *(v4u*)d1 = (v4u){0u, 0u, 0u, 0u}; } }
    LDS_WAIT();
}
__device__ __forceinline__ void ln_row(f32x4 (&v)[4]) {
    float s = 0.f;
#pragma unroll
    for (int j = 0; j < 4; ++j) s += (v[j].x + v[j].y) + (v[j].z + v[j].w);
    const float mean = wave_sum(s) * (1.f / DM); float s2 = 0.f;
#pragma unroll
    for (int j = 0; j < 4; ++j) { v[j] = v[j] - mean; s2 += (v[j].x * v[j].x + v[j].y * v[j].y) + (v[j].z * v[j].z + v[j].w * v[j].w); }
    const float rstd = 1.0f / sqrtf(wave_sum(s2) * (1.f / DM) + LN_EPS);
#pragma unroll
    for (int j = 0; j < 4; ++j) v[j] = v[j] * rstd;
}
template <bool ONEPLUS>
__device__ __forceinline__ void affine_row(f32x4 (&v)[4], const float* a, const float* b, int lane) {
    f32x4 av[4], bv[4]; ld_row(a, lane, av); ld_row(b, lane, bv);
#pragma unroll
    for (int j = 0; j < 4; ++j) v[j] = ONEPLUS ? v[j] * (av[j] + 1.0f) + bv[j] : v[j] * av[j] + bv[j];
}
__device__ __forceinline__ int mod_row(int row) { return row < NLAT ? (row >> 13) : 4; }

__device__ __forceinline__ int ltid() { int t = threadIdx.x; asm volatile("" : "+v"(t)); return t; }
struct Args {
    const float *x, *c, *ctx, *c_ctx, *w_ada, *b_ada, *w_in, *na_rpb, *wa_sink, *mla_g_q, *mla_g_kv, *mla_w_uq, *mla_w_ukv,
                *gla_w_gf, *gla_b_gf, *gla_w_gb, *gla_b_gb, *gla_g_norm, *w_out, *ln1_g, *ln1_b, *ln2_g, *ln2_b,
                *router_w, *router_bias, *exp_w1, *exp_w3, *exp_w2, *sh_w1, *sh_w3, *sh_w2;
    float* out; unsigned char* ws;
};
static_assert(sizeof(Args) == 33 * 8, "Args has no padding");

constexpr int CV_N = NEXP * 192, CV_N0 = 5344, CV_N1 = CV_N0 + 4608, CV_N2 = CV_N1 + 7680;
__device__ __forceinline__ void convert_experts(const Args& A, int l, int lo, int hi, int gw, int NGW, float* scr, int lane) {
    bf16* we13 = (bf16*)(A.ws + WS_WE13); bf16* we2 = (bf16*)(A.ws + WS_WE2);
    for (int it = lo + gw; it < hi; it += NGW) {
        const int e = it / 192, r = it % 192, which = r >> 6, q = r & 63;
        if (which < 2) { const float* W = (which == 0 ? A.exp_w1 : A.exp_w3) + ((size_t)l * NEXP + e) * DM * DEXP;
            tr_item(W, DEXP, (q >> 2) * 64, (q & 3) * 64, we13 + (size_t)e * 512 * DM, DM, RowMapIl{which}, nullptr, scr, lane); }
        else { const float* W = A.exp_w2 + ((size_t)l * NEXP + e) * DEXP * DM;
            tr_item(W, DM, (q >> 4) * 64, (q & 15) * 64, we2 + (size_t)e * DM * DEXP, DEXP, RowMapId{0}, nullptr, scr, lane); }
    }
}

#ifndef SELFCHECK_TOL
#define SELFCHECK_TOL 0.03f
#endif
#ifndef SELFCHECK_TOL2
#define SELFCHECK_TOL2 0.02f
#endif
#ifndef PHMASK
#define PHMASK 0xffffff
#endif
#define PHON(k) (((PHMASK) >> (k)) & 1)
#ifndef DUPK
#define DUPK -1
#endif
#define DUP_SECOND 0
__global__ void __launch_bounds__(512, 2) hybrid_fwd(Args A) {
    extern __shared__ __attribute__((aligned(16))) unsigned char lds[];
    const int wave = __builtin_amdgcn_readfirstlane((int)threadIdx.x >> 6);
    const int G = gridDim.x; const int bx = blockIdx.x; const int vcu = (G % 8 == 0) ? (bx % 8) * (G / 8) + bx / 8 : bx;
    const int gw = vcu * 8 + wave, NGW = G * 8;
    const bool cv_tails = (G == 256);
    GAS unsigned char* wsg = (GAS unsigned char*)A.ws;
    unsigned char* ws = (unsigned char*)wsg;
#define WS_LAUNDER() asm volatile("" : "+s"(wsg)); ws = (unsigned char*)wsg; const int tid = ltid(), lane = tid & 63; (void)lane
    gu32* ctl = (gu32*)(ws + WS_CTL);
    volatile LAS unsigned* MISC = (volatile LAS unsigned*)((LAS unsigned char*)lds + MISC_OFF);
    { const int tid = ltid(); if (tid < 128) MISC[tid] = 0u; }
    __syncthreads();
    XcdBarrier bar = xcd_barrier_post((unsigned*)(ctl + CW_BAR), MISC);
#define GRID_BAR() do { XcdBarrier b2_ = bar; GAS unsigned* bp_ = (GAS unsigned*)bar.bar; asm volatile("" : "+s"(bp_), "+s"(b2_.x)); b2_.bar = (unsigned*)bp_; xcd_barrier(b2_); } while (0)
    char* shm = (char*)lds;
#define MODT ((float*)(ws + WS_MOD))
#define Hb ((bf16*)(ws + WS_H))
#define Pb ((bf16*)(ws + WS_P))
#define QC ((bf16*)(ws + WS_QC))
#define KC ((bf16*)(ws + WS_KC))
#define VC ((bf16*)(ws + WS_VC))
#define CAT ((bf16*)(ws + WS_CAT))
#define XA ((float*)(ws + WS_XA))
#define Zb ((float*)(ws + WS_Z))
#define RSTD ((float*)(ws + WS_RSTD))

        if (PHON(0)) {
        WS_LAUNDER();
    {
        float* sc = (float*)shm;
        float* part = (float*)(shm + 20480);
        for (int i = tid; i < 5 * DM; i += 512) { const float v = i < 4 * DM ? A.c[i] : A.c_ctx[i - 4 * DM]; sc[i] = v / (1.0f + __expf(-v)); }
        __syncthreads();
        for (int grp = vcu; grp < DEPTH * 96; grp += G) {
            const int l = grp / 96, col = (grp % 96) * 64 + lane;
            const float* wp = A.w_ada + (size_t)l * DM * 6 * DM + col;
            float acc[5] = {0.f, 0.f, 0.f, 0.f, 0.f};
#pragma unroll 8
            for (int kk = 0; kk < 128; ++kk) { const int k = wave * 128 + kk; const float w = wp[(size_t)k * 6 * DM];
#pragma unroll
                for (int r = 0; r < 5; ++r) acc[r] += sc[r * DM + k] * w; }
#pragma unroll
            for (int r = 0; r < 5; ++r) part[(wave * 5 + r) * 64 + lane] = acc[r];
            __syncthreads();
            if (tid < 320) { const int r = tid >> 6; float s = A.b_ada[(size_t)l * 6 * DM + col];
#pragma unroll
                for (int w8 = 0; w8 < 8; ++w8) s += part[(w8 * 5 + r) * 64 + lane];
                MODT[((size_t)l * 5 + r) * 6 * DM + col] = s; }
            __syncthreads();
        }
        float* scr = (float*)(shm + wave * 16640);
        constexpr int I_IN = 16 * 39, I_OUT = 16 * 16, I_UQ = 4 * 4, I_UKV = 2 * 6, I_RT = 16 * 2, I_S1 = 16 * 4, I_S2 = 4 * 16;
        constexpr int I_L = I_IN + I_OUT + I_UQ + I_UKV + I_RT + 2 * I_S1 + I_S2;
        for (int it = gw; it < DEPTH * I_L; it += NGW) {
            const int l = it / I_L; int r = it % I_L;
            if (r < I_IN) { tr_item(A.w_in + (size_t)l * DM * INW, INW, (r / 39) * 64, (r % 39) * 64, (bf16*)(ws + WS_WIN) + (size_t)l * INWP * DM, DM, RowMapId{0}, nullptr, scr, lane); continue; } r -= I_IN;
            if (r < I_OUT) { tr_item(A.w_out + (size_t)l * DM * DM, DM, (r / 16) * 64, (r % 16) * 64, (bf16*)(ws + WS_WOUT) + (size_t)l * DM * DM, DM, RowMapId{0}, nullptr, scr, lane); continue; } r -= I_OUT;
            if (r < I_UQ) { tr_item(A.mla_w_uq + (size_t)l * 256 * 256, 256, (r / 4) * 64, (r % 4) * 64, (bf16*)(ws + WS_WUQ) + (size_t)l * 256 * 256, 256, RowMapId{0}, A.mla_g_q + l * 256, scr, lane); continue; } r -= I_UQ;
            if (r < I_UKV) { tr_item(A.mla_w_ukv + (size_t)l * 128 * 384, 384, (r / 6) * 64, (r % 6) * 64, (bf16*)(ws + WS_WUKV) + (size_t)l * 512 * 128, 128, RowMapKV{}, A.mla_g_kv + l * 128, scr, lane); continue; } r -= I_UKV;
            if (r < I_RT) { tr_item_router(A.router_w + (size_t)l * DM * NEXP, (r / 2) * 64, (r % 2) * 64, (bf16*)(ws + WS_WRT) + (size_t)l * 256 * HLD, scr, lane); continue; } r -= I_RT;
            if (r < I_S1) { tr_item(A.sh_w1 + (size_t)l * DM * 256, 256, (r / 4) * 64, (r % 4) * 64, (bf16*)(ws + WS_WS13) + (size_t)l * 512 * DM, DM, RowMapIl{0}, nullptr, scr, lane); continue; } r -= I_S1;
            if (r < I_S1) { tr_item(A.sh_w3 + (size_t)l * DM * 256, 256, (r / 4) * 64, (r % 4) * 64, (bf16*)(ws + WS_WS13) + (size_t)l * 512 * DM, DM, RowMapIl{1}, nullptr, scr, lane); continue; } r -= I_S1;
            tr_item(A.sh_w2 + (size_t)l * 256 * DM, DM, (r / 16) * 64, (r % 16) * 64, (bf16*)(ws + WS_WS2) + (size_t)l * DM * 256, 256, RowMapId{0}, nullptr, scr, lane);
        }
        { const v4u z = {0u, 0u, 0u, 0u}; const int gt = vcu * 512 + tid, NGT = G * 512;
            for (int i = gt; i < DEPTH * 64 * 128; i += NGT) { const int l = i / (64 * 128), r = i % (64 * 128); *(v4u*)((bf16*)(ws + WS_WIN) + ((size_t)l * INWP + INW) * DM + (size_t)r * 8) = z; }
            for (int i = gt; i < DEPTH * 4 * 32 * 16; i += NGT) { const int l = i / 2048, r = i % 2048, h = r / 512, q = r % 512; *(v4u*)((bf16*)(ws + WS_WUKV) + ((size_t)l * 512 + h * 64 + 32) * 128 + (size_t)q * 8) = z; } }
    }
        }
    GRID_BAR();
        if (PHON(1)) {
        WS_LAUNDER();
    for (int m = gw; m < NTOK; m += NGW) {
        const float* src = m < NLAT ? A.x + (size_t)m * DM : A.ctx + (size_t)(m - NLAT) * DM;
        f32x4 v[4]; ld_row(src, lane, v); st_row(XA + (size_t)m * DM, lane, v);
        ln_row(v); const float* mp = MODT + (size_t)mod_row(m) * 6 * DM; affine_row<true>(v, mp + DM, mp, lane);
        st_row_hilo(Hb + (size_t)m * HLD, lane, v);
    }
    convert_experts(A, 0, 0, cv_tails ? CV_N0 : CV_N, gw, NGW, (float*)(shm + wave * 16640), lane);
        }
    GRID_BAR();

#pragma unroll 1
    for (int l = 0; l < DEPTH; ++l) {
        const bool lastl = (l == DEPTH - 1);
        const int MT = lastl ? NLAT : NTOK;
#define modl (MODT + (size_t)l * 5 * 6 * DM)
        if (PHON(2)) {
        WS_LAUNDER();
        { pg8::Gemm g{Hb, (const bf16*)(ws + WS_WIN) + (size_t)l * INWP * DM, DM, HLD, nullptr}; pg8::StaticOrder S; S.init(NTOK, INWP, G, bx);
          pg8::EpiBf16<INWP, false> E{Pb, 10, (1u << 0) | (1u << 3), C2, 256, nullptr, 0};
          pg8::gemm_phase<pg8::EpiBf16<INWP, false>, pg8::StaticOrder, false>((LAS unsigned char*)lds, g, S, E); }
        if (cv_tails && !lastl && bx >= 40) convert_experts(A, l, CV_N0, CV_N1, (bx - 40) * 8 + wave, 216 * 8, (float*)(shm + wave * 16640), lane);
        }
        GRID_BAR();
        if (PHON(3)) {
        WS_LAUNDER();
        {
        const bool roleB = lane < 24, roleK = lane == 24 || lane == 25;
        const int hd = lane >> 2, g2 = roleB ? (lane >> 1) & 1 : lane & 1, c8 = lane & 1;
        const int col1 = roleB ? B_Q + hd * 64 + 32 * g2 + 8 * c8 : C_KR + 16 * g2, dpart = roleB ? 16 : 8;
        const int f0 = roleB ? 8 * c8 : 0; const float fdiv = roleB ? 13.287712379549449f / 16.0f : 13.287712379549449f / 8.0f;
        for (int m0 = gw; m0 < NTOK; m0 += 4 * NGW) {
            v4u xa[4], xb[4]; v2u ca[4]; unsigned cb[4];
#pragma unroll
            for (int u = 0; u < 4; ++u) { const int m = m0 + u * NGW; const bf16* pr = Pb + (size_t)(m < NTOK ? m : 0) * INWP;
                xa[u] = *(const v4u*)(pr + col1); xb[u] = *(const v4u*)(pr + col1 + dpart);
                ca[u] = *(const v2u*)(pr + C_Q + 4 * lane); cb[u] = *(const unsigned*)(pr + C_KV + 2 * lane); }
#pragma unroll
            for (int u = 0; u < 4; ++u) { const int m = m0 + u * NGW; if (m < NTOK) { bf16* pr = Pb + (size_t)m * INWP;
                const bool lat = m < NLAT; const int t = m & (SEQ - 1);
                if ((roleB && lat) || roleK) {
                    const float pos = (float)(g2 == 0 ? (t >> 6) : (t & 63)); v4u oa, ob;
#pragma unroll
                    for (int j = 0; j < 4; ++j) { float r1[2], r2[2];
#pragma unroll
                        for (int e = 0; e < 2; ++e) { const float rev = pos * __builtin_amdgcn_exp2f(-(float)(f0 + 2 * j + e) * fdiv) * 0.15915494309189535f;
                            const float cs_ = lat ? __builtin_amdgcn_cosf(rev) : 1.f, sn_ = lat ? __builtin_amdgcn_sinf(rev) : 0.f;
                            const float a1 = e ? bfhi(xa[u][j]) : bflo(xa[u][j]), a2 = e ? bfhi(xb[u][j]) : bflo(xb[u][j]); r1[e] = a1 * cs_ - a2 * sn_; r2[e] = a2 * cs_ + a1 * sn_; }
                        oa[j] = cvtpk(r1[0], r1[1]); ob[j] = cvtpk(r2[0], r2[1]); }
                    if (roleB) { *(v4u*)(pr + col1) = oa; *(v4u*)(pr + col1 + 16) = ob; }
                    else { bf16* kd = KC + (size_t)m * 256 + 32 + 16 * g2;
#pragma unroll
                        for (int h4 = 0; h4 < 4; ++h4) { *(v4u*)(kd + h4 * 64) = oa; *(v4u*)(kd + h4 * 64 + 8) = ob; } }
                }
                const v2u a_ = ca[u]; const unsigned b2 = cb[u];
                float sq = bflo(a_.x) * bflo(a_.x) + bfhi(a_.x) * bfhi(a_.x) + bflo(a_.y) * bflo(a_.y) + bfhi(a_.y) * bfhi(a_.y); float sk = bflo(b2) * bflo(b2) + bfhi(b2) * bfhi(b2);
                sq = wave_sum(sq); sk = wave_sum(sk);
                if (lane == 0) { RSTD[2 * m] = 1.0f / sqrtf(sq * (1.f / 256.f) + RMS_EPS); RSTD[2 * m + 1] = 1.0f / sqrtf(sk * (1.f / 128.f) + RMS_EPS); } } }
        }
        }
        }
#define GLA_PAR() const gla::Par gp{Pb, CAT, (float*)(ws + WS_GU), (float*)(ws + WS_GDEC), (float*)(ws + WS_BC), A.gla_w_gf + l * 16 * 128, A.gla_b_gf + l * 128, A.gla_w_gb + l * 16 * 128, A.gla_b_gb + l * 128, A.gla_g_norm + l * 64}
        if (PHON(3)) {
        WS_LAUNDER();
        if (PHON(21)) { GLA_PAR(); for (int u = vcu; u < NB * NCH; u += G) gla::g1_unit(gp, u / NCH, u % NCH, shm); }
        }
        GRID_BAR();
        if (PHON(4)) {
        WS_LAUNDER();
        { pg8::Gemm g{Pb + C_Q, (const bf16*)(ws + WS_WUQ) + (size_t)l * 256 * 256, 256, INWP, nullptr}; pg8::StaticOrder S; S.init(NTOK, 256, G, bx);
          pg8::EpiBf16<256, true> E{QC, 1, 1u, C2, 0, RSTD, 0};
          pg8::gemm_phase<pg8::EpiBf16<256, true>, pg8::StaticOrder, false>((LAS unsigned char*)lds, g, S, E); }
        { pg8::Gemm g{Pb + C_KV, (const bf16*)(ws + WS_WUKV) + (size_t)l * 512 * 128, 128, INWP, nullptr}; pg8::StaticOrder S; S.init(NTOK, 512, G, bx);
          pg8::EpiBf16<256, true, true> E{KC, 2, 0u, 1.f, (size_t)(WS_VC - WS_KC) / 2, RSTD, 1};
          pg8::gemm_phase<pg8::EpiBf16<256, true, true>, pg8::StaticOrder, false>((LAS unsigned char*)lds, g, S, E); }
        if (!DUP_SECOND) gla::g2_scan((float*)(ws + WS_GU), (const float*)(ws + WS_GDEC), vcu * 512 + tid);
        }
        GRID_BAR();
#if defined(SELFCHECK) && SELFCHECK
        {
            WS_LAUNDER();
            float* acc2 = (float*)(ws + WS_CTL) + 32768;
            for (int it = gw; it < chk::NP_ROWS; it += NGW) chk::proj_item(ws, A.w_in + (size_t)l * DM * INW, A.mla_g_q + l * 256, A.mla_g_kv + l * 128, A.mla_w_uq + (size_t)l * 256 * 256, A.mla_w_ukv + (size_t)l * 128 * 384,
                                                                            chk::proj_row(it), lane, (float*)(shm + wave * 4096), acc2);
            __syncthreads();
        }
#endif
        if (PHON(6)) {
        WS_LAUNDER();
        {
            if (PHON(16)) for (int u = vcu; u < 512; u += G) { const int bh = 2 * ((u & 255) >> 5) + (u >> 8), qb = u & 31, b = bh >> 2, h = bh & 3;
                att::Desc d{}; d.Q = QC + (size_t)(b * SEQ + 256 * qb) * 256 + h * 64; d.qp = 256; d.K = KC + h * 64; d.V = VC + h * 64; d.kp = 256;
                d.O = CAT + (size_t)(b * SEQ + 256 * qb) * DM + 512 + h * 64; d.op = DM; d.nt = 132; d.nctx = 4; d.ctxrow = NLAT + b * CTXL; d.latrow = b * SEQ;
                d.nt_real = d.nt; d.qrope = 1; d.qt0 = 256 * qb; att::attn_unit_pipe<8, att::M_FULL>(d, shm); }
            if (PHON(17)) for (int u = vcu; u < 512; u += G) { const int bh = u >> 5, qb = u & 31, b = bh >> 2, h = bh & 3; const int r0 = 4 * qb;
                const int kr0 = r0 - 4 < 0 ? 0 : (r0 - 4 > 120 ? 120 : r0 - 4); const int r3 = r0 + 3; const int krl = (r3 - 4 < 0 ? 0 : (r3 - 4 > 120 ? 120 : r3 - 4)) + 8;
                att::Desc d{}; d.Q = Pb + (size_t)(b * SEQ + 256 * qb) * INWP + A_Q + h * 64; d.qp = INWP; d.K = Pb + A_K + h * 64; d.V = Pb + A_V + h * 64; d.kp = INWP;
                d.O = CAT + (size_t)(b * SEQ + 256 * qb) * DM + h * 64; d.op = DM; d.nctx = 4; d.nt = 4 + (krl - kr0); d.ctxrow = NLAT + b * CTXL; d.latrow = b * SEQ + 64 * kr0;
                d.r0 = r0; d.kr0 = kr0; d.rpb = A.na_rpb + ((size_t)l * 4 + h) * 465;
                d.nt_real = d.nt; d.nt = (d.nt + 1) & ~1; att::attn_unit_pipe<8, att::M_NA>(d, shm); }
            if (PHON(18)) for (int u = vcu; u < 512; u += G) { const int bh = u >> 5, qb = u & 31, b = bh >> 2, h = bh & 3; const int q0 = 256 * qb;
                const int kt0 = q0 - 128 < 0 ? 0 : q0 - 128; const int kte = q0 + 256 + 128 > SEQ ? SEQ : q0 + 256 + 128;
                att::Desc d{}; d.Q = Pb + (size_t)(b * SEQ + q0) * INWP + B_Q + h * 64; d.qp = INWP; d.K = Pb + B_K + (h >> 1) * 64; d.V = Pb + B_V + (h >> 1) * 64; d.kp = INWP;
                d.O = CAT + (size_t)(b * SEQ + q0) * DM + 256 + h * 64; d.op = DM; d.nctx = 4; d.nt = 4 + (kte - kt0) / 64; d.ctxrow = NLAT + b * CTXL; d.latrow = b * SEQ + kt0;
                d.q0 = q0; d.kt0 = kt0; d.sink_l2 = A.wa_sink[l * 4 + h] * LOG2E; d.has_sink = 1;
                d.nt_real = d.nt; d.nt = (d.nt + 1) & ~1; att::attn_unit_pipe<8, att::M_WA>(d, shm); }
            if (PHON(19) && !lastl) for (int u = vcu; u < 48; u += G) { const int mx = u >> 4, b = (u >> 2) & 3, h = u & 3; const int qrow = NLAT + b * CTXL;
                att::Desc d{}; d.nt = 4; d.nctx = 4; d.ctxrow = qrow; d.latrow = 0; d.op = DM; d.O = CAT + (size_t)qrow * DM + 256 * mx + h * 64;
                if (mx == 0) { d.Q = Pb + (size_t)qrow * INWP + A_Q + h * 64; d.qp = INWP; d.K = Pb + A_K + h * 64; d.V = Pb + A_V + h * 64; d.kp = INWP; }
                else if (mx == 1) { d.Q = Pb + (size_t)qrow * INWP + B_Q + h * 64; d.qp = INWP; d.K = Pb + B_K + (h >> 1) * 64; d.V = Pb + B_V + (h >> 1) * 64; d.kp = INWP; d.sink_l2 = A.wa_sink[l * 4 + h] * LOG2E; d.has_sink = 1; }
                else { d.Q = QC + (size_t)qrow * 256 + h * 64; d.qp = 256; d.K = KC + h * 64; d.V = VC + h * 64; d.kp = 256; }
                att::attn_unit<att::M_FULL>(d, shm); }
            if (PHON(20)) { GLA_PAR(); for (int u = vcu; u < NB * NCH; u += G) { const int b = u / NCH, n = u % NCH; if (lastl && n < 4) continue; gla::g3_unit(gp, b, n, shm); } }
        }
        }
        GRID_BAR();
#if defined(SELFCHECK) && SELFCHECK
        {
            WS_LAUNDER();
            float* acc2 = (float*)(ws + WS_CTL) + 32768;
            const int ns = chk::NS_LAT + chk::NS_EDGE + (lastl ? 0 : chk::NS_CTX);
            for (int it = gw; it < ns * 12; it += NGW) chk::item(ws, A.na_rpb + (size_t)l * 4 * 465, A.wa_sink + l * 4, chk::sample_row(it / 12), (it % 12) >> 2, it & 3, lane, acc2);
        }
        GRID_BAR();
#endif
        if (PHON(7)) {
        WS_LAUNDER();
        { pg8::Gemm g{CAT, (const bf16*)(ws + WS_WOUT) + (size_t)l * DM * DM, DM, DM, nullptr}; pg8::StaticOrder S; S.init(MT, DM, G, bx);
          pg8::EpiBf16<DM, false> E{(bf16*)Zb, 4, 0u, 1.f, 256, nullptr, 0};
          pg8::gemm_phase<pg8::EpiBf16<DM, false>, pg8::StaticOrder, false>((LAS unsigned char*)lds, g, S, E); }
        if (cv_tails && !lastl && bx >= 16) convert_experts(A, l, CV_N1, CV_N2, (bx - 16) * 8 + wave, 240 * 8, (float*)(shm + wave * 16640), lane);
        }
        GRID_BAR();
        if (PHON(8)) {
        WS_LAUNDER();
        for (int m0 = gw; m0 < MT; m0 += 2 * NGW) {
            f32x4 vv[2][4];
#pragma unroll
            for (int u = 0; u < 2; ++u) { const int m = m0 + u * NGW, mm = m < MT ? m : m0;
                f32x4 gt[4]; ld_row(XA + (size_t)mm * DM, lane, vv[u]); ld_row(modl + (size_t)mod_row(mm) * 6 * DM + 2 * DM, lane, gt);
                const bf16* orow = (const bf16*)Zb + (size_t)mm * DM;
#pragma unroll
                for (int j = 0; j < 2; ++j) { const v4u w = *(const v4u*)(orow + 512 * j + 8 * lane);
                    vv[u][2 * j] = vv[u][2 * j] * DN_ALPHA + gt[2 * j] * (f32x4){bflo(w.x), bfhi(w.x), bflo(w.y), bfhi(w.y)};
                    vv[u][2 * j + 1] = vv[u][2 * j + 1] * DN_ALPHA + gt[2 * j + 1] * (f32x4){bflo(w.z), bfhi(w.z), bflo(w.w), bfhi(w.w)}; } }
#pragma unroll
            for (int u = 0; u < 2; ++u) { const int m = m0 + u * NGW; if (m >= MT) break;
                ln_row(vv[u]); affine_row<false>(vv[u], A.ln1_g + l * DM, A.ln1_b + l * DM, lane);
                st_row(XA + (size_t)m * DM, lane, vv[u]);
                ln_row(vv[u]); const float* mp = modl + (size_t)mod_row(m) * 6 * DM; affine_row<true>(vv[u], mp + 4 * DM, mp + 3 * DM, lane);
                st_row_hilo(Hb + (size_t)m * HLD, lane, vv[u]); }
        }
        }
        GRID_BAR();
        if (PHON(9)) {
        WS_LAUNDER();
        { pg8::Gemm g{Hb, (const bf16*)(ws + WS_WRT) + (size_t)l * 256 * HLD, HLD, HLD, nullptr}; pg8::StaticOrder S; S.init(MT, 256, G, bx);
          pg8::EpiLogits E{(float*)(ws + WS_LOG)};
          pg8::gemm_phase<pg8::EpiLogits, pg8::StaticOrder, false>((LAS unsigned char*)lds, g, S, E); }
        if (cv_tails && !lastl && bx >= 132) { convert_experts(A, l, CV_N2, CV_N, (bx - 132) * 8 + wave, 124 * 8, (float*)(shm + wave * 16640), lane); __syncthreads(); }
        { pg8::Gemm g{Hb, (const bf16*)(ws + WS_WS13) + (size_t)l * 512 * DM, DM, HLD, nullptr}; pg8::AfterRouterOrder S; S.init(MT, G, bx);
          pg8::EpiSwiGLU E{(bf16*)(ws + WS_HSS), 2, nullptr};
          pg8::gemm_phase<pg8::EpiSwiGLU, pg8::AfterRouterOrder, false>((LAS unsigned char*)lds, g, S, E); }
        }
        GRID_BAR();
        if (PHON(10)) {
        WS_LAUNDER();
        }
        const int TPB = MT / G;
        if (PHON(10)) {
        WS_LAUNDER();
        }
        int* gcnt = (int*)(ws + WS_CTL) + CW_CNT + l * NEXP;
        if (PHON(10)) {
        WS_LAUNDER();
        {
            int* hist = (int*)shm;
            if (tid < NEXP) hist[tid] = 0;
            __syncthreads();
            const float rb0 = A.router_bias[l * NEXP + lane], rb1 = A.router_bias[l * NEXP + 64 + lane];
            for (int i = wave; i < TPB; i += 8) {
                const int tok = vcu * TPB + i; const float* lg = (const float*)(ws + WS_LOG) + (size_t)tok * NEXP;
                const float s0 = 1.0f / (1.0f + __expf(-lg[lane])), s1 = 1.0f / (1.0f + __expf(-lg[64 + lane]));
                float v0 = s0 + rb0, v1 = s1 + rb1; int my_e = 0; float my_s = 0.f, ssum = 0.f;
#pragma unroll
                for (int k = 0; k < TOPK; ++k) {
                    float bv = v0 >= v1 ? v0 : v1; int bi = v0 >= v1 ? lane : lane + 64;
#pragma unroll
                    for (int off = 32; off >= 1; off >>= 1) { const float ov = __shfl_xor(bv, off); const int oi = __shfl_xor(bi, off); if (ov > bv || (ov == bv && oi < bi)) { bv = ov; bi = oi; } }
                    const float ssel = __shfl(bi < 64 ? s0 : s1, bi & 63);
                    if (lane == (bi & 63)) { if (bi < 64) v0 = -INFINITY; else v1 = -INFINITY; }
                    ssum += ssel; if (lane == k) { my_e = bi; my_s = ssel; }
                }
                if (lane < TOPK) { const int rk = atomicAdd(&hist[my_e], 1);
                    ((int*)(ws + WS_SEL))[tok * 8 + lane] = my_e; ((float*)(ws + WS_GATE))[tok * 8 + lane] = 2.5f * my_s / ssum; ((int*)(ws + WS_RANK))[tok * 8 + lane] = rk; }
            }
            __syncthreads();
            if (tid < NEXP) { const int base = __hip_atomic_fetch_add(gcnt + tid, hist[tid], __ATOMIC_RELAXED, __HIP_MEMORY_SCOPE_AGENT); ((int*)(ws + WS_BBASE))[vcu * NEXP + tid] = base; }
        }
        }
        GRID_BAR();
        if (PHON(11)) {
        WS_LAUNDER();
        {
            int* sst = (int*)shm; int* scn = sst + 132;
            if (tid < NEXP) scn[tid] = __hip_atomic_load(gcnt + tid, __ATOMIC_RELAXED, __HIP_MEMORY_SCOPE_AGENT);
            __syncthreads();
            if (tid == 0) { int a = 0; for (int e = 0; e < NEXP; ++e) { sst[e] = a; a += (scn[e] + 255) & ~255; } sst[NEXP] = a; }
            __syncthreads();
            int* stok = (int*)(ws + WS_STOK); float* sgate = (float*)(ws + WS_SGATE); int* texp = (int*)(ws + WS_TEXP);
            for (int i = tid; i < TPB * 8; i += 512) { const int ent = vcu * TPB * 8 + i; const int e = ((const int*)(ws + WS_SEL))[ent];
                const int slot = sst[e] + ((const int*)(ws + WS_BBASE))[vcu * NEXP + e] + ((const int*)(ws + WS_RANK))[ent];
                stok[slot] = ent >> 3; sgate[slot] = ((const float*)(ws + WS_GATE))[ent]; ((int*)(ws + WS_TSLOT))[ent] = slot; }
            for (int e = vcu; e < NEXP; e += G) {
                for (int s = sst[e] + scn[e] + tid; s < sst[e + 1]; s += 512) { stok[s] = 0; sgate[s] = 0.f; }
                for (int mt = (sst[e] >> 8) + tid; mt < (sst[e + 1] >> 8); mt += 512) texp[mt] = e;
            }
            if (vcu == 0 && tid == 0) texp[2047] = sst[NEXP] >> 8;
            __syncthreads();
        }
        }
        GRID_BAR();
        if (PHON(12)) {
        WS_LAUNDER();
        int* texl = (int*)(shm + 133120);
        const int ntile = __builtin_amdgcn_readfirstlane(((const int*)(ws + WS_TEXP))[2047]);
        for (int i = tid; i < ntile; i += 512) texl[i] = ((const int*)(ws + WS_TEXP))[i];
        __syncthreads();
        { pg8::Gemm g{Hb, (const bf16*)(ws + WS_WE13), DM, HLD, (const int*)(ws + WS_STOK)}; pg8::GroupedOrder S; S.init(texl, ntile, 2, G, bx);
          pg8::EpiSwiGLU E{(bf16*)(ws + WS_HS), 2, (const float*)(ws + WS_SGATE)};
          pg8::gemm_phase<pg8::EpiSwiGLU, pg8::GroupedOrder, true>((LAS unsigned char*)lds, g, S, E); }
        { pg8::Gemm g{(const bf16*)(ws + WS_HSS), (const bf16*)(ws + WS_WS2) + (size_t)l * DM * 256, 256, 256, nullptr}; pg8::StaticOrder S;
          { const int c0 = (ntile * 2) % G; S.init(MT, DM, G, (bx - c0 + G) % G); }
          pg8::EpiBf16<DM, false> E{(bf16*)(ws + WS_YS), 4, 0u, 1.f, 256, nullptr, 0};
          pg8::gemm_phase<pg8::EpiBf16<DM, false>, pg8::StaticOrder, false>((LAS unsigned char*)lds, g, S, E); }
        }
        GRID_BAR();
        if (PHON(13)) {
        WS_LAUNDER();
        int* texl = (int*)(shm + 133120);
        const int ntile = __builtin_amdgcn_readfirstlane(((const int*)(ws + WS_TEXP))[2047]);
        for (int i = tid; i < ntile; i += 512) texl[i] = ((const int*)(ws + WS_TEXP))[i];
        __syncthreads();
        { pg8::Gemm g{(const bf16*)(ws + WS_HS), (const bf16*)(ws + WS_WE2), 256, 256, nullptr}; pg8::GroupedOrder S; S.init(texl, ntile, 4, G, bx);
          pg8::EpiBf16<DM, false> E{(bf16*)(ws + WS_Y), 4, 0u, 1.f, 256, nullptr, 0};
          pg8::gemm_phase<pg8::EpiBf16<DM, false>, pg8::GroupedOrder, false>((LAS unsigned char*)lds, g, S, E); }
        }
        GRID_BAR();
        if (PHON(14)) {
        WS_LAUNDER();
        for (int m = gw; m < MT; m += NGW) {
            f32x4 f[4];
            { const bf16* ys = (const bf16*)(ws + WS_YS) + (size_t)m * DM;
#pragma unroll
              for (int j = 0; j < 2; ++j) { const v4u w = *(const v4u*)(ys + 512 * j + 8 * lane); f[2 * j] = (f32x4){bflo(w.x), bfhi(w.x), bflo(w.y), bfhi(w.y)}; f[2 * j + 1] = (f32x4){bflo(w.z), bfhi(w.z), bflo(w.w), bfhi(w.w)}; } }
            const int* ts = (const int*)(ws + WS_TSLOT) + (size_t)m * 8;
#pragma unroll
            for (int k = 0; k < TOPK; ++k) { const bf16* yr = (const bf16*)(ws + WS_Y) + (size_t)ts[k] * DM;
#pragma unroll
                for (int j = 0; j < 2; ++j) { const v4u w = *(const v4u*)(yr + 512 * j + 8 * lane); f[2 * j] += (f32x4){bflo(w.x), bfhi(w.x), bflo(w.y), bfhi(w.y)}; f[2 * j + 1] += (f32x4){bflo(w.z), bfhi(w.z), bflo(w.w), bfhi(w.w)}; } }
            f32x4 v[4], gt[4]; ld_row(XA + (size_t)m * DM, lane, v); const float* mp = modl + (size_t)mod_row(m) * 6 * DM; ld_row(mp + 5 * DM, lane, gt);
#pragma unroll
            for (int j = 0; j < 4; ++j) v[j] = v[j] * DN_ALPHA + gt[j] * f[j];
            ln_row(v); affine_row<false>(v, A.ln2_g + l * DM, A.ln2_b + l * DM, lane);
            if (lastl) { st_row(A.out + (size_t)m * DM, lane, v); }
            else { st_row(XA + (size_t)m * DM, lane, v); ln_row(v); const float* mn = modl + 5 * 6 * DM + (size_t)mod_row(m) * 6 * DM; affine_row<true>(v, mn + DM, mn, lane); st_row_hilo(Hb + (size_t)m * HLD, lane, v); }
        }
        }
        if (!lastl) {
        if (PHON(15)) {
        WS_LAUNDER(); convert_experts(A, l + 1, 0, (cv_tails && l + 1 < DEPTH - 1) ? CV_N0 : CV_N, gw, NGW, (float*)(shm + wave * 16640), lane);
        }
        GRID_BAR(); }
    }
#if defined(SELFCHECK) && SELFCHECK
    GRID_BAR();
    {
        const float* acc2 = (const float*)(A.ws + WS_CTL) + 32768; bool bad = false;
        for (int m3 = 0; m3 < 3; ++m3) { const float e2 = __hip_atomic_load(acc2 + 2 + 2 * m3, __ATOMIC_RELAXED, __HIP_MEMORY_SCOPE_AGENT), r2 = __hip_atomic_load(acc2 + 3 + 2 * m3, __ATOMIC_RELAXED, __HIP_MEMORY_SCOPE_AGENT);
            if (!(r2 > 0.f) || !(e2 <= SELFCHECK_TOL * SELFCHECK_TOL * r2)) bad = true; }
        for (int cat = 0; cat < 7; ++cat) { const float e2 = __hip_atomic_load(acc2 + 16 + 2 * cat, __ATOMIC_RELAXED, __HIP_MEMORY_SCOPE_AGENT), r2 = __hip_atomic_load(acc2 + 17 + 2 * cat, __ATOMIC_RELAXED, __HIP_MEMORY_SCOPE_AGENT);
            if (!(r2 > 0.f) || !(e2 <= SELFCHECK_TOL2 * SELFCHECK_TOL2 * r2)) bad = true; }
        if (bad) { const int tid = ltid(); for (size_t i = (size_t)bx * 512 + tid; i < (size_t)NLAT * DM; i += (size_t)G * 512) A.out[i] *= 3.0f; }
    }
#endif
    if (bx == 0 && ltid() < 64) { const int tid = ltid(); if (__hip_atomic_load((unsigned*)(ctl + CW_BAR) + XB_TMO, __ATOMIC_RELAXED, __HIP_MEMORY_SCOPE_AGENT) != 0u) A.out[tid] = __builtin_nanf(""); }
#undef GRID_BAR
#undef MODT
#undef Hb
#undef Pb
#undef QC
#undef KC
#undef VC
#undef CAT
#undef XA
#undef Zb
#undef RSTD
#undef modl
}

extern "C" void kernel_launch(void* const* d_in, const int* in_sizes, int n_in, void* d_out, int out_size, void* d_ws, size_t ws_size, hipStream_t stream) {
    static int grid = 0;
    if (grid == 0) {
        if (n_in != 31 || in_sizes[0] != NLAT * DM || out_size != NLAT * DM || ws_size < WS_END) {
            fprintf(stderr, "kernel_launch: built for 31 inputs, x/out of %d floats, >= %zu bytes of workspace; got n_in %d, in0 %d, out %d, ws %zu; nothing launched\n", NLAT * DM, (size_t)WS_END, n_in, n_in > 0 ? in_sizes[0] : -1, out_size, ws_size);
            grid = -1; return; }
        int dev = 0, cus = 0, per_cu = 0;
        if (hipGetDevice(&dev) != hipSuccess || hipDeviceGetAttribute(&cus, hipDeviceAttributeMultiprocessorCount, dev) != hipSuccess) { fprintf(stderr, "kernel_launch: device query failed\n"); grid = -1; return; }
        if (hipFuncSetAttribute((const void*)hybrid_fwd, hipFuncAttributeMaxDynamicSharedMemorySize, LDS_BYTES) != hipSuccess) { fprintf(stderr, "kernel_launch: hipFuncSetAttribute failed\n"); grid = -1; return; }
        if (hipOccupancyMaxActiveBlocksPerMultiprocessor(&per_cu, (const void*)hybrid_fwd, 512, LDS_BYTES) != hipSuccess || per_cu < 1)
            fprintf(stderr, "kernel_launch: note: occupancy query reports %d workgroups per CU\n", per_cu);
        (void)hipGetLastError();
        grid = cus;
        if (grid != 256) fprintf(stderr, "kernel_launch: note: %d CUs (tuned for 256)\n", grid);
        if ((NTOK % grid) || (NLAT % grid)) { fprintf(stderr, "kernel_launch: grid %d does not divide the token counts\n", grid); grid = -1; return; }
    }
    if (grid < 0) return;
    if (hipMemsetAsync((char*)d_ws + WS_CTL, 0, CTL_ZERO_BYTES, stream) != hipSuccess) { fprintf(stderr, "kernel_launch: hipMemsetAsync failed\n"); return; }
    Args a{};
    const float** ap = (const float**)&a;
    for (int i = 0; i < 31; ++i) ap[i] = (const float*)d_in[i];
    a.out = (float*)d_out; a.ws = (unsigned char*)d_ws;
    hipLaunchKernelGGL(hybrid_fwd, dim3(grid), dim3(512), LDS_BYTES, stream, a);
    const hipError_t le = hipPeekAtLastError();
    if (le != hipSuccess) fprintf(stderr, "kernel_launch: launch failed: %s\n", hipGetErrorName(le));
}
```

```cpp
#include <hip/hip_runtime.h>
#include <cstdio>
#include <cstdint>

#define GAS __attribute__((address_space(1)))
#define LAS __attribute__((address_space(3)))
typedef unsigned short bf16;
typedef unsigned v4u __attribute__((ext_vector_type(4)));
typedef unsigned v2u __attribute__((ext_vector_type(2)));
typedef float f32x4 __attribute__((ext_vector_type(4)));
typedef float f32x2 __attribute__((ext_vector_type(2)));
typedef float f32x16 __attribute__((ext_vector_type(16)));
typedef short bf16x8 __attribute__((ext_vector_type(8)));
typedef short s16x4 __attribute__((ext_vector_type(4)));
typedef GAS unsigned gu32;
#define RLX_AGENT __ATOMIC_RELAXED, __HIP_MEMORY_SCOPE_AGENT
#define LDS_WAIT() asm volatile("s_waitcnt lgkmcnt(0)" ::: "memory")
#define VM_WAIT() asm volatile("s_waitcnt vmcnt(0)" ::: "memory")

constexpr int NB = 4, SEQ = 8192, CTXL = 256, DM = 1024, DEPTH = 4;
constexpr int NLAT = NB * SEQ, NCTX = NB * CTXL, NTOK = NLAT + NCTX;
constexpr int INW = 2496, INWP = 2560;
constexpr int A_Q = 0, A_K = 256, A_V = 512, B_Q = 768, B_K = 1024, B_V = 1152, C_Q = 1280, C_KV = 1536, C_KR = 1664,
              D_Q = 1696, D_K = 1824, D_V = 1952, D_R = 2208, D_ZF = 2464, D_ZB = 2480;
constexpr int NEXP = 128, TOPK = 8, DEXP = 256;
constexpr int NSLOT_MAX = NTOK * TOPK + NEXP * 256;
constexpr int NCH = 132;
constexpr float LN_EPS = 1e-5f, RMS_EPS = 1e-6f;
constexpr float DN_ALPHA = 1.6817928305074290f;
constexpr float LOG2E = 1.4426950408889634f;
constexpr float C2 = 0.125f * LOG2E;

#ifndef ROUTER_SPLIT
#define ROUTER_SPLIT 0
#endif
constexpr int HLD = ROUTER_SPLIT ? 2 * DM : DM;
constexpr size_t al256(size_t x) { return (x + 255) & ~(size_t)255; }
constexpr size_t WS_CTL = 0, CTL_ZERO_BYTES = 1u << 20;
constexpr size_t WS_MOD = CTL_ZERO_BYTES;
constexpr size_t WS_WIN = al256(WS_MOD + (size_t)DEPTH * 5 * 6 * DM * 4);
constexpr size_t WS_WOUT = WS_WIN + (size_t)DEPTH * INWP * DM * 2;
constexpr size_t WS_WUQ = WS_WOUT + (size_t)DEPTH * DM * DM * 2;
constexpr size_t WS_WUKV = WS_WUQ + (size_t)DEPTH * 256 * 256 * 2;
constexpr size_t WS_WRT = WS_WUKV + (size_t)DEPTH * 512 * 128 * 2;
constexpr size_t WS_WS13 = WS_WRT + (size_t)DEPTH * 256 * HLD * 2;
constexpr size_t WS_WS2 = WS_WS13 + (size_t)DEPTH * 512 * DM * 2;
constexpr size_t WS_WE13 = WS_WS2 + (size_t)DEPTH * DM * 256 * 2;
constexpr size_t WS_WE2 = WS_WE13 + (size_t)NEXP * 512 * DM * 2;
constexpr size_t WS_XA = WS_WE2 + (size_t)NEXP * DM * 256 * 2;
constexpr size_t WS_Z = WS_XA + (size_t)NTOK * DM * 4;
constexpr size_t WS_H = WS_Z + (size_t)NTOK * DM * 4;
constexpr size_t WS_P = WS_H + (size_t)NTOK * HLD * 2;
constexpr size_t WS_QC = WS_P + (size_t)NTOK * INWP * 2;
constexpr size_t WS_KC = WS_QC + (size_t)NTOK * 256 * 2;
constexpr size_t WS_VC = WS_KC + (size_t)NTOK * 256 * 2;
constexpr size_t WS_CAT = WS_VC + (size_t)NTOK * 256 * 2;
constexpr size_t WS_GU = WS_CAT + (size_t)NTOK * DM * 2;
constexpr size_t WS_GDEC = WS_GU + (size_t)32 * NCH * 2048 * 4;
constexpr size_t WS_RSTD = WS_GDEC + (size_t)32 * NCH * 32 * 4;
constexpr size_t WS_LOG = al256(WS_RSTD + (size_t)NTOK * 2 * 4);
constexpr size_t WS_SEL = WS_LOG + (size_t)NTOK * 128 * 4;
constexpr size_t WS_GATE = WS_SEL + (size_t)NTOK * 8 * 4;
constexpr size_t WS_RANK = WS_GATE + (size_t)NTOK * 8 * 4;
constexpr size_t WS_TSLOT = WS_RANK + (size_t)NTOK * 8 * 4;
constexpr size_t WS_BBASE = WS_TSLOT + (size_t)NTOK * 8 * 4;
constexpr size_t WS_STOK = WS_BBASE + (size_t)256 * 128 * 4;
constexpr size_t WS_SGATE = al256(WS_STOK + (size_t)NSLOT_MAX * 4);
constexpr size_t WS_TEXP = al256(WS_SGATE + (size_t)NSLOT_MAX * 4);
constexpr size_t WS_HS = WS_TEXP + 2048 * 4;
constexpr size_t WS_HSS = WS_HS + (size_t)NSLOT_MAX * 256 * 2;
constexpr size_t WS_Y = WS_HSS + (size_t)NTOK * 256 * 2;
constexpr size_t WS_YS = WS_Y + (size_t)NSLOT_MAX * DM * 2;
constexpr size_t WS_BC = WS_YS + (size_t)NTOK * DM * 2;
constexpr size_t WS_END = WS_BC + (size_t)NTOK * 256 * 4;
static_assert(WS_END <= (size_t)2147483648u, "d_ws map must fit 2 GiB");
constexpr int CW_BAR = 4096;
constexpr int CW_CNT = 16384;

constexpr int LDS_BYTES = 147456;
constexpr int MISC_OFF = LDS_BYTES - 512;
constexpr int SCR_BYTES = MISC_OFF;

__device__ __forceinline__ unsigned f2bf(float f) { unsigned u = __builtin_bit_cast(unsigned, f); return (u + 0x7fffu + ((u >> 16) & 1u)) >> 16; }
__device__ __forceinline__ unsigned pk2(float lo, float hi) { return f2bf(lo) | (f2bf(hi) << 16); }
__device__ __forceinline__ float bf2f(unsigned short b) { return __builtin_bit_cast(float, (unsigned)b << 16); }
__device__ __forceinline__ float bflo(unsigned w) { return __builtin_bit_cast(float, w << 16); }
__device__ __forceinline__ float bfhi(unsigned w) { return __builtin_bit_cast(float, w & 0xffff0000u); }
typedef __bf16 bf16x2_t __attribute__((ext_vector_type(2)));
__device__ __forceinline__ unsigned cvtpk(float lo, float hi) { f32x2 v = {lo, hi}; bf16x2_t b = __builtin_convertvector(v, bf16x2_t); return __builtin_bit_cast(unsigned, b); }
__device__ __forceinline__ float wave_sum(float v) {
    v = v + __builtin_bit_cast(float, __builtin_amdgcn_update_dpp(0, __builtin_bit_cast(int, v), 0xB1, 0xf, 0xf, true));
    v = v + __builtin_bit_cast(float, __builtin_amdgcn_update_dpp(0, __builtin_bit_cast(int, v), 0x4E, 0xf, 0xf, true));
    v = v + __builtin_bit_cast(float, __builtin_amdgcn_update_dpp(0, __builtin_bit_cast(int, v), 0x141, 0xf, 0xf, true));
    v = v + __builtin_bit_cast(float, __builtin_amdgcn_update_dpp(0, __builtin_bit_cast(int, v), 0x140, 0xf, 0xf, true));
    v += __shfl_xor(v, 16); v += __shfl_xor(v, 32);
    return v;
}
__device__ __forceinline__ float fsilu(float a) { return a * __builtin_amdgcn_rcpf(1.0f + __builtin_amdgcn_exp2f(-a * LOG2E)); }
namespace pg8 {
typedef unsigned short bf16_t;
constexpr int BM = 256, BK = 64, HALF = 128, HTB = HALF * BK * 2  , STAGE_BYTES = 8 * HTB, NXCD = 8, WGM = 8;

__host__ __device__ __forceinline__ int lds_byte(int r, int c) { const int st = (r >> 4) * 2 + (c >> 5), rr = r & 15, cc = c & 31, ob = rr * 64 + cc * 2; return st * 1024 + (ob ^ (((ob >> 9) & 1) << 5)); }
__host__ __device__ __forceinline__ void stage_rc(int b, int& R, int& C) { const int st = b / 1024, sb = b % 1024, swz = sb ^ (((sb >> 9) & 1) << 5); R = (st >> 1) * 16 + swz / 64; C = (st & 1) * 32 + (swz % 64) / 2; }
__host__ __device__ __forceinline__ int perm32(int rho) { const int n = rho >> 4, i = rho & 15; return 8 * (i >> 2) + 4 * n + (i & 3); }

struct Unit { int pm, pn; };
struct Gemm { const bf16_t* A; const bf16_t* Bt; int K; int lda; const int* rowidx; };

struct StaticOrder {
    int nM, nN, nwg, G, c;
    __device__ void init(int M, int N, int G_, int c_) { nM = M / BM; nN = N / BM; nwg = nM * nN; G = G_; c = c_; }
    __device__ bool next(int i, Unit& u) const {
        const long L = (long)i * G + c; if (L >= nwg) return false;
        int wgid = (int)L; { const int q = nwg / NXCD, r = nwg % NXCD, xcd = wgid % NXCD, off = wgid / NXCD; wgid = (xcd < r ? xcd * (q + 1) : r * (q + 1) + (xcd - r) * q) + off; }
        const int nig = WGM * nN, gid = wgid / nig, fm = gid * WGM, gsz = (nM - fm) < WGM ? (nM - fm) : WGM;
        u.pm = fm + ((wgid % nig) % gsz); u.pn = (wgid % nig) / gsz; return true;
    }
};
struct AfterRouterOrder {
    int nR, G, c;
    __device__ void init(int M, int G_, int c_) { nR = M / BM; G = G_; c = c_; }
    __device__ bool next(int i, Unit& u) const {
        const int nidle = G - nR; int L;
        if (nidle <= 0 || 2 * nR - 2 * nidle > nR) { L = i * G + c; if (L >= 2 * nR) return false; }
        else if (c >= nR) { if (i >= 2) return false; L = 2 * (c - nR) + i; if (L >= 2 * nR) return false; }
        else { if (i >= 1) return false; L = 2 * nidle + c; if (L >= 2 * nR) return false; }
        u.pm = L >> 1; u.pn = L & 1; return true;
    }
};
struct GroupedOrder {
    const int* texp; int nN, G, c, ntile;
    __device__ void init(const int* texp_, int ntile_, int nN_, int G_, int c_) { texp = texp_; nN = nN_; G = G_; c = c_; ntile = ntile_; }
    __device__ bool next(int i, Unit& u) const {
        const long L = (long)i * G + c; if (L >= (long)ntile * nN) return false;
        const int mt = (int)(L / nN), nt = (int)(L % nN); u.pm = mt; u.pn = __builtin_amdgcn_readfirstlane(texp[mt]) * nN + nt; return true;
    }
};

template <class Epi, class Sched, bool GATHER, bool ALIGN_EPI = true>
__device__ __forceinline__ void gemm_phase(LAS unsigned char* lds, const Gemm g, const Sched& S, const Epi& E) {
    int tid_ = threadIdx.x; asm volatile("" : "+v"(tid_));
    const int tid = tid_, wid = __builtin_amdgcn_readfirstlane(tid >> 6), lane = tid & 63, wr = wid >> 2, wc = wid & 3, fr = lane & 15, fq = lane >> 4;
    const int K = g.K, nt = K / BK;
    unsigned voffB[2], voffA[2]; int RA[2]; unsigned CA2[2];
#pragma unroll
    for (int i = 0; i < 2; ++i) { int R, C; stage_rc(tid * 16 + i * 8192, R, C); const int Rb = Epi::PERM ? ((R & ~31) + perm32(R & 31)) : R;
        RA[i] = R; CA2[i] = (unsigned)C * 2u; voffB[i] = (unsigned)(Rb * K + C) * 2u; voffA[i] = (unsigned)(R * g.lda + C) * 2u; }
    const size_t hstepA = (size_t)HALF * g.lda * 2;
    const size_t kstep = (size_t)(BK * 2);
    const size_t hstep = (size_t)HALF * K * 2;
    const size_t tstep = 2 * hstep;
    const size_t tstepA = (size_t)BM * g.lda * 2;
    const unsigned ldsw = (unsigned)wid * 1024u;
    const int aoff = lds_byte(wr * 64 + fr, fq * 8), boff = lds_byte(wc * 32 + fr, fq * 8);
#define PG8_SA(b, h) (((b) * 2 + (h)) * HTB)
#define PG8_SB(b, h) ((4 + (b) * 2 + (h)) * HTB)
#define PG8_STAGE(bufoff, gbase, voff) do { _Pragma("unroll") for (int _i = 0; _i < 2; ++_i) \
        __builtin_amdgcn_global_load_lds((const unsigned*)((const char*)(gbase) + (voff)[_i]), (LAS unsigned*)(lds + (bufoff) + ldsw + _i * 8192), 16, 0, 0); } while (0)
#define PG8_LDA(dst, b, h) do { _Pragma("unroll") for (int m = 0; m < 4; ++m) _Pragma("unroll") for (int k = 0; k < 2; ++k) dst[m][k] = *(const LAS bf16x8*)(lds + PG8_SA(b, h) + aoff + m * 2048 + k * 1024); } while (0)
#define PG8_LDB(dst, b, h) do { _Pragma("unroll") for (int n = 0; n < 2; ++n) _Pragma("unroll") for (int k = 0; k < 2; ++k) dst[n][k] = *(const LAS bf16x8*)(lds + PG8_SB(b, h) + boff + n * 2048 + k * 1024); } while (0)
#define PG8_MMA(ai, bj, At, Bt) do { __builtin_amdgcn_s_setprio(1); _Pragma("unroll") for (int m = 0; m < 4; ++m) _Pragma("unroll") for (int n = 0; n < 2; ++n) _Pragma("unroll") for (int k = 0; k < 2; ++k) \
        acc[ai][bj][m][n] = __builtin_amdgcn_mfma_f32_16x16x32_bf16(Bt[n][k], At[m][k], acc[ai][bj][m][n], 0, 0, 0); __builtin_amdgcn_s_setprio(0); } while (0)
#define PG8_WAIT_V(n) asm volatile("s_waitcnt vmcnt(" #n ")" ::: "memory")
#define PG8_WAIT_L(n) asm volatile("s_waitcnt lgkmcnt(" #n ")" ::: "memory")
#define PG8_BAR __builtin_amdgcn_s_barrier()
#define PG8_SCHED __builtin_amdgcn_sched_barrier(0)
#define PG8_AOFF(dst, u) do { if constexpr (GATHER) { _Pragma("unroll") for (int _h = 0; _h < 2; ++_h) _Pragma("unroll") for (int _i = 0; _i < 2; ++_i) \
        dst[_h][_i] = (unsigned)g.rowidx[(u).pm * BM + _h * HALF + RA[_i]] * (unsigned)(g.lda * 2) + CA2[_i]; } } while (0)
#define PG8_STAGE_A(bufoff, gbase, h, useN) do { if constexpr (GATHER) { unsigned _o[2]; _o[0] = (useN) ? offN[h][0] : offC[h][0]; _o[1] = (useN) ? offN[h][1] : offC[h][1]; PG8_STAGE(bufoff, gbase, _o); } \
        else { PG8_STAGE(bufoff, (gbase) + (h) * hstepA, voffA); } } while (0)
    Unit cur, nxt; int ui = 0;
    if (!S.next(0, cur)) return;
    f32x4 acc[2][2][4][2];
#pragma unroll
    for (int a = 0; a < 2; ++a)
#pragma unroll
        for (int b = 0; b < 2; ++b)
#pragma unroll
            for (int m = 0; m < 4; ++m)
#pragma unroll
                for (int n = 0; n < 2; ++n) acc[a][b][m][n] = (f32x4){0.f, 0.f, 0.f, 0.f};
    bf16x8 At[4][2], B0[2][2], B1[2][2];
    unsigned offC[2][2], offN[2][2];
    PG8_AOFF(offC, cur);
    const char* cA = GATHER ? (const char*)g.A : (const char*)g.A + (size_t)cur.pm * tstepA; const char* cB = (const char*)g.Bt + (size_t)cur.pn * tstep;
    PG8_STAGE(PG8_SB(0, 0), cB, voffB); PG8_STAGE(PG8_SB(0, 1), cB + hstep, voffB); PG8_STAGE_A(PG8_SA(0, 0), cA, 0, false); PG8_STAGE_A(PG8_SA(0, 1), cA, 1, false);
    if (wr == 1) PG8_BAR;
    PG8_WAIT_V(2); PG8_BAR;
    PG8_STAGE(PG8_SB(1, 0), cB + kstep, voffB); PG8_STAGE_A(PG8_SA(1, 0), cA + kstep, 0, false); PG8_STAGE(PG8_SB(1, 1), cB + hstep + kstep, voffB);
    PG8_WAIT_V(6); PG8_BAR;
    for (;;) {
        const bool has_next = S.next(ui + 1, nxt);
        if constexpr (GATHER) { if (has_next) { PG8_AOFF(offN, nxt); } else {
#pragma unroll
            for (int h = 0; h < 2; ++h)
#pragma unroll
                for (int i = 0; i < 2; ++i) offN[h][i] = offC[h][i]; } }
        const char* nA = has_next ? (GATHER ? (const char*)g.A : (const char*)g.A + (size_t)nxt.pm * tstepA) : cA; const char* nB = has_next ? (const char*)g.Bt + (size_t)nxt.pn * tstep : cB;
#pragma unroll 1
        for (int t = 0; t < nt; t += 2) {
            const bool last = (t == nt - 2);
            const char* a1 = cA + (size_t)(t + 1) * kstep;
            const char* a2 = last ? nA : cA + (size_t)(t + 2) * kstep; const char* b2 = last ? nB : cB + (size_t)(t + 2) * kstep;
            const char* a3 = a2 + kstep; const char* b3 = b2 + kstep;
            PG8_LDB(B0, 0, 0); PG8_LDB(B1, 0, 1); PG8_SCHED; PG8_LDA(At, 0, 0); PG8_STAGE_A(PG8_SA(1, 1), a1, 1, false);
            PG8_WAIT_V(8); PG8_WAIT_L(0); PG8_BAR; PG8_MMA(0, 0, At, B0); PG8_MMA(0, 1, At, B1); PG8_BAR; PG8_SCHED;
            PG8_LDA(At, 0, 1); PG8_STAGE(PG8_SB(0, 0), b2, voffB); PG8_STAGE(PG8_SB(0, 1), b2 + hstep, voffB); PG8_STAGE_A(PG8_SA(0, 0), a2, 0, last);
            PG8_WAIT_V(8); PG8_WAIT_L(0); PG8_BAR; PG8_MMA(1, 0, At, B0); PG8_MMA(1, 1, At, B1); PG8_BAR; PG8_SCHED;
            PG8_LDB(B0, 1, 0); PG8_LDB(B1, 1, 1); PG8_SCHED; PG8_LDA(At, 1, 0); PG8_STAGE_A(PG8_SA(0, 1), a2, 1, last);
            PG8_WAIT_V(8); PG8_WAIT_L(0); PG8_BAR; PG8_MMA(0, 0, At, B0); PG8_MMA(0, 1, At, B1); PG8_BAR; PG8_SCHED;
            PG8_LDA(At, 1, 1); PG8_STAGE(PG8_SB(1, 0), b3, voffB); PG8_STAGE(PG8_SB(1, 1), b3 + hstep, voffB); PG8_STAGE_A(PG8_SA(1, 0), a3, 0, last);
            PG8_WAIT_V(8); PG8_WAIT_L(0); PG8_BAR; PG8_MMA(1, 0, At, B0); PG8_MMA(1, 1, At, B1); PG8_BAR; PG8_SCHED;
        }
        if constexpr (ALIGN_EPI) { if (wr == 0) PG8_BAR; }
        E(acc, cur, wr, wc, fr, fq);
        if (!has_next) break;
#pragma unroll
        for (int a = 0; a < 2; ++a)
#pragma unroll
            for (int b = 0; b < 2; ++b)
#pragma unroll
                for (int m = 0; m < 4; ++m)
#pragma unroll
                    for (int n = 0; n < 2; ++n) acc[a][b][m][n] = (f32x4){0.f, 0.f, 0.f, 0.f};
        cur = nxt; cA = nA; cB = nB; ++ui;
        if constexpr (GATHER) {
#pragma unroll
            for (int h = 0; h < 2; ++h)
#pragma unroll
                for (int i = 0; i < 2; ++i) offC[h][i] = offN[h][i]; }
        if constexpr (ALIGN_EPI) { if (wr == 1) PG8_BAR; }
    }
    PG8_WAIT_V(0);
    if constexpr (!ALIGN_EPI) { if (wr == 0) PG8_BAR; }
    PG8_BAR;
#undef PG8_SA
#undef PG8_SB
#undef PG8_STAGE
#undef PG8_LDA
#undef PG8_LDB
#undef PG8_MMA
#undef PG8_WAIT_V
#undef PG8_WAIT_L
#undef PG8_BAR
#undef PG8_SCHED
#undef PG8_AOFF
#undef PG8_STAGE_A
}
}
namespace pg8 {
__device__ __forceinline__ unsigned cvt_pk_bf16(float lo, float hi) { unsigned r; asm volatile("v_cvt_pk_bf16_f32 %0, %1, %2" : "=v"(r) : "v"(lo), "v"(hi)); return r; }
template <int LDC, bool ROWSCALE, bool SKIPROPE = false> struct EpiBf16 {
    static constexpr bool PERM = true;
    bf16_t* O; int nloc; unsigned scmask; float sc; size_t tile_stride; const float* rowscale; int rs_off;
    __device__ __forceinline__ void operator()(const f32x4 (&acc)[2][2][4][2], const Unit& u, int wr, int wc, int fr, int fq) const {
        const int pnl = u.pn % nloc; const int row0 = u.pm * BM + wr * 64 + fr;
        bf16_t* p0 = O + (size_t)pnl * tile_stride + (size_t)row0 * LDC + wc * 32 + 8 * fq;
        const float s = ((scmask >> pnl) & 1u) ? sc : 1.f;
        if (SKIPROPE && pnl == 0 && (wc & 1)) return;
#pragma unroll
        for (int ai = 0; ai < 2; ++ai)
#pragma unroll
            for (int m = 0; m < 4; ++m) { bf16_t* rowp = p0 + (size_t)(ai * HALF + m * 16) * LDC;
                float rsc = s; if constexpr (ROWSCALE) rsc *= rowscale[2 * (row0 + ai * HALF + m * 16) + rs_off];
#pragma unroll
                for (int bj = 0; bj < 2; ++bj) { const f32x4 v0 = acc[ai][bj][m][0] * rsc, v1 = acc[ai][bj][m][1] * rsc;
                    v4u w; w.x = cvt_pk_bf16(v0[0], v0[1]); w.y = cvt_pk_bf16(v0[2], v0[3]); w.z = cvt_pk_bf16(v1[0], v1[1]); w.w = cvt_pk_bf16(v1[2], v1[3]);
                    *(v4u*)(rowp + bj * HALF) = w; } }
    }
};
struct EpiLogits {
    static constexpr bool PERM = false;
    float* O;
    __device__ __forceinline__ void operator()(const f32x4 (&acc)[2][2][4][2], const Unit& u, int wr, int wc, int fr, int fq) const {
        const int col0 = wc * 32 + 4 * fq;
#pragma unroll
        for (int ai = 0; ai < 2; ++ai)
#pragma unroll
            for (int m = 0; m < 4; ++m) { float* rowp = O + (size_t)(u.pm * BM + ai * HALF + wr * 64 + m * 16 + fr) * 128 + col0;
#pragma unroll
                for (int n = 0; n < 2; ++n) *(f32x4*)(rowp + n * 16) = acc[ai][0][m][n] + acc[ai][1][m][n]; }
    }
};
struct EpiSwiGLU {
    static constexpr bool PERM = true;
    bf16_t* O; int nloc; const float* gate;
    __device__ __forceinline__ void operator()(const f32x4 (&acc)[2][2][4][2], const Unit& u, int wr, int wc, int fr, int fq) const {
        const int pnl = u.pn % nloc; const int row0 = u.pm * BM + wr * 64 + fr; const int col0 = pnl * 128 + wc * 16 + 4 * fq;
#pragma unroll
        for (int ai = 0; ai < 2; ++ai)
#pragma unroll
            for (int m = 0; m < 4; ++m) { const int row = row0 + ai * HALF + m * 16; const float gt = gate ? gate[row] : 1.f; bf16_t* rowp = O + (size_t)row * 256 + col0;
#pragma unroll
                for (int bj = 0; bj < 2; ++bj) { const f32x4 a = acc[ai][bj][m][0], b = acc[ai][bj][m][1];
                    v2u w; w.x = cvt_pk_bf16(fsilu(a[0]) * b[0] * gt, fsilu(a[1]) * b[1] * gt); w.y = cvt_pk_bf16(fsilu(a[2]) * b[2] * gt, fsilu(a[3]) * b[3] * gt);
                    *(v2u*)(rowp + bj * 64) = w; } }
    }
};
}
#define XB_TMO      128
#define XB_XCNT(j)  (256  + 64 * (j))
#define XB_XSUB(j)  (1280 + 64 * (j))
#define XB_XGEN(j)  (2304 + 64 * (j))
#define XB_TOP      3328
#define XB_TOPGEN   3392
#define XCD_BAR_WORDS 3456
#define XB_SPIN_CAP (1u << 18)

__device__ __forceinline__ unsigned xb_ld(unsigned* p)              { return __hip_atomic_load(p, __ATOMIC_RELAXED, __HIP_MEMORY_SCOPE_AGENT); }
__device__ __forceinline__ unsigned xb_add(unsigned* p, unsigned v) { return __hip_atomic_fetch_add(p, v, __ATOMIC_RELAXED, __HIP_MEMORY_SCOPE_AGENT); }
__device__ __forceinline__ unsigned xb_xcc_id() { return (unsigned)__builtin_amdgcn_s_getreg((3 << 11) | 20) & 0xFu; }
#define XB_SPIN(cond, bar) do { unsigned _sp = 0; while (cond) { __builtin_amdgcn_s_sleep(1); \
    if ((++_sp & 255u) == 0u) { if (xb_ld(&(bar)[XB_TMO])) break; if (_sp > XB_SPIN_CAP) { atomicAdd(&(bar)[XB_TMO], 1u); break; } } } } while (0)

struct XcdBarrier {
    unsigned* bar; unsigned x;
    volatile LAS unsigned* st;
};

__device__ __forceinline__ XcdBarrier xcd_barrier_post(unsigned* bar, volatile LAS unsigned* st) {
    XcdBarrier b; b.bar = bar; b.x = xb_xcc_id(); b.st = st;
    if (threadIdx.x == 0) (void)xb_add(&bar[XB_XCNT(b.x)], 1u);
    return b;
}
__device__ __forceinline__ void xcd_barrier_complete(unsigned* bar, unsigned x, unsigned& nloc, unsigned& nx) {
    const unsigned G = gridDim.x * gridDim.y * gridDim.z;
    unsigned sum, cnt, mine, sp = 0u;
    for (;;) {
        sum = 0u; cnt = 0u; mine = 0u;
#pragma unroll
        for (unsigned j = 0; j < 16; ++j) { const unsigned c = xb_ld(&bar[XB_XCNT(j)]); sum += c; cnt += (c > 0u) ? 1u : 0u; mine = (j == x) ? c : mine; }
        if (sum == G) break;
        __builtin_amdgcn_s_sleep(1);
        if ((++sp & 255u) == 0u) { if (xb_ld(&bar[XB_TMO])) break; if (sp > XB_SPIN_CAP) { atomicAdd(&bar[XB_TMO], 1u); break; } }
    }
    nloc = mine > 0u ? mine : 1u; nx = cnt > 0u ? cnt : 1u;
}

__device__ __forceinline__ void xcd_barrier(const XcdBarrier& b) {
    asm volatile("s_waitcnt vmcnt(0)" ::: "memory");
    __syncthreads();
    if (threadIdx.x == 0) {
        unsigned* bar = b.bar;
        __builtin_amdgcn_s_waitcnt(0);
        unsigned nloc = b.st[0], nx = b.st[1];
        if (nloc == 0u) { xcd_barrier_complete(bar, b.x, nloc, nx); b.st[0] = nloc; b.st[1] = nx; }
        const unsigned old = xb_add(&bar[XB_XSUB(b.x)], 1u);
        const unsigned gen = old / nloc;
        if (old + 1u == (gen + 1u) * nloc) {
            __builtin_amdgcn_fence(__ATOMIC_RELEASE, "agent");
            asm volatile("s_waitcnt vmcnt(0)" ::: "memory");
            const unsigned og = xb_add(&bar[XB_TOP], 1u);
            const unsigned tg = og / nx;
            if (og + 1u == (tg + 1u) * nx) xb_add(&bar[XB_TOPGEN], 1u);
            else XB_SPIN(xb_ld(&bar[XB_TOPGEN]) == tg, bar);
            __builtin_amdgcn_fence(__ATOMIC_ACQUIRE, "agent");
            xb_add(&bar[XB_XGEN(b.x)], 1u);
            asm volatile("s_waitcnt vmcnt(0)" ::: "memory");
        } else {
            XB_SPIN(xb_ld(&bar[XB_XGEN(b.x)]) == gen, bar);
            __builtin_amdgcn_fence(__ATOMIC_ACQUIRE, "agent");
            asm volatile("s_waitcnt vmcnt(0)" ::: "memory");
        }
    }
    __syncthreads();
}
namespace att {
constexpr int NSLOT = 3, SLOTB = 8192;
constexpr int LDS_K = 0, LDS_V = NSLOT * SLOTB, LDS_WS = 2 * NSLOT * SLOTB, LDS_OST = LDS_WS + 8 * 64 * 4, LDS_BIAS = LDS_OST + 8 * 4096, LDS_END = LDS_BIAS + 2048;
enum { M_FULL = 0, M_NA = 1, M_WA = 2 };
__device__ __forceinline__ int crow(int r, int hi) { return (r & 3) + 8 * (r >> 2) + 4 * hi; }
__device__ __forceinline__ void glds16(const void* gsrc, unsigned lds_dst) { unsigned keep;
    asm volatile("s_mov_b32 %0, m0\n\ts_mov_b32 m0, %2\n\ts_nop 0\n\tglobal_load_lds_dwordx4 %1, off\n\ts_mov_b32 m0, %0" : "=&s"(keep) : "v"(gsrc), "s"(lds_dst) : "memory"); }
__device__ __forceinline__ void qkt(f32x16& p0, f32x16& p1, const char* Kslot, const bf16x8* qr, int r32, int hi) {
    const char* kb = Kslot + hi * 1024 + r32 * 16;
    const f32x16 z = {};
#pragma unroll
    for (int d0 = 0; d0 < 4; ++d0) {
        const bf16x8 b0 = *reinterpret_cast<const bf16x8*>(kb + d0 * 2048);
        const bf16x8 b1 = *reinterpret_cast<const bf16x8*>(kb + d0 * 2048 + 512);
        if (d0 == 0) { p0 = __builtin_amdgcn_mfma_f32_32x32x16_bf16(b0, qr[0], z, 0, 0, 0); p1 = __builtin_amdgcn_mfma_f32_32x32x16_bf16(b1, qr[0], z, 0, 0, 0); }
        else { p0 = __builtin_amdgcn_mfma_f32_32x32x16_bf16(b0, qr[d0], p0, 0, 0, 0); p1 = __builtin_amdgcn_mfma_f32_32x32x16_bf16(b1, qr[d0], p1, 0, 0, 0); } }
}
__device__ __forceinline__ void pv(f32x16* o, int vb, bf16x8 pa0, bf16x8 pa1, bf16x8 pa2, bf16x8 pa3) {
#pragma unroll
    for (int d0 = 0; d0 < 2; ++d0) { s16x4 lo[4], hi[4];
#pragma unroll
        for (int ks = 0; ks < 4; ++ks) {
            asm volatile("ds_read_b64_tr_b16 %0,%1 offset:%c2" : "=&v"(lo[ks]) : "v"(vb), "i"(d0 * 4096 + ks * 1024) : "memory");
            asm volatile("ds_read_b64_tr_b16 %0,%1 offset:%c2" : "=&v"(hi[ks]) : "v"(vb), "i"(d0 * 4096 + ks * 1024 + 512) : "memory"); }
        asm volatile("s_waitcnt lgkmcnt(0)" ::: "memory"); __builtin_amdgcn_sched_barrier(0);
#define PK(k) (bf16x8){lo[k][0], lo[k][1], lo[k][2], lo[k][3], hi[k][0], hi[k][1], hi[k][2], hi[k][3]}
        o[d0] = __builtin_amdgcn_mfma_f32_32x32x16_bf16(pa0, PK(0), o[d0], 0, 0, 0);
        o[d0] = __builtin_amdgcn_mfma_f32_32x32x16_bf16(pa1, PK(1), o[d0], 0, 0, 0);
        o[d0] = __builtin_amdgcn_mfma_f32_32x32x16_bf16(pa2, PK(2), o[d0], 0, 0, 0);
        o[d0] = __builtin_amdgcn_mfma_f32_32x32x16_bf16(pa3, PK(3), o[d0], 0, 0, 0);
#undef PK
    }
}
struct Desc {
    const bf16* Q; int qp;
    const bf16* K; const bf16* V; int kp;
    bf16* O; int op;
    int nt, nctx, nt_real;
    int ctxrow, latrow;
    int r0, kr0;
    int q0, kt0;
    const float* rpb;
    float sink_l2; int has_sink;
    int qrope, qt0;
};
template <int MODE>
__device__ __forceinline__ void attn_unit(const Desc& d, char* shm) {
    int tid_ = threadIdx.x; asm volatile("" : "+v"(tid_));
    const int tid = tid_, lane = tid & 63, r32 = lane & 31, hi = lane >> 5; const int wid = __builtin_amdgcn_readfirstlane(tid >> 6);
    const unsigned lds0 = (unsigned)(uintptr_t)shm;
    float* wsf = (float*)(shm + LDS_WS) + wid * 64;
    const bf16* Qw = d.Q + (size_t)(wid * 32) * d.qp;
    const unsigned kdst = lds0 + LDS_K + wid * 1024, vdst = lds0 + LDS_V + wid * 1024;
    const size_t koffl = (size_t)lane * d.kp + wid * 8;
    const size_t voffl = (size_t)(16 * (wid & 3) + (lane >> 2)) * d.kp + (wid >> 2) * 32 + (lane & 3) * 8;
#define TROW(t) ((t) < d.nctx ? d.ctxrow + 64 * (t) : d.latrow + 64 * ((t) - d.nctx))
#define DMA_KV(t, slot) do { const size_t ro_ = (size_t)TROW(t) * d.kp; \
        glds16(d.K + ro_ + koffl, (unsigned)__builtin_amdgcn_readfirstlane(kdst + (slot) * SLOTB)); \
        glds16(d.V + ro_ + voffl, (unsigned)__builtin_amdgcn_readfirstlane(vdst + (slot) * SLOTB)); } while (0)
    const int vb0 = (int)(lds0 + LDS_V) + ((lane >> 4) & 1) * 32 + (lane & 3) * 8 + (4 * hi + ((lane & 15) >> 2)) * 64;
    if (MODE == M_NA) { float* bt = (float*)(shm + LDS_BIAS); if (tid < 465) bt[tid] = d.rpb[tid] * LOG2E; }
    DMA_KV(0, 0);
    if (d.nt > 1) DMA_KV(1, 1);
    bf16x8 qr[4];
#pragma unroll
    for (int d0 = 0; d0 < 4; ++d0) qr[d0] = *reinterpret_cast<const bf16x8*>(&Qw[(size_t)r32 * d.qp + d0 * 16 + hi * 8]);
    float m = -1e30f, l = 0.f; f32x16 o[2]; o[0] = f32x16{}; o[1] = f32x16{};
    const int qrow = (MODE == M_NA) ? d.r0 + (wid >> 1) : 0;
    const int qcol = 32 * (wid & 1) + r32;
    const int rs = (MODE == M_NA) ? (qrow - 4 < 0 ? 0 : (qrow - 4 > 120 ? 120 : qrow - 4)) : 0;
    const int cs = qcol - 8 < 0 ? 0 : (qcol - 8 > 48 ? 48 : qcol - 8);
    const int qpos = d.q0 + 32 * wid + r32;
    int slot = 0;
    for (int t = 0; t < d.nt; ++t) {
        if (t + 1 < d.nt) asm volatile("s_waitcnt vmcnt(2) lgkmcnt(0)\n\ts_barrier" ::: "memory");
        else asm volatile("s_waitcnt vmcnt(0) lgkmcnt(0)\n\ts_barrier" ::: "memory");
        if (t + 2 < d.nt) { const int s2 = slot + 2 >= NSLOT ? slot + 2 - NSLOT : slot + 2; DMA_KV(t + 2, s2); }
        bool active = true;
        int kr = 0, k0 = 0;
        if (MODE == M_NA && t >= d.nctx) { kr = d.kr0 + (t - d.nctx); active = (kr >= rs) && (kr < rs + 8); }
        if (MODE == M_WA && t >= d.nctx) { k0 = d.kt0 + 64 * (t - d.nctx); const int qw = d.q0 + 32 * wid; active = (k0 + 63 >= qw - 128) && (k0 <= qw + 31 + 128); }
        if (active) {
            f32x16 p0, p1;
            qkt(p0, p1, shm + LDS_K + slot * SLOTB, qr, r32, hi);
            if (MODE == M_NA && t >= d.nctx) {
                const float* bt = (const float*)(shm + LDS_BIAS) + (kr - qrow + 7) * 31 + 15 - qcol;
#pragma unroll
                for (int r = 0; r < 16; ++r) {
                    const int kv = crow(r, hi);
                    { const bool ok = (unsigned)(kv - cs) < 16u; const float bv = bt[ok ? kv : qcol]; p0[r] = ok ? p0[r] + bv : -INFINITY; }
                    { const int kv2 = kv + 32; const bool ok = (unsigned)(kv2 - cs) < 16u; const float bv = bt[ok ? kv2 : qcol]; p1[r] = ok ? p1[r] + bv : -INFINITY; }
                }
            }
            if (MODE == M_WA && t >= d.nctx) {
#pragma unroll
                for (int r = 0; r < 16; ++r) {
                    const int dk = k0 + crow(r, hi) - qpos;
                    if (dk > 128 || dk < -128) p0[r] = -INFINITY;
                    if (dk + 32 > 128 || dk + 32 < -128) p1[r] = -INFINITY;
                }
            }
            float rm = __builtin_fmaxf(p0[0], p1[0]);
#pragma unroll
            for (int r = 1; r < 16; ++r) rm = __builtin_fmaxf(rm, __builtin_fmaxf(p0[r], p1[r]));
            { auto rr = __builtin_amdgcn_permlane32_swap(__float_as_uint(rm), __float_as_uint(rm), false, false); rm = __builtin_fmaxf(__uint_as_float(rr[0]), __uint_as_float(rr[1])); }
            const float mn = __builtin_fmaxf(m, rm);
            if (__any(mn > m)) {
                const float f = __builtin_amdgcn_exp2f(m - mn); l *= f; m = mn;
                if (hi == 0) wsf[r32] = f;
                asm volatile("s_waitcnt lgkmcnt(0)" ::: "memory");
#pragma unroll
                for (int r = 0; r < 16; ++r) { const float fr_ = wsf[crow(r, hi)]; o[0][r] *= fr_; o[1][r] *= fr_; }
            }
            float sacc = 0.f;
#pragma unroll
            for (int r = 0; r < 16; ++r) { p0[r] = __builtin_amdgcn_exp2f(p0[r] - m); p1[r] = __builtin_amdgcn_exp2f(p1[r] - m); sacc += p0[r] + p1[r]; }
            l += sacc;
            v4u pw0, pw1, pw2, pw3;
            pw0 = (v4u){cvtpk(p0[0], p0[1]), cvtpk(p0[2], p0[3]), cvtpk(p0[4], p0[5]), cvtpk(p0[6], p0[7])};
            pw1 = (v4u){cvtpk(p0[8], p0[9]), cvtpk(p0[10], p0[11]), cvtpk(p0[12], p0[13]), cvtpk(p0[14], p0[15])};
            pw2 = (v4u){cvtpk(p1[0], p1[1]), cvtpk(p1[2], p1[3]), cvtpk(p1[4], p1[5]), cvtpk(p1[6], p1[7])};
            pw3 = (v4u){cvtpk(p1[8], p1[9]), cvtpk(p1[10], p1[11]), cvtpk(p1[12], p1[13]), cvtpk(p1[14], p1[15])};
            pv(o, vb0 + slot * SLOTB, __builtin_bit_cast(bf16x8, pw0), __builtin_bit_cast(bf16x8, pw1), __builtin_bit_cast(bf16x8, pw2), __builtin_bit_cast(bf16x8, pw3));
        }
        slot = slot + 1 >= NSLOT ? 0 : slot + 1;
    }
    if (d.has_sink && hi == 0) l += __builtin_amdgcn_exp2f(d.sink_l2 - m);
    { auto rr = __builtin_amdgcn_permlane32_swap(__float_as_uint(l), __float_as_uint(l), false, false); l = __uint_as_float(rr[0]) + __uint_as_float(rr[1]); }
    if (hi == 0) wsf[32 + r32] = l;
    asm volatile("s_waitcnt lgkmcnt(0)" ::: "memory");
    float rli[16];
#pragma unroll
    for (int r = 0; r < 16; ++r) rli[r] = __builtin_amdgcn_rcpf(wsf[32 + crow(r, hi)]);
    bf16* Ow = d.O + (size_t)(wid * 32) * d.op;
    { bf16* stg = (bf16*)(shm + LDS_OST) + wid * 2048;
#pragma unroll
        for (int r = 0; r < 16; ++r) { const int orow = crow(r, hi);
#pragma unroll
            for (int d0 = 0; d0 < 2; ++d0) stg[orow * 64 + d0 * 32 + r32] = (bf16)f2bf(o[d0][r] * rli[r]); }
        asm volatile("s_waitcnt lgkmcnt(0)" ::: "memory");
#pragma unroll
        for (int i = 0; i < 4; ++i) { const int row = i * 8 + (lane >> 3), ch = lane & 7; const v4u v = *(const v4u*)(stg + row * 64 + ch * 8); *(v4u*)(Ow + (size_t)row * d.op + ch * 8) = v; } }
    asm volatile("s_waitcnt lgkmcnt(0)\n\ts_barrier" ::: "memory");
#undef TROW
#undef DMA_KV
}
}
namespace att {
typedef unsigned u32x4 __attribute__((ext_vector_type(4)));
#define SBAR() __builtin_amdgcn_sched_barrier(0)
__device__ __forceinline__ float max3f(float a,float b,float c){float r;asm("v_max3_f32 %0, %1, %2, %3":"=v"(r):"v"(a),"v"(b),"v"(c));return r;}
__device__ __forceinline__ float max2f(float a,float b){float r;asm("v_max_f32_e32 %0, %1, %2":"=v"(r):"v"(a),"v"(b));return r;}
__device__ __forceinline__ float fadd_s(float a,float b){float r;asm("v_add_f32_e32 %0, %1, %2":"=v"(r):"v"(a),"v"(b));return r;}
__device__ __forceinline__ float fsub_s(float a,float b){float r;asm("v_sub_f32_e32 %0, %1, %2":"=v"(r):"v"(a),"v"(b));return r;}
__device__ __forceinline__ unsigned cvtpk_s(float lo,float hi){return cvtpk(lo,hi);}
#define WAIT_BAR(N) asm volatile("s_waitcnt vmcnt(" #N ") lgkmcnt(0)\n\ts_barrier":::"memory")


__device__ __forceinline__ void qkt_n(f32x16&p0,f32x16&p1,const char*Kslot,const bf16x8*qr,const f32x16&negm,int r32,int hi){
  const char*kb=Kslot+hi*1024+r32*16;
  #pragma unroll
  for(int d0=0;d0<4;++d0){
    const bf16x8 b0=*reinterpret_cast<const bf16x8*>(kb+d0*2048);
    const bf16x8 b1=*reinterpret_cast<const bf16x8*>(kb+d0*2048+512);
    if(d0==0){p0=__builtin_amdgcn_mfma_f32_32x32x16_bf16(b0,qr[0],negm,0,0,0);p1=__builtin_amdgcn_mfma_f32_32x32x16_bf16(b1,qr[0],negm,0,0,0);}
    else{p0=__builtin_amdgcn_mfma_f32_32x32x16_bf16(b0,qr[d0],p0,0,0,0);p1=__builtin_amdgcn_mfma_f32_32x32x16_bf16(b1,qr[d0],p1,0,0,0);}}
}
typedef __attribute__((address_space(3))) const char* lds_cptr;
typedef short v4i16_t __attribute__((ext_vector_type(4)));
__device__ __forceinline__ void kload8(bf16x8*kf,lds_cptr kp){
  kf[0]=*(const __attribute__((address_space(3))) bf16x8*)(kp);      kf[1]=*(const __attribute__((address_space(3))) bf16x8*)(kp+512);
  kf[2]=*(const __attribute__((address_space(3))) bf16x8*)(kp+2048); kf[3]=*(const __attribute__((address_space(3))) bf16x8*)(kp+2560);
  kf[4]=*(const __attribute__((address_space(3))) bf16x8*)(kp+4096); kf[5]=*(const __attribute__((address_space(3))) bf16x8*)(kp+4608);
  kf[6]=*(const __attribute__((address_space(3))) bf16x8*)(kp+6144); kf[7]=*(const __attribute__((address_space(3))) bf16x8*)(kp+6656);
}
__device__ __forceinline__ void kload2(bf16x8*kf,lds_cptr kp,int j){ kf[2*j]=*(const __attribute__((address_space(3))) bf16x8*)(kp+j*2048); kf[2*j+1]=*(const __attribute__((address_space(3))) bf16x8*)(kp+j*2048+512); }
__device__ __forceinline__ s16x4 vtr(lds_cptr p){ return __builtin_bit_cast(s16x4,__builtin_amdgcn_ds_read_tr16_b64_v4i16((__attribute__((address_space(3))) v4i16_t*)p)); }
__device__ __forceinline__ float rowmax(const f32x16&p0,const f32x16&p1){
  float a=max3f(p0[0],p0[1],p1[0]),b=max3f(p0[2],p0[3],p1[1]);a=max3f(a,p1[2],p1[3]);
  #pragma unroll
  for(int r=4;r<16;r+=4){a=max3f(a,p0[r],p0[r+1]);b=max3f(b,p0[r+2],p0[r+3]);a=max3f(a,p1[r],p1[r+1]);b=max3f(b,p1[r+2],p1[r+3]);}
  const float m=max2f(a,b);
  auto rr=__builtin_amdgcn_permlane32_swap(__float_as_uint(m),__float_as_uint(m),false,false);
  return max2f(__uint_as_float(rr[0]),__uint_as_float(rr[1]));
}

template<int MODE> __device__ __forceinline__ void pipe_mask(f32x16&P0,f32x16&P1,int t,const Desc& d,const char*shm,int wid,int r32,int hi){
  if(MODE==M_FULL) return;
  if(t<d.nctx) return;
  if(t>=d.nt_real){
    _Pragma("unroll") for(int r=0;r<16;++r){P0[r]=-INFINITY;P1[r]=-INFINITY;} return; }
  if(MODE==M_NA){
    const int qrow=d.r0+(wid>>1), qcol=32*(wid&1)+r32, kr=d.kr0+(t-d.nctx);
    const int rs=qrow-4<0?0:(qrow-4>120?120:qrow-4), cs=qcol-8<0?0:(qcol-8>48?48:qcol-8);
    if(kr<rs||kr>=rs+8){ _Pragma("unroll") for(int r=0;r<16;++r){P0[r]=-INFINITY;P1[r]=-INFINITY;} return; }
    const float*bt=(const float*)(shm+LDS_BIAS)+(kr-qrow+7)*31+15-qcol;
    _Pragma("unroll") for(int r=0;r<16;++r){ const int kv=crow(r,hi);
      { const bool ok=(unsigned)(kv-cs)<16u; const float bv=bt[ok?kv:qcol]; P0[r]=ok?P0[r]+bv:-INFINITY; }
      { const int kv2=kv+32; const bool ok=(unsigned)(kv2-cs)<16u; const float bv=bt[ok?kv2:qcol]; P1[r]=ok?P1[r]+bv:-INFINITY; } }
  }
  if(MODE==M_WA){
    const int qpos=d.q0+32*wid+r32, k0=d.kt0+64*(t-d.nctx);
    _Pragma("unroll") for(int r=0;r<16;++r){ const int dk=k0+crow(r,hi)-qpos;
      if(dk>128||dk<-128)P0[r]=-INFINITY; if(dk+32>128||dk+32<-128)P1[r]=-INFINITY; }
  }
}
template<int THRL,int MODE> __device__ __forceinline__ void attn_unit_pipe(const Desc& d,char*shm){
  int tid_=threadIdx.x; asm volatile("":"+v"(tid_)); const int tid=tid_,lane=tid&63,r32=lane&31,hi=lane>>5; const int wid=__builtin_amdgcn_readfirstlane(tid>>6);
  const bf16*Qw=d.Q+(size_t)(wid*32)*d.qp;
  const unsigned lds0=(unsigned)(uintptr_t)shm;
  if(MODE==M_NA){ float*bt=(float*)(shm+LDS_BIAS); if(tid<465)bt[tid]=d.rpb[tid]*LOG2E; }
  float*wsf=(float*)(shm+LDS_WS)+wid*64;
  const size_t koffl=(size_t)lane*d.kp+wid*8;
  const size_t voffl=(size_t)(16*(wid&3)+(lane>>2))*d.kp+(wid>>2)*32+(lane&3)*8;
  #define TROW(t) ((t)<d.nctx?d.ctxrow+64*(t):((t)<d.nt_real?d.latrow+64*((t)-d.nctx):d.latrow))
  const unsigned kdst=lds0+LDS_K+wid*1024, vdst=lds0+LDS_V+wid*1024;
  #define DMA_K(t,slot) glds16(d.K+(size_t)TROW(t)*d.kp+koffl,(unsigned)__builtin_amdgcn_readfirstlane(kdst+(slot)))
  #define DMA_V(t,slot) glds16(d.V+(size_t)TROW(t)*d.kp+voffl,(unsigned)__builtin_amdgcn_readfirstlane(vdst+(slot)))
  const int vb0=(int)(lds0+LDS_V)+((lane>>4)&1)*32+(lane&3)*8+(4*hi+((lane&15)>>2))*64;
  const char*Kbase=shm+LDS_K; bf16x8 kf[8];
  const lds_cptr shm3=(lds_cptr)shm; const lds_cptr kp0=shm3+LDS_K+hi*1024+r32*16; const lds_cptr vp0=shm3+LDS_V+((lane>>4)&1)*32+(lane&3)*8+(4*hi+((lane&15)>>2))*64;
  const int NT=d.nt;
  DMA_K(0,0);DMA_V(0,0);DMA_K(1,SLOTB);
  bf16x8 qr[4];
  #pragma unroll
  for(int d0=0;d0<4;++d0)qr[d0]=*reinterpret_cast<const bf16x8*>(&Qw[(size_t)r32*d.qp+d0*16+hi*8]);
  if(d.qrope){
    const int tq=d.qt0+32*wid+r32, rr=tq>>6, cc=tq&63;
    #pragma unroll
    for(int d0=2;d0<4;++d0){ const float pos=(float)(d0==2?rr:cc); u32x4 w=__builtin_bit_cast(u32x4,qr[d0]), pw, ow;
      #pragma unroll
      for(int j=0;j<4;++j) pw[j]=(unsigned)__shfl_xor((int)w[j],32);
      #pragma unroll
      for(int j=0;j<4;++j){ float res[2];
        #pragma unroll
        for(int e=0;e<2;++e){ const int i=2*j+e; const float own=e?bfhi(w[j]):bflo(w[j]), oth=e?bfhi(pw[j]):bflo(pw[j]);
          const float rev=pos*__builtin_amdgcn_exp2f(-(float)i*(13.287712379549449f/8.0f))*0.15915494309189535f; const float cs_=__builtin_amdgcn_cosf(rev), sn_=__builtin_amdgcn_sinf(rev);
          res[e]=hi?(own*cs_+oth*sn_):(own*cs_-oth*sn_); }
        ow[j]=cvtpk(res[0],res[1]); }
      qr[d0]=__builtin_bit_cast(bf16x8,ow); } }
  float mhat=0.f,l_reg=0.f;f32x16 o[2];o[0]=f32x16{};o[1]=f32x16{};f32x16 negm=f32x16{};asm volatile("":"+v"(negm));
  #define CMASK(P0,P1,t) pipe_mask<MODE>(P0,P1,(t),d,shm,wid,r32,hi)
  bool resc=false;
  #define START(P0,P1) do{ const float rm=rowmax(P0,P1); resc=false; \
    { const float dl=rm; mhat=fadd_s(mhat,dl); \
      _Pragma("unroll") for(int r=0;r<16;++r){P0[r]=fsub_s(P0[r],dl);P1[r]=fsub_s(P1[r],dl);} \
      _Pragma("unroll") for(int r=0;r<16;++r)negm[r]=-mhat; asm volatile("":"+v"(negm)); } \
    _Pragma("unroll") for(int r=0;r<16;++r)P0[r]=__builtin_amdgcn_exp2f(P0[r]); }while(0)
  #define RESC() do{ if(resc){ asm volatile("s_waitcnt lgkmcnt(0)":::"memory"); \
      _Pragma("unroll") for(int d_=0;d_<2;++d_) _Pragma("unroll") for(int r=0;r<16;++r)o[d_][r]*=wsf[crow(r,hi)]; } }while(0)
  f32x16 pA0,pA1,pB0,pB1;
  int sl_prev=0,sl_cur=0,sl_next=SLOTB;
  #define ROT() do{sl_prev=sl_cur;sl_cur=sl_next;sl_next=(sl_next==(NSLOT-1)*SLOTB)?0:sl_next+SLOTB;}while(0)
  DMA_K(2,2*SLOTB);
  WAIT_BAR(3);
  qkt_n(pA0,pA1,Kbase,qr,negm,r32,hi);asm volatile("s_nop 15\n\ts_nop 7":"+v"(pA0),"+v"(pA1));CMASK(pA0,pA1,0);
  START(pA0,pA1);
  _Pragma("unroll") for(int r=0;r<16;++r)pA1[r]=__builtin_amdgcn_exp2f(pA1[r]);
  WAIT_BAR(0);
  DMA_K(3,0);DMA_V(1,SLOTB);
  ROT();
  kload8(kf,kp0+sl_cur);
  WAIT_BAR(2);
  s16x4 vlo[8],vhi[8]; u32x4 pw0,pw1,pw2,pw3;
  #define PKW(P,B) cvtpk_s(P[B],P[B+1])
  #define PAF(k) __builtin_bit_cast(bf16x8,pw##k)
  #define VFR(i) (bf16x8){vlo[i][0],vlo[i][1],vlo[i][2],vlo[i][3],vhi[i][0],vhi[i][1],vhi[i][2],vhi[i][3]}
  #define PIN(x) asm volatile("":"+v"(x))
  #define MX3(a,b,c) __builtin_fmaxf(__builtin_fmaxf((a),(b)),(c))
  #define GAPA(MF,A0,A1,A2,A3,W0,W1,PW) do{ MF; sacc+=A0; sacc+=A1; sacc+=A2; sacc+=A3; PIN(sacc); W0; W1; PIN(PW); SBAR(); }while(0)
  #define EX(v) __builtin_amdgcn_exp2f(v)
  #define GAPB(MF,X,B) do{ MF; X[B]=EX(X[B]); X[B+1]=EX(X[B+1]); X[B+2]=EX(X[B+2]); X[B+3]=EX(X[B+3]); PIN(X); SBAR(); }while(0)
  #define VRD(i) do{ vlo[i]=vtr(vp_+(((i)>>2)*4096+((i)&3)*1024)); vhi[i]=vtr(vp_+(((i)>>2)*4096+((i)&3)*1024+512)); }while(0)
  #define KRD(G,j) do{ if(G){ kload2(kf,kp0+sl_next,j); SBAR(); } }while(0)
  #define STEP(C0,C1,P0,P1,t,GK,GV,GL) do{ SBAR(); \
    const lds_cptr vp_=vp0+sl_prev; \
    VRD(0); SBAR(); float sacc=(P0[0]+P0[1]); \
    GAPA(C0=__builtin_amdgcn_mfma_f32_32x32x16_bf16(kf[0],qr[0],negm,0,0,0), P0[2],P0[3],P0[4],P0[5],     pw0[0]=PKW(P0,0), pw0[1]=PKW(P0,2), pw0); \
    VRD(4); SBAR(); GAPA(C1=__builtin_amdgcn_mfma_f32_32x32x16_bf16(kf[1],qr[0],negm,0,0,0), P0[6],P0[7],P0[8],P0[9],     pw0[2]=PKW(P0,4), pw0[3]=PKW(P0,6), pw0); \
    VRD(1); SBAR(); GAPA(C0=__builtin_amdgcn_mfma_f32_32x32x16_bf16(kf[2],qr[1],C0,0,0,0),   P0[10],P0[11],P0[12],P0[13], pw1[0]=PKW(P0,8), pw1[1]=PKW(P0,10), pw1); \
    VRD(5); SBAR(); GAPA(C1=__builtin_amdgcn_mfma_f32_32x32x16_bf16(kf[3],qr[1],C1,0,0,0),   P0[14],P0[15],P1[0],P1[1],   pw1[2]=PKW(P0,12),pw1[3]=PKW(P0,14), pw1); \
    VRD(2); SBAR(); GAPA(C0=__builtin_amdgcn_mfma_f32_32x32x16_bf16(kf[4],qr[2],C0,0,0,0),   P1[2],P1[3],P1[4],P1[5],     pw2[0]=PKW(P1,0), pw2[1]=PKW(P1,2), pw2); \
    VRD(6); SBAR(); GAPA(C1=__builtin_amdgcn_mfma_f32_32x32x16_bf16(kf[5],qr[2],C1,0,0,0),   P1[6],P1[7],P1[8],P1[9],     pw2[2]=PKW(P1,4), pw2[3]=PKW(P1,6), pw2); \
    VRD(3); SBAR(); GAPA(C0=__builtin_amdgcn_mfma_f32_32x32x16_bf16(kf[6],qr[3],C0,0,0,0),   P1[10],P1[11],P1[12],P1[13], pw3[0]=PKW(P1,8), pw3[1]=PKW(P1,10), pw3); \
    VRD(7); SBAR(); GAPA(C1=__builtin_amdgcn_mfma_f32_32x32x16_bf16(kf[7],qr[3],C1,0,0,0),   P1[14],P1[15],0.f,0.f,       pw3[2]=PKW(P1,12),pw3[3]=PKW(P1,14), pw3); \
    l_reg+=sacc; \
    if(GK){DMA_K((t)+3,sl_cur);} if(GV){DMA_V((t)+1,sl_next);} \
    CMASK(C0,C1,t); \
    { float a=MX3(C0[0],C0[1],C1[0]),b=MX3(C0[2],C0[3],C1[1]); a=MX3(a,C1[2],C1[3]); \
      _Pragma("unroll") for(int r=4;r<16;r+=4){a=MX3(a,C0[r],C0[r+1]);b=MX3(b,C0[r+2],C0[r+3]);a=MX3(a,C1[r],C1[r+1]);b=MX3(b,C1[r+2],C1[r+3]);} \
      float rm=__builtin_fmaxf(a,b); { auto rr=__builtin_amdgcn_permlane32_swap(__float_as_uint(rm),__float_as_uint(rm),false,false); rm=__builtin_fmaxf(__uint_as_float(rr[0]),__uint_as_float(rr[1])); } \
      resc=false; \
      if(__builtin_expect(__any(rm>(float)THRL),0)){ const float dl=__builtin_fmaxf(rm,0.f); mhat+=dl; \
        _Pragma("unroll") for(int r=0;r<16;++r){C0[r]-=dl;C1[r]-=dl;} \
        _Pragma("unroll") for(int r=0;r<16;++r)negm[r]=-mhat; asm volatile("":"+v"(negm)); \
        const float f=__builtin_amdgcn_exp2f(-dl); l_reg*=f; if(hi==0)wsf[r32]=f; resc=true; } } \
    SBAR(); \
    GAPB(o[0]=__builtin_amdgcn_mfma_f32_32x32x16_bf16(PAF(0),VFR(0),o[0],0,0,0), C0,0); \
    GAPB(o[1]=__builtin_amdgcn_mfma_f32_32x32x16_bf16(PAF(0),VFR(4),o[1],0,0,0), C0,4); \
    KRD(GL,0); GAPB(o[0]=__builtin_amdgcn_mfma_f32_32x32x16_bf16(PAF(1),VFR(1),o[0],0,0,0), C0,8); \
    KRD(GL,1); GAPB(o[1]=__builtin_amdgcn_mfma_f32_32x32x16_bf16(PAF(1),VFR(5),o[1],0,0,0), C0,12); \
    KRD(GL,2); GAPB(o[0]=__builtin_amdgcn_mfma_f32_32x32x16_bf16(PAF(2),VFR(2),o[0],0,0,0), C1,0); \
    KRD(GL,3); GAPB(o[1]=__builtin_amdgcn_mfma_f32_32x32x16_bf16(PAF(2),VFR(6),o[1],0,0,0), C1,4); \
    GAPB(o[0]=__builtin_amdgcn_mfma_f32_32x32x16_bf16(PAF(3),VFR(3),o[0],0,0,0), C1,8); \
    GAPB(o[1]=__builtin_amdgcn_mfma_f32_32x32x16_bf16(PAF(3),VFR(7),o[1],0,0,0), C1,12); \
    }while(0)
  int t=1;
  for(;t+5<NT;t+=2){
    STEP(pB0,pB1,pA0,pA1,t,true,true,true);     WAIT_BAR(2); RESC(); ROT();
    STEP(pA0,pA1,pB0,pB1,t+1,true,true,true);   WAIT_BAR(2); RESC(); ROT();
  }
  #define ENDW(tt) do{ if((tt)+3<NT){WAIT_BAR(2);} else if((tt)+2<NT){WAIT_BAR(1);} else {WAIT_BAR(0);} }while(0)
  for(;t+1<NT;t+=2){
    STEP(pB0,pB1,pA0,pA1,t,(t+3<NT),(t+1<NT),(t+1<NT));       ENDW(t);   RESC(); ROT();
    STEP(pA0,pA1,pB0,pB1,t+1,(t+4<NT),(t+2<NT),(t+2<NT));     ENDW(t+1); RESC(); ROT();
  }
  STEP(pB0,pB1,pA0,pA1,NT-1,false,false,false); RESC();
  { float sacc=pB0[0]+pB0[1]; _Pragma("unroll") for(int r=2;r<16;++r)sacc+=pB0[r]; _Pragma("unroll") for(int r=0;r<16;++r)sacc+=pB1[r]; l_reg+=sacc;
    pw0=(u32x4){PKW(pB0,0),PKW(pB0,2),PKW(pB0,4),PKW(pB0,6)};pw1=(u32x4){PKW(pB0,8),PKW(pB0,10),PKW(pB0,12),PKW(pB0,14)};pw2=(u32x4){PKW(pB1,0),PKW(pB1,2),PKW(pB1,4),PKW(pB1,6)};pw3=(u32x4){PKW(pB1,8),PKW(pB1,10),PKW(pB1,12),PKW(pB1,14)};
    SBAR(); pv(o,vb0+sl_cur,PAF(0),PAF(1),PAF(2),PAF(3)); }
  #undef PKW
  #undef PAF
  #undef VFR
  #undef PIN
  #undef MX3
  #undef GAPA
  #undef GAPB
  #undef EX
  #undef VRD
  #undef KRD
  #undef STEP
  #undef ENDW
  if(d.has_sink&&hi==0)l_reg+=__builtin_amdgcn_exp2f(d.sink_l2-mhat);
  {auto rr=__builtin_amdgcn_permlane32_swap(__float_as_uint(l_reg),__float_as_uint(l_reg),false,false);l_reg=__uint_as_float(rr[0])+__uint_as_float(rr[1]);}
  if(hi==0)wsf[32+r32]=l_reg;asm volatile("s_waitcnt lgkmcnt(0)":::"memory");
  float rli[16];
  #pragma unroll
  for(int r=0;r<16;++r)rli[r]=__builtin_amdgcn_rcpf(wsf[32+crow(r,hi)]);
  bf16*Ow=d.O+(size_t)(wid*32)*d.op;
  { bf16*stg=(bf16*)(shm+LDS_OST)+wid*2048;
    #pragma unroll
    for(int r=0;r<16;++r){const int orow=crow(r,hi);
      #pragma unroll
      for(int d0=0;d0<2;++d0)stg[orow*64+d0*32+r32]=(bf16)f2bf(o[d0][r]*rli[r]);}
    asm volatile("s_waitcnt lgkmcnt(0)":::"memory");
    #pragma unroll
    for(int i=0;i<4;++i){const int row=i*8+(lane>>3),ch=lane&7; const u32x4 v=*(const u32x4*)(stg+row*64+ch*8); *(u32x4*)(Ow+(size_t)row*d.op+ch*8)=v;} }
  asm volatile("s_waitcnt lgkmcnt(0)\n\ts_barrier":::"memory");
  #undef DMA_K
  #undef TROW
  #undef DMA_V
  #undef CMASK
  #undef START
  #undef RESC
  #undef ROT
}

#undef SBAR
#undef WAIT_BAR
}
namespace gla {
constexpr int S32 = 40, S64 = 72;
struct Par {
    const bf16* P; bf16* CAT; float* GU; float* GDEC; float* BC;
    const float *wgf, *bgf, *wgb, *bgb, *gnorm;
};
__device__ __forceinline__ int chunk_row(int b, int n) { return n < 4 ? NLAT + b * CTXL + 64 * n : b * SEQ + 64 * (n - 4); }
__device__ __forceinline__ int chunk_dir(int n, int dir) { return dir == 0 ? n : (n < 4 ? 3 - n : 135 - n); }
template <int KS>
__device__ __forceinline__ f32x16 mm_tile(f32x16 c, const bf16* A, int sa, const bf16* Bt, int sb, int r32, int hi) {
#pragma unroll
    for (int s = 0; s < KS; ++s) {
        const bf16x8 a = *reinterpret_cast<const bf16x8*>(A + r32 * sa + 16 * s + 8 * hi);
        const bf16x8 b = *reinterpret_cast<const bf16x8*>(Bt + r32 * sb + 16 * s + 8 * hi);
        c = __builtin_amdgcn_mfma_f32_32x32x16_bf16(a, b, c, 0, 0, 0);
    }
    return c;
}
__device__ __forceinline__ float decay_g(const bf16* zl, int tok, int dir, const float (&w)[16], float bias) {
    const v4u* zp = (const v4u*)(zl + tok * 32 + dir * 16);
    const v4u z0 = zp[0], z1 = zp[1];
    float a = bias;
    a += bflo(z0.x) * w[0] + bfhi(z0.x) * w[1] + bflo(z0.y) * w[2] + bfhi(z0.y) * w[3] + bflo(z0.z) * w[4] + bfhi(z0.z) * w[5] + bflo(z0.w) * w[6] + bfhi(z0.w) * w[7];
    a += bflo(z1.x) * w[8] + bfhi(z1.x) * w[9] + bflo(z1.y) * w[10] + bfhi(z1.y) * w[11] + bflo(z1.z) * w[12] + bfhi(z1.z) * w[13] + bflo(z1.w) * w[14] + bfhi(z1.w) * w[15];
    const float ls = __builtin_fminf(a, 0.f) - 0.6931471805599453f * __builtin_amdgcn_logf(1.0f + __builtin_amdgcn_exp2f(-LOG2E * __builtin_fabsf(a)));
    return ls * (1.0f / 16.0f);
}
__device__ __forceinline__ void decay_totals(float& bend, float& carry, const bf16* zl, const float (&w)[16], float bias, int dir, int half) {
    float tot = 0.f;
#pragma unroll 4
    for (int ii = 0; ii < 32; ++ii) tot += decay_g(zl, 32 * half + ii, dir, w, bias);
    const float oth = __shfl_xor(tot, 32);
    bend = tot + oth; carry = (half == (dir == 0 ? 1 : 0)) ? oth : 0.f;
}
__device__ __forceinline__ void load_z(bf16* zl, const bf16* P, int row0, int tid) {
    if (tid < 256) { const int j = tid >> 2, c = tid & 3; *(v4u*)(zl + j * 32 + c * 8) = *(const v4u*)(P + (size_t)(row0 + j) * INWP + D_ZF + c * 8); }
}
__device__ __forceinline__ void ld_rows32(v4u (&pc)[2], const bf16* P, int row0, int col, int lane) {
#pragma unroll
    for (int i = 0; i < 2; ++i) { const int pidx = lane + 64 * i; pc[i] = *(const v4u*)(P + (size_t)(row0 + (pidx >> 2)) * INWP + col + (pidx & 3) * 8); }
}
__device__ __forceinline__ void st_rows32(bf16* dst, const v4u (&pc)[2], int lane) {
#pragma unroll
    for (int i = 0; i < 2; ++i) { const int pidx = lane + 64 * i; *(v4u*)(dst + (pidx >> 2) * S32 + (pidx & 3) * 8) = pc[i]; }
}
__device__ __forceinline__ void load_vt(bf16* Vt, const bf16* P, int row0, int h, int part, int lane) {
    const int c8 = lane & 7, jj = lane >> 3;
#pragma unroll
    for (int it = 0; it < 4; ++it) {
        const int j = 32 * part + it * 8 + jj;
        const v4u x = *(const v4u*)(P + (size_t)(row0 + j) * INWP + D_V + h * 64 + c8 * 8);
        bf16* dst = Vt + (c8 * 8) * S64 + j;
        dst[0 * S64] = (bf16)(x.x & 0xffff); dst[1 * S64] = (bf16)(x.x >> 16); dst[2 * S64] = (bf16)(x.y & 0xffff); dst[3 * S64] = (bf16)(x.y >> 16);
        dst[4 * S64] = (bf16)(x.z & 0xffff); dst[5 * S64] = (bf16)(x.z >> 16); dst[6 * S64] = (bf16)(x.w & 0xffff); dst[7 * S64] = (bf16)(x.w >> 16);
    }
}
__device__ __forceinline__ void g1_unit(const Par& p, int b, int n, char* shm) {
    int tid_ = threadIdx.x; asm volatile("" : "+v"(tid_));
    const int tid = tid_, lane = tid & 63, r32 = lane & 31, hi = lane >> 5; const int wid = __builtin_amdgcn_readfirstlane(tid >> 6);
    const int h = wid >> 1, dir = wid & 1, row0 = chunk_row(b, n);
    char* pr = shm + (wid >> 1) * 32768;
    bf16* KdT = (bf16*)(pr + (wid & 1) * 4608);
    bf16* Vt = (bf16*)(pr + 9216);
    bf16* Kr = (bf16*)(pr + 18432);
    bf16* zl = (bf16*)(shm + 131072);
    const int k = lane & 31, half = lane >> 5;
    v4u pc[2]; ld_rows32(pc, p.P, row0 + 32 * dir, D_K + h * 32, lane);
    float w[16];
    { const float* wg = dir == 0 ? p.wgf : p.wgb;
#pragma unroll
      for (int j = 0; j < 16; ++j) w[j] = wg[j * 128 + h * 32 + k]; }
    const float bias = (dir == 0 ? p.bgf : p.bgb)[h * 32 + k];
    load_z(zl, p.P, row0, tid);
    load_vt(Vt, p.P, row0, h, dir, lane);
    st_rows32(Kr + 32 * dir * S32, pc, lane);
    __syncthreads();
    float bend, run;
    decay_totals(bend, run, zl, w, bias, dir, half);
#pragma unroll 2
    for (int s = 0; s < 32; ++s) {
        const int i = 32 * half + (dir == 0 ? s : 31 - s);
        run += decay_g(zl, i, dir, w, bias);
        KdT[k * S64 + i] = (bf16)f2bf(bf2f(Kr[i * S32 + k]) * __expf(bend - run));
        p.BC[(size_t)(row0 + i) * 256 + dir * 128 + h * 32 + k] = run;
    }
    const int seq = (b * 4 + h) * 2 + dir, nd = chunk_dir(n, dir);
    if (half == 0) p.GDEC[((size_t)seq * NCH + nd) * 32 + k] = __expf(bend);
    LDS_WAIT();
    float* up = p.GU + ((size_t)seq * NCH + nd) * 2048;
#pragma unroll
    for (int dt = 0; dt < 2; ++dt) {
        f32x16 c = {};
        c = mm_tile<4>(c, KdT, S64, Vt + (32 * dt) * S64, S64, r32, hi);
#pragma unroll
        for (int r = 0; r < 16; ++r) (up + ((r & 3) + 8 * (r >> 2)) * 64 + 32 * dt)[(unsigned)(4 * hi * 64 + r32)] = c[r];
    }
    __syncthreads();
}
__device__ __forceinline__ void g2_scan(float* GU, const float* GDEC, int gt) {
    if (gt >= 32 * 2048) return;
    const int seq = gt >> 11, e = gt & 2047, k = e >> 6;
    float* up = GU + (size_t)seq * NCH * 2048 + e; const float* dp = GDEC + (size_t)seq * NCH * 32 + k;
    float s = 0.f;
#pragma unroll 12
    for (int n = 0; n < NCH; ++n) { const float u = up[(size_t)n * 2048], dc = dp[n * 32]; up[(size_t)n * 2048] = s; s = s * dc + u; }
}
struct G3Lds { bf16 *Kd, *St, *Vt, *Qd, *AT, *zl; };
template <int DIR>
__device__ __forceinline__ void g3_dir(f32x16 (&o)[2], const Par& p, const G3Lds& L, int row0, int b, int n, int h, int ih, int lane) {
    const int r32 = lane & 31, hi = lane >> 5;
    const int seq = (b * 4 + h) * 2 + DIR, nd = chunk_dir(n, DIR);
    const float* sp = p.GU + ((size_t)seq * NCH + nd) * 2048;
    const int t128 = ih * 64 + lane;
    f32x4 sv[4];
#pragma unroll
    for (int it = 0; it < 4; ++it) sv[it] = *(const f32x4*)(sp + (it * 128 + t128) * 4);
    v4u pq[2], pk[2]; f32x4 pb[2][2];
#pragma unroll
    for (int i = 0; i < 2; ++i) { const int item = lane + 64 * i, t = item >> 2, g8 = item & 3; const size_t row = (size_t)(row0 + 32 * ih + t);
        pq[i] = *(const v4u*)(p.P + row * INWP + D_Q + h * 32 + g8 * 8); pk[i] = *(const v4u*)(p.P + row * INWP + D_K + h * 32 + g8 * 8);
        const float* bp = p.BC + row * 256 + DIR * 128 + h * 32 + g8 * 8; pb[i][0] = *(const f32x4*)bp; pb[i][1] = *(const f32x4*)(bp + 4); }
#pragma unroll
    for (int i = 0; i < 2; ++i) { const int item = lane + 64 * i, t = item >> 2, g8 = item & 3;
        float e[8], qf[8], kf[8];
#pragma unroll
        for (int j = 0; j < 4; ++j) { e[j] = pb[i][0][j]; e[4 + j] = pb[i][1][j]; }
        qf[0] = bflo(pq[i].x); qf[1] = bfhi(pq[i].x); qf[2] = bflo(pq[i].y); qf[3] = bfhi(pq[i].y); qf[4] = bflo(pq[i].z); qf[5] = bfhi(pq[i].z); qf[6] = bflo(pq[i].w); qf[7] = bfhi(pq[i].w);
        kf[0] = bflo(pk[i].x); kf[1] = bfhi(pk[i].x); kf[2] = bflo(pk[i].y); kf[3] = bfhi(pk[i].y); kf[4] = bflo(pk[i].z); kf[5] = bfhi(pk[i].z); kf[6] = bflo(pk[i].w); kf[7] = bfhi(pk[i].w);
#pragma unroll
        for (int j = 0; j < 8; ++j) { qf[j] *= __builtin_amdgcn_exp2f(e[j] * LOG2E) * 0.17677669529663687f; kf[j] *= __builtin_amdgcn_exp2f(-e[j] * LOG2E); }
        v4u wq, wk; wq.x = cvtpk(qf[0], qf[1]); wq.y = cvtpk(qf[2], qf[3]); wq.z = cvtpk(qf[4], qf[5]); wq.w = cvtpk(qf[6], qf[7]);
        wk.x = cvtpk(kf[0], kf[1]); wk.y = cvtpk(kf[2], kf[3]); wk.z = cvtpk(kf[4], kf[5]); wk.w = cvtpk(kf[6], kf[7]);
        *(v4u*)(L.Qd + t * S32 + g8 * 8) = wq; *(v4u*)(L.Kd + (32 * ih + t) * S32 + g8 * 8) = wk; }
#pragma unroll
    for (int it = 0; it < 4; ++it) { const int e4 = (it * 128 + t128) * 4, kk = e4 >> 6, d0 = e4 & 63; const f32x4 v = sv[it];
        L.St[(d0 + 0) * S32 + kk] = (bf16)f2bf(v.x); L.St[(d0 + 1) * S32 + kk] = (bf16)f2bf(v.y); L.St[(d0 + 2) * S32 + kk] = (bf16)f2bf(v.z); L.St[(d0 + 3) * S32 + kk] = (bf16)f2bf(v.w); }
    __syncthreads();
#pragma unroll
    for (int jt = 0; jt < 2; ++jt) {
        f32x16 c = {};
        c = mm_tile<2>(c, L.Qd, S32, L.Kd + (32 * jt) * S32, S32, r32, hi);
        const int j = 32 * jt + r32;
#pragma unroll
        for (int r = 0; r < 16; ++r) { const int il = att::crow(r, hi), ig = 32 * ih + il; const bool keep = DIR == 0 ? (j <= ig) : (j >= ig);
            L.AT[il * S64 + j] = (bf16)f2bf(keep ? c[r] : 0.f); }
    }
    LDS_WAIT();
#pragma unroll
    for (int dt = 0; dt < 2; ++dt) {
        o[dt] = mm_tile<4>(o[dt], L.AT, S64, L.Vt + (32 * dt) * S64, S64, r32, hi);
        o[dt] = mm_tile<2>(o[dt], L.Qd, S32, L.St + (32 * dt) * S32, S32, r32, hi);
    }
    __syncthreads();
}
__device__ __forceinline__ void g3_unit(const Par& p, int b, int n, char* shm) {
    int tid_ = threadIdx.x; asm volatile("" : "+v"(tid_));
    const int tid = tid_, lane = tid & 63, r32 = lane & 31, hi = lane >> 5; const int wid = __builtin_amdgcn_readfirstlane(tid >> 6);
    const int h = wid >> 1, ih = wid & 1, row0 = chunk_row(b, n);
    char* pr = shm + (wid >> 1) * 33792;
    G3Lds L;
    L.Kd = (bf16*)pr;
    L.St = (bf16*)(pr + 5120);
    L.Vt = (bf16*)(pr + 10240);
    L.Qd = (bf16*)(pr + 19456 + ih * 7168);
    L.AT = (bf16*)(pr + 19456 + ih * 7168 + 2560);
    L.zl = nullptr;
    load_vt(L.Vt, p.P, row0, h, ih, lane);
    __syncthreads();
    f32x16 o[2]; o[0] = f32x16{}; o[1] = f32x16{};
    g3_dir<0>(o, p, L, row0, b, n, h, ih, lane);
    g3_dir<1>(o, p, L, row0, b, n, h, ih, lane);
    { v4u pg[4];
#pragma unroll
      for (int i = 0; i < 4; ++i) { const int pidx = lane + 64 * i; pg[i] = *(const v4u*)(p.P + (size_t)(row0 + 32 * ih + (pidx >> 3)) * INWP + D_R + h * 64 + (pidx & 7) * 8); }
#pragma unroll
      for (int i = 0; i < 4; ++i) { const int pidx = lane + 64 * i; *(v4u*)(L.AT + (pidx >> 3) * S64 + (pidx & 7) * 8) = pg[i]; } }
    const float gn0 = p.gnorm[r32], gn1 = p.gnorm[32 + r32];
    const unsigned lc_ = (unsigned)(4 * hi * DM + r32);
    LDS_WAIT();
#pragma unroll
    for (int r = 0; r < 16; ++r) {
        float ss = o[0][r] * o[0][r] + o[1][r] * o[1][r];
        ss += __shfl_xor(ss, 1); ss += __shfl_xor(ss, 2); ss += __shfl_xor(ss, 4); ss += __shfl_xor(ss, 8); ss += __shfl_xor(ss, 16);
        const float rstd = __builtin_amdgcn_rsqf(ss * (1.0f / 64.0f) + RMS_EPS);
        const int il = att::crow(r, hi);
        bf16* cp = p.CAT + (size_t)(row0 + 32 * ih + (r & 3) + 8 * (r >> 2)) * DM + 768 + h * 64;
        cp[lc_] = (bf16)f2bf(o[0][r] * rstd * gn0 * fsilu(bf2f(L.AT[il * S64 + r32])));
        cp[lc_ + 32] = (bf16)f2bf(o[1][r] * rstd * gn1 * fsilu(bf2f(L.AT[il * S64 + 32 + r32])));
    }
    __syncthreads();
}
}
#if defined(SELFCHECK) && SELFCHECK
namespace chk {
__device__ __forceinline__ void item(const unsigned char* ws, const float* rpb_l, const float* sink_l, int row, int mx, int h, int lane, float* acc2) {
    const bf16* P = (const bf16*)(ws + WS_P); const bf16* QC = (const bf16*)(ws + WS_QC); const bf16* KC = (const bf16*)(ws + WS_KC); const bf16* VC = (const bf16*)(ws + WS_VC); const bf16* CATp = (const bf16*)(ws + WS_CAT);
    const bool lat = row < NLAT; const int b = lat ? row >> 13 : (row - NLAT) >> 8; const int t = row & (SEQ - 1), r = t >> 6, c = t & 63;
    const bf16* qp; const bf16* Kb; const bf16* Vb; int kp;
    if (mx == 0) { qp = P + (size_t)row * INWP + A_Q + h * 64; Kb = P + A_K + h * 64; Vb = P + A_V + h * 64; kp = INWP; }
    else if (mx == 1) { qp = P + (size_t)row * INWP + B_Q + h * 64; Kb = P + B_K + (h >> 1) * 64; Vb = P + B_V + (h >> 1) * 64; kp = INWP; }
    else { qp = QC + (size_t)row * 256 + h * 64; Kb = KC + h * 64; Vb = VC + h * 64; kp = 256; }
    float q[64];
#pragma unroll
    for (int d = 0; d < 64; ++d) q[d] = bf2f(qp[d]);
    if (mx == 2 && lat) {
#pragma unroll
        for (int g2 = 0; g2 < 2; ++g2) { const float pos = (float)(g2 == 0 ? r : c);
#pragma unroll
            for (int i = 0; i < 8; ++i) { const float ang = pos * exp2f(-(float)i * (13.287712379549449f / 8.0f)); const float cs_ = __cosf(ang), sn_ = __sinf(ang);
                const float x1 = q[32 + 16 * g2 + i], x2 = q[32 + 16 * g2 + 8 + i]; q[32 + 16 * g2 + i] = x1 * cs_ - x2 * sn_; q[32 + 16 * g2 + 8 + i] = x2 * cs_ + x1 * sn_; } }
    }
    const int rs = r - 4 < 0 ? 0 : (r - 4 > 120 ? 120 : r - 4), cs = c - 8 < 0 ? 0 : (c - 8 > 48 ? 48 : c - 8);
    const int nlatk = !lat ? 0 : (mx == 0 ? 128 : (mx == 1 ? 257 : SEQ)), ncand = nlatk + CTXL;
    float mxv = -1e30f;
    for (int pass = 0; pass < 2; ++pass) {
        float l = 0.f, o[64];
#pragma unroll
        for (int d = 0; d < 64; ++d) o[d] = 0.f;
        float pm = -1e30f;
        for (int j = lane; j < ncand; j += 64) {
            int krow; float bias = 0.f; bool ok = true;
            if (j >= nlatk) krow = NLAT + b * CTXL + (j - nlatk);
            else if (mx == 0) { const int i = j >> 4, jj = j & 15; krow = b * SEQ + (rs + i) * 64 + cs + jj; bias = rpb_l[h * 465 + (rs + i - r + 7) * 31 + (cs + jj - c + 15)] * LOG2E; }
            else if (mx == 1) { const int kpos = t - 128 + j; ok = kpos >= 0 && kpos < SEQ; krow = b * SEQ + (ok ? kpos : 0); }
            else krow = b * SEQ + j;
            if (!ok) continue;
            const bf16* kr = Kb + (size_t)krow * kp; float s = bias;
#pragma unroll
            for (int d = 0; d < 64; d += 2) { const unsigned w = *(const unsigned*)(kr + d); s += q[d] * bflo(w) + q[d + 1] * bfhi(w); }
            if (pass == 0) pm = fmaxf(pm, s);
            else { const float pe = __builtin_amdgcn_exp2f(s - mxv); l += pe; const bf16* vr = Vb + (size_t)krow * kp;
#pragma unroll
                for (int d = 0; d < 64; d += 2) { const unsigned w = *(const unsigned*)(vr + d); o[d] += pe * bflo(w); o[d + 1] += pe * bfhi(w); } }
        }
        if (pass == 0) {
#pragma unroll
            for (int off = 32; off >= 1; off >>= 1) pm = fmaxf(pm, __shfl_xor(pm, off));
            mxv = pm;
        } else {
            l = wave_sum(l); if (mx == 1) l += __builtin_amdgcn_exp2f(sink_l[h] * LOG2E - mxv);
            float e2 = 0.f, r2 = 0.f;
#pragma unroll
            for (int d = 0; d < 64; ++d) { const float od = wave_sum(o[d]) / l; const float cd = bf2f(CATp[(size_t)row * DM + mx * 256 + h * 64 + d]); e2 += (od - cd) * (od - cd); r2 += od * od; }
            if (lane == 0) { atomicAdd(acc2, e2); atomicAdd(acc2 + 1, r2); atomicAdd(acc2 + 2 + 2 * mx, e2); atomicAdd(acc2 + 3 + 2 * mx, r2); }
        }
    }
}
__device__ __forceinline__ void rope_pair(float& x1, float& x2, float pos, int i, int half) {
    const float ang = pos * exp2f(-(float)i * (13.287712379549449f / (float)half)); const float cs_ = __cosf(ang), sn_ = __sinf(ang);
    const float a = x1, b = x2; x1 = a * cs_ - b * sn_; x2 = b * cs_ + a * sn_;
}
__device__ __forceinline__ void proj_item(const unsigned char* ws, const float* w_in_l, const float* gq, const float* gkv, const float* wuq, const float* wukv, int row, int lane, float* pl, float* acc2) {
    const bf16* Hh = (const bf16*)(ws + WS_H) + (size_t)row * HLD; const bf16* P = (const bf16*)(ws + WS_P) + (size_t)row * INWP;
    const bf16* QCr = (const bf16*)(ws + WS_QC) + (size_t)row * 256; const bf16* KCr = (const bf16*)(ws + WS_KC) + (size_t)row * 256; const bf16* VCr = (const bf16*)(ws + WS_VC) + (size_t)row * 256;
    const bool lat = row < NLAT; const int t = row & (SEQ - 1); const float pr_ = (float)(t >> 6), pc_ = (float)(t & 63);
    for (int j = 0; j < 15; ++j) { const int cc = lane + 64 * j; if (cc >= 928) break; const int col = 768 + cc; float s = 0.f;
        for (int k = 0; k < DM; ++k) { float hv = bf2f(Hh[k]); if (ROUTER_SPLIT) hv += bf2f(Hh[DM + k]); s += hv * w_in_l[(size_t)k * INW + col]; }
        pl[cc] = s; }
    LDS_WAIT();
    float e2[7] = {0.f, 0.f, 0.f, 0.f, 0.f, 0.f, 0.f}, r2[7] = {0.f, 0.f, 0.f, 0.f, 0.f, 0.f, 0.f};
#define CHK_ACC(cat, ref, got) do { const float rf_ = (ref), gt_ = (got); e2[cat] += (rf_ - gt_) * (rf_ - gt_); r2[cat] += rf_ * rf_; } while (0)
    for (int pi = lane; pi < 6 * 32; pi += 64) { const int hd = pi >> 5, i = pi & 31, g2 = i >> 4, ii = i & 15; const int base = hd * 64 + 32 * g2 + ii;
        float x1 = pl[base], x2 = pl[base + 16]; if (lat) rope_pair(x1, x2, g2 == 0 ? pr_ : pc_, ii, 16);
        if (hd < 4) { CHK_ACC(0, x1 * C2, bf2f(P[B_Q + base])); CHK_ACC(0, x2 * C2, bf2f(P[B_Q + base + 16])); } else { CHK_ACC(1, x1, bf2f(P[B_Q + base])); CHK_ACC(1, x2, bf2f(P[B_Q + base + 16])); } }
    for (int i = lane; i < 128; i += 64) CHK_ACC(2, pl[B_V - 768 + i], bf2f(P[B_V + i]));
    float sq = 0.f, sk = 0.f;
    for (int i = lane; i < 256; i += 64) { const float v = pl[C_Q - 768 + i]; sq += v * v; }
    for (int i = lane; i < 128; i += 64) { const float v = pl[C_KV - 768 + i]; sk += v * v; }
    const float rq = 1.0f / sqrtf(wave_sum(sq) / 256.f + RMS_EPS), rk = 1.0f / sqrtf(wave_sum(sk) / 128.f + RMS_EPS);
    for (int n = lane; n < 256; n += 64) { float s = 0.f; for (int k = 0; k < 256; ++k) s += pl[C_Q - 768 + k] * rq * gq[k] * wuq[(size_t)k * 256 + n]; CHK_ACC(3, s * C2, bf2f(QCr[n])); }
    for (int n = lane; n < 384; n += 64) { float s = 0.f; for (int k = 0; k < 128; ++k) s += pl[C_KV - 768 + k] * rk * gkv[k] * wukv[(size_t)k * 384 + n];
        const int h = n / 96, jj = n % 96; if (jj < 32) CHK_ACC(4, s, bf2f(KCr[h * 64 + jj])); else CHK_ACC(6, s, bf2f(VCr[h * 64 + jj - 32])); }
    for (int pi = lane; pi < 4 * 16; pi += 64) { const int h = pi >> 4, i = pi & 15, g2 = i >> 3, ii = i & 7; const int base = 16 * g2 + ii;
        float x1 = pl[C_KR - 768 + base], x2 = pl[C_KR - 768 + base + 8]; if (lat) rope_pair(x1, x2, g2 == 0 ? pr_ : pc_, ii, 8);
        CHK_ACC(5, x1, bf2f(KCr[h * 64 + 32 + base])); CHK_ACC(5, x2, bf2f(KCr[h * 64 + 32 + base + 8])); }
#undef CHK_ACC
#pragma unroll
    for (int cat = 0; cat < 7; ++cat) { const float a = wave_sum(e2[cat]), b = wave_sum(r2[cat]); if (lane == 0) { atomicAdd(acc2 + 16 + 2 * cat, a); atomicAdd(acc2 + 17 + 2 * cat, b); } }
}
constexpr int NP_ROWS = 112;
__device__ __forceinline__ int proj_row(int s) { return s < 96 ? (int)(((long)s * 7919 + 5) % NLAT) : NLAT + ((s - 96) * 61 + 7) % NCTX; }
constexpr int NS_LAT = 640, NS_CTX = 48, NS_EDGE = 28;
__device__ __forceinline__ int sample_row(int s) {
    if (s < NS_LAT) return (int)(((long)s * 6151 + 17) % NLAT);
    s -= NS_LAT;
    if (s < NS_EDGE) { const int b = s / 7, k = s % 7; const int tt[7] = {0, 1, 63, 64, 4095, 8127, 8191}; int t = 0;
#pragma unroll
        for (int i = 0; i < 7; ++i) if (i == k) t = tt[i];
        return b * SEQ + t; }
    s -= NS_EDGE;
    return NLAT + (s * 21 + 3) % NCTX;
}
}
#endif
struct RowMapId { int off; __device__ __forceinline__ int operator()(int n) const { return off + n; } };
struct RowMapIl { int sub; __device__ __forceinline__ int operator()(int n) const { return 8 * (n >> 2) + 4 * sub + (n & 3); } };
struct RowMapKV { __device__ __forceinline__ int operator()(int n) const { const int h = n / 96, j = n % 96; return j < 32 ? h * 64 + j : 256 + h * 64 + (j - 32); } };
template <class RowMap>
__device__ __forceinline__ void tr_item(const float* W, int ldw, int k0, int n0, bf16* WT, int ldt, const RowMap& rm, const float* kscale, float* scr, int lane) {
#pragma unroll 4
    for (int it = 0; it < 16; ++it) { const int k = it * 4 + (lane >> 4), n4 = (lane & 15) * 4;
        f32x4 x = *(const f32x4*)(W + (size_t)(k0 + k) * ldw + n0 + n4);
        if (kscale) x = x * kscale[k0 + k];
        float* s = scr + k * 65 + n4; s[0] = x.x; s[1] = x.y; s[2] = x.z; s[3] = x.w; }
    LDS_WAIT();
#pragma unroll 2
    for (int it = 0; it < 8; ++it) { const int n = it * 8 + (lane >> 3), c = lane & 7; const float* s = scr + (8 * c) * 65 + n;
        v4u o; o.x = pk2(s[0 * 65], s[1 * 65]); o.y = pk2(s[2 * 65], s[3 * 65]); o.z = pk2(s[4 * 65], s[5 * 65]); o.w = pk2(s[6 * 65], s[7 * 65]);
        *(v4u*)(WT + (size_t)rm(n0 + n) * ldt + k0 + 8 * c) = o; }
    LDS_WAIT();
}
__device__ __forceinline__ void ld_row(const float* p, int lane, f32x4 (&v)[4]) {
#pragma unroll
    for (int j = 0; j < 2; ++j) { v[2 * j] = *(const f32x4*)(p + 512 * j + 8 * lane); v[2 * j + 1] = *(const f32x4*)(p + 512 * j + 8 * lane + 4); }
}
__device__ __forceinline__ void st_row(float* p, int lane, const f32x4 (&v)[4]) {
#pragma unroll
    for (int j = 0; j < 2; ++j) { *(f32x4*)(p + 512 * j + 8 * lane) = v[2 * j]; *(f32x4*)(p + 512 * j + 8 * lane + 4) = v[2 * j + 1]; }
}
__device__ __forceinline__ void st_row_hilo(bf16* p, int lane, const f32x4 (&v)[4]) {
#pragma unroll
    for (int j = 0; j < 2; ++j) { v4u w, wl; const f32x4 a = v[2 * j], b = v[2 * j + 1];
        w.x = cvtpk(a.x, a.y); w.y = cvtpk(a.z, a.w); w.z = cvtpk(b.x, b.y); w.w = cvtpk(b.z, b.w);
        wl.x = cvtpk(a.x - bflo(w.x), a.y - bfhi(w.x)); wl.y = cvtpk(a.z - bflo(w.y), a.w - bfhi(w.y)); wl.z = cvtpk(b.x - bflo(w.z), b.y - bfhi(w.z)); wl.w = cvtpk(b.z - bflo(w.w), b.w - bfhi(w.w));
        *(v4u*)(p + 512 * j + 8 * lane) = w; if (ROUTER_SPLIT) *(v4u*)(p + DM + 512 * j + 8 * lane) = wl; }
}
__device__ __forceinline__ void tr_item_router(const float* W, int k0, int n0, bf16* WT, float* scr, int lane) {
#pragma unroll 4
    for (int it = 0; it < 16; ++it) { const int k = it * 4 + (lane >> 4), n4 = (lane & 15) * 4;
        const f32x4 x = *(const f32x4*)(W + (size_t)(k0 + k) * NEXP + n0 + n4);
        float* s = scr + k * 65 + n4; s[0] = x.x; s[1] = x.y; s[2] = x.z; s[3] = x.w; }
    LDS_WAIT();
#pragma unroll 2
    for (int it = 0; it < 8; ++it) { const int n = it * 8 + (lane >> 3), c = lane & 7; const float* s = scr + (8 * c) * 65 + n;
        float f[8]; v4u o, ol;
#pragma unroll
        for (int i = 0; i < 8; ++i) f[i] = s[i * 65];
        o.x = cvtpk(f[0], f[1]); o.y = cvtpk(f[2], f[3]); o.z = cvtpk(f[4], f[5]); o.w = cvtpk(f[6], f[7]);
        ol.x = cvtpk(f[0] - bflo(o.x), f[1] - bfhi(o.x)); ol.y = cvtpk(f[2] - bflo(o.y), f[3] - bfhi(o.y)); ol.z = cvtpk(f[4] - bflo(o.z), f[5] - bfhi(o.z)); ol.w = cvtpk(f[6] - bflo(o.w), f[7] - bfhi(o.w));
        bf16* d0 = WT + (size_t)(n0 + n) * HLD + k0 + 8 * c; bf16* d1 = WT + (size_t)(128 + n0 + n) * HLD + k0 + 8 * c;
        if (ROUTER_SPLIT) { *(v4u*)d0 = o; *(v4u*)(d0 + DM) = o; *(v4u*)d1 = ol; *(v4u*)(d1 + DM) = ol; }
        else { *(v4u*)d0 = o; *(v4u*)d1 = (v4u){0u, 0u, 0u, 0u}; } }
    LDS_WAIT();
}
__device__ __forceinline__ void ln_row(f32x4 (&v)[4]) {
    float s = 0.f;
#pragma unroll
    for (int j = 0; j < 4; ++j) s += (v[j].x + v[j].y) + (v[j].z + v[j].w);
    const float mean = wave_sum(s) * (1.f / DM); float s2 = 0.f;
#pragma unroll
    for (int j = 0; j < 4; ++j) { v[j] = v[j] - mean; s2 += (v[j].x * v[j].x + v[j].y * v[j].y) + (v[j].z * v[j].z + v[j].w * v[j].w); }
    const float rstd = 1.0f / sqrtf(wave_sum(s2) * (1.f / DM) + LN_EPS);
#pragma unroll
    for (int j = 0; j < 4; ++j) v[j] = v[j] * rstd;
}
template <bool ONEPLUS>
__device__ __forceinline__ void affine_row(f32x4 (&v)[4], const float* a, const float* b, int lane) {
    f32x4 av[4], bv[4]; ld_row(a, lane, av); ld_row(b, lane, bv);
#pragma unroll
    for (int j = 0; j < 4; ++j) v[j] = ONEPLUS ? v[j] * (av[j] + 1.0f) + bv[j] : v[j] * av[j] + bv[j];
}
__device__ __forceinline__ int mod_row(int row) { return row < NLAT ? (row >> 13) : 4; }

__device__ __forceinline__ int ltid() { int t = threadIdx.x; asm volatile("" : "+v"(t)); return t; }
struct Args {
    const float *x, *c, *ctx, *c_ctx, *w_ada, *b_ada, *w_in, *na_rpb, *wa_sink, *mla_g_q, *mla_g_kv, *mla_w_uq, *mla_w_ukv,
                *gla_w_gf, *gla_b_gf, *gla_w_gb, *gla_b_gb, *gla_g_norm, *w_out, *ln1_g, *ln1_b, *ln2_g, *ln2_b,
                *router_w, *router_bias, *exp_w1, *exp_w3, *exp_w2, *sh_w1, *sh_w3, *sh_w2;
    float* out; unsigned char* ws;
};
static_assert(sizeof(Args) == 33 * 8, "Args has no padding");

constexpr int CV_N = NEXP * 192, CV_N0 = 5344, CV_N1 = CV_N0 + 4608, CV_N2 = CV_N1 + 7680;
__device__ __forceinline__ void convert_experts(const Args& A, int l, int lo, int hi, int gw, int NGW, float* scr, int lane) {
    bf16* we13 = (bf16*)(A.ws + WS_WE13); bf16* we2 = (bf16*)(A.ws + WS_WE2);
    for (int it = lo + gw; it < hi; it += NGW) {
        const int e = it / 192, r = it % 192, which = r >> 6, q = r & 63;
        if (which < 2) { const float* W = (which == 0 ? A.exp_w1 : A.exp_w3) + ((size_t)l * NEXP + e) * DM * DEXP;
            tr_item(W, DEXP, (q >> 2) * 64, (q & 3) * 64, we13 + (size_t)e * 512 * DM, DM, RowMapIl{which}, nullptr, scr, lane); }
        else { const float* W = A.exp_w2 + ((size_t)l * NEXP + e) * DEXP * DM;
            tr_item(W, DM, (q >> 4) * 64, (q & 15) * 64, we2 + (size_t)e * DM * DEXP, DEXP, RowMapId{0}, nullptr, scr, lane); }
    }
}

#ifndef SELFCHECK_TOL
#define SELFCHECK_TOL 0.03f
#endif
#ifndef SELFCHECK_TOL2
#define SELFCHECK_TOL2 0.02f
#endif
#ifndef PHMASK
#define PHMASK 0xffffff
#endif
#define PHON(k) (((PHMASK) >> (k)) & 1)
#ifndef DUPK
#define DUPK -1
#endif
__global__ void __launch_bounds__(512, 2) hybrid_fwd(Args A) {
    extern __shared__ __attribute__((aligned(16))) unsigned char lds[];
    const int wave = __builtin_amdgcn_readfirstlane((int)threadIdx.x >> 6);
    const int G = gridDim.x; const int bx = blockIdx.x; const int vcu = (G % 8 == 0) ? (bx % 8) * (G / 8) + bx / 8 : bx;
    const int gw = vcu * 8 + wave, NGW = G * 8;
    const bool cv_tails = (G == 256);
    GAS unsigned char* wsg = (GAS unsigned char*)A.ws;
    unsigned char* ws = (unsigned char*)wsg;
#define WS_LAUNDER() asm volatile("" : "+s"(wsg)); ws = (unsigned char*)wsg; const int tid = ltid(), lane = tid & 63; (void)lane
    gu32* ctl = (gu32*)(ws + WS_CTL);
    volatile LAS unsigned* MISC = (volatile LAS unsigned*)((LAS unsigned char*)lds + MISC_OFF);
    { const int tid = ltid(); if (tid < 128) MISC[tid] = 0u; }
    __syncthreads();
    XcdBarrier bar = xcd_barrier_post((unsigned*)(ctl + CW_BAR), MISC);
#define GRID_BAR() do { XcdBarrier b2_ = bar; GAS unsigned* bp_ = (GAS unsigned*)bar.bar; asm volatile("" : "+s"(bp_), "+s"(b2_.x)); b2_.bar = (unsigned*)bp_; xcd_barrier(b2_); } while (0)
    char* shm = (char*)lds;
#define MODT ((float*)(ws + WS_MOD))
#define Hb ((bf16*)(ws + WS_H))
#define Pb ((bf16*)(ws + WS_P))
#define QC ((bf16*)(ws + WS_QC))
#define KC ((bf16*)(ws + WS_KC))
#define VC ((bf16*)(ws + WS_VC))
#define CAT ((bf16*)(ws + WS_CAT))
#define XA ((float*)(ws + WS_XA))
#define Zb ((float*)(ws + WS_Z))
#define RSTD ((float*)(ws + WS_RSTD))

        if (PHON(0)) {
        WS_LAUNDER();
    {
        float* sc = (float*)shm;
        float* part = (float*)(shm + 20480);
        for (int i = tid; i < 5 * DM; i += 512) { const float v = i < 4 * DM ? A.c[i] : A.c_ctx[i - 4 * DM]; sc[i] = v / (1.0f + __expf(-v)); }
        __syncthreads();
        for (int grp = vcu; grp < DEPTH * 96; grp += G) {
            const int l = grp / 96, col = (grp % 96) * 64 + lane;
            const float* wp = A.w_ada + (size_t)l * DM * 6 * DM + col;
            float acc[5] = {0.f, 0.f, 0.f, 0.f, 0.f};
#pragma unroll 8
            for (int kk = 0; kk < 128; ++kk) { const int k = wave * 128 + kk; const float w = wp[(size_t)k * 6 * DM];
#pragma unroll
                for (int r = 0; r < 5; ++r) acc[r] += sc[r * DM + k] * w; }
#pragma unroll
            for (int r = 0; r < 5; ++r) part[(wave * 5 + r) * 64 + lane] = acc[r];
            __syncthreads();
            if (tid < 320) { const int r = tid >> 6; float s = A.b_ada[(size_t)l * 6 * DM + col];
#pragma unroll
                for (int w8 = 0; w8 < 8; ++w8) s += part[(w8 * 5 + r) * 64 + lane];
                MODT[((size_t)l * 5 + r) * 6 * DM + col] = s; }
            __syncthreads();
        }
        float* scr = (float*)(shm + wave * 16640);
        constexpr int I_IN = 16 * 39, I_OUT = 16 * 16, I_UQ = 4 * 4, I_UKV = 2 * 6, I_RT = 16 * 2, I_S1 = 16 * 4, I_S2 = 4 * 16;
        constexpr int I_L = I_IN + I_OUT + I_UQ + I_UKV + I_RT + 2 * I_S1 + I_S2;
        for (int it = gw; it < DEPTH * I_L; it += NGW) {
            const int l = it / I_L; int r = it % I_L;
            if (r < I_IN) { tr_item(A.w_in + (size_t)l * DM * INW, INW, (r / 39) * 64, (r % 39) * 64, (bf16*)(ws + WS_WIN) + (size_t)l * INWP * DM, DM, RowMapId{0}, nullptr, scr, lane); continue; } r -= I_IN;
            if (r < I_OUT) { tr_item(A.w_out + (size_t)l * DM * DM, DM, (r / 16) * 64, (r % 16) * 64, (bf16*)(ws + WS_WOUT) + (size_t)l * DM * DM, DM, RowMapId{0}, nullptr, scr, lane); continue; } r -= I_OUT;
            if (r < I_UQ) { tr_item(A.mla_w_uq + (size_t)l * 256 * 256, 256, (r / 4) * 64, (r % 4) * 64, (bf16*)(ws + WS_WUQ) + (size_t)l * 256 * 256, 256, RowMapId{0}, A.mla_g_q + l * 256, scr, lane); continue; } r -= I_UQ;
            if (r < I_UKV) { tr_item(A.mla_w_ukv + (size_t)l * 128 * 384, 384, (r / 6) * 64, (r % 6) * 64, (bf16*)(ws + WS_WUKV) + (size_t)l * 512 * 128, 128, RowMapKV{}, A.mla_g_kv + l * 128, scr, lane); continue; } r -= I_UKV;
            if (r < I_RT) { tr_item_router(A.router_w + (size_t)l * DM * NEXP, (r / 2) * 64, (r % 2) * 64, (bf16*)(ws + WS_WRT) + (size_t)l * 256 * HLD, scr, lane); continue; } r -= I_RT;
            if (r < I_S1) { tr_item(A.sh_w1 + (size_t)l * DM * 256, 256, (r / 4) * 64, (r % 4) * 64, (bf16*)(ws + WS_WS13) + (size_t)l * 512 * DM, DM, RowMapIl{0}, nullptr, scr, lane); continue; } r -= I_S1;
            if (r < I_S1) { tr_item(A.sh_w3 + (size_t)l * DM * 256, 256, (r / 4) * 64, (r % 4) * 64, (bf16*)(ws + WS_WS13) + (size_t)l * 512 * DM, DM, RowMapIl{1}, nullptr, scr, lane); continue; } r -= I_S1;
            tr_item(A.sh_w2 + (size_t)l * 256 * DM, DM, (r / 16) * 64, (r % 16) * 64, (bf16*)(ws + WS_WS2) + (size_t)l * DM * 256, 256, RowMapId{0}, nullptr, scr, lane);
        }
        { const v4u z = {0u, 0u, 0u, 0u}; const int gt = vcu * 512 + tid, NGT = G * 512;
            for (int i = gt; i < DEPTH * 64 * 128; i += NGT) { const int l = i / (64 * 128), r = i % (64 * 128); *(v4u*)((bf16*)(ws + WS_WIN) + ((size_t)l * INWP + INW) * DM + (size_t)r * 8) = z; }
            for (int i = gt; i < DEPTH * 4 * 32 * 16; i += NGT) { const int l = i / 2048, r = i % 2048, h = r / 512, q = r % 512; *(v4u*)((bf16*)(ws + WS_WUKV) + ((size_t)l * 512 + h * 64 + 32) * 128 + (size_t)q * 8) = z; } }
    }
        }
    GRID_BAR();
        if (PHON(1)) {
        WS_LAUNDER();
    for (int m = gw; m < NTOK; m += NGW) {
        const float* src = m < NLAT ? A.x + (size_t)m * DM : A.ctx + (size_t)(m - NLAT) * DM;
        f32x4 v[4]; ld_row(src, lane, v); st_row(XA + (size_t)m * DM, lane, v);
        ln_row(v); const float* mp = MODT + (size_t)mod_row(m) * 6 * DM; affine_row<true>(v, mp + DM, mp, lane);
        st_row_hilo(Hb + (size_t)m * HLD, lane, v);
    }
    convert_experts(A, 0, 0, cv_tails ? CV_N0 : CV_N, gw, NGW, (float*)(shm + wave * 16640), lane);
        }
    GRID_BAR();

#pragma unroll 1
    for (int l = 0; l < DEPTH; ++l) {
        const bool lastl = (l == DEPTH - 1);
        const int MT = lastl ? NLAT : NTOK;
#define modl (MODT + (size_t)l * 5 * 6 * DM)
        if (PHON(2)) {
        WS_LAUNDER();
        { pg8::Gemm g{Hb, (const bf16*)(ws + WS_WIN) + (size_t)l * INWP * DM, DM, HLD, nullptr}; pg8::StaticOrder S; S.init(NTOK, INWP, G, bx);
          pg8::EpiBf16<INWP, false> E{Pb, 10, (1u << 0) | (1u << 3), C2, 256, nullptr, 0};
          pg8::gemm_phase<pg8::EpiBf16<INWP, false>, pg8::StaticOrder, false>((LAS unsigned char*)lds, g, S, E); }
        if (cv_tails && !lastl && bx >= 40) convert_experts(A, l, CV_N0, CV_N1, (bx - 40) * 8 + wave, 216 * 8, (float*)(shm + wave * 16640), lane);
        }
        GRID_BAR();
        if (PHON(3)) {
        WS_LAUNDER();
        {
        const bool roleB = lane < 24, roleK = lane == 24 || lane == 25;
        const int hd = lane >> 2, g2 = roleB ? (lane >> 1) & 1 : lane & 1, c8 = lane & 1;
        const int col1 = roleB ? B_Q + hd * 64 + 32 * g2 + 8 * c8 : C_KR + 16 * g2, dpart = roleB ? 16 : 8;
        const int f0 = roleB ? 8 * c8 : 0; const float fdiv = roleB ? 13.287712379549449f / 16.0f : 13.287712379549449f / 8.0f;
        for (int m0 = gw; m0 < NTOK; m0 += 4 * NGW) {
            v4u xa[4], xb[4]; v2u ca[4]; unsigned cb[4];
#pragma unroll
            for (int u = 0; u < 4; ++u) { const int m = m0 + u * NGW; const bf16* pr = Pb + (size_t)(m < NTOK ? m : 0) * INWP;
                xa[u] = *(const v4u*)(pr + col1); xb[u] = *(const v4u*)(pr + col1 + dpart);
                ca[u] = *(const v2u*)(pr + C_Q + 4 * lane); cb[u] = *(const unsigned*)(pr + C_KV + 2 * lane); }
#pragma unroll
            for (int u = 0; u < 4; ++u) { const int m = m0 + u * NGW; if (m < NTOK) { bf16* pr = Pb + (size_t)m * INWP;
                const bool lat = m < NLAT; const int t = m & (SEQ - 1);
                if ((roleB && lat) || roleK) {
                    const float pos = (float)(g2 == 0 ? (t >> 6) : (t & 63)); v4u oa, ob;
#pragma unroll
                    for (int j = 0; j < 4; ++j) { float r1[2], r2[2];
#pragma unroll
                        for (int e = 0; e < 2; ++e) { const float rev = pos * __builtin_amdgcn_exp2f(-(float)(f0 + 2 * j + e) * fdiv) * 0.15915494309189535f;
                            const float cs_ = lat ? __builtin_amdgcn_cosf(rev) : 1.f, sn_ = lat ? __builtin_amdgcn_sinf(rev) : 0.f;
                            const float a1 = e ? bfhi(xa[u][j]) : bflo(xa[u][j]), a2 = e ? bfhi(xb[u][j]) : bflo(xb[u][j]); r1[e] = a1 * cs_ - a2 * sn_; r2[e] = a2 * cs_ + a1 * sn_; }
                        oa[j] = cvtpk(r1[0], r1[1]); ob[j] = cvtpk(r2[0], r2[1]); }
                    if (roleB) { *(v4u*)(pr + col1) = oa; *(v4u*)(pr + col1 + 16) = ob; }
                    else { bf16* kd = KC + (size_t)m * 256 + 32 + 16 * g2;
#pragma unroll
                        for (int h4 = 0; h4 < 4; ++h4) { *(v4u*)(kd + h4 * 64) = oa; *(v4u*)(kd + h4 * 64 + 8) = ob; } }
                }
                const v2u a_ = ca[u]; const unsigned b2 = cb[u];
                float sq = bflo(a_.x) * bflo(a_.x) + bfhi(a_.x) * bfhi(a_.x) + bflo(a_.y) * bflo(a_.y) + bfhi(a_.y) * bfhi(a_.y); float sk = bflo(b2) * bflo(b2) + bfhi(b2) * bfhi(b2);
                sq = wave_sum(sq); sk = wave_sum(sk);
                if (lane == 0) { RSTD[2 * m] = 1.0f / sqrtf(sq * (1.f / 256.f) + RMS_EPS); RSTD[2 * m + 1] = 1.0f / sqrtf(sk * (1.f / 128.f) + RMS_EPS); } } }
        }
        }
        }
#define GLA_PAR() const gla::Par gp{Pb, CAT, (float*)(ws + WS_GU), (float*)(ws + WS_GDEC), (float*)(ws + WS_BC), A.gla_w_gf + l * 16 * 128, A.gla_b_gf + l * 128, A.gla_w_gb + l * 16 * 128, A.gla_b_gb + l * 128, A.gla_g_norm + l * 64}
        if (PHON(3)) {
        WS_LAUNDER();
        if (PHON(21)) { GLA_PAR(); for (int u = vcu; u < NB * NCH; u += G) gla::g1_unit(gp, u / NCH, u % NCH, shm); }
        }
        GRID_BAR();
        if (PHON(4)) {
        WS_LAUNDER();
        { pg8::Gemm g{Pb + C_Q, (const bf16*)(ws + WS_WUQ) + (size_t)l * 256 * 256, 256, INWP, nullptr}; pg8::StaticOrder S; S.init(NTOK, 256, G, bx);
          pg8::EpiBf16<256, true> E{QC, 1, 1u, C2, 0, RSTD, 0};
          pg8::gemm_phase<pg8::EpiBf16<256, true>, pg8::StaticOrder, false>((LAS unsigned char*)lds, g, S, E); }
        { pg8::Gemm g{Pb + C_KV, (const bf16*)(ws + WS_WUKV) + (size_t)l * 512 * 128, 128, INWP, nullptr}; pg8::StaticOrder S; S.init(NTOK, 512, G, bx);
          pg8::EpiBf16<256, true, true> E{KC, 2, 0u, 1.f, (size_t)(WS_VC - WS_KC) / 2, RSTD, 1};
          pg8::gemm_phase<pg8::EpiBf16<256, true, true>, pg8::StaticOrder, false>((LAS unsigned char*)lds, g, S, E); }
        gla::g2_scan((float*)(ws + WS_GU), (const float*)(ws + WS_GDEC), vcu * 512 + tid);
        }
        GRID_BAR();
#if defined(SELFCHECK) && SELFCHECK
        {
            WS_LAUNDER();
            float* acc2 = (float*)(ws + WS_CTL) + 32768;
            for (int it = gw; it < chk::NP_ROWS; it += NGW) chk::proj_item(ws, A.w_in + (size_t)l * DM * INW, A.mla_g_q + l * 256, A.mla_g_kv + l * 128, A.mla_w_uq + (size_t)l * 256 * 256, A.mla_w_ukv + (size_t)l * 128 * 384,
                                                                            chk::proj_row(it), lane, (float*)(shm + wave * 4096), acc2);
            __syncthreads();
        }
#endif
        if (PHON(6)) {
        WS_LAUNDER();
        {
            if (PHON(16)) for (int u = vcu; u < 512; u += G) { const int bh = 2 * ((u & 255) >> 5) + (u >> 8), qb = u & 31, b = bh >> 2, h = bh & 3;
                att::Desc d{}; d.Q = QC + (size_t)(b * SEQ + 256 * qb) * 256 + h * 64; d.qp = 256; d.K = KC + h * 64; d.V = VC + h * 64; d.kp = 256;
                d.O = CAT + (size_t)(b * SEQ + 256 * qb) * DM + 512 + h * 64; d.op = DM; d.nt = 132; d.nctx = 4; d.ctxrow = NLAT + b * CTXL; d.latrow = b * SEQ;
                d.nt_real = d.nt; d.qrope = 1; d.qt0 = 256 * qb; att::attn_unit_pipe<8, att::M_FULL>(d, shm); }
            if (PHON(17)) for (int u = vcu; u < 512; u += G) { const int bh = u >> 5, qb = u & 31, b = bh >> 2, h = bh & 3; const int r0 = 4 * qb;
                const int kr0 = r0 - 4 < 0 ? 0 : (r0 - 4 > 120 ? 120 : r0 - 4); const int r3 = r0 + 3; const int krl = (r3 - 4 < 0 ? 0 : (r3 - 4 > 120 ? 120 : r3 - 4)) + 8;
                att::Desc d{}; d.Q = Pb + (size_t)(b * SEQ + 256 * qb) * INWP + A_Q + h * 64; d.qp = INWP; d.K = Pb + A_K + h * 64; d.V = Pb + A_V + h * 64; d.kp = INWP;
                d.O = CAT + (size_t)(b * SEQ + 256 * qb) * DM + h * 64; d.op = DM; d.nctx = 4; d.nt = 4 + (krl - kr0); d.ctxrow = NLAT + b * CTXL; d.latrow = b * SEQ + 64 * kr0;
                d.r0 = r0; d.kr0 = kr0; d.rpb = A.na_rpb + ((size_t)l * 4 + h) * 465;
                d.nt_real = d.nt; d.nt = (d.nt + 1) & ~1; att::attn_unit_pipe<8, att::M_NA>(d, shm); }
            if (PHON(18)) for (int u = vcu; u < 512; u += G) { const int bh = u >> 5, qb = u & 31, b = bh >> 2, h = bh & 3; const int q0 = 256 * qb;
                const int kt0 = q0 - 128 < 0 ? 0 : q0 - 128; const int kte = q0 + 256 + 128 > SEQ ? SEQ : q0 + 256 + 128;
                att::Desc d{}; d.Q = Pb + (size_t)(b * SEQ + q0) * INWP + B_Q + h * 64; d.qp = INWP; d.K = Pb + B_K + (h >> 1) * 64; d.V = Pb + B_V + (h >> 1) * 64; d.kp = INWP;
                d.O = CAT + (size_t)(b * SEQ + q0) * DM + 256 + h * 64; d.op = DM; d.nctx = 4; d.nt = 4 + (kte - kt0) / 64; d.ctxrow = NLAT + b * CTXL; d.latrow = b * SEQ + kt0;
                d.q0 = q0; d.kt0 = kt0; d.sink_l2 = A.wa_sink[l * 4 + h] * LOG2E; d.has_sink = 1;
                d.nt_real = d.nt; d.nt = (d.nt + 1) & ~1; att::attn_unit_pipe<8, att::M_WA>(d, shm); }
            if (PHON(19) && !lastl) for (int u = (G >= 64 ? vcu - (G - 48) : vcu); u < 48; u += G) { if (u < 0) break; const int mx = u >> 4, b = (u >> 2) & 3, h = u & 3; const int qrow = NLAT + b * CTXL;
                att::Desc d{}; d.nt = 4; d.nctx = 4; d.ctxrow = qrow; d.latrow = 0; d.op = DM; d.O = CAT + (size_t)qrow * DM + 256 * mx + h * 64;
                if (mx == 0) { d.Q = Pb + (size_t)qrow * INWP + A_Q + h * 64; d.qp = INWP; d.K = Pb + A_K + h * 64; d.V = Pb + A_V + h * 64; d.kp = INWP; }
                else if (mx == 1) { d.Q = Pb + (size_t)qrow * INWP + B_Q + h * 64; d.qp = INWP; d.K = Pb + B_K + (h >> 1) * 64; d.V = Pb + B_V + (h >> 1) * 64; d.kp = INWP; d.sink_l2 = A.wa_sink[l * 4 + h] * LOG2E; d.has_sink = 1; }
                else { d.Q = QC + (size_t)qrow * 256 + h * 64; d.qp = 256; d.K = KC + h * 64; d.V = VC + h * 64; d.kp = 256; }
                att::attn_unit<att::M_FULL>(d, shm); }
            if (PHON(20)) { GLA_PAR(); for (int u = vcu; u < NB * NCH; u += G) { const int b = u / NCH, n = u % NCH; if (lastl && n < 4) continue; gla::g3_unit(gp, b, n, shm); } }
        }
        }
        GRID_BAR();
#if defined(SELFCHECK) && SELFCHECK
        {
            WS_LAUNDER();
            float* acc2 = (float*)(ws + WS_CTL) + 32768;
            const int ns = chk::NS_LAT + chk::NS_EDGE + (lastl ? 0 : chk::NS_CTX);
            for (int it = gw; it < ns * 12; it += NGW) chk::item(ws, A.na_rpb + (size_t)l * 4 * 465, A.wa_sink + l * 4, chk::sample_row(it / 12), (it % 12) >> 2, it & 3, lane, acc2);
        }
        GRID_BAR();
#endif
        if (PHON(7)) {
        WS_LAUNDER();
        { pg8::Gemm g{CAT, (const bf16*)(ws + WS_WOUT) + (size_t)l * DM * DM, DM, DM, nullptr}; pg8::StaticOrder S; S.init(MT, DM, G, bx);
          pg8::EpiBf16<DM, false> E{(bf16*)Zb, 4, 0u, 1.f, 256, nullptr, 0};
          pg8::gemm_phase<pg8::EpiBf16<DM, false>, pg8::StaticOrder, false>((LAS unsigned char*)lds, g, S, E); }
        if (cv_tails && !lastl && bx >= 16) convert_experts(A, l, CV_N1, CV_N2, (bx - 16) * 8 + wave, 240 * 8, (float*)(shm + wave * 16640), lane);
        }
        GRID_BAR();
        if (PHON(8)) {
        WS_LAUNDER();
        for (int m0 = gw; m0 < MT; m0 += 2 * NGW) {
            f32x4 vv[2][4];
#pragma unroll
            for (int u = 0; u < 2; ++u) { const int m = m0 + u * NGW, mm = m < MT ? m : m0;
                f32x4 gt[4]; ld_row(XA + (size_t)mm * DM, lane, vv[u]); ld_row(modl + (size_t)mod_row(mm) * 6 * DM + 2 * DM, lane, gt);
                const bf16* orow = (const bf16*)Zb + (size_t)mm * DM;
#pragma unroll
                for (int j = 0; j < 2; ++j) { const v4u w = *(const v4u*)(orow + 512 * j + 8 * lane);
                    vv[u][2 * j] = vv[u][2 * j] * DN_ALPHA + gt[2 * j] * (f32x4){bflo(w.x), bfhi(w.x), bflo(w.y), bfhi(w.y)};
                    vv[u][2 * j + 1] = vv[u][2 * j + 1] * DN_ALPHA + gt[2 * j + 1] * (f32x4){bflo(w.z), bfhi(w.z), bflo(w.w), bfhi(w.w)}; } }
#pragma unroll
            for (int u = 0; u < 2; ++u) { const int m = m0 + u * NGW; if (m >= MT) break;
                ln_row(vv[u]); affine_row<false>(vv[u], A.ln1_g + l * DM, A.ln1_b + l * DM, lane);
                st_row(XA + (size_t)m * DM, lane, vv[u]);
                ln_row(vv[u]); const float* mp = modl + (size_t)mod_row(m) * 6 * DM; affine_row<true>(vv[u], mp + 4 * DM, mp + 3 * DM, lane);
                st_row_hilo(Hb + (size_t)m * HLD, lane, vv[u]); }
        }
        }
        GRID_BAR();
        if (PHON(9)) {
        WS_LAUNDER();
        { pg8::Gemm g{Hb, (const bf16*)(ws + WS_WRT) + (size_t)l * 256 * HLD, HLD, HLD, nullptr}; pg8::StaticOrder S; S.init(MT, 256, G, bx);
          pg8::EpiLogits E{(float*)(ws + WS_LOG)};
          pg8::gemm_phase<pg8::EpiLogits, pg8::StaticOrder, false>((LAS unsigned char*)lds, g, S, E); }
        if (cv_tails && !lastl && bx >= 132) { convert_experts(A, l, CV_N2, CV_N, (bx - 132) * 8 + wave, 124 * 8, (float*)(shm + wave * 16640), lane); __syncthreads(); }
        { pg8::Gemm g{Hb, (const bf16*)(ws + WS_WS13) + (size_t)l * 512 * DM, DM, HLD, nullptr}; pg8::AfterRouterOrder S; S.init(MT, G, bx);
          pg8::EpiSwiGLU E{(bf16*)(ws + WS_HSS), 2, nullptr};
          pg8::gemm_phase<pg8::EpiSwiGLU, pg8::AfterRouterOrder, false>((LAS unsigned char*)lds, g, S, E); }
        }
        GRID_BAR();
        if (PHON(10)) {
        WS_LAUNDER();
        }
        const int TPB = MT / G;
        if (PHON(10)) {
        WS_LAUNDER();
        }
        int* gcnt = (int*)(ws + WS_CTL) + CW_CNT + l * NEXP;
        if (PHON(10)) {
        WS_LAUNDER();
        {
            int* hist = (int*)shm;
            if (tid < NEXP) hist[tid] = 0;
            __syncthreads();
            const float rb0 = A.router_bias[l * NEXP + lane], rb1 = A.router_bias[l * NEXP + 64 + lane];
            for (int i = wave; i < TPB; i += 8) {
                const int tok = vcu * TPB + i; const float* lg = (const float*)(ws + WS_LOG) + (size_t)tok * NEXP;
                const float s0 = 1.0f / (1.0f + __expf(-lg[lane])), s1 = 1.0f / (1.0f + __expf(-lg[64 + lane]));
                float v0 = s0 + rb0, v1 = s1 + rb1; int my_e = 0; float my_s = 0.f, ssum = 0.f;
#pragma unroll
                for (int k = 0; k < TOPK; ++k) {
                    float bv = v0 >= v1 ? v0 : v1; int bi = v0 >= v1 ? lane : lane + 64;
#pragma unroll
                    for (int off = 32; off >= 1; off >>= 1) { const float ov = __shfl_xor(bv, off); const int oi = __shfl_xor(bi, off); if (ov > bv || (ov == bv && oi < bi)) { bv = ov; bi = oi; } }
                    const float ssel = __shfl(bi < 64 ? s0 : s1, bi & 63);
                    if (lane == (bi & 63)) { if (bi < 64) v0 = -INFINITY; else v1 = -INFINITY; }
                    ssum += ssel; if (lane == k) { my_e = bi; my_s = ssel; }
                }
                if (lane < TOPK) { const int rk = atomicAdd(&hist[my_e], 1);
                    ((int*)(ws + WS_SEL))[tok * 8 + lane] = my_e; ((float*)(ws + WS_GATE))[tok * 8 + lane] = 2.5f * my_s / ssum; ((int*)(ws + WS_RANK))[tok * 8 + lane] = rk; }
            }
            __syncthreads();
            if (tid < NEXP) { const int base = __hip_atomic_fetch_add(gcnt + tid, hist[tid], __ATOMIC_RELAXED, __HIP_MEMORY_SCOPE_AGENT); ((int*)(ws + WS_BBASE))[vcu * NEXP + tid] = base; }
        }
        }
        GRID_BAR();
        if (PHON(11)) {
        WS_LAUNDER();
        {
            int* sst = (int*)shm; int* scn = sst + 132;
            if (tid < NEXP) scn[tid] = __hip_atomic_load(gcnt + tid, __ATOMIC_RELAXED, __HIP_MEMORY_SCOPE_AGENT);
            __syncthreads();
            if (tid == 0) { int a = 0; for (int e = 0; e < NEXP; ++e) { sst[e] = a; a += (scn[e] + 255) & ~255; } sst[NEXP] = a; }
            __syncthreads();
            int* stok = (int*)(ws + WS_STOK); float* sgate = (float*)(ws + WS_SGATE); int* texp = (int*)(ws + WS_TEXP);
            for (int i = tid; i < TPB * 8; i += 512) { const int ent = vcu * TPB * 8 + i; const int e = ((const int*)(ws + WS_SEL))[ent];
                const int slot = sst[e] + ((const int*)(ws + WS_BBASE))[vcu * NEXP + e] + ((const int*)(ws + WS_RANK))[ent];
                stok[slot] = ent >> 3; sgate[slot] = ((const float*)(ws + WS_GATE))[ent]; ((int*)(ws + WS_TSLOT))[ent] = slot; }
            for (int e = vcu; e < NEXP; e += G) {
                for (int s = sst[e] + scn[e] + tid; s < sst[e + 1]; s += 512) { stok[s] = 0; sgate[s] = 0.f; }
                for (int mt = (sst[e] >> 8) + tid; mt < (sst[e + 1] >> 8); mt += 512) texp[mt] = e;
            }
            if (vcu == 0 && tid == 0) texp[2047] = sst[NEXP] >> 8;
            __syncthreads();
        }
        }
        GRID_BAR();
        if (PHON(12)) {
        WS_LAUNDER();
        int* texl = (int*)(shm + 133120);
        const int ntile = __builtin_amdgcn_readfirstlane(((const int*)(ws + WS_TEXP))[2047]);
        for (int i = tid; i < ntile; i += 512) texl[i] = ((const int*)(ws + WS_TEXP))[i];
        __syncthreads();
        { pg8::Gemm g{Hb, (const bf16*)(ws + WS_WE13), DM, HLD, (const int*)(ws + WS_STOK)}; pg8::GroupedOrder S; S.init(texl, ntile, 2, G, bx);
          pg8::EpiSwiGLU E{(bf16*)(ws + WS_HS), 2, (const float*)(ws + WS_SGATE)};
          pg8::gemm_phase<pg8::EpiSwiGLU, pg8::GroupedOrder, true>((LAS unsigned char*)lds, g, S, E); }
        { pg8::Gemm g{(const bf16*)(ws + WS_HSS), (const bf16*)(ws + WS_WS2) + (size_t)l * DM * 256, 256, 256, nullptr}; pg8::StaticOrder S;
          { const int c0 = (ntile * 2) % G; S.init(MT, DM, G, (bx - c0 + G) % G); }
          pg8::EpiBf16<DM, false> E{(bf16*)(ws + WS_YS), 4, 0u, 1.f, 256, nullptr, 0};
          pg8::gemm_phase<pg8::EpiBf16<DM, false>, pg8::StaticOrder, false>((LAS unsigned char*)lds, g, S, E); }
        }
        GRID_BAR();
        if (PHON(13)) {
        WS_LAUNDER();
        int* texl = (int*)(shm + 133120);
        const int ntile = __builtin_amdgcn_readfirstlane(((const int*)(ws + WS_TEXP))[2047]);
        for (int i = tid; i < ntile; i += 512) texl[i] = ((const int*)(ws + WS_TEXP))[i];
        __syncthreads();
        { pg8::Gemm g{(const bf16*)(ws + WS_HS), (const bf16*)(ws + WS_WE2), 256, 256, nullptr}; pg8::GroupedOrder S; S.init(texl, ntile, 4, G, bx);
          pg8::EpiBf16<DM, false> E{(bf16*)(ws + WS_Y), 4, 0u, 1.f, 256, nullptr, 0};
          pg8::gemm_phase<pg8::EpiBf16<DM, false>, pg8::GroupedOrder, false>((LAS unsigned char*)lds, g, S, E); }
        }
        GRID_BAR();
        if (PHON(14)) {
        WS_LAUNDER();
        for (int m = gw; m < MT; m += NGW) {
            f32x4 f[4];
            { const bf16* ys = (const bf16*)(ws + WS_YS) + (size_t)m * DM;
#pragma unroll
              for (int j = 0; j < 2; ++j) { const v4u w = *(const v4u*)(ys + 512 * j + 8 * lane); f[2 * j] = (f32x4){bflo(w.x), bfhi(w.x), bflo(w.y), bfhi(w.y)}; f[2 * j + 1] = (f32x4){bflo(w.z), bfhi(w.z), bflo(w.w), bfhi(w.w)}; } }
            const int* ts = (const int*)(ws + WS_TSLOT) + (size_t)m * 8;
#pragma unroll
            for (int k = 0; k < TOPK; ++k) { const bf16* yr = (const bf16*)(ws + WS_Y) + (size_t)ts[k] * DM;
#pragma unroll
                for (int j = 0; j < 2; ++j) { const v4u w = *(const v4u*)(yr + 512 * j + 8 * lane); f[2 * j] += (f32x4){bflo(w.x), bfhi(w.x), bflo(w.y), bfhi(w.y)}; f[2 * j + 1] += (f32x4){bflo(w.z), bfhi(w.z), bflo(w.w), bfhi(w.w)}; } }
            f32x4 v[4], gt[4]; ld_row(XA + (size_t)m * DM, lane, v); const float* mp = modl + (size_t)mod_row(m) * 6 * DM; ld_row(mp + 5 * DM, lane, gt);
#pragma unroll
            for (int j = 0; j < 4; ++j) v[j] = v[j] * DN_ALPHA + gt[j] * f[j];
            ln_row(v); affine_row<false>(v, A.ln2_g + l * DM, A.ln2_b + l * DM, lane);
            if (lastl) { st_row(A.out + (size_t)m * DM, lane, v); }
            else { st_row(XA + (size_t)m * DM, lane, v); ln_row(v); const float* mn = modl + 5 * 6 * DM + (size_t)mod_row(m) * 6 * DM; affine_row<true>(v, mn + DM, mn, lane); st_row_hilo(Hb + (size_t)m * HLD, lane, v); }
        }
        }
        if (!lastl) {
        if (PHON(15)) {
        WS_LAUNDER(); convert_experts(A, l + 1, 0, (cv_tails && l + 1 < DEPTH - 1) ? CV_N0 : CV_N, gw, NGW, (float*)(shm + wave * 16640), lane);
        }
        GRID_BAR(); }
    }
#if defined(SELFCHECK) && SELFCHECK
    GRID_BAR();
    {
        const float* acc2 = (const float*)(A.ws + WS_CTL) + 32768; bool bad = false;
        for (int m3 = 0; m3 < 3; ++m3) { const float e2 = __hip_atomic_load(acc2 + 2 + 2 * m3, __ATOMIC_RELAXED, __HIP_MEMORY_SCOPE_AGENT), r2 = __hip_atomic_load(acc2 + 3 + 2 * m3, __ATOMIC_RELAXED, __HIP_MEMORY_SCOPE_AGENT);
            if (!(r2 > 0.f) || !(e2 <= SELFCHECK_TOL * SELFCHECK_TOL * r2)) bad = true; }
        for (int cat = 0; cat < 7; ++cat) { const float e2 = __hip_atomic_load(acc2 + 16 + 2 * cat, __ATOMIC_RELAXED, __HIP_MEMORY_SCOPE_AGENT), r2 = __hip_atomic_load(acc2 + 17 + 2 * cat, __ATOMIC_RELAXED, __HIP_MEMORY_SCOPE_AGENT);
            if (!(r2 > 0.f) || !(e2 <= SELFCHECK_TOL2 * SELFCHECK_TOL2 * r2)) bad = true; }
        if (bad) { const int tid = ltid(); for (size_t i = (size_t)bx * 512 + tid; i < (size_t)NLAT * DM; i += (size_t)G * 512) A.out[i] *= 3.0f; }
    }
#endif
    if (bx == 0 && ltid() < 64) { const int tid = ltid(); if (__hip_atomic_load((unsigned*)(ctl + CW_BAR) + XB_TMO, __ATOMIC_RELAXED, __HIP_MEMORY_SCOPE_AGENT) != 0u) A.out[tid] = __builtin_nanf(""); }
#undef GRID_BAR
#undef MODT
#undef Hb
#undef Pb
#undef QC
#undef KC
#undef VC
#undef CAT
#undef XA
#undef Zb
#undef RSTD
#undef modl
}

extern "C" void kernel_launch(void* const* d_in, const int* in_sizes, int n_in, void* d_out, int out_size, void* d_ws, size_t ws_size, hipStream_t stream) {
    static int grid = 0;
    if (grid == 0) {
        if (n_in != 31 || in_sizes[0] != NLAT * DM || out_size != NLAT * DM || ws_size < WS_END) {
            fprintf(stderr, "kernel_launch: built for 31 inputs, x/out of %d floats, >= %zu bytes of workspace; got n_in %d, in0 %d, out %d, ws %zu; nothing launched\n", NLAT * DM, (size_t)WS_END, n_in, n_in > 0 ? in_sizes[0] : -1, out_size, ws_size);
            grid = -1; return; }
        int dev = 0, cus = 0, per_cu = 0;
        if (hipGetDevice(&dev) != hipSuccess || hipDeviceGetAttribute(&cus, hipDeviceAttributeMultiprocessorCount, dev) != hipSuccess) { fprintf(stderr, "kernel_launch: device query failed\n"); grid = -1; return; }
        if (hipFuncSetAttribute((const void*)hybrid_fwd, hipFuncAttributeMaxDynamicSharedMemorySize, LDS_BYTES) != hipSuccess) { fprintf(stderr, "kernel_launch: hipFuncSetAttribute failed\n"); grid = -1; return; }
        if (hipOccupancyMaxActiveBlocksPerMultiprocessor(&per_cu, (const void*)hybrid_fwd, 512, LDS_BYTES) != hipSuccess || per_cu < 1)
            fprintf(stderr, "kernel_launch: note: occupancy query reports %d workgroups per CU\n", per_cu);
        (void)hipGetLastError();
        grid = cus;
        if (grid != 256) fprintf(stderr, "kernel_launch: note: %d CUs (tuned for 256)\n", grid);
        if ((NTOK % grid) || (NLAT % grid)) { fprintf(stderr, "kernel_launch: grid %d does not divide the token counts\n", grid); grid = -1; return; }
    }
    if (grid < 0) return;
    if (hipMemsetAsync((char*)d_ws + WS_CTL, 0, CTL_ZERO_BYTES, stream) != hipSuccess) { fprintf(stderr, "kernel_launch: hipMemsetAsync failed\n"); return; }
    Args a{};
    const float** ap = (const float**)&a;
    for (int i = 0; i < 31; ++i) ap[i] = (const float*)d_in[i];
    a.out = (float*)d_out; a.ws = (unsigned char*)d_ws;
    hipLaunchKernelGGL(hybrid_fwd, dim3(grid), dim3(512), LDS_BYTES, stream, a);
    const hipError_t le = hipPeekAtLastError();
    if (le != hipSuccess) fprintf(stderr, "kernel_launch: launch failed: %s\n", hipGetErrorName(le));
}
```

```cpp
#include <hip/hip_runtime.h>
#include <cstdio>
#include <cstdint>

#define GAS __attribute__((address_space(1)))
#define LAS __attribute__((address_space(3)))
typedef unsigned short bf16;
typedef unsigned v4u __attribute__((ext_vector_type(4)));
typedef unsigned v2u __attribute__((ext_vector_type(2)));
typedef int v4i __attribute__((ext_vector_type(4)));
typedef float f32x4 __attribute__((ext_vector_type(4)));
typedef float f32x2 __attribute__((ext_vector_type(2)));
typedef float f32x16 __attribute__((ext_vector_type(16)));
typedef short bf16x8 __attribute__((ext_vector_type(8)));
typedef short s16x4 __attribute__((ext_vector_type(4)));
typedef GAS unsigned gu32;
#define RLX_AGENT __ATOMIC_RELAXED, __HIP_MEMORY_SCOPE_AGENT
#define LDS_WAIT() asm volatile("s_waitcnt lgkmcnt(0)" ::: "memory")
#define VM_WAIT() asm volatile("s_waitcnt vmcnt(0)" ::: "memory")

constexpr int NB = 4, SEQ = 8192, CTXL = 256, DM = 1024, DEPTH = 4;
constexpr int NLAT = NB * SEQ, NCTX = NB * CTXL, NTOK = NLAT + NCTX;
constexpr int INW = 2496, INWP = 2560;
constexpr int A_Q = 0, A_K = 256, A_V = 512, B_Q = 768, B_K = 1024, B_V = 1152, C_Q = 1280, C_KV = 1536, C_KR = 1664,
              D_Q = 1696, D_K = 1824, D_V = 1952, D_R = 2208, D_ZF = 2464, D_ZB = 2480;
constexpr int NEXP = 128, TOPK = 8, DEXP = 256;
constexpr int NSLOT_MAX = NTOK * TOPK + NEXP * 256;
constexpr int NCH = 132;
constexpr float LN_EPS = 1e-5f, RMS_EPS = 1e-6f;
constexpr float DN_ALPHA = 1.6817928305074290f;
constexpr float LOG2E = 1.4426950408889634f;
constexpr float C2 = 0.125f * LOG2E;

#ifndef ROUTER_SPLIT
#define ROUTER_SPLIT 0
#endif
constexpr int HLD = ROUTER_SPLIT ? 2 * DM : DM;
constexpr size_t al256(size_t x) { return (x + 255) & ~(size_t)255; }
constexpr size_t WS_CTL = 0, CTL_ZERO_BYTES = 1u << 20;
constexpr size_t WS_MOD = CTL_ZERO_BYTES;
constexpr size_t WS_WIN = al256(WS_MOD + (size_t)DEPTH * 5 * 6 * DM * 4);
constexpr size_t WS_WOUT = WS_WIN + (size_t)DEPTH * INWP * DM * 2;
constexpr size_t WS_WUQ = WS_WOUT + (size_t)DEPTH * DM * DM * 2;
constexpr size_t WS_WUKV = WS_WUQ + (size_t)DEPTH * 256 * 256 * 2;
constexpr size_t WS_WRT = WS_WUKV + (size_t)DEPTH * 512 * 128 * 2;
constexpr size_t WS_WS13 = WS_WRT + (size_t)DEPTH * 256 * HLD * 2;
constexpr size_t WS_WS2 = WS_WS13 + (size_t)DEPTH * 512 * DM * 2;
constexpr size_t WS_WE13 = WS_WS2 + (size_t)DEPTH * DM * 256 * 2;
constexpr size_t WS_WE2 = WS_WE13 + (size_t)NEXP * 512 * DM * 2;
constexpr size_t WS_XA = WS_WE2 + (size_t)NEXP * DM * 256 * 2;
constexpr size_t WS_Z = WS_XA + (size_t)NTOK * DM * 4;
constexpr size_t WS_H = WS_Z + (size_t)NTOK * DM * 4;
constexpr size_t WS_P = WS_H + (size_t)NTOK * HLD * 2;
constexpr size_t WS_QC = WS_P + (size_t)NTOK * INWP * 2;
constexpr size_t WS_KC = WS_QC + (size_t)NTOK * 256 * 2;
constexpr size_t WS_VC = WS_KC + (size_t)NTOK * 256 * 2;
constexpr size_t WS_CAT = WS_VC + (size_t)NTOK * 256 * 2;
constexpr size_t WS_GU = WS_CAT + (size_t)NTOK * DM * 2;
constexpr size_t WS_GDEC = WS_GU + (size_t)32 * NCH * 2048 * 4;
constexpr size_t WS_RSTD = WS_GDEC + (size_t)32 * NCH * 32 * 4;
constexpr size_t WS_LOG = al256(WS_RSTD + (size_t)NTOK * 2 * 4);
constexpr size_t WS_SEL = WS_LOG + (size_t)NTOK * 128 * 4;
constexpr size_t WS_GATE = WS_SEL + (size_t)NTOK * 8 * 4;
constexpr size_t WS_RANK = WS_GATE + (size_t)NTOK * 8 * 4;
constexpr size_t WS_TSLOT = WS_RANK + (size_t)NTOK * 8 * 4;
constexpr size_t WS_BBASE = WS_TSLOT + (size_t)NTOK * 8 * 4;
constexpr size_t WS_STOK = WS_BBASE + (size_t)256 * 128 * 4;
constexpr size_t WS_SGATE = al256(WS_STOK + (size_t)NSLOT_MAX * 4);
constexpr size_t WS_TEXP = al256(WS_SGATE + (size_t)NSLOT_MAX * 4);
constexpr size_t WS_HS = WS_TEXP + 2048 * 4;
constexpr size_t WS_HSS = WS_HS + (size_t)NSLOT_MAX * 256 * 2;
constexpr size_t WS_Y = WS_HSS + (size_t)NTOK * 256 * 2;
constexpr size_t WS_YS = WS_Y + (size_t)NSLOT_MAX * DM * 2;
constexpr size_t WS_BC = WS_YS + (size_t)NTOK * DM * 2;
constexpr size_t WS_YDST = WS_BC + (size_t)NTOK * 256 * 4;
constexpr size_t WS_CARRY = al256(WS_YDST + (size_t)NSLOT_MAX * 4);
constexpr size_t WS_END = WS_CARRY + (size_t)NB * NCH * 2 * 2 * 128 * 4;
static_assert(WS_END <= (size_t)2147483648u, "d_ws map must fit 2 GiB");
constexpr int CW_BAR = 4096;
constexpr int CW_CNT = 16384;

constexpr int LDS_BYTES = 147456;
constexpr int MISC_OFF = LDS_BYTES - 512;
constexpr int SCR_BYTES = MISC_OFF;

__device__ __forceinline__ unsigned f2bf(float f) { unsigned u = __builtin_bit_cast(unsigned, f); return (u + 0x7fffu + ((u >> 16) & 1u)) >> 16; }
__device__ __forceinline__ unsigned pk2(float lo, float hi) { return f2bf(lo) | (f2bf(hi) << 16); }
__device__ __forceinline__ float bf2f(unsigned short b) { return __builtin_bit_cast(float, (unsigned)b << 16); }
__device__ __forceinline__ float bflo(unsigned w) { return __builtin_bit_cast(float, w << 16); }
__device__ __forceinline__ float bfhi(unsigned w) { return __builtin_bit_cast(float, w & 0xffff0000u); }
typedef __bf16 bf16x2_t __attribute__((ext_vector_type(2)));
__device__ __forceinline__ unsigned cvtpk(float lo, float hi) { f32x2 v = {lo, hi}; bf16x2_t b = __builtin_convertvector(v, bf16x2_t); return __builtin_bit_cast(unsigned, b); }
__device__ __forceinline__ float wave_sum(float v) {
    v = v + __builtin_bit_cast(float, __builtin_amdgcn_update_dpp(0, __builtin_bit_cast(int, v), 0xB1, 0xf, 0xf, true));
    v = v + __builtin_bit_cast(float, __builtin_amdgcn_update_dpp(0, __builtin_bit_cast(int, v), 0x4E, 0xf, 0xf, true));
    v = v + __builtin_bit_cast(float, __builtin_amdgcn_update_dpp(0, __builtin_bit_cast(int, v), 0x141, 0xf, 0xf, true));
    v = v + __builtin_bit_cast(float, __builtin_amdgcn_update_dpp(0, __builtin_bit_cast(int, v), 0x140, 0xf, 0xf, true));
    v += __shfl_xor(v, 16); v += __shfl_xor(v, 32);
    return v;
}
#ifndef XA_BF16
#define XA_BF16 1
#endif
#if XA_BF16
typedef bf16 xa_t;
#else
typedef float xa_t;
#endif
#ifndef ROWSCALE_ASM
#define ROWSCALE_ASM 0
#endif
#ifndef ROWVALS_ASM
#define ROWVALS_ASM 1
#endif
#ifndef SD_BALANCE
#define SD_BALANCE 1
#endif
#ifndef G3_EDGE
#define G3_EDGE 0
#endif
#ifndef P2_ROWSKIP
#define P2_ROWSKIP 1
#endif
#ifndef P7_ROWS
#define P7_ROWS 3
#endif
#ifndef P13_ROWS
#define P13_ROWS 2
#endif
#ifndef DEFER_OFFN
#define DEFER_OFFN false
#endif
#ifndef AOFF_ASM
#define AOFF_ASM true
#endif
#ifndef FUSE9
#define FUSE9 0
#endif
#ifndef ZEROC
#define ZEROC 0
#endif
#ifndef ZEROC_GATHER
#define ZEROC_GATHER 0
#endif
#ifndef GATE_IN_COMBINE
#define GATE_IN_COMBINE 0
#endif
#ifndef BF_FULL
#define BF_FULL false
#endif
#ifndef BJ8_EPI
#define BJ8_EPI true
#endif
#ifndef XR11
#define XR11 true
#endif
#ifndef XR12
#define XR12 true
#endif
#ifndef WT_STORES
#define WT_STORES 0
#endif
#ifndef WT_MASK
#define WT_MASK 7
#endif
template <int WHO>
__device__ __forceinline__ void st16_wtw(void* p, v4u w) {
    if (WT_STORES && ((WT_MASK >> WHO) & 1)) asm volatile("global_store_dwordx4 %0, %1, off sc1\n\ts_nop 1" :: "v"(p), "v"(w) : "memory");
    else *(v4u*)p = w;
}
__device__ __forceinline__ float fsilu(float a) { return a * __builtin_amdgcn_rcpf(1.0f + __builtin_amdgcn_exp2f(-a * LOG2E)); }
namespace pg8 {
typedef unsigned short bf16_t;
constexpr int BM = 256, BK = 64, HALF = 128, HTB = HALF * BK * 2  , STAGE_BYTES = 8 * HTB, NXCD = 8, WGM = 8;

__host__ __device__ __forceinline__ int lds_byte(int r, int c) { const int st = (r >> 4) * 2 + (c >> 5), rr = r & 15, cc = c & 31, ob = rr * 64 + cc * 2; return st * 1024 + (ob ^ (((ob >> 9) & 1) << 5)); }
__host__ __device__ __forceinline__ void stage_rc(int b, int& R, int& C) { const int st = b / 1024, sb = b % 1024, swz = sb ^ (((sb >> 9) & 1) << 5); R = (st >> 1) * 16 + swz / 64; C = (st & 1) * 32 + (swz % 64) / 2; }
__host__ __device__ __forceinline__ int perm32(int rho) { const int n = rho >> 4, i = rho & 15; return 8 * (i >> 2) + 4 * n + (i & 3); }

struct Unit { int pm, pn, li; };
struct Gemm { const bf16_t* A; const bf16_t* Bt; int K; int lda; const int* rowidx; const LAS int* rowl; };

template <int CM = 0, int CN = 0, int CM2 = 0> struct StaticOrderT {
    int nM, nN, nwg, G, c, ov0, ovn;
    __device__ void init(int M, int N, int G_, int c_) { nM = M / BM; nN = N / BM; nwg = nM * nN; G = G_; c = c_; ov0 = -1; ovn = 0; }
    __device__ void set_range(int first, int count) { ov0 = first; ovn = count; }
    static __device__ __forceinline__ bool calc(int i, int nM, int nN, int nwg, int G, int c, Unit& u) {
        const int L = i * G + c; if (L >= nwg) return false;
        int wgid = L; { const int q = nwg / NXCD, r = nwg % NXCD, xcd = wgid % NXCD, off = wgid / NXCD; wgid = (xcd < r ? xcd * (q + 1) : r * (q + 1) + (xcd - r) * q) + off; }
        const int nig = WGM * nN, gid = wgid / nig, fm = gid * WGM, gsz = (nM - fm) < WGM ? (nM - fm) : WGM;
        u.pm = fm + ((wgid % nig) % gsz); u.pn = (wgid % nig) / gsz; return true;
    }
    __device__ bool next(int i, Unit& u) const {
        if (ov0 >= 0) { if (i >= ovn) return false; const int U = ov0 + i; const int nn = CN > 0 ? CN / BM : nN; u.pm = U / nn; u.pn = U % nn; return true; }
        if (CM > 0 && CN > 0 && G == 256) {
            if (nM == CM / BM) return calc(i, CM / BM, CN / BM, (CM / BM) * (CN / BM), 256, c, u);
            if (CM2 > 0 && nM == CM2 / BM) return calc(i, CM2 / BM, CN / BM, (CM2 / BM) * (CN / BM), 256, c, u); }
        return calc(i, nM, nN, nwg, G, c, u);
    }
};
typedef StaticOrderT<0, 0> StaticOrder;
struct AfterRouterOrder {
    int nR, G, c;
    __device__ void init(int M, int G_, int c_) { nR = M / BM; G = G_; c = c_; }
    __device__ bool next(int i, Unit& u) const {
        const int nidle = G - nR; int L;
        if (nidle <= 0 || 2 * nR - 2 * nidle > nR) { L = i * G + c; if (L >= 2 * nR) return false; }
        else if (c >= nR) { if (i >= 2) return false; L = 2 * (c - nR) + i; if (L >= 2 * nR) return false; }
        else { if (i >= 1) return false; L = 2 * nidle + c; if (L >= 2 * nR) return false; }
        u.pm = L >> 1; u.pn = L & 1; return true;
    }
};
struct TailOrder {
    int nunits, b0, G, c;
    __device__ void init(int nunits_, int b0_, int G_, int c_) { nunits = nunits_; b0 = b0_; G = G_; c = c_; }
    __device__ bool next(int i, Unit& u) const { if (c < b0) return false; const int L = i * (G - b0) + (c - b0); if (L >= nunits) return false; u.pm = L >> 1; u.pn = L & 1; return true; }
};
template <bool XR = false, int NN = 0> struct GroupedOrderT {
    const int* texp; int nN, G, c, ntile;
    __device__ void init(const int* texp_, int ntile_, int nN_, int G_, int c_) { texp = texp_; nN = nN_; G = G_; c = c_; ntile = ntile_; }
    __device__ bool next(int i, Unit& u) const {
        int mt, nt;
        if (XR && NN > 0 && G == 256) {
            constexpr int per = 32, gm = per / NN;
            const int x = c & 7, j = c >> 3;
            const int m0 = (x * ntile) >> 3, nm = (((x + 1) * ntile) >> 3) - m0;
            const int l = i * per + j; if (l >= nm * NN) return false;
            const int full = nm & ~(gm - 1);
            if (l < full * NN) { mt = i * gm + (j & (gm - 1)); nt = j / gm; } else { const int l2 = l - full * NN; mt = full + l2 / NN; nt = l2 & (NN - 1); }
            mt += m0;
        } else {
        const int L = i * G + c, tot = ntile * nN; if (L >= tot) return false;
        const int grp = 8 * nN;
        if (L < tot / grp * grp) { mt = L / grp * 8 + (L & 7); nt = (L % grp) >> 3; } else { mt = L / nN; nt = L % nN; }
        }
        u.pm = mt; u.pn = __builtin_amdgcn_readfirstlane(texp[mt]) * nN + nt; u.li = i; return true;
    }
};
typedef GroupedOrderT<false> GroupedOrder;

template <class E, class = void> struct has_bj8 { static constexpr bool v = false; };
template <class E> struct has_bj8<E, decltype((void)E::BJ8)> { static constexpr bool v = E::BJ8; };
template <class E> __device__ __forceinline__ constexpr bool epi_bj8() { return has_bj8<E>::v; }
template <class E, class = void> struct has_zc { static constexpr bool v = false; };
template <class E> struct has_zc<E, decltype((void)E::ZC_OK)> { static constexpr bool v = E::ZC_OK; };
template <class Epi, class Sched, int GATHER, bool ALIGN_EPI = true>
__device__ __forceinline__ void gemm_phase(LAS unsigned char* lds, const Gemm g, const Sched& S, const Epi& E) {
    int tid_ = threadIdx.x; asm volatile("" : "+v"(tid_));
    const int tid = tid_, wid = __builtin_amdgcn_readfirstlane(tid >> 6), lane = tid & 63, wr = wid >> 2, wc = wid & 3, fr = lane & 15, fq = lane >> 4;
    constexpr bool ZC = ZEROC && has_zc<Epi>::v;
    const int K = g.K, nt = K / BK;
    unsigned voffB[2], voffA[2]; int RA[2]; unsigned CA2[2];
#pragma unroll
    for (int i = 0; i < 2; ++i) { int R, C; stage_rc(tid * 16 + i * 8192, R, C); const int Rb = epi_bj8<Epi>() ? (64 * (R >> 5) + 16 * ((R >> 2) & 3) + 4 * ((R >> 4) & 1) + (R & 3)) : Epi::PERM ? ((R & ~31) + perm32(R & 31)) : R;
        RA[i] = R; CA2[i] = (unsigned)C * 2u; voffB[i] = (unsigned)(Rb * K + C) * 2u; voffA[i] = (unsigned)(R * g.lda + C) * 2u; }
    const size_t hstepA = (size_t)HALF * g.lda * 2;
    const size_t kstep = (size_t)(BK * 2);
    const size_t hstep = (size_t)HALF * K * 2;
    const size_t hstepB = epi_bj8<Epi>() ? (size_t)8 * K * 2 : hstep;
    const size_t tstep = 2 * hstep;
    const size_t tstepA = (size_t)BM * g.lda * 2;
    const unsigned ldsw = (unsigned)wid * 1024u;
    const int aoff = lds_byte(wr * 64 + fr, fq * 8), boff = lds_byte(wc * 32 + fr, fq * 8);
#define PG8_SA(b, h) (((b) * 2 + (h)) * HTB)
#define PG8_SB(b, h) ((4 + (b) * 2 + (h)) * HTB)
#define PG8_STAGE(bufoff, gbase, voff) do { _Pragma("unroll") for (int _i = 0; _i < 2; ++_i) \
        __builtin_amdgcn_global_load_lds((const unsigned*)((const char*)(gbase) + (voff)[_i]), (LAS unsigned*)(lds + (bufoff) + ldsw + _i * 8192), 16, 0, 0); } while (0)
#define PG8_LDA(dst, b, h) do { _Pragma("unroll") for (int m = 0; m < 4; ++m) _Pragma("unroll") for (int k = 0; k < 2; ++k) dst[m][k] = *(const LAS bf16x8*)(lds + PG8_SA(b, h) + aoff + m * 2048 + k * 1024); } while (0)
#define PG8_LDB(dst, b, h) do { _Pragma("unroll") for (int n = 0; n < 2; ++n) _Pragma("unroll") for (int k = 0; k < 2; ++k) dst[n][k] = *(const LAS bf16x8*)(lds + PG8_SB(b, h) + boff + n * 2048 + k * 1024); } while (0)
#define PG8_MMA(ai, bj, At, Bt) do { __builtin_amdgcn_s_setprio(1); _Pragma("unroll") for (int m = 0; m < 4; ++m) _Pragma("unroll") for (int n = 0; n < 2; ++n) _Pragma("unroll") for (int k = 0; k < 2; ++k) \
        acc[ai][bj][m][n] = __builtin_amdgcn_mfma_f32_16x16x32_bf16(Bt[n][k], At[m][k], acc[ai][bj][m][n], 0, 0, 0); __builtin_amdgcn_s_setprio(0); } while (0)
#define PG8_MMA0(ai, bj, At, Bt) do { __builtin_amdgcn_s_setprio(1); _Pragma("unroll") for (int m = 0; m < 4; ++m) _Pragma("unroll") for (int n = 0; n < 2; ++n) { \
        acc[ai][bj][m][n] = __builtin_amdgcn_mfma_f32_16x16x32_bf16(Bt[n][0], At[m][0], (f32x4){0.f, 0.f, 0.f, 0.f}, 0, 0, 0); \
        acc[ai][bj][m][n] = __builtin_amdgcn_mfma_f32_16x16x32_bf16(Bt[n][1], At[m][1], acc[ai][bj][m][n], 0, 0, 0); } __builtin_amdgcn_s_setprio(0); } while (0)
#define PG8_WAIT_V(n) asm volatile("s_waitcnt vmcnt(" #n ")" ::: "memory")
#define PG8_WAIT_L(n) asm volatile("s_waitcnt lgkmcnt(" #n ")" ::: "memory")
#define PG8_BAR __builtin_amdgcn_s_barrier()
#define PG8_SCHED __builtin_amdgcn_sched_barrier(0)
#define PG8_AOFF(dst, u) do { if constexpr (GATHER) { \
        if constexpr (AOFF_ASM && GATHER == 1) { unsigned _r0, _r1, _r2, _r3; const unsigned _b = (unsigned)((u).pm * BM) * 4u; \
            const unsigned _q0 = _b + (unsigned)RA[0] * 4u, _q1 = _b + (unsigned)RA[1] * 4u, _q2 = _q0 + HALF * 4u, _q3 = _q1 + HALF * 4u; \
            asm volatile("s_nop 4\n\tglobal_load_dword %0, %4, %8\n\tglobal_load_dword %1, %5, %8\n\tglobal_load_dword %2, %6, %8\n\tglobal_load_dword %3, %7, %8\n\ts_waitcnt vmcnt(0)" \
                : "=&v"(_r0), "=&v"(_r1), "=&v"(_r2), "=&v"(_r3) : "v"(_q0), "v"(_q1), "v"(_q2), "v"(_q3), "s"(g.rowidx) : "memory"); \
            dst[0][0] = _r0 * (unsigned)(g.lda * 2) + CA2[0]; dst[0][1] = _r1 * (unsigned)(g.lda * 2) + CA2[1]; dst[1][0] = _r2 * (unsigned)(g.lda * 2) + CA2[0]; dst[1][1] = _r3 * (unsigned)(g.lda * 2) + CA2[1]; } \
        else { _Pragma("unroll") for (int _h = 0; _h < 2; ++_h) _Pragma("unroll") for (int _i = 0; _i < 2; ++_i) \
        dst[_h][_i] = (unsigned)(GATHER == 2 ? g.rowl[(u).li * BM + _h * HALF + RA[_i]] : g.rowidx[(u).pm * BM + _h * HALF + RA[_i]]) * (unsigned)(g.lda * 2) + CA2[_i]; } } } while (0)
#define PG8_STAGE_A(bufoff, gbase, h, useN) do { if constexpr (GATHER) { unsigned _o[2]; \
        if constexpr (DEFER_OFFN) { _o[0] = offC[h][0]; _o[1] = offC[h][1]; if (useN) { _o[0] = offN[h][0]; _o[1] = offN[h][1]; asm volatile("" : "+v"(_o[0]), "+v"(_o[1])); } } \
        else { _o[0] = (useN) ? offN[h][0] : offC[h][0]; _o[1] = (useN) ? offN[h][1] : offC[h][1]; } PG8_STAGE(bufoff, gbase, _o); } \
        else { PG8_STAGE(bufoff, (gbase) + (h) * hstepA, voffA); } } while (0)
    Unit cur, nxt; int ui = 0;
    if (!S.next(0, cur)) return;
    f32x4 acc[2][2][4][2];
    if constexpr (!ZC) {
#pragma unroll
    for (int a = 0; a < 2; ++a)
#pragma unroll
        for (int b = 0; b < 2; ++b)
#pragma unroll
            for (int m = 0; m < 4; ++m)
#pragma unroll
                for (int n = 0; n < 2; ++n) acc[a][b][m][n] = (f32x4){0.f, 0.f, 0.f, 0.f}; }
    bf16x8 At[4][2], B0[2][2], B1[2][2];
    unsigned offC[2][2], offN[2][2];
    PG8_AOFF(offC, cur);
    const char* cA = GATHER ? (const char*)g.A : (const char*)g.A + (size_t)cur.pm * tstepA; const char* cB = (const char*)g.Bt + (size_t)cur.pn * tstep;
    PG8_STAGE(PG8_SB(0, 0), cB, voffB); PG8_STAGE(PG8_SB(0, 1), cB + hstepB, voffB); PG8_STAGE_A(PG8_SA(0, 0), cA, 0, false); PG8_STAGE_A(PG8_SA(0, 1), cA, 1, false);
    if (wr == 1) PG8_BAR;
    PG8_WAIT_V(2); PG8_BAR;
    PG8_STAGE(PG8_SB(1, 0), cB + kstep, voffB); PG8_STAGE_A(PG8_SA(1, 0), cA + kstep, 0, false); PG8_STAGE(PG8_SB(1, 1), cB + hstepB + kstep, voffB);
    PG8_WAIT_V(6); PG8_BAR;
    for (;;) {
        const bool has_next = S.next(ui + 1, nxt);
        if constexpr (GATHER) { if (has_next) { PG8_AOFF(offN, nxt); } else {
#pragma unroll
            for (int h = 0; h < 2; ++h)
#pragma unroll
                for (int i = 0; i < 2; ++i) offN[h][i] = offC[h][i]; } }
        const char* nA = has_next ? (GATHER ? (const char*)g.A : (const char*)g.A + (size_t)nxt.pm * tstepA) : cA; const char* nB = has_next ? (const char*)g.Bt + (size_t)nxt.pn * tstep : cB;
#define PG8_KBODY(MMAF) { \
            const bool last = (t == nt - 2); \
            const char* a1 = cA + (size_t)(t + 1) * kstep; \
            const char* a2 = last ? nA : cA + (size_t)(t + 2) * kstep; const char* b2 = last ? nB : cB + (size_t)(t + 2) * kstep; \
            const char* a3 = a2 + kstep; const char* b3 = b2 + kstep; \
            PG8_LDB(B0, 0, 0); PG8_LDB(B1, 0, 1); PG8_SCHED; PG8_LDA(At, 0, 0); PG8_STAGE_A(PG8_SA(1, 1), a1, 1, false); \
            PG8_WAIT_V(8); PG8_WAIT_L(0); PG8_BAR; MMAF(0, 0, At, B0); MMAF(0, 1, At, B1); PG8_BAR; PG8_SCHED; \
            PG8_LDA(At, 0, 1); PG8_STAGE(PG8_SB(0, 0), b2, voffB); PG8_STAGE(PG8_SB(0, 1), b2 + hstepB, voffB); PG8_STAGE_A(PG8_SA(0, 0), a2, 0, last); \
            PG8_WAIT_V(8); PG8_WAIT_L(0); PG8_BAR; MMAF(1, 0, At, B0); MMAF(1, 1, At, B1); PG8_BAR; PG8_SCHED; \
            PG8_LDB(B0, 1, 0); PG8_LDB(B1, 1, 1); PG8_SCHED; PG8_LDA(At, 1, 0); PG8_STAGE_A(PG8_SA(0, 1), a2, 1, last); \
            PG8_WAIT_V(8); PG8_WAIT_L(0); PG8_BAR; PG8_MMA(0, 0, At, B0); PG8_MMA(0, 1, At, B1); PG8_BAR; PG8_SCHED; \
            PG8_LDA(At, 1, 1); PG8_STAGE(PG8_SB(1, 0), b3, voffB); PG8_STAGE(PG8_SB(1, 1), b3 + hstepB, voffB); PG8_STAGE_A(PG8_SA(1, 0), a3, 0, last); \
            PG8_WAIT_V(8); PG8_WAIT_L(0); PG8_BAR; PG8_MMA(1, 0, At, B0); PG8_MMA(1, 1, At, B1); PG8_BAR; PG8_SCHED; }
        if constexpr (ZC) { int t = 0; PG8_KBODY(PG8_MMA0);
#pragma unroll 1
          for (t = 2; t < nt; t += 2) PG8_KBODY(PG8_MMA); }
        else {
#pragma unroll 1
          for (int t = 0; t < nt; t += 2) PG8_KBODY(PG8_MMA); }
#undef PG8_KBODY
        if constexpr (ALIGN_EPI) { if (wr == 0) PG8_BAR; }
        E(acc, cur, wr, wc, fr, fq);
        if (!has_next) break;
        if constexpr (!ZC) {
#pragma unroll
        for (int a = 0; a < 2; ++a)
#pragma unroll
            for (int b = 0; b < 2; ++b)
#pragma unroll
                for (int m = 0; m < 4; ++m)
#pragma unroll
                    for (int n = 0; n < 2; ++n) acc[a][b][m][n] = (f32x4){0.f, 0.f, 0.f, 0.f}; }
        cur = nxt; cA = nA; cB = nB; ++ui;
        if constexpr (GATHER) {
#pragma unroll
            for (int h = 0; h < 2; ++h)
#pragma unroll
                for (int i = 0; i < 2; ++i) offC[h][i] = offN[h][i]; }
        if constexpr (ALIGN_EPI) { if (wr == 1) PG8_BAR; }
    }
    PG8_WAIT_V(0);
    if constexpr (!ALIGN_EPI) { if (wr == 0) PG8_BAR; }
    PG8_BAR;
#undef PG8_SA
#undef PG8_SB
#undef PG8_STAGE
#undef PG8_LDA
#undef PG8_LDB
#undef PG8_MMA
#undef PG8_MMA0
#undef PG8_WAIT_V
#undef PG8_WAIT_L
#undef PG8_BAR
#undef PG8_SCHED
#undef PG8_AOFF
#undef PG8_STAGE_A
}
}
namespace pg8 {
#define PG8_ROWVALS(dst, base, voff, O1, O2, O3, O4, O5, O6, O7) asm volatile("s_nop 4\n\tglobal_load_dword %0, %8, %9\n\tglobal_load_dword %1, %8, %9 offset:" #O1 "\n\tglobal_load_dword %2, %8, %9 offset:" #O2 "\n\tglobal_load_dword %3, %8, %9 offset:" #O3 \
        "\n\tglobal_load_dword %4, %8, %9 offset:" #O4 "\n\tglobal_load_dword %5, %8, %9 offset:" #O5 "\n\tglobal_load_dword %6, %8, %9 offset:" #O6 "\n\tglobal_load_dword %7, %8, %9 offset:" #O7 "\n\ts_waitcnt vmcnt(0)" \
        : "=&v"(dst[0]), "=&v"(dst[1]), "=&v"(dst[2]), "=&v"(dst[3]), "=&v"(dst[4]), "=&v"(dst[5]), "=&v"(dst[6]), "=&v"(dst[7]) : "v"(voff), "s"(base) : "memory")
__device__ __forceinline__ unsigned cvt_pk_bf16(float lo, float hi) { unsigned r; asm volatile("v_cvt_pk_bf16_f32 %0, %1, %2" : "=v"(r) : "v"(lo), "v"(hi)); return r; }
template <int LDC, bool ROWSCALE, bool SKIPROPE = false, bool ROWMAP = false> struct EpiBf16 {
    static constexpr bool PERM = true; static constexpr bool BJ8 = BF_FULL && !ROWSCALE; static constexpr int NST = SKIPROPE ? 0 : 16;
    bf16_t* O; int nloc; unsigned scmask; float sc; size_t tile_stride; const float* rowscale; int rs_off; const int* rowmap;
    __device__ __forceinline__ void operator()(const f32x4 (&acc)[2][2][4][2], const Unit& u, int wr, int wc, int fr, int fq) const {
        const int pnl = u.pn % nloc; const int row0 = u.pm * BM + wr * 64 + fr;
        const float s = ((scmask >> pnl) & 1u) ? sc : 1.f;
        if constexpr (BJ8) {
            const int hi = fr >> 3, chunk = 2 * fq + hi; const bool skip = SKIPROPE && pnl == 0 && chunk >= 4;
            const int rowA = u.pm * BM + wr * 64 + (fr & 7);
            bf16_t* pb = O + (size_t)pnl * tile_stride + wc * 64 + chunk * 8;
#pragma unroll
            for (int ai = 0; ai < 2; ++ai)
#pragma unroll
                for (int m = 0; m < 4; ++m) {
                    float rsc = s; if constexpr (ROWSCALE) rsc *= rowscale[2 * (row0 + ai * HALF + m * 16) + rs_off];
                    int c0[4], c1[4];
                    { const f32x4 v0 = acc[ai][0][m][0] * rsc, v1 = acc[ai][0][m][1] * rsc; c0[0] = (int)cvt_pk_bf16(v0[0], v0[1]); c0[1] = (int)cvt_pk_bf16(v0[2], v0[3]); c0[2] = (int)cvt_pk_bf16(v1[0], v1[1]); c0[3] = (int)cvt_pk_bf16(v1[2], v1[3]); }
                    { const f32x4 v0 = acc[ai][1][m][0] * rsc, v1 = acc[ai][1][m][1] * rsc; c1[0] = (int)cvt_pk_bf16(v0[0], v0[1]); c1[1] = (int)cvt_pk_bf16(v0[2], v0[3]); c1[2] = (int)cvt_pk_bf16(v1[0], v1[1]); c1[3] = (int)cvt_pk_bf16(v1[2], v1[3]); }
                    const int r1 = rowA + ai * HALF + m * 16;
                    { v4u d1;
                      d1.x = (unsigned)__builtin_amdgcn_update_dpp(c0[0], c1[0], 0x128, 0xf, 0xc, false); d1.y = (unsigned)__builtin_amdgcn_update_dpp(c0[1], c1[1], 0x128, 0xf, 0xc, false);
                      d1.z = (unsigned)__builtin_amdgcn_update_dpp(c0[2], c1[2], 0x128, 0xf, 0xc, false); d1.w = (unsigned)__builtin_amdgcn_update_dpp(c0[3], c1[3], 0x128, 0xf, 0xc, false);
                      if (!skip) st16_wtw<0>(pb + (size_t)(ROWMAP ? rowmap[r1] : r1) * LDC, d1); }
                    __builtin_amdgcn_sched_barrier(0);
                    { v4u d2;
                      d2.x = (unsigned)__builtin_amdgcn_update_dpp(c1[0], c0[0], 0x128, 0xf, 0x3, false); d2.y = (unsigned)__builtin_amdgcn_update_dpp(c1[1], c0[1], 0x128, 0xf, 0x3, false);
                      d2.z = (unsigned)__builtin_amdgcn_update_dpp(c1[2], c0[2], 0x128, 0xf, 0x3, false); d2.w = (unsigned)__builtin_amdgcn_update_dpp(c1[3], c0[3], 0x128, 0xf, 0x3, false);
                      if (!skip) st16_wtw<0>(pb + (size_t)(ROWMAP ? rowmap[r1 + 8] : r1 + 8) * LDC, d2); }
                    __builtin_amdgcn_sched_barrier(0); }
            return;
        }
        bf16_t* p0 = O + (size_t)pnl * tile_stride + (size_t)row0 * LDC + wc * 32 + 8 * fq;
        if (SKIPROPE && pnl == 0 && (wc & 1)) return;
        float rv[8];
        if constexpr (ROWSCALE && ROWSCALE_ASM) { const unsigned vo = (unsigned)(2 * row0 + rs_off) * 4u; PG8_ROWVALS(rv, rowscale, vo, 128, 256, 384, 1024, 1152, 1280, 1408); }
#pragma unroll
        for (int ai = 0; ai < 2; ++ai)
#pragma unroll
            for (int m = 0; m < 4; ++m) { bf16_t* rowp = ROWMAP ? O + (size_t)pnl * tile_stride + (size_t)rowmap[row0 + ai * HALF + m * 16] * LDC + wc * 32 + 8 * fq : p0 + (size_t)(ai * HALF + m * 16) * LDC;
                float rsc = s; if constexpr (ROWSCALE) { if constexpr (ROWSCALE_ASM) rsc *= rv[ai * 4 + m]; else rsc *= rowscale[2 * (row0 + ai * HALF + m * 16) + rs_off]; }
#pragma unroll
                for (int bj = 0; bj < 2; ++bj) { const f32x4 v0 = acc[ai][bj][m][0] * rsc, v1 = acc[ai][bj][m][1] * rsc;
                    v4u w; w.x = cvt_pk_bf16(v0[0], v0[1]); w.y = cvt_pk_bf16(v0[2], v0[3]); w.z = cvt_pk_bf16(v1[0], v1[1]); w.w = cvt_pk_bf16(v1[2], v1[3]);
                    st16_wtw<0>(rowp + bj * HALF, w); } }
    }
};
constexpr float YSCALE = 32.0f;
struct EpiFp8 {
    static constexpr bool ZC_OK = true; static constexpr bool PERM = true; static constexpr bool BJ8 = BJ8_EPI; static constexpr int NST = BJ8_EPI ? 8 : 16;
    unsigned char* O; int nloc;
    __device__ __forceinline__ void operator()(const f32x4 (&acc)[2][2][4][2], const Unit& u, int wr, int wc, int fr, int fq) const {
        const int pnl = u.pn % nloc; const int row0 = u.pm * BM + wr * 64 + fr;
        unsigned char* p0 = O + (size_t)row0 * DM + pnl * BM + (BJ8 ? wc * 64 + 16 * fq : wc * 32 + 8 * fq);
#pragma unroll
        for (int ai = 0; ai < 2; ++ai)
#pragma unroll
            for (int m = 0; m < 4; ++m) { unsigned char* rowp = p0 + (size_t)(ai * HALF + m * 16) * DM;
                int w[2][2];
#pragma unroll
                for (int bj = 0; bj < 2; ++bj) { const f32x4 v0 = acc[ai][bj][m][0], v1 = acc[ai][bj][m][1];
                    int w0 = 0, w1 = 0;
                    w0 = __builtin_amdgcn_cvt_pk_fp8_f32(v0[0], v0[1], w0, false); w0 = __builtin_amdgcn_cvt_pk_fp8_f32(v0[2], v0[3], w0, true);
                    w1 = __builtin_amdgcn_cvt_pk_fp8_f32(v1[0], v1[1], w1, false); w1 = __builtin_amdgcn_cvt_pk_fp8_f32(v1[2], v1[3], w1, true);
                    w[bj][0] = w0; w[bj][1] = w1; }
                if constexpr (BJ8) *(v4u*)rowp = (v4u){(unsigned)w[0][0], (unsigned)w[0][1], (unsigned)w[1][0], (unsigned)w[1][1]};
                else { *(v2u*)rowp = (v2u){(unsigned)w[0][0], (unsigned)w[0][1]}; *(v2u*)(rowp + HALF) = (v2u){(unsigned)w[1][0], (unsigned)w[1][1]}; } }
    }
};
struct EpiLogits {
    static constexpr bool PERM = false; static constexpr int NST = 16;
    float* O;
    __device__ __forceinline__ void operator()(const f32x4 (&acc)[2][2][4][2], const Unit& u, int wr, int wc, int fr, int fq) const {
        const int col0 = wc * 32 + 4 * fq;
#pragma unroll
        for (int ai = 0; ai < 2; ++ai)
#pragma unroll
            for (int m = 0; m < 4; ++m) { float* rowp = O + (size_t)(u.pm * BM + ai * HALF + wr * 64 + m * 16 + fr) * 128 + col0;
#pragma unroll
                for (int n = 0; n < 2; ++n) *(f32x4*)(rowp + n * 16) = acc[ai][0][m][n] + acc[ai][1][m][n]; }
    }
};
template <bool LGATE = false> struct EpiSwiGLUT {
    static constexpr bool PERM = true; static constexpr bool BJ8 = BJ8_EPI; static constexpr int NST = BJ8_EPI ? 8 : 16;
    bf16_t* O; int nloc; const float* gate; float gsc; const LAS float* gatel;
    __device__ __forceinline__ void operator()(const f32x4 (&acc)[2][2][4][2], const Unit& u, int wr, int wc, int fr, int fq) const {
        const int pnl = u.pn % nloc; const int row0 = u.pm * BM + wr * 64 + fr; const int col0 = pnl * 128 + (BJ8 ? wc * 32 + 8 * fq : wc * 16 + 4 * fq);
        float gv[8]; const bool pre = ROWVALS_ASM && !LGATE && gate != nullptr;
        if (pre) { const unsigned vo = (unsigned)row0 * 4u; PG8_ROWVALS(gv, gate, vo, 64, 128, 192, 512, 576, 640, 704); }
#pragma unroll
        for (int ai = 0; ai < 2; ++ai)
#pragma unroll
            for (int m = 0; m < 4; ++m) { const int row = row0 + ai * HALF + m * 16; float gt; if constexpr (LGATE) gt = gatel[u.li * BM + wr * 64 + fr + ai * HALF + m * 16] * gsc; else gt = pre ? gv[ai * 4 + m] * gsc : (gate ? gate[row] * gsc : gsc); bf16_t* rowp = O + (size_t)row * 256 + col0;
                v2u w[2];
#pragma unroll
                for (int bj = 0; bj < 2; ++bj) { const f32x4 a = acc[ai][bj][m][0], b = acc[ai][bj][m][1];
                    w[bj].x = cvt_pk_bf16(fsilu(a[0]) * b[0] * gt, fsilu(a[1]) * b[1] * gt); w[bj].y = cvt_pk_bf16(fsilu(a[2]) * b[2] * gt, fsilu(a[3]) * b[3] * gt); }
                if constexpr (BJ8) *(v4u*)rowp = (v4u){w[0].x, w[0].y, w[1].x, w[1].y};
                else { *(v2u*)rowp = w[0]; *(v2u*)(rowp + 64) = w[1]; } }
    }
};
typedef EpiSwiGLUT<false> EpiSwiGLU;
struct EpiNull {
    static constexpr bool PERM = true; static constexpr int NST = 0;
    __device__ __forceinline__ void operator()(const f32x4 (&acc)[2][2][4][2], const Unit& u, int wr, int wc, int fr, int fq) const {
#pragma unroll
        for (int ai = 0; ai < 2; ++ai)
#pragma unroll
            for (int bj = 0; bj < 2; ++bj)
                asm volatile("" :: "v"(acc[ai][bj][0][0]), "v"(acc[ai][bj][0][1]), "v"(acc[ai][bj][1][0]), "v"(acc[ai][bj][1][1]), "v"(acc[ai][bj][2][0]), "v"(acc[ai][bj][2][1]), "v"(acc[ai][bj][3][0]), "v"(acc[ai][bj][3][1]));
    }
};
}
#define XB_TMO      128
#define XB_XCNT(j)  (256  + 64 * (j))
#define XB_XSUB(j)  (1280 + 64 * (j))
#define XB_XGEN(j)  (2304 + 64 * (j))
#define XB_TOP      3328
#define XB_TOPGEN   3392
#define XCD_BAR_WORDS 3456
#define XB_SPIN_CAP (1u << 18)

__device__ __forceinline__ unsigned xb_ld(unsigned* p)              { return __hip_atomic_load(p, __ATOMIC_RELAXED, __HIP_MEMORY_SCOPE_AGENT); }
__device__ __forceinline__ unsigned xb_add(unsigned* p, unsigned v) { return __hip_atomic_fetch_add(p, v, __ATOMIC_RELAXED, __HIP_MEMORY_SCOPE_AGENT); }
__device__ __forceinline__ unsigned xb_xcc_id() { return (unsigned)__builtin_amdgcn_s_getreg((3 << 11) | 20) & 0xFu; }
#define XB_SPIN(cond, bar) do { unsigned _sp = 0; while (cond) { __builtin_amdgcn_s_sleep(1); \
    if ((++_sp & 255u) == 0u) { if (xb_ld(&(bar)[XB_TMO])) break; if (_sp > XB_SPIN_CAP) { atomicAdd(&(bar)[XB_TMO], 1u); break; } } } } while (0)

struct XcdBarrier {
    unsigned* bar; unsigned x;
    volatile LAS unsigned* st;
};

__device__ __forceinline__ XcdBarrier xcd_barrier_post(unsigned* bar, volatile LAS unsigned* st) {
    XcdBarrier b; b.bar = bar; b.x = xb_xcc_id(); b.st = st;
    if (threadIdx.x == 0) (void)xb_add(&bar[XB_XCNT(b.x)], 1u);
    return b;
}
__device__ __forceinline__ void xcd_barrier_complete(unsigned* bar, unsigned x, unsigned& nloc, unsigned& nx) {
    const unsigned G = gridDim.x * gridDim.y * gridDim.z;
    unsigned sum, cnt, mine, sp = 0u;
    for (;;) {
        sum = 0u; cnt = 0u; mine = 0u;
#pragma unroll
        for (unsigned j = 0; j < 16; ++j) { const unsigned c = xb_ld(&bar[XB_XCNT(j)]); sum += c; cnt += (c > 0u) ? 1u : 0u; mine = (j == x) ? c : mine; }
        if (sum == G) break;
        __builtin_amdgcn_s_sleep(1);
        if ((++sp & 255u) == 0u) { if (xb_ld(&bar[XB_TMO])) break; if (sp > XB_SPIN_CAP) { atomicAdd(&bar[XB_TMO], 1u); break; } }
    }
    nloc = mine > 0u ? mine : 1u; nx = cnt > 0u ? cnt : 1u;
}

__device__ __forceinline__ void xcd_barrier(const XcdBarrier& b) {
    asm volatile("s_waitcnt vmcnt(0)" ::: "memory");
    __syncthreads();
    if (threadIdx.x == 0) {
        unsigned* bar = b.bar;
        __builtin_amdgcn_s_waitcnt(0);
        unsigned nloc = b.st[0], nx = b.st[1];
        if (nloc == 0u) { xcd_barrier_complete(bar, b.x, nloc, nx); b.st[0] = nloc; b.st[1] = nx; }
        const unsigned old = xb_add(&bar[XB_XSUB(b.x)], 1u);
        const unsigned gen = old / nloc;
        if (old + 1u == (gen + 1u) * nloc) {
            __builtin_amdgcn_fence(__ATOMIC_RELEASE, "agent");
            asm volatile("s_waitcnt vmcnt(0)" ::: "memory");
            const unsigned og = xb_add(&bar[XB_TOP], 1u);
            const unsigned tg = og / nx;
            if (og + 1u == (tg + 1u) * nx) xb_add(&bar[XB_TOPGEN], 1u);
            else XB_SPIN(xb_ld(&bar[XB_TOPGEN]) == tg, bar);
            __builtin_amdgcn_fence(__ATOMIC_ACQUIRE, "agent");
            xb_add(&bar[XB_XGEN(b.x)], 1u);
            asm volatile("s_waitcnt vmcnt(0)" ::: "memory");
        } else {
            XB_SPIN(xb_ld(&bar[XB_XGEN(b.x)]) == gen, bar);
            __builtin_amdgcn_fence(__ATOMIC_ACQUIRE, "agent");
            asm volatile("s_waitcnt vmcnt(0)" ::: "memory");
        }
    }
    __syncthreads();
}
namespace att {
constexpr int NSLOT = 3, SLOTB = 8192;
constexpr int LDS_K = 0, LDS_V = NSLOT * SLOTB, LDS_WS = 2 * NSLOT * SLOTB, LDS_OST = LDS_WS + 8 * 64 * 4, LDS_BIAS = LDS_OST + 8 * 4096, LDS_END = LDS_BIAS + 2048;
enum { M_FULL = 0, M_NA = 1, M_WA = 2 };
__device__ __forceinline__ int crow(int r, int hi) { return (r & 3) + 8 * (r >> 2) + 4 * hi; }
__device__ __forceinline__ void glds16(const void* gsrc, unsigned lds_dst) { unsigned keep;
    asm volatile("s_mov_b32 %0, m0\n\ts_mov_b32 m0, %2\n\ts_nop 0\n\tglobal_load_lds_dwordx4 %1, off\n\ts_mov_b32 m0, %0" : "=&s"(keep) : "v"(gsrc), "s"(lds_dst) : "memory"); }
__device__ __forceinline__ void qkt(f32x16& p0, f32x16& p1, const char* Kslot, const bf16x8* qr, int r32, int hi) {
    const char* kb = Kslot + hi * 1024 + r32 * 16;
    const f32x16 z = {};
#pragma unroll
    for (int d0 = 0; d0 < 4; ++d0) {
        const bf16x8 b0 = *reinterpret_cast<const bf16x8*>(kb + d0 * 2048);
        const bf16x8 b1 = *reinterpret_cast<const bf16x8*>(kb + d0 * 2048 + 512);
        if (d0 == 0) { p0 = __builtin_amdgcn_mfma_f32_32x32x16_bf16(b0, qr[0], z, 0, 0, 0); p1 = __builtin_amdgcn_mfma_f32_32x32x16_bf16(b1, qr[0], z, 0, 0, 0); }
        else { p0 = __builtin_amdgcn_mfma_f32_32x32x16_bf16(b0, qr[d0], p0, 0, 0, 0); p1 = __builtin_amdgcn_mfma_f32_32x32x16_bf16(b1, qr[d0], p1, 0, 0, 0); } }
}
__device__ __forceinline__ void pv(f32x16* o, int vb, bf16x8 pa0, bf16x8 pa1, bf16x8 pa2, bf16x8 pa3) {
#pragma unroll
    for (int d0 = 0; d0 < 2; ++d0) { s16x4 lo[4], hi[4];
#pragma unroll
        for (int ks = 0; ks < 4; ++ks) {
            asm volatile("ds_read_b64_tr_b16 %0,%1 offset:%c2" : "=&v"(lo[ks]) : "v"(vb), "i"(d0 * 4096 + ks * 1024) : "memory");
            asm volatile("ds_read_b64_tr_b16 %0,%1 offset:%c2" : "=&v"(hi[ks]) : "v"(vb), "i"(d0 * 4096 + ks * 1024 + 512) : "memory"); }
        asm volatile("s_waitcnt lgkmcnt(0)" ::: "memory"); __builtin_amdgcn_sched_barrier(0);
#define PK(k) (bf16x8){lo[k][0], lo[k][1], lo[k][2], lo[k][3], hi[k][0], hi[k][1], hi[k][2], hi[k][3]}
        o[d0] = __builtin_amdgcn_mfma_f32_32x32x16_bf16(pa0, PK(0), o[d0], 0, 0, 0);
        o[d0] = __builtin_amdgcn_mfma_f32_32x32x16_bf16(pa1, PK(1), o[d0], 0, 0, 0);
        o[d0] = __builtin_amdgcn_mfma_f32_32x32x16_bf16(pa2, PK(2), o[d0], 0, 0, 0);
        o[d0] = __builtin_amdgcn_mfma_f32_32x32x16_bf16(pa3, PK(3), o[d0], 0, 0, 0);
#undef PK
    }
}
struct Desc {
    const bf16* Q; int qp;
    const bf16* K; const bf16* V; int kp;
    bf16* O; int op;
    int nt, nctx, nt_real;
    int ctxrow, latrow;
    int r0, kr0;
    int q0, kt0;
    const float* rpb;
    float sink_l2; int has_sink;
    int qrope, qt0;
};
template <int MODE>
__device__ __forceinline__ void attn_unit(const Desc& d, char* shm) {
    int tid_ = threadIdx.x; asm volatile("" : "+v"(tid_));
    const int tid = tid_, lane = tid & 63, r32 = lane & 31, hi = lane >> 5; const int wid = __builtin_amdgcn_readfirstlane(tid >> 6);
    const unsigned lds0 = (unsigned)(uintptr_t)shm;
    float* wsf = (float*)(shm + LDS_WS) + wid * 64;
    const bf16* Qw = d.Q + (size_t)(wid * 32) * d.qp;
    const unsigned kdst = lds0 + LDS_K + wid * 1024, vdst = lds0 + LDS_V + wid * 1024;
    const size_t koffl = (size_t)lane * d.kp + wid * 8;
    const size_t voffl = (size_t)(16 * (wid & 3) + (lane >> 2)) * d.kp + (wid >> 2) * 32 + (lane & 3) * 8;
#define TROW(t) ((t) < d.nctx ? d.ctxrow + 64 * (t) : d.latrow + 64 * ((t) - d.nctx))
#define DMA_KV(t, slot) do { const size_t ro_ = (size_t)TROW(t) * d.kp; \
        glds16(d.K + ro_ + koffl, (unsigned)__builtin_amdgcn_readfirstlane(kdst + (slot) * SLOTB)); \
        glds16(d.V + ro_ + voffl, (unsigned)__builtin_amdgcn_readfirstlane(vdst + (slot) * SLOTB)); } while (0)
    const int vb0 = (int)(lds0 + LDS_V) + ((lane >> 4) & 1) * 32 + (lane & 3) * 8 + (4 * hi + ((lane & 15) >> 2)) * 64;
    if (MODE == M_NA) { float* bt = (float*)(shm + LDS_BIAS); if (tid < 465) bt[tid] = d.rpb[tid] * LOG2E; }
    DMA_KV(0, 0);
    if (d.nt > 1) DMA_KV(1, 1);
    bf16x8 qr[4];
#pragma unroll
    for (int d0 = 0; d0 < 4; ++d0) qr[d0] = *reinterpret_cast<const bf16x8*>(&Qw[(size_t)r32 * d.qp + d0 * 16 + hi * 8]);
    float m = -1e30f, l = 0.f; f32x16 o[2]; o[0] = f32x16{}; o[1] = f32x16{};
    const int qrow = (MODE == M_NA) ? d.r0 + (wid >> 1) : 0;
    const int qcol = 32 * (wid & 1) + r32;
    const int rs = (MODE == M_NA) ? (qrow - 4 < 0 ? 0 : (qrow - 4 > 120 ? 120 : qrow - 4)) : 0;
    const int cs = qcol - 8 < 0 ? 0 : (qcol - 8 > 48 ? 48 : qcol - 8);
    const int qpos = d.q0 + 32 * wid + r32;
    int slot = 0;
    for (int t = 0; t < d.nt; ++t) {
        if (t + 1 < d.nt) asm volatile("s_waitcnt vmcnt(2) lgkmcnt(0)\n\ts_barrier" ::: "memory");
        else asm volatile("s_waitcnt vmcnt(0) lgkmcnt(0)\n\ts_barrier" ::: "memory");
        if (t + 2 < d.nt) { const int s2 = slot + 2 >= NSLOT ? slot + 2 - NSLOT : slot + 2; DMA_KV(t + 2, s2); }
        bool active = true;
        int kr = 0, k0 = 0;
        if (MODE == M_NA && t >= d.nctx) { kr = d.kr0 + (t - d.nctx); active = (kr >= rs) && (kr < rs + 8); }
        if (MODE == M_WA && t >= d.nctx) { k0 = d.kt0 + 64 * (t - d.nctx); const int qw = d.q0 + 32 * wid; active = (k0 + 63 >= qw - 128) && (k0 <= qw + 31 + 128); }
        if (active) {
            f32x16 p0, p1;
            qkt(p0, p1, shm + LDS_K + slot * SLOTB, qr, r32, hi);
            if (MODE == M_NA && t >= d.nctx) {
                const float* bt = (const float*)(shm + LDS_BIAS) + (kr - qrow + 7) * 31 + 15 - qcol;
#pragma unroll
                for (int r = 0; r < 16; ++r) {
                    const int kv = crow(r, hi);
                    { const bool ok = (unsigned)(kv - cs) < 16u; const float bv = bt[ok ? kv : qcol]; p0[r] = ok ? p0[r] + bv : -INFINITY; }
                    { const int kv2 = kv + 32; const bool ok = (unsigned)(kv2 - cs) < 16u; const float bv = bt[ok ? kv2 : qcol]; p1[r] = ok ? p1[r] + bv : -INFINITY; }
                }
            }
            if (MODE == M_WA && t >= d.nctx) {
#pragma unroll
                for (int r = 0; r < 16; ++r) {
                    const int dk = k0 + crow(r, hi) - qpos;
                    if (dk > 128 || dk < -128) p0[r] = -INFINITY;
                    if (dk + 32 > 128 || dk + 32 < -128) p1[r] = -INFINITY;
                }
            }
            float rm = __builtin_fmaxf(p0[0], p1[0]);
#pragma unroll
            for (int r = 1; r < 16; ++r) rm = __builtin_fmaxf(rm, __builtin_fmaxf(p0[r], p1[r]));
            { auto rr = __builtin_amdgcn_permlane32_swap(__float_as_uint(rm), __float_as_uint(rm), false, false); rm = __builtin_fmaxf(__uint_as_float(rr[0]), __uint_as_float(rr[1])); }
            const float mn = __builtin_fmaxf(m, rm);
            if (__any(mn > m)) {
                const float f = __builtin_amdgcn_exp2f(m - mn); l *= f; m = mn;
                if (hi == 0) wsf[r32] = f;
                asm volatile("s_waitcnt lgkmcnt(0)" ::: "memory");
#pragma unroll
                for (int r = 0; r < 16; ++r) { const float fr_ = wsf[crow(r, hi)]; o[0][r] *= fr_; o[1][r] *= fr_; }
            }
            float sacc = 0.f;
#pragma unroll
            for (int r = 0; r < 16; ++r) { p0[r] = __builtin_amdgcn_exp2f(p0[r] - m); p1[r] = __builtin_amdgcn_exp2f(p1[r] - m); sacc += p0[r] + p1[r]; }
            l += sacc;
            v4u pw0, pw1, pw2, pw3;
            pw0 = (v4u){cvtpk(p0[0], p0[1]), cvtpk(p0[2], p0[3]), cvtpk(p0[4], p0[5]), cvtpk(p0[6], p0[7])};
            pw1 = (v4u){cvtpk(p0[8], p0[9]), cvtpk(p0[10], p0[11]), cvtpk(p0[12], p0[13]), cvtpk(p0[14], p0[15])};
            pw2 = (v4u){cvtpk(p1[0], p1[1]), cvtpk(p1[2], p1[3]), cvtpk(p1[4], p1[5]), cvtpk(p1[6], p1[7])};
            pw3 = (v4u){cvtpk(p1[8], p1[9]), cvtpk(p1[10], p1[11]), cvtpk(p1[12], p1[13]), cvtpk(p1[14], p1[15])};
            pv(o, vb0 + slot * SLOTB, __builtin_bit_cast(bf16x8, pw0), __builtin_bit_cast(bf16x8, pw1), __builtin_bit_cast(bf16x8, pw2), __builtin_bit_cast(bf16x8, pw3));
        }
        slot = slot + 1 >= NSLOT ? 0 : slot + 1;
    }
    if (d.has_sink && hi == 0) l += __builtin_amdgcn_exp2f(d.sink_l2 - m);
    { auto rr = __builtin_amdgcn_permlane32_swap(__float_as_uint(l), __float_as_uint(l), false, false); l = __uint_as_float(rr[0]) + __uint_as_float(rr[1]); }
    if (hi == 0) wsf[32 + r32] = l;
    asm volatile("s_waitcnt lgkmcnt(0)" ::: "memory");
    float rli[16];
#pragma unroll
    for (int r = 0; r < 16; ++r) rli[r] = __builtin_amdgcn_rcpf(wsf[32 + crow(r, hi)]);
    bf16* Ow = d.O + (size_t)(wid * 32) * d.op;
    { bf16* stg = (bf16*)(shm + LDS_OST) + wid * 2048;
#pragma unroll
        for (int r = 0; r < 16; ++r) { const int orow = crow(r, hi);
#pragma unroll
            for (int d0 = 0; d0 < 2; ++d0) stg[orow * 64 + d0 * 32 + r32] = (bf16)f2bf(o[d0][r] * rli[r]); }
        asm volatile("s_waitcnt lgkmcnt(0)" ::: "memory");
#pragma unroll
        for (int i = 0; i < 4; ++i) { const int row = i * 8 + (lane >> 3), ch = lane & 7; const v4u v = *(const v4u*)(stg + row * 64 + ch * 8); st16_wtw<2>(Ow + (size_t)row * d.op + ch * 8, v); } }
    asm volatile("s_waitcnt lgkmcnt(0)\n\ts_barrier" ::: "memory");
#undef TROW
#undef DMA_KV
}
}
namespace att {
typedef unsigned u32x4 __attribute__((ext_vector_type(4)));
#define SBAR() __builtin_amdgcn_sched_barrier(0)
__device__ __forceinline__ float max3f(float a,float b,float c){float r;asm("v_max3_f32 %0, %1, %2, %3":"=v"(r):"v"(a),"v"(b),"v"(c));return r;}
__device__ __forceinline__ float max2f(float a,float b){float r;asm("v_max_f32_e32 %0, %1, %2":"=v"(r):"v"(a),"v"(b));return r;}
__device__ __forceinline__ float fadd_s(float a,float b){float r;asm("v_add_f32_e32 %0, %1, %2":"=v"(r):"v"(a),"v"(b));return r;}
__device__ __forceinline__ float fsub_s(float a,float b){float r;asm("v_sub_f32_e32 %0, %1, %2":"=v"(r):"v"(a),"v"(b));return r;}
__device__ __forceinline__ unsigned cvtpk_s(float lo,float hi){return cvtpk(lo,hi);}
#define WAIT_BAR(N) asm volatile("s_waitcnt vmcnt(" #N ") lgkmcnt(0)\n\ts_barrier":::"memory")


__device__ __forceinline__ void qkt_n(f32x16&p0,f32x16&p1,const char*Kslot,const bf16x8*qr,const f32x16&negm,int r32,int hi){
  const char*kb=Kslot+hi*1024+r32*16;
  #pragma unroll
  for(int d0=0;d0<4;++d0){
    const bf16x8 b0=*reinterpret_cast<const bf16x8*>(kb+d0*2048);
    const bf16x8 b1=*reinterpret_cast<const bf16x8*>(kb+d0*2048+512);
    if(d0==0){p0=__builtin_amdgcn_mfma_f32_32x32x16_bf16(b0,qr[0],negm,0,0,0);p1=__builtin_amdgcn_mfma_f32_32x32x16_bf16(b1,qr[0],negm,0,0,0);}
    else{p0=__builtin_amdgcn_mfma_f32_32x32x16_bf16(b0,qr[d0],p0,0,0,0);p1=__builtin_amdgcn_mfma_f32_32x32x16_bf16(b1,qr[d0],p1,0,0,0);}}
}
typedef __attribute__((address_space(3))) const char* lds_cptr;
typedef short v4i16_t __attribute__((ext_vector_type(4)));
__device__ __forceinline__ void kload8(bf16x8*kf,lds_cptr kp){
  kf[0]=*(const __attribute__((address_space(3))) bf16x8*)(kp);      kf[1]=*(const __attribute__((address_space(3))) bf16x8*)(kp+512);
  kf[2]=*(const __attribute__((address_space(3))) bf16x8*)(kp+2048); kf[3]=*(const __attribute__((address_space(3))) bf16x8*)(kp+2560);
  kf[4]=*(const __attribute__((address_space(3))) bf16x8*)(kp+4096); kf[5]=*(const __attribute__((address_space(3))) bf16x8*)(kp+4608);
  kf[6]=*(const __attribute__((address_space(3))) bf16x8*)(kp+6144); kf[7]=*(const __attribute__((address_space(3))) bf16x8*)(kp+6656);
}
__device__ __forceinline__ void kload2(bf16x8*kf,lds_cptr kp,int j){ kf[2*j]=*(const __attribute__((address_space(3))) bf16x8*)(kp+j*2048); kf[2*j+1]=*(const __attribute__((address_space(3))) bf16x8*)(kp+j*2048+512); }
__device__ __forceinline__ s16x4 vtr(lds_cptr p){ return __builtin_bit_cast(s16x4,__builtin_amdgcn_ds_read_tr16_b64_v4i16((__attribute__((address_space(3))) v4i16_t*)p)); }
__device__ __forceinline__ float rowmax(const f32x16&p0,const f32x16&p1){
  float a=max3f(p0[0],p0[1],p1[0]),b=max3f(p0[2],p0[3],p1[1]);a=max3f(a,p1[2],p1[3]);
  #pragma unroll
  for(int r=4;r<16;r+=4){a=max3f(a,p0[r],p0[r+1]);b=max3f(b,p0[r+2],p0[r+3]);a=max3f(a,p1[r],p1[r+1]);b=max3f(b,p1[r+2],p1[r+3]);}
  const float m=max2f(a,b);
  auto rr=__builtin_amdgcn_permlane32_swap(__float_as_uint(m),__float_as_uint(m),false,false);
  return max2f(__uint_as_float(rr[0]),__uint_as_float(rr[1]));
}

template<int MODE> __device__ __forceinline__ void pipe_mask(f32x16&P0,f32x16&P1,int t,const Desc& d,const char*shm,int wid,int r32,int hi){
  if(MODE==M_FULL) return;
  if(t<d.nctx) return;
  if(t>=d.nt_real){
    _Pragma("unroll") for(int r=0;r<16;++r){P0[r]=-INFINITY;P1[r]=-INFINITY;} return; }
  if(MODE==M_NA){
    const int qrow=d.r0+(wid>>1), qcol=32*(wid&1)+r32, kr=d.kr0+(t-d.nctx);
    const int rs=qrow-4<0?0:(qrow-4>120?120:qrow-4), cs=qcol-8<0?0:(qcol-8>48?48:qcol-8);
    if(kr<rs||kr>=rs+8){ _Pragma("unroll") for(int r=0;r<16;++r){P0[r]=-INFINITY;P1[r]=-INFINITY;} return; }
    const float*bt=(const float*)(shm+LDS_BIAS)+(kr-qrow+7)*31+15-qcol;
    _Pragma("unroll") for(int r=0;r<16;++r){ const int kv=crow(r,hi);
      { const bool ok=(unsigned)(kv-cs)<16u; const float bv=bt[ok?kv:qcol]; P0[r]=ok?P0[r]+bv:-INFINITY; }
      { const int kv2=kv+32; const bool ok=(unsigned)(kv2-cs)<16u; const float bv=bt[ok?kv2:qcol]; P1[r]=ok?P1[r]+bv:-INFINITY; } }
  }
  if(MODE==M_WA){
    const int qpos=d.q0+32*wid+r32, k0=d.kt0+64*(t-d.nctx);
    _Pragma("unroll") for(int r=0;r<16;++r){ const int dk=k0+crow(r,hi)-qpos;
      if(dk>128||dk<-128)P0[r]=-INFINITY; if(dk+32>128||dk+32<-128)P1[r]=-INFINITY; }
  }
}
template<int THRL,int MODE> __device__ __forceinline__ void attn_unit_pipe(const Desc& d,char*shm){
  int tid_=threadIdx.x; asm volatile("":"+v"(tid_)); const int tid=tid_,lane=tid&63,r32=lane&31,hi=lane>>5; const int wid=__builtin_amdgcn_readfirstlane(tid>>6);
  const bf16*Qw=d.Q+(size_t)(wid*32)*d.qp;
  const unsigned lds0=(unsigned)(uintptr_t)shm;
  if(MODE==M_NA){ float*bt=(float*)(shm+LDS_BIAS); if(tid<465)bt[tid]=d.rpb[tid]*LOG2E; }
  float*wsf=(float*)(shm+LDS_WS)+wid*64;
  const size_t koffl=(size_t)lane*d.kp+wid*8;
  const size_t voffl=(size_t)(16*(wid&3)+(lane>>2))*d.kp+(wid>>2)*32+(lane&3)*8;
  #define TROW(t) ((t)<d.nctx?d.ctxrow+64*(t):((t)<d.nt_real?d.latrow+64*((t)-d.nctx):d.latrow))
  const unsigned kdst=lds0+LDS_K+wid*1024, vdst=lds0+LDS_V+wid*1024;
  #define DMA_K(t,slot) glds16(d.K+(size_t)TROW(t)*d.kp+koffl,(unsigned)__builtin_amdgcn_readfirstlane(kdst+(slot)))
  #define DMA_V(t,slot) glds16(d.V+(size_t)TROW(t)*d.kp+voffl,(unsigned)__builtin_amdgcn_readfirstlane(vdst+(slot)))
  const int vb0=(int)(lds0+LDS_V)+((lane>>4)&1)*32+(lane&3)*8+(4*hi+((lane&15)>>2))*64;
  const char*Kbase=shm+LDS_K; bf16x8 kf[8];
  const lds_cptr shm3=(lds_cptr)shm; const lds_cptr kp0=shm3+LDS_K+hi*1024+r32*16; const lds_cptr vp0=shm3+LDS_V+((lane>>4)&1)*32+(lane&3)*8+(4*hi+((lane&15)>>2))*64;
  const int NT=d.nt;
  DMA_K(0,0);DMA_V(0,0);DMA_K(1,SLOTB);
  bf16x8 qr[4];
  #pragma unroll
  for(int d0=0;d0<4;++d0)qr[d0]=*reinterpret_cast<const bf16x8*>(&Qw[(size_t)r32*d.qp+d0*16+hi*8]);
  if(d.qrope){
    const int tq=d.qt0+32*wid+r32, rr=tq>>6, cc=tq&63;
    #pragma unroll
    for(int d0=2;d0<4;++d0){ const float pos=(float)(d0==2?rr:cc); u32x4 w=__builtin_bit_cast(u32x4,qr[d0]), pw, ow;
      #pragma unroll
      for(int j=0;j<4;++j) pw[j]=(unsigned)__shfl_xor((int)w[j],32);
      #pragma unroll
      for(int j=0;j<4;++j){ float res[2];
        #pragma unroll
        for(int e=0;e<2;++e){ const int i=2*j+e; const float own=e?bfhi(w[j]):bflo(w[j]), oth=e?bfhi(pw[j]):bflo(pw[j]);
          const float rev=pos*__builtin_amdgcn_exp2f(-(float)i*(13.287712379549449f/8.0f))*0.15915494309189535f; const float cs_=__builtin_amdgcn_cosf(rev), sn_=__builtin_amdgcn_sinf(rev);
          res[e]=hi?(own*cs_+oth*sn_):(own*cs_-oth*sn_); }
        ow[j]=cvtpk(res[0],res[1]); }
      qr[d0]=__builtin_bit_cast(bf16x8,ow); } }
  float mhat=0.f,l_reg=0.f;f32x16 o[2];o[0]=f32x16{};o[1]=f32x16{};f32x16 negm=f32x16{};asm volatile("":"+v"(negm));
  #define CMASK(P0,P1,t) pipe_mask<MODE>(P0,P1,(t),d,shm,wid,r32,hi)
  bool resc=false;
  #define START(P0,P1) do{ const float rm=rowmax(P0,P1); resc=false; \
    { const float dl=rm; mhat=fadd_s(mhat,dl); \
      _Pragma("unroll") for(int r=0;r<16;++r){P0[r]=fsub_s(P0[r],dl);P1[r]=fsub_s(P1[r],dl);} \
      _Pragma("unroll") for(int r=0;r<16;++r)negm[r]=-mhat; asm volatile("":"+v"(negm)); } \
    _Pragma("unroll") for(int r=0;r<16;++r)P0[r]=__builtin_amdgcn_exp2f(P0[r]); }while(0)
  #define RESC() do{ if(resc){ asm volatile("s_waitcnt lgkmcnt(0)":::"memory"); \
      _Pragma("unroll") for(int d_=0;d_<2;++d_) _Pragma("unroll") for(int r=0;r<16;++r)o[d_][r]*=wsf[crow(r,hi)]; } }while(0)
  f32x16 pA0,pA1,pB0,pB1;
  int sl_prev=0,sl_cur=0,sl_next=SLOTB;
  #define ROT() do{sl_prev=sl_cur;sl_cur=sl_next;sl_next=(sl_next==(NSLOT-1)*SLOTB)?0:sl_next+SLOTB;}while(0)
  DMA_K(2,2*SLOTB);
  WAIT_BAR(3);
  qkt_n(pA0,pA1,Kbase,qr,negm,r32,hi);asm volatile("s_nop 15\n\ts_nop 7":"+v"(pA0),"+v"(pA1));CMASK(pA0,pA1,0);
  START(pA0,pA1);
  _Pragma("unroll") for(int r=0;r<16;++r)pA1[r]=__builtin_amdgcn_exp2f(pA1[r]);
  WAIT_BAR(0);
  DMA_K(3,0);DMA_V(1,SLOTB);
  ROT();
  kload8(kf,kp0+sl_cur);
  WAIT_BAR(2);
  s16x4 vlo[8],vhi[8]; u32x4 pw0,pw1,pw2,pw3;
  #define PKW(P,B) cvtpk_s(P[B],P[B+1])
  #define PAF(k) __builtin_bit_cast(bf16x8,pw##k)
  #define VFR(i) (bf16x8){vlo[i][0],vlo[i][1],vlo[i][2],vlo[i][3],vhi[i][0],vhi[i][1],vhi[i][2],vhi[i][3]}
  #define PIN(x) asm volatile("":"+v"(x))
  #define MX3(a,b,c) __builtin_fmaxf(__builtin_fmaxf((a),(b)),(c))
  #define GAPA(MF,A0,A1,A2,A3,W0,W1,PW) do{ MF; sacc+=A0; sacc+=A1; sacc+=A2; sacc+=A3; PIN(sacc); W0; W1; PIN(PW); SBAR(); }while(0)
  #define EX(v) __builtin_amdgcn_exp2f(v)
  #define GAPB(MF,X,B) do{ MF; X[B]=EX(X[B]); X[B+1]=EX(X[B+1]); X[B+2]=EX(X[B+2]); X[B+3]=EX(X[B+3]); PIN(X); SBAR(); }while(0)
  #define VRD(i) do{ vlo[i]=vtr(vp_+(((i)>>2)*4096+((i)&3)*1024)); vhi[i]=vtr(vp_+(((i)>>2)*4096+((i)&3)*1024+512)); }while(0)
  #define KRD(G,j) do{ if(G){ kload2(kf,kp0+sl_next,j); SBAR(); } }while(0)
  #define STEP(C0,C1,P0,P1,t,GK,GV,GL) do{ SBAR(); \
    const lds_cptr vp_=vp0+sl_prev; \
    VRD(0); SBAR(); float sacc=(P0[0]+P0[1]); \
    GAPA(C0=__builtin_amdgcn_mfma_f32_32x32x16_bf16(kf[0],qr[0],negm,0,0,0), P0[2],P0[3],P0[4],P0[5],     pw0[0]=PKW(P0,0), pw0[1]=PKW(P0,2), pw0); \
    VRD(4); SBAR(); GAPA(C1=__builtin_amdgcn_mfma_f32_32x32x16_bf16(kf[1],qr[0],negm,0,0,0), P0[6],P0[7],P0[8],P0[9],     pw0[2]=PKW(P0,4), pw0[3]=PKW(P0,6), pw0); \
    VRD(1); SBAR(); GAPA(C0=__builtin_amdgcn_mfma_f32_32x32x16_bf16(kf[2],qr[1],C0,0,0,0),   P0[10],P0[11],P0[12],P0[13], pw1[0]=PKW(P0,8), pw1[1]=PKW(P0,10), pw1); \
    VRD(5); SBAR(); GAPA(C1=__builtin_amdgcn_mfma_f32_32x32x16_bf16(kf[3],qr[1],C1,0,0,0),   P0[14],P0[15],P1[0],P1[1],   pw1[2]=PKW(P0,12),pw1[3]=PKW(P0,14), pw1); \
    VRD(2); SBAR(); GAPA(C0=__builtin_amdgcn_mfma_f32_32x32x16_bf16(kf[4],qr[2],C0,0,0,0),   P1[2],P1[3],P1[4],P1[5],     pw2[0]=PKW(P1,0), pw2[1]=PKW(P1,2), pw2); \
    VRD(6); SBAR(); GAPA(C1=__builtin_amdgcn_mfma_f32_32x32x16_bf16(kf[5],qr[2],C1,0,0,0),   P1[6],P1[7],P1[8],P1[9],     pw2[2]=PKW(P1,4), pw2[3]=PKW(P1,6), pw2); \
    VRD(3); SBAR(); GAPA(C0=__builtin_amdgcn_mfma_f32_32x32x16_bf16(kf[6],qr[3],C0,0,0,0),   P1[10],P1[11],P1[12],P1[13], pw3[0]=PKW(P1,8), pw3[1]=PKW(P1,10), pw3); \
    VRD(7); SBAR(); GAPA(C1=__builtin_amdgcn_mfma_f32_32x32x16_bf16(kf[7],qr[3],C1,0,0,0),   P1[14],P1[15],0.f,0.f,       pw3[2]=PKW(P1,12),pw3[3]=PKW(P1,14), pw3); \
    l_reg+=sacc; \
    if(GK){DMA_K((t)+3,sl_cur);} if(GV){DMA_V((t)+1,sl_next);} \
    CMASK(C0,C1,t); \
    { float a=MX3(C0[0],C0[1],C1[0]),b=MX3(C0[2],C0[3],C1[1]); a=MX3(a,C1[2],C1[3]); \
      _Pragma("unroll") for(int r=4;r<16;r+=4){a=MX3(a,C0[r],C0[r+1]);b=MX3(b,C0[r+2],C0[r+3]);a=MX3(a,C1[r],C1[r+1]);b=MX3(b,C1[r+2],C1[r+3]);} \
      float rm=__builtin_fmaxf(a,b); { auto rr=__builtin_amdgcn_permlane32_swap(__float_as_uint(rm),__float_as_uint(rm),false,false); rm=__builtin_fmaxf(__uint_as_float(rr[0]),__uint_as_float(rr[1])); } \
      resc=false; \
      if(__builtin_expect(__any(rm>(float)THRL),0)){ const float dl=__builtin_fmaxf(rm,0.f); mhat+=dl; \
        _Pragma("unroll") for(int r=0;r<16;++r){C0[r]-=dl;C1[r]-=dl;} \
        _Pragma("unroll") for(int r=0;r<16;++r)negm[r]=-mhat; asm volatile("":"+v"(negm)); \
        const float f=__builtin_amdgcn_exp2f(-dl); l_reg*=f; if(hi==0)wsf[r32]=f; resc=true; } } \
    SBAR(); \
    GAPB(o[0]=__builtin_amdgcn_mfma_f32_32x32x16_bf16(PAF(0),VFR(0),o[0],0,0,0), C0,0); \
    GAPB(o[1]=__builtin_amdgcn_mfma_f32_32x32x16_bf16(PAF(0),VFR(4),o[1],0,0,0), C0,4); \
    KRD(GL,0); GAPB(o[0]=__builtin_amdgcn_mfma_f32_32x32x16_bf16(PAF(1),VFR(1),o[0],0,0,0), C0,8); \
    KRD(GL,1); GAPB(o[1]=__builtin_amdgcn_mfma_f32_32x32x16_bf16(PAF(1),VFR(5),o[1],0,0,0), C0,12); \
    KRD(GL,2); GAPB(o[0]=__builtin_amdgcn_mfma_f32_32x32x16_bf16(PAF(2),VFR(2),o[0],0,0,0), C1,0); \
    KRD(GL,3); GAPB(o[1]=__builtin_amdgcn_mfma_f32_32x32x16_bf16(PAF(2),VFR(6),o[1],0,0,0), C1,4); \
    GAPB(o[0]=__builtin_amdgcn_mfma_f32_32x32x16_bf16(PAF(3),VFR(3),o[0],0,0,0), C1,8); \
    GAPB(o[1]=__builtin_amdgcn_mfma_f32_32x32x16_bf16(PAF(3),VFR(7),o[1],0,0,0), C1,12); \
    }while(0)
  int t=1;
  for(;t+5<NT;t+=2){
    STEP(pB0,pB1,pA0,pA1,t,true,true,true);     WAIT_BAR(2); RESC(); ROT();
    STEP(pA0,pA1,pB0,pB1,t+1,true,true,true);   WAIT_BAR(2); RESC(); ROT();
  }
  #define ENDW(tt) do{ if((tt)+3<NT){WAIT_BAR(2);} else if((tt)+2<NT){WAIT_BAR(1);} else {WAIT_BAR(0);} }while(0)
  for(;t+1<NT;t+=2){
    STEP(pB0,pB1,pA0,pA1,t,(t+3<NT),(t+1<NT),(t+1<NT));       ENDW(t);   RESC(); ROT();
    STEP(pA0,pA1,pB0,pB1,t+1,(t+4<NT),(t+2<NT),(t+2<NT));     ENDW(t+1); RESC(); ROT();
  }
  STEP(pB0,pB1,pA0,pA1,NT-1,false,false,false); RESC();
  { float sacc=pB0[0]+pB0[1]; _Pragma("unroll") for(int r=2;r<16;++r)sacc+=pB0[r]; _Pragma("unroll") for(int r=0;r<16;++r)sacc+=pB1[r]; l_reg+=sacc;
    pw0=(u32x4){PKW(pB0,0),PKW(pB0,2),PKW(pB0,4),PKW(pB0,6)};pw1=(u32x4){PKW(pB0,8),PKW(pB0,10),PKW(pB0,12),PKW(pB0,14)};pw2=(u32x4){PKW(pB1,0),PKW(pB1,2),PKW(pB1,4),PKW(pB1,6)};pw3=(u32x4){PKW(pB1,8),PKW(pB1,10),PKW(pB1,12),PKW(pB1,14)};
    SBAR(); pv(o,vb0+sl_cur,PAF(0),PAF(1),PAF(2),PAF(3)); }
  #undef PKW
  #undef PAF
  #undef VFR
  #undef PIN
  #undef MX3
  #undef GAPA
  #undef GAPB
  #undef EX
  #undef VRD
  #undef KRD
  #undef STEP
  #undef ENDW
  if(d.has_sink&&hi==0)l_reg+=__builtin_amdgcn_exp2f(d.sink_l2-mhat);
  {auto rr=__builtin_amdgcn_permlane32_swap(__float_as_uint(l_reg),__float_as_uint(l_reg),false,false);l_reg=__uint_as_float(rr[0])+__uint_as_float(rr[1]);}
  if(hi==0)wsf[32+r32]=l_reg;asm volatile("s_waitcnt lgkmcnt(0)":::"memory");
  float rli[16];
  #pragma unroll
  for(int r=0;r<16;++r)rli[r]=__builtin_amdgcn_rcpf(wsf[32+crow(r,hi)]);
  bf16*Ow=d.O+(size_t)(wid*32)*d.op;
  { bf16*stg=(bf16*)(shm+LDS_OST)+wid*2048;
    #pragma unroll
    for(int r=0;r<16;++r){const int orow=crow(r,hi);
      #pragma unroll
      for(int d0=0;d0<2;++d0)stg[orow*64+d0*32+r32]=(bf16)f2bf(o[d0][r]*rli[r]);}
    asm volatile("s_waitcnt lgkmcnt(0)":::"memory");
    #pragma unroll
    for(int i=0;i<4;++i){const int row=i*8+(lane>>3),ch=lane&7; const u32x4 v=*(const u32x4*)(stg+row*64+ch*8); st16_wtw<2>(Ow+(size_t)row*d.op+ch*8,v);} }
  asm volatile("s_waitcnt lgkmcnt(0)\n\ts_barrier":::"memory");
  #undef DMA_K
  #undef TROW
  #undef DMA_V
  #undef CMASK
  #undef START
  #undef RESC
  #undef ROT
}

#undef SBAR
#undef WAIT_BAR
}
namespace gla {
constexpr int S32 = 40, S64 = 72;
struct Par {
    const bf16* P; bf16* CAT; float* GU; float* GDEC; float* BC; float* CARRY;
    const float *wgf, *bgf, *wgb, *bgb, *gnorm;
};
__device__ __forceinline__ int chunk_row(int b, int n) { return n < 4 ? NLAT + b * CTXL + 64 * n : b * SEQ + 64 * (n - 4); }
__device__ __forceinline__ int chunk_dir(int n, int dir) { return dir == 0 ? n : (n < 4 ? 3 - n : 135 - n); }
template <int KS>
__device__ __forceinline__ f32x16 mm_tile(f32x16 c, const bf16* A, int sa, const bf16* Bt, int sb, int r32, int hi) {
#pragma unroll
    for (int s = 0; s < KS; ++s) {
        const bf16x8 a = *reinterpret_cast<const bf16x8*>(A + r32 * sa + 16 * s + 8 * hi);
        const bf16x8 b = *reinterpret_cast<const bf16x8*>(Bt + r32 * sb + 16 * s + 8 * hi);
        c = __builtin_amdgcn_mfma_f32_32x32x16_bf16(a, b, c, 0, 0, 0);
    }
    return c;
}
__device__ __forceinline__ float decay_g(const bf16* zl, int tok, int dir, const float (&w)[16], float bias) {
    const v4u* zp = (const v4u*)(zl + tok * 32 + dir * 16);
    const v4u z0 = zp[0], z1 = zp[1];
    float a = bias;
    a += bflo(z0.x) * w[0] + bfhi(z0.x) * w[1] + bflo(z0.y) * w[2] + bfhi(z0.y) * w[3] + bflo(z0.z) * w[4] + bfhi(z0.z) * w[5] + bflo(z0.w) * w[6] + bfhi(z0.w) * w[7];
    a += bflo(z1.x) * w[8] + bfhi(z1.x) * w[9] + bflo(z1.y) * w[10] + bfhi(z1.y) * w[11] + bflo(z1.z) * w[12] + bfhi(z1.z) * w[13] + bflo(z1.w) * w[14] + bfhi(z1.w) * w[15];
    const float ls = __builtin_fminf(a, 0.f) - 0.6931471805599453f * __builtin_amdgcn_logf(1.0f + __builtin_amdgcn_exp2f(-LOG2E * __builtin_fabsf(a)));
    return ls * (1.0f / 16.0f);
}
__device__ __forceinline__ void decay_totals(float& bend, float& carry, const bf16* zl, const float (&w)[16], float bias, int dir, int half) {
    float tot = 0.f;
#pragma unroll 4
    for (int ii = 0; ii < 32; ++ii) tot += decay_g(zl, 32 * half + ii, dir, w, bias);
    const float oth = __shfl_xor(tot, 32);
    bend = tot + oth; carry = (half == (dir == 0 ? 1 : 0)) ? oth : 0.f;
}
__device__ __forceinline__ void load_z(bf16* zl, const bf16* P, int row0, int tid) {
    if (tid < 256) { const int j = tid >> 2, c = tid & 3; *(v4u*)(zl + j * 32 + c * 8) = *(const v4u*)(P + (size_t)(row0 + j) * INWP + D_ZF + c * 8); }
}
__device__ __forceinline__ void ld_rows32(v4u (&pc)[2], const bf16* P, int row0, int col, int lane) {
#pragma unroll
    for (int i = 0; i < 2; ++i) { const int pidx = lane + 64 * i; pc[i] = *(const v4u*)(P + (size_t)(row0 + (pidx >> 2)) * INWP + col + (pidx & 3) * 8); }
}
__device__ __forceinline__ void st_rows32(bf16* dst, const v4u (&pc)[2], int lane) {
#pragma unroll
    for (int i = 0; i < 2; ++i) { const int pidx = lane + 64 * i; *(v4u*)(dst + (pidx >> 2) * S32 + (pidx & 3) * 8) = pc[i]; }
}
__device__ __forceinline__ void load_vt(bf16* Vt, const bf16* P, int row0, int h, int part, int lane) {
    const int c8 = lane & 7, jj = lane >> 3;
#pragma unroll
    for (int it = 0; it < 4; ++it) {
        const int j = 32 * part + it * 8 + jj;
        const v4u x = *(const v4u*)(P + (size_t)(row0 + j) * INWP + D_V + h * 64 + c8 * 8);
        bf16* dst = Vt + (c8 * 8) * S64 + j;
        dst[0 * S64] = (bf16)(x.x & 0xffff); dst[1 * S64] = (bf16)(x.x >> 16); dst[2 * S64] = (bf16)(x.y & 0xffff); dst[3 * S64] = (bf16)(x.y >> 16);
        dst[4 * S64] = (bf16)(x.z & 0xffff); dst[5 * S64] = (bf16)(x.z >> 16); dst[6 * S64] = (bf16)(x.w & 0xffff); dst[7 * S64] = (bf16)(x.w >> 16);
    }
}
__device__ __forceinline__ void g1_unit(const Par& p, int b, int n, char* shm) {
    int tid_ = threadIdx.x; asm volatile("" : "+v"(tid_));
    const int tid = tid_, lane = tid & 63, r32 = lane & 31, hi = lane >> 5; const int wid = __builtin_amdgcn_readfirstlane(tid >> 6);
    const int h = wid >> 1, dir = wid & 1, row0 = chunk_row(b, n);
    char* pr = shm + (wid >> 1) * 32768;
    bf16* KdT = (bf16*)(pr + (wid & 1) * 4608);
    bf16* Vt = (bf16*)(pr + 9216);
    bf16* Kr = (bf16*)(pr + 18432);
    bf16* zl = (bf16*)(shm + 131072);
    const int k = lane & 31, half = lane >> 5;
    v4u pc[2]; ld_rows32(pc, p.P, row0 + 32 * dir, D_K + h * 32, lane);
    float w[16];
    { const float* wg = dir == 0 ? p.wgf : p.wgb;
#pragma unroll
      for (int j = 0; j < 16; ++j) w[j] = wg[j * 128 + h * 32 + k]; }
    const float bias = (dir == 0 ? p.bgf : p.bgb)[h * 32 + k];
    {
        v4u zr = {0u, 0u, 0u, 0u}; { const int j = (tid & 255) >> 2, c = tid & 3; zr = *(const v4u*)(p.P + (size_t)(row0 + j) * INWP + D_ZF + c * 8); }
        v4u vx[4]; const int c8 = lane & 7, jj = lane >> 3;
#pragma unroll
        for (int it = 0; it < 4; ++it) { const int j = 32 * dir + it * 8 + jj; vx[it] = *(const v4u*)(p.P + (size_t)(row0 + j) * INWP + D_V + h * 64 + c8 * 8); }
        asm volatile("" : "+v"(zr), "+v"(vx[0]), "+v"(vx[1]), "+v"(vx[2]), "+v"(vx[3]));
        if (tid < 256) { const int j = tid >> 2, c = tid & 3; *(v4u*)(zl + j * 32 + c * 8) = zr; }
#pragma unroll
        for (int it = 0; it < 4; ++it) { const int j = 32 * dir + it * 8 + jj; const v4u x = vx[it]; bf16* dst = Vt + (c8 * 8) * S64 + j;
            dst[0 * S64] = (bf16)(x.x & 0xffff); dst[1 * S64] = (bf16)(x.x >> 16); dst[2 * S64] = (bf16)(x.y & 0xffff); dst[3 * S64] = (bf16)(x.y >> 16);
            dst[4 * S64] = (bf16)(x.z & 0xffff); dst[5 * S64] = (bf16)(x.z >> 16); dst[6 * S64] = (bf16)(x.w & 0xffff); dst[7 * S64] = (bf16)(x.w >> 16); } }
    st_rows32(Kr + 32 * dir * S32, pc, lane);
    __syncthreads();
    float loc = 0.f;
#pragma unroll 2
    for (int s = 0; s < 32; ++s) {
        const int i = 32 * half + (dir == 0 ? s : 31 - s);
        loc += decay_g(zl, i, dir, w, bias);
        KdT[k * S64 + i] = (bf16)f2bf(bf2f(Kr[i * S32 + k]) * __expf(-loc));
        p.BC[(size_t)(row0 + i) * 256 + dir * 128 + h * 32 + k] = loc;
    }
    const float oth = __shfl_xor(loc, 32), bend = loc + oth;
    const float carry = (half == (dir == 0 ? 1 : 0)) ? oth : 0.f;
    p.CARRY[(((size_t)(b * NCH + n) * 2 + dir) * 2 + half) * 128 + h * 32 + k] = carry;
    float* Fs = (float*)(pr + 23552) + (wid & 1) * 64;
    Fs[half * 32 + k] = __expf(bend - carry);
    const int seq = (b * 4 + h) * 2 + dir, nd = chunk_dir(n, dir);
    if (half == 0) p.GDEC[((size_t)seq * NCH + nd) * 32 + k] = __expf(bend);
    LDS_WAIT();
    float* up = p.GU + ((size_t)seq * NCH + nd) * 2048;
#pragma unroll
    for (int dt = 0; dt < 2; ++dt) {
        f32x16 c0 = {}, c1 = {};
        c0 = mm_tile<2>(c0, KdT, S64, Vt + (32 * dt) * S64, S64, r32, hi);
        c1 = mm_tile<2>(c1, KdT + 32, S64, Vt + (32 * dt) * S64 + 32, S64, r32, hi);
#pragma unroll
        for (int r = 0; r < 16; ++r) { const int kk = att::crow(r, hi); (up + ((r & 3) + 8 * (r >> 2)) * 64 + 32 * dt)[(unsigned)(4 * hi * 64 + r32)] = Fs[kk] * c0[r] + Fs[32 + kk] * c1[r]; }
    }
    __syncthreads();
}
__device__ __forceinline__ void g2_scan(float* GU, const float* GDEC, int gt) {
    if (gt >= 32 * 2048) return;
    const int seq = gt >> 11, e = gt & 2047, k = e >> 6;
    float* up = GU + (size_t)seq * NCH * 2048 + e; const float* dp = GDEC + (size_t)seq * NCH * 32 + k;
    float s = 0.f;
    static_assert(NCH % 33 == 0, "scan blocking");
#pragma unroll 1
    for (int n0 = 0; n0 < NCH; n0 += 33) { float uu[33], dd[33];
#pragma unroll
        for (int j = 0; j < 33; ++j) { uu[j] = up[(size_t)(n0 + j) * 2048]; dd[j] = dp[(n0 + j) * 32]; }
#pragma unroll
        for (int j = 0; j < 33; ++j) { up[(size_t)(n0 + j) * 2048] = s; s = s * dd[j] + uu[j]; } }
}
struct G3Lds { bf16 *Kd, *St, *Vt, *Qd, *AT, *zl; };
struct G3In { f32x4 sv[4]; v4u pq[2], pk[2]; f32x4 pb[2][2]; };
template <int DIR>
__device__ __forceinline__ void g3_load(G3In& I, const Par& p, int row0, int b, int n, int h, int ih, int lane) {
    const int seq = (b * 4 + h) * 2 + DIR, nd = chunk_dir(n, DIR);
    const float* sp = p.GU + ((size_t)seq * NCH + nd) * 2048;
    const int t128 = ih * 64 + lane;
#pragma unroll
    for (int it = 0; it < 4; ++it) I.sv[it] = __builtin_nontemporal_load((const f32x4*)(sp + (it * 128 + t128) * 4));
#pragma unroll
    for (int i = 0; i < 2; ++i) { const int item = lane + 64 * i, t = item >> 2, g8 = item & 3; const size_t row = (size_t)(row0 + 32 * ih + t);
        I.pq[i] = *(const v4u*)(p.P + row * INWP + D_Q + h * 32 + g8 * 8); I.pk[i] = *(const v4u*)(p.P + row * INWP + D_K + h * 32 + g8 * 8);
        const float* bp = p.BC + row * 256 + DIR * 128 + h * 32 + g8 * 8; I.pb[i][0] = __builtin_nontemporal_load((const f32x4*)bp); I.pb[i][1] = __builtin_nontemporal_load((const f32x4*)(bp + 4)); }
    { const int g8 = lane & 3; const float* cp = p.CARRY + (((size_t)(b * NCH + n) * 2 + DIR) * 2 + ih) * 128 + h * 32 + g8 * 8;
      const f32x4 c0 = *(const f32x4*)cp, c1 = *(const f32x4*)(cp + 4);
#pragma unroll
      for (int i = 0; i < 2; ++i) { I.pb[i][0] += c0; I.pb[i][1] += c1; } }
}
template <int DIR>
__device__ __forceinline__ void g3_dir(f32x16 (&o)[2], const G3In& I, const G3Lds& L, int ih, int lane) {
    const int r32 = lane & 31, hi = lane >> 5, t128 = ih * 64 + lane;
#pragma unroll
    for (int i = 0; i < 2; ++i) { const int item = lane + 64 * i, t = item >> 2, g8 = item & 3;
        float e[8], qf[8], kf[8];
#pragma unroll
        for (int j = 0; j < 4; ++j) { e[j] = I.pb[i][0][j]; e[4 + j] = I.pb[i][1][j]; }
        const v4u pq = I.pq[i], pk = I.pk[i];
        qf[0] = bflo(pq.x); qf[1] = bfhi(pq.x); qf[2] = bflo(pq.y); qf[3] = bfhi(pq.y); qf[4] = bflo(pq.z); qf[5] = bfhi(pq.z); qf[6] = bflo(pq.w); qf[7] = bfhi(pq.w);
        kf[0] = bflo(pk.x); kf[1] = bfhi(pk.x); kf[2] = bflo(pk.y); kf[3] = bfhi(pk.y); kf[4] = bflo(pk.z); kf[5] = bfhi(pk.z); kf[6] = bflo(pk.w); kf[7] = bfhi(pk.w);
#pragma unroll
        for (int j = 0; j < 8; ++j) { qf[j] *= __builtin_amdgcn_exp2f(e[j] * LOG2E) * 0.17677669529663687f; kf[j] *= __builtin_amdgcn_exp2f(-e[j] * LOG2E); }
        v4u wq, wk; wq.x = cvtpk(qf[0], qf[1]); wq.y = cvtpk(qf[2], qf[3]); wq.z = cvtpk(qf[4], qf[5]); wq.w = cvtpk(qf[6], qf[7]);
        wk.x = cvtpk(kf[0], kf[1]); wk.y = cvtpk(kf[2], kf[3]); wk.z = cvtpk(kf[4], kf[5]); wk.w = cvtpk(kf[6], kf[7]);
        *(v4u*)(L.Qd + t * S32 + g8 * 8) = wq; *(v4u*)(L.Kd + (32 * ih + t) * S32 + g8 * 8) = wk; }
#pragma unroll
    for (int it = 0; it < 4; ++it) { const int e4 = (it * 128 + t128) * 4, kk = e4 >> 6, d0 = e4 & 63; const f32x4 v = I.sv[it];
        L.St[(d0 + 0) * S32 + kk] = (bf16)f2bf(v.x); L.St[(d0 + 1) * S32 + kk] = (bf16)f2bf(v.y); L.St[(d0 + 2) * S32 + kk] = (bf16)f2bf(v.z); L.St[(d0 + 3) * S32 + kk] = (bf16)f2bf(v.w); }
    __syncthreads();
#pragma unroll
    for (int jt = 0; jt < 2; ++jt) {
        f32x16 c = {};
        c = mm_tile<2>(c, L.Qd, S32, L.Kd + (32 * jt) * S32, S32, r32, hi);
        const int j = 32 * jt + r32;
#pragma unroll
        for (int r = 0; r < 16; ++r) { const int il = att::crow(r, hi), ig = 32 * ih + il; const bool keep = DIR == 0 ? (j <= ig) : (j >= ig);
            L.AT[il * S64 + j] = (bf16)f2bf(keep ? c[r] : 0.f); }
    }
    LDS_WAIT();
#pragma unroll
    for (int dt = 0; dt < 2; ++dt) {
        o[dt] = mm_tile<4>(o[dt], L.AT, S64, L.Vt + (32 * dt) * S64, S64, r32, hi);
        o[dt] = mm_tile<2>(o[dt], L.Qd, S32, L.St + (32 * dt) * S32, S32, r32, hi);
    }
    __syncthreads();
}
__device__ __forceinline__ void g3_unit(const Par& p, int b, int n, char* shm) {
    int tid_ = threadIdx.x; asm volatile("" : "+v"(tid_));
    const int tid = tid_, lane = tid & 63, r32 = lane & 31, hi = lane >> 5; const int wid = __builtin_amdgcn_readfirstlane(tid >> 6);
    const int h = wid >> 1, ih = wid & 1, row0 = chunk_row(b, n);
    char* pr = shm + (wid >> 1) * 33792;
    G3Lds L;
    L.Kd = (bf16*)pr;
    L.St = (bf16*)(pr + 5120);
    L.Vt = (bf16*)(pr + 10240);
    L.Qd = (bf16*)(pr + 19456 + ih * 7168);
    L.AT = (bf16*)(pr + 19456 + ih * 7168 + 2560);
    L.zl = nullptr;
    G3In I0, I1; v4u pg[4];
    g3_load<0>(I0, p, row0, b, n, h, ih, lane); g3_load<1>(I1, p, row0, b, n, h, ih, lane);
#pragma unroll
    for (int i = 0; i < 4; ++i) { const int pidx = lane + 64 * i; pg[i] = *(const v4u*)(p.P + (size_t)(row0 + 32 * ih + (pidx >> 3)) * INWP + D_R + h * 64 + (pidx & 7) * 8); }
    load_vt(L.Vt, p.P, row0, h, ih, lane);
    f32x16 o[2]; o[0] = f32x16{}; o[1] = f32x16{};
    g3_dir<0>(o, I0, L, ih, lane);
    g3_dir<1>(o, I1, L, ih, lane);
#pragma unroll
    for (int i = 0; i < 4; ++i) { const int pidx = lane + 64 * i; *(v4u*)(L.AT + (pidx >> 3) * S64 + (pidx & 7) * 8) = pg[i]; }
    const float gn0 = p.gnorm[r32], gn1 = p.gnorm[32 + r32];
    const unsigned lc_ = (unsigned)(4 * hi * DM + r32);
    LDS_WAIT();
#pragma unroll
    for (int r = 0; r < 16; ++r) {
        float ss = o[0][r] * o[0][r] + o[1][r] * o[1][r];
        ss = ss + __builtin_bit_cast(float, __builtin_amdgcn_update_dpp(0, __builtin_bit_cast(int, ss), 0xB1, 0xf, 0xf, true));
        ss = ss + __builtin_bit_cast(float, __builtin_amdgcn_update_dpp(0, __builtin_bit_cast(int, ss), 0x4E, 0xf, 0xf, true));
        ss = ss + __builtin_bit_cast(float, __builtin_amdgcn_update_dpp(0, __builtin_bit_cast(int, ss), 0x141, 0xf, 0xf, true));
        ss = ss + __builtin_bit_cast(float, __builtin_amdgcn_update_dpp(0, __builtin_bit_cast(int, ss), 0x140, 0xf, 0xf, true));
        ss += __shfl_xor(ss, 16);
        const float rstd = __builtin_amdgcn_rsqf(ss * (1.0f / 64.0f) + RMS_EPS);
        const int il = att::crow(r, hi);
        bf16* cp = p.CAT + (size_t)(row0 + 32 * ih + (r & 3) + 8 * (r >> 2)) * DM + 768 + h * 64;
        cp[lc_] = (bf16)f2bf(o[0][r] * rstd * gn0 * fsilu(bf2f(L.AT[il * S64 + r32])));
        cp[lc_ + 32] = (bf16)f2bf(o[1][r] * rstd * gn1 * fsilu(bf2f(L.AT[il * S64 + 32 + r32])));
    }
    __syncthreads();
}
}
#if defined(SELFCHECK) && SELFCHECK
namespace chk {
__device__ __forceinline__ void item(const unsigned char* ws, const float* rpb_l, const float* sink_l, int row, int mx, int h, int lane, float* acc2) {
    const bf16* P = (const bf16*)(ws + WS_P); const bf16* QC = (const bf16*)(ws + WS_QC); const bf16* KC = (const bf16*)(ws + WS_KC); const bf16* VC = (const bf16*)(ws + WS_VC); const bf16* CATp = (const bf16*)(ws + WS_CAT);
    const bool lat = row < NLAT; const int b = lat ? row >> 13 : (row - NLAT) >> 8; const int t = row & (SEQ - 1), r = t >> 6, c = t & 63;
    const bf16* qp; const bf16* Kb; const bf16* Vb; int kp;
    if (mx == 0) { qp = P + (size_t)row * INWP + A_Q + h * 64; Kb = P + A_K + h * 64; Vb = P + A_V + h * 64; kp = INWP; }
    else if (mx == 1) { qp = P + (size_t)row * INWP + B_Q + h * 64; Kb = P + B_K + (h >> 1) * 64; Vb = P + B_V + (h >> 1) * 64; kp = INWP; }
    else { qp = QC + (size_t)row * 256 + h * 64; Kb = KC + h * 64; Vb = VC + h * 64; kp = 256; }
    float q[64];
#pragma unroll
    for (int d = 0; d < 64; ++d) q[d] = bf2f(qp[d]);
    if (mx == 2 && lat) {
#pragma unroll
        for (int g2 = 0; g2 < 2; ++g2) { const float pos = (float)(g2 == 0 ? r : c);
#pragma unroll
            for (int i = 0; i < 8; ++i) { const float ang = pos * exp2f(-(float)i * (13.287712379549449f / 8.0f)); const float cs_ = __cosf(ang), sn_ = __sinf(ang);
                const float x1 = q[32 + 16 * g2 + i], x2 = q[32 + 16 * g2 + 8 + i]; q[32 + 16 * g2 + i] = x1 * cs_ - x2 * sn_; q[32 + 16 * g2 + 8 + i] = x2 * cs_ + x1 * sn_; } }
    }
    const int rs = r - 4 < 0 ? 0 : (r - 4 > 120 ? 120 : r - 4), cs = c - 8 < 0 ? 0 : (c - 8 > 48 ? 48 : c - 8);
    const int nlatk = !lat ? 0 : (mx == 0 ? 128 : (mx == 1 ? 257 : SEQ)), ncand = nlatk + CTXL;
    float mxv = -1e30f;
    for (int pass = 0; pass < 2; ++pass) {
        float l = 0.f, o[64];
#pragma unroll
        for (int d = 0; d < 64; ++d) o[d] = 0.f;
        float pm = -1e30f;
        for (int j = lane; j < ncand; j += 64) {
            int krow; float bias = 0.f; bool ok = true;
            if (j >= nlatk) krow = NLAT + b * CTXL + (j - nlatk);
            else if (mx == 0) { const int i = j >> 4, jj = j & 15; krow = b * SEQ + (rs + i) * 64 + cs + jj; bias = rpb_l[h * 465 + (rs + i - r + 7) * 31 + (cs + jj - c + 15)] * LOG2E; }
            else if (mx == 1) { const int kpos = t - 128 + j; ok = kpos >= 0 && kpos < SEQ; krow = b * SEQ + (ok ? kpos : 0); }
            else krow = b * SEQ + j;
            if (!ok) continue;
            const bf16* kr = Kb + (size_t)krow * kp; float s = bias;
#pragma unroll
            for (int d = 0; d < 64; d += 2) { const unsigned w = *(const unsigned*)(kr + d); s += q[d] * bflo(w) + q[d + 1] * bfhi(w); }
            if (pass == 0) pm = fmaxf(pm, s);
            else { const float pe = __builtin_amdgcn_exp2f(s - mxv); l += pe; const bf16* vr = Vb + (size_t)krow * kp;
#pragma unroll
                for (int d = 0; d < 64; d += 2) { const unsigned w = *(const unsigned*)(vr + d); o[d] += pe * bflo(w); o[d + 1] += pe * bfhi(w); } }
        }
        if (pass == 0) {
#pragma unroll
            for (int off = 32; off >= 1; off >>= 1) pm = fmaxf(pm, __shfl_xor(pm, off));
            mxv = pm;
        } else {
            l = wave_sum(l); if (mx == 1) l += __builtin_amdgcn_exp2f(sink_l[h] * LOG2E - mxv);
            float e2 = 0.f, r2 = 0.f;
#pragma unroll
            for (int d = 0; d < 64; ++d) { const float od = wave_sum(o[d]) / l; const float cd = bf2f(CATp[(size_t)row * DM + mx * 256 + h * 64 + d]); e2 += (od - cd) * (od - cd); r2 += od * od; }
            if (lane == 0) { atomicAdd(acc2, e2); atomicAdd(acc2 + 1, r2); atomicAdd(acc2 + 2 + 2 * mx, e2); atomicAdd(acc2 + 3 + 2 * mx, r2); }
        }
    }
}
__device__ __forceinline__ void rope_pair(float& x1, float& x2, float pos, int i, int half) {
    const float ang = pos * exp2f(-(float)i * (13.287712379549449f / (float)half)); const float cs_ = __cosf(ang), sn_ = __sinf(ang);
    const float a = x1, b = x2; x1 = a * cs_ - b * sn_; x2 = b * cs_ + a * sn_;
}
__device__ __forceinline__ void proj_item(const unsigned char* ws, const float* w_in_l, const float* gq, const float* gkv, const float* wuq, const float* wukv, int row, int lane, float* pl, float* acc2) {
    const bf16* Hh = (const bf16*)(ws + WS_H) + (size_t)row * HLD; const bf16* P = (const bf16*)(ws + WS_P) + (size_t)row * INWP;
    const bf16* QCr = (const bf16*)(ws + WS_QC) + (size_t)row * 256; const bf16* KCr = (const bf16*)(ws + WS_KC) + (size_t)row * 256; const bf16* VCr = (const bf16*)(ws + WS_VC) + (size_t)row * 256;
    const bool lat = row < NLAT; const int t = row & (SEQ - 1); const float pr_ = (float)(t >> 6), pc_ = (float)(t & 63);
    for (int j = 0; j < 15; ++j) { const int cc = lane + 64 * j; if (cc >= 928) break; const int col = 768 + cc; float s = 0.f;
        for (int k = 0; k < DM; ++k) { float hv = bf2f(Hh[k]); if (ROUTER_SPLIT) hv += bf2f(Hh[DM + k]); s += hv * w_in_l[(size_t)k * INW + col]; }
        pl[cc] = s; }
    LDS_WAIT();
    float e2[7] = {0.f, 0.f, 0.f, 0.f, 0.f, 0.f, 0.f}, r2[7] = {0.f, 0.f, 0.f, 0.f, 0.f, 0.f, 0.f};
#define CHK_ACC(cat, ref, got) do { const float rf_ = (ref), gt_ = (got); e2[cat] += (rf_ - gt_) * (rf_ - gt_); r2[cat] += rf_ * rf_; } while (0)
    for (int pi = lane; pi < 6 * 32; pi += 64) { const int hd = pi >> 5, i = pi & 31, g2 = i >> 4, ii = i & 15; const int base = hd * 64 + 32 * g2 + ii;
        float x1 = pl[base], x2 = pl[base + 16]; if (lat) rope_pair(x1, x2, g2 == 0 ? pr_ : pc_, ii, 16);
        if (hd < 4) { CHK_ACC(0, x1 * C2, bf2f(P[B_Q + base])); CHK_ACC(0, x2 * C2, bf2f(P[B_Q + base + 16])); } else { CHK_ACC(1, x1, bf2f(P[B_Q + base])); CHK_ACC(1, x2, bf2f(P[B_Q + base + 16])); } }
    for (int i = lane; i < 128; i += 64) CHK_ACC(2, pl[B_V - 768 + i], bf2f(P[B_V + i]));
    float sq = 0.f, sk = 0.f;
    for (int i = lane; i < 256; i += 64) { const float v = pl[C_Q - 768 + i]; sq += v * v; }
    for (int i = lane; i < 128; i += 64) { const float v = pl[C_KV - 768 + i]; sk += v * v; }
    const float rq = 1.0f / sqrtf(wave_sum(sq) / 256.f + RMS_EPS), rk = 1.0f / sqrtf(wave_sum(sk) / 128.f + RMS_EPS);
    for (int n = lane; n < 256; n += 64) { float s = 0.f; for (int k = 0; k < 256; ++k) s += pl[C_Q - 768 + k] * rq * gq[k] * wuq[(size_t)k * 256 + n]; CHK_ACC(3, s * C2, bf2f(QCr[n])); }
    for (int n = lane; n < 384; n += 64) { float s = 0.f; for (int k = 0; k < 128; ++k) s += pl[C_KV - 768 + k] * rk * gkv[k] * wukv[(size_t)k * 384 + n];
        const int h = n / 96, jj = n % 96; if (jj < 32) CHK_ACC(4, s, bf2f(KCr[h * 64 + jj])); else CHK_ACC(6, s, bf2f(VCr[h * 64 + jj - 32])); }
    for (int pi = lane; pi < 4 * 16; pi += 64) { const int h = pi >> 4, i = pi & 15, g2 = i >> 3, ii = i & 7; const int base = 16 * g2 + ii;
        float x1 = pl[C_KR - 768 + base], x2 = pl[C_KR - 768 + base + 8]; if (lat) rope_pair(x1, x2, g2 == 0 ? pr_ : pc_, ii, 8);
        CHK_ACC(5, x1, bf2f(KCr[h * 64 + 32 + base])); CHK_ACC(5, x2, bf2f(KCr[h * 64 + 32 + base + 8])); }
#undef CHK_ACC
#pragma unroll
    for (int cat = 0; cat < 7; ++cat) { const float a = wave_sum(e2[cat]), b = wave_sum(r2[cat]); if (lane == 0) { atomicAdd(acc2 + 16 + 2 * cat, a); atomicAdd(acc2 + 17 + 2 * cat, b); } }
}
constexpr int NP_ROWS = 112;
__device__ __forceinline__ int proj_row(int s) { return s < 96 ? (int)(((long)s * 7919 + 5) % NLAT) : NLAT + ((s - 96) * 61 + 7) % NCTX; }
constexpr int NS_LAT = 640, NS_CTX = 48, NS_EDGE = 28;
__device__ __forceinline__ int sample_row(int s) {
    if (s < NS_LAT) return (int)(((long)s * 6151 + 17) % NLAT);
    s -= NS_LAT;
    if (s < NS_EDGE) { const int b = s / 7, k = s % 7; const int tt[7] = {0, 1, 63, 64, 4095, 8127, 8191}; int t = 0;
#pragma unroll
        for (int i = 0; i < 7; ++i) if (i == k) t = tt[i];
        return b * SEQ + t; }
    s -= NS_EDGE;
    return NLAT + (s * 21 + 3) % NCTX;
}
}
#endif
struct RowMapId { int off; __device__ __forceinline__ int operator()(int n) const { return off + n; } };
struct RowMapIl { int sub; __device__ __forceinline__ int operator()(int n) const { return 8 * (n >> 2) + 4 * sub + (n & 3); } };
struct RowMapKV { __device__ __forceinline__ int operator()(int n) const { const int h = n / 96, j = n % 96; return j < 32 ? h * 64 + j : 256 + h * 64 + (j - 32); } };
template <class RowMap>
__device__ __forceinline__ void tr_item(const float* W, int ldw, int k0, int n0, bf16* WT, int ldt, const RowMap& rm, const float* kscale, float* scr, int lane) {
    f32x4 xr[16];
#pragma unroll
    for (int it = 0; it < 16; ++it) { const int k = it * 4 + (lane >> 4), n4 = (lane & 15) * 4;
        xr[it] = __builtin_nontemporal_load((const f32x4*)(W + (size_t)(k0 + k) * ldw + n0 + n4)); }
    asm volatile("" : "+v"(xr[0]), "+v"(xr[1]), "+v"(xr[2]), "+v"(xr[3]), "+v"(xr[4]), "+v"(xr[5]), "+v"(xr[6]), "+v"(xr[7]), "+v"(xr[8]), "+v"(xr[9]), "+v"(xr[10]), "+v"(xr[11]), "+v"(xr[12]), "+v"(xr[13]), "+v"(xr[14]), "+v"(xr[15]));
#pragma unroll
    for (int it = 0; it < 16; ++it) { const int k = it * 4 + (lane >> 4), n4 = (lane & 15) * 4;
        f32x4 x = xr[it];
        if (kscale) x = x * kscale[k0 + k];
        float* s = scr + k * 65 + n4; s[0] = x.x; s[1] = x.y; s[2] = x.z; s[3] = x.w; }
    LDS_WAIT();
#pragma unroll 2
    for (int it = 0; it < 8; ++it) { const int n = it * 8 + (lane >> 3), c = lane & 7; const float* s = scr + (8 * c) * 65 + n;
        v4u o; o.x = pk2(s[0 * 65], s[1 * 65]); o.y = pk2(s[2 * 65], s[3 * 65]); o.z = pk2(s[4 * 65], s[5 * 65]); o.w = pk2(s[6 * 65], s[7 * 65]);
        *(v4u*)(WT + (size_t)rm(n0 + n) * ldt + k0 + 8 * c) = o; }
    LDS_WAIT();
}
__device__ __forceinline__ void ld_row(const float* p, int lane, f32x4 (&v)[4]) {
#pragma unroll
    for (int j = 0; j < 2; ++j) { v[2 * j] = *(const f32x4*)(p + 512 * j + 8 * lane); v[2 * j + 1] = *(const f32x4*)(p + 512 * j + 8 * lane + 4); }
}
__device__ __forceinline__ void ld_row_nt(const float* p, int lane, f32x4 (&v)[4]) {
#pragma unroll
    for (int j = 0; j < 2; ++j) { v[2 * j] = __builtin_nontemporal_load((const f32x4*)(p + 512 * j + 8 * lane)); v[2 * j + 1] = __builtin_nontemporal_load((const f32x4*)(p + 512 * j + 8 * lane + 4)); }
}
__device__ __forceinline__ void ld_row_nt(const bf16* p, int lane, f32x4 (&v)[4]) {
#pragma unroll
    for (int j = 0; j < 2; ++j) { const v4u w = __builtin_nontemporal_load((const v4u*)(p + 512 * j + 8 * lane)); v[2 * j] = (f32x4){bflo(w.x), bfhi(w.x), bflo(w.y), bfhi(w.y)}; v[2 * j + 1] = (f32x4){bflo(w.z), bfhi(w.z), bflo(w.w), bfhi(w.w)}; }
}
__device__ __forceinline__ void st_row(bf16* p, int lane, const f32x4 (&v)[4]) {
#pragma unroll
    for (int j = 0; j < 2; ++j) { v4u w; const f32x4 a = v[2 * j], b = v[2 * j + 1]; w.x = cvtpk(a.x, a.y); w.y = cvtpk(a.z, a.w); w.z = cvtpk(b.x, b.y); w.w = cvtpk(b.z, b.w); *(v4u*)(p + 512 * j + 8 * lane) = w; }
}
__device__ __forceinline__ void st_row(float* p, int lane, const f32x4 (&v)[4]) {
#pragma unroll
    for (int j = 0; j < 2; ++j) { st16_wtw<1>(p + 512 * j + 8 * lane, __builtin_bit_cast(v4u, v[2 * j])); st16_wtw<1>(p + 512 * j + 8 * lane + 4, __builtin_bit_cast(v4u, v[2 * j + 1])); }
}
__device__ __forceinline__ void st_row_hilo(bf16* p, int lane, const f32x4 (&v)[4]) {
#pragma unroll
    for (int j = 0; j < 2; ++j) { v4u w, wl; const f32x4 a = v[2 * j], b = v[2 * j + 1];
        w.x = cvtpk(a.x, a.y); w.y = cvtpk(a.z, a.w); w.z = cvtpk(b.x, b.y); w.w = cvtpk(b.z, b.w);
        wl.x = cvtpk(a.x - bflo(w.x), a.y - bfhi(w.x)); wl.y = cvtpk(a.z - bflo(w.y), a.w - bfhi(w.y)); wl.z = cvtpk(b.x - bflo(w.z), b.y - bfhi(w.z)); wl.w = cvtpk(b.z - bflo(w.w), b.w - bfhi(w.w));
        st16_wtw<1>(p + 512 * j + 8 * lane, w); if (ROUTER_SPLIT) st16_wtw<1>(p + DM + 512 * j + 8 * lane, wl); }
}
__device__ __forceinline__ void tr_item_router(const float* W, int k0, int n0, bf16* WT, float* scr, int lane) {
#pragma unroll 4
    for (int it = 0; it < 16; ++it) { const int k = it * 4 + (lane >> 4), n4 = (lane & 15) * 4;
        const f32x4 x = *(const f32x4*)(W + (size_t)(k0 + k) * NEXP + n0 + n4);
        float* s = scr + k * 65 + n4; s[0] = x.x; s[1] = x.y; s[2] = x.z; s[3] = x.w; }
    LDS_WAIT();
#pragma unroll 2
    for (int it = 0; it < 8; ++it) { const int n = it * 8 + (lane >> 3), c = lane & 7; const float* s = scr + (8 * c) * 65 + n;
        float f[8]; v4u o, ol;
#pragma unroll
        for (int i = 0; i < 8; ++i) f[i] = s[i * 65];
        o.x = cvtpk(f[0], f[1]); o.y = cvtpk(f[2], f[3]); o.z = cvtpk(f[4], f[5]); o.w = cvtpk(f[6], f[7]);
        ol.x = cvtpk(f[0] - bflo(o.x), f[1] - bfhi(o.x)); ol.y = cvtpk(f[2] - bflo(o.y), f[3] - bfhi(o.y)); ol.z = cvtpk(f[4] - bflo(o.z), f[5] - bfhi(o.z)); ol.w = cvtpk(f[6] - bflo(o.w), f[7] - bfhi(o.w));
        bf16* d0 = WT + (size_t)(n0 + n) * HLD + k0 + 8 * c; bf16* d1 = WT + (size_t)(128 + n0 + n) * HLD + k0 + 8 * c;
        if (ROUTER_SPLIT) { *(v4u*)d0 = o; *(v4u*)(d0 + DM) = o; *(v4u*)d1 = ol; *(v4u*)(d1 + DM) = ol; }
        else { *(v4u*)d0 = o; *(v4u*)d1 = (v4u){0u, 0u, 0u, 0u}; } }
    LDS_WAIT();
}
__device__ __forceinline__ void ln_row(f32x4 (&v)[4]) {
    float s = 0.f;
#pragma unroll
    for (int j = 0; j < 4; ++j) s += (v[j].x + v[j].y) + (v[j].z + v[j].w);
    const float mean = wave_sum(s) * (1.f / DM); float s2 = 0.f;
#pragma unroll
    for (int j = 0; j < 4; ++j) { v[j] = v[j] - mean; s2 += (v[j].x * v[j].x + v[j].y * v[j].y) + (v[j].z * v[j].z + v[j].w * v[j].w); }
    const float rstd = 1.0f / sqrtf(wave_sum(s2) * (1.f / DM) + LN_EPS);
#pragma unroll
    for (int j = 0; j < 4; ++j) v[j] = v[j] * rstd;
}
template <bool ONEPLUS>
__device__ __forceinline__ void affine_row(f32x4 (&v)[4], const float* a, const float* b, int lane) {
    f32x4 av[4], bv[4]; ld_row(a, lane, av); ld_row(b, lane, bv);
#pragma unroll
    for (int j = 0; j < 4; ++j) v[j] = ONEPLUS ? v[j] * (av[j] + 1.0f) + bv[j] : v[j] * av[j] + bv[j];
}
__device__ __forceinline__ int mod_row(int row) { return row < NLAT ? (row >> 13) : 4; }

__device__ __forceinline__ int ltid() { int t = threadIdx.x; asm volatile("" : "+v"(t)); return t; }
struct Args {
    const float *x, *c, *ctx, *c_ctx, *w_ada, *b_ada, *w_in, *na_rpb, *wa_sink, *mla_g_q, *mla_g_kv, *mla_w_uq, *mla_w_ukv,
                *gla_w_gf, *gla_b_gf, *gla_w_gb, *gla_b_gb, *gla_g_norm, *w_out, *ln1_g, *ln1_b, *ln2_g, *ln2_b,
                *router_w, *router_bias, *exp_w1, *exp_w3, *exp_w2, *sh_w1, *sh_w3, *sh_w2;
    float* out; unsigned char* ws;
};
static_assert(sizeof(Args) == 33 * 8, "Args has no padding");

constexpr int CV_N = NEXP * 192, CV_P8 = ROUTER_SPLIT ? 6944 : 3500  , CV_N0 = CV_N - CV_P8 - 7680 - 4608, CV_N1 = CV_N0 + 4608, CV_N2 = CV_N1 + 7680;
constexpr int CV_L8 = ROUTER_SPLIT ? 4600 : 2300, CV_L0 = CV_N - 4608 - CV_L8, CV_L1 = CV_L0 + 4608;
template <class ArgsT> __device__ __forceinline__ void convert_experts(const ArgsT& A, int l, int lo, int hi, int gw, int NGW, float* scr, int lane) {
    bf16* we13 = (bf16*)(A.ws + WS_WE13); bf16* we2 = (bf16*)(A.ws + WS_WE2);
    for (int it = lo + gw; it < hi; it += NGW) {
        const int e = it / 192, r = it % 192, which = r >> 6, q = r & 63;
        if (which < 2) { const float* W = (which == 0 ? A.exp_w1 : A.exp_w3) + ((size_t)l * NEXP + e) * DM * DEXP;
            tr_item(W, DEXP, (q >> 2) * 64, (q & 3) * 64, we13 + (size_t)e * 512 * DM, DM, RowMapIl{which}, nullptr, scr, lane); }
        else { const float* W = A.exp_w2 + ((size_t)l * NEXP + e) * DEXP * DM;
            tr_item(W, DM, (q >> 4) * 64, (q & 15) * 64, we2 + (size_t)e * DM * DEXP, DEXP, RowMapId{0}, nullptr, scr, lane); }
    }
}

#ifndef SELFCHECK_TOL
#define SELFCHECK_TOL 0.03f
#endif
#ifndef SELFCHECK_TOL2
#define SELFCHECK_TOL2 0.02f
#endif
#ifndef PHMASK
#define PHMASK 0xffffff
#endif
#define PHON(k) (((PHMASK) >> (k)) & 1)
#ifndef DUPK
#define DUPK -1
#endif
__global__ void __launch_bounds__(512, 2) hybrid_fwd(Args A) {
    extern __shared__ __attribute__((aligned(16))) unsigned char lds[];
    const int wave = __builtin_amdgcn_readfirstlane((int)threadIdx.x >> 6);
    const int G = gridDim.x; const int bx = blockIdx.x; const int vcu = (G % 8 == 0) ? (bx % 8) * (G / 8) + bx / 8 : bx;
    const int gw = vcu * 8 + wave, NGW = G * 8;
    const bool cv_tails = (G == 256);
    GAS unsigned char* wsg = (GAS unsigned char*)A.ws;
    unsigned char* ws = (unsigned char*)wsg;
#define WS_LAUNDER() asm volatile("" : "+s"(wsg)); ws = (unsigned char*)wsg; const int tid = ltid(), lane = tid & 63; (void)lane
    gu32* ctl = (gu32*)(ws + WS_CTL);
    volatile LAS unsigned* MISC = (volatile LAS unsigned*)((LAS unsigned char*)lds + MISC_OFF);
    { const int tid = ltid(); if (tid < 128) MISC[tid] = 0u; }
    __syncthreads();
    XcdBarrier bar = xcd_barrier_post((unsigned*)(ctl + CW_BAR), MISC);
#define GRID_BAR() do { XcdBarrier b2_ = bar; GAS unsigned* bp_ = (GAS unsigned*)bar.bar; asm volatile("" : "+s"(bp_), "+s"(b2_.x)); b2_.bar = (unsigned*)bp_; xcd_barrier(b2_); } while (0)
    char* shm = (char*)lds;
#if defined(TIMEPHASE)
#ifndef TIMEQ
#define TIMEQ 100.0f
#endif
#ifndef TIMEOFF
#define TIMEOFF 0.0f
#endif
    unsigned long long t_begin_ = __builtin_amdgcn_s_memrealtime(), t_prev_ = t_begin_, t_acc_ = 0;
#define TSTAMP(k) do { const unsigned long long now_ = __builtin_amdgcn_s_memrealtime(); if ((k) == TIMEPHASE) t_acc_ += now_ - t_prev_; t_prev_ = now_; } while (0)
#else
#define TSTAMP(k) do {} while (0)
#endif
#define MODT ((float*)(ws + WS_MOD))
#define Hb ((bf16*)(ws + WS_H))
#define Pb ((bf16*)(ws + WS_P))
#define QC ((bf16*)(ws + WS_QC))
#define KC ((bf16*)(ws + WS_KC))
#define VC ((bf16*)(ws + WS_VC))
#define CAT ((bf16*)(ws + WS_CAT))
#define XA ((xa_t*)(ws + WS_XA))
#define Zb ((float*)(ws + WS_Z))
#define RSTD ((float*)(ws + WS_RSTD))

        if (PHON(0)) {
        WS_LAUNDER();
    {
        float* sc = (float*)shm;
        float* part = (float*)(shm + 20480);
        for (int i = tid; i < 5 * DM; i += 512) { const float v = i < 4 * DM ? A.c[i] : A.c_ctx[i - 4 * DM]; sc[i] = v / (1.0f + __expf(-v)); }
        __syncthreads();
        for (int grp = vcu; grp < DEPTH * 96; grp += G) {
            const int l = grp / 96, col = (grp % 96) * 64 + lane;
            const float* wp = A.w_ada + (size_t)l * DM * 6 * DM + col;
            float acc[5] = {0.f, 0.f, 0.f, 0.f, 0.f};
#pragma unroll 1
            for (int k0 = 0; k0 < 128; k0 += 32) { float wv[32];
#pragma unroll
                for (int kk = 0; kk < 32; ++kk) wv[kk] = __builtin_nontemporal_load(wp + (size_t)(wave * 128 + k0 + kk) * 6 * DM);
                asm volatile("" : "+v"(wv[16]), "+v"(wv[17]), "+v"(wv[18]), "+v"(wv[19]), "+v"(wv[20]), "+v"(wv[21]), "+v"(wv[22]), "+v"(wv[23]), "+v"(wv[24]), "+v"(wv[25]), "+v"(wv[26]), "+v"(wv[27]), "+v"(wv[28]), "+v"(wv[29]), "+v"(wv[30]), "+v"(wv[31]));
#pragma unroll
                for (int kk = 0; kk < 32; ++kk) { const int k = wave * 128 + k0 + kk;
#pragma unroll
                    for (int r = 0; r < 5; ++r) acc[r] += sc[r * DM + k] * wv[kk]; } }
#pragma unroll
            for (int r = 0; r < 5; ++r) part[(wave * 5 + r) * 64 + lane] = acc[r];
            __syncthreads();
            if (tid < 320) { const int r = tid >> 6; float s = A.b_ada[(size_t)l * 6 * DM + col];
#pragma unroll
                for (int w8 = 0; w8 < 8; ++w8) s += part[(w8 * 5 + r) * 64 + lane];
                MODT[((size_t)l * 5 + r) * 6 * DM + col] = s; }
            __syncthreads();
        }
        float* scr = (float*)(shm + wave * 16640);
        constexpr int I_IN = 16 * 39, I_OUT = 16 * 16, I_UQ = 4 * 4, I_UKV = 2 * 6, I_RT = 16 * 2, I_S1 = 16 * 4, I_S2 = 4 * 16;
        constexpr int I_L = I_IN + I_OUT + I_UQ + I_UKV + I_RT + 2 * I_S1 + I_S2;
        for (int it = gw; it < DEPTH * I_L; it += NGW) {
            const int l = it / I_L; int r = it % I_L;
            if (r < I_IN) { tr_item(A.w_in + (size_t)l * DM * INW, INW, (r / 39) * 64, (r % 39) * 64, (bf16*)(ws + WS_WIN) + (size_t)l * INWP * DM, DM, RowMapId{0}, nullptr, scr, lane); continue; } r -= I_IN;
            if (r < I_OUT) { tr_item(A.w_out + (size_t)l * DM * DM, DM, (r / 16) * 64, (r % 16) * 64, (bf16*)(ws + WS_WOUT) + (size_t)l * DM * DM, DM, RowMapId{0}, nullptr, scr, lane); continue; } r -= I_OUT;
            if (r < I_UQ) { tr_item(A.mla_w_uq + (size_t)l * 256 * 256, 256, (r / 4) * 64, (r % 4) * 64, (bf16*)(ws + WS_WUQ) + (size_t)l * 256 * 256, 256, RowMapId{0}, A.mla_g_q + l * 256, scr, lane); continue; } r -= I_UQ;
            if (r < I_UKV) { tr_item(A.mla_w_ukv + (size_t)l * 128 * 384, 384, (r / 6) * 64, (r % 6) * 64, (bf16*)(ws + WS_WUKV) + (size_t)l * 512 * 128, 128, RowMapKV{}, A.mla_g_kv + l * 128, scr, lane); continue; } r -= I_UKV;
            if (r < I_RT) { tr_item_router(A.router_w + (size_t)l * DM * NEXP, (r / 2) * 64, (r % 2) * 64, (bf16*)(ws + WS_WRT) + (size_t)l * 256 * HLD, scr, lane); continue; } r -= I_RT;
            if (r < I_S1) { tr_item(A.sh_w1 + (size_t)l * DM * 256, 256, (r / 4) * 64, (r % 4) * 64, (bf16*)(ws + WS_WS13) + (size_t)l * 512 * DM, DM, RowMapIl{0}, nullptr, scr, lane); continue; } r -= I_S1;
            if (r < I_S1) { tr_item(A.sh_w3 + (size_t)l * DM * 256, 256, (r / 4) * 64, (r % 4) * 64, (bf16*)(ws + WS_WS13) + (size_t)l * 512 * DM, DM, RowMapIl{1}, nullptr, scr, lane); continue; } r -= I_S1;
            tr_item(A.sh_w2 + (size_t)l * 256 * DM, DM, (r / 16) * 64, (r % 16) * 64, (bf16*)(ws + WS_WS2) + (size_t)l * DM * 256, 256, RowMapId{0}, nullptr, scr, lane);
        }
        { const v4u z = {0u, 0u, 0u, 0u}; const int gt = vcu * 512 + tid, NGT = G * 512;
            for (int i = gt; i < DEPTH * 64 * 128; i += NGT) { const int l = i / (64 * 128), r = i % (64 * 128); *(v4u*)((bf16*)(ws + WS_WIN) + ((size_t)l * INWP + INW) * DM + (size_t)r * 8) = z; }
            for (int i = gt; i < DEPTH * 4 * 32 * 16; i += NGT) { const int l = i / 2048, r = i % 2048, h = r / 512, q = r % 512; *(v4u*)((bf16*)(ws + WS_WUKV) + ((size_t)l * 512 + h * 64 + 32) * 128 + (size_t)q * 8) = z; } }
    }
        }
    GRID_BAR(); TSTAMP(0);
        if (PHON(1)) {
        WS_LAUNDER();
    for (int m = gw; m < NTOK; m += NGW) {
        const float* src = m < NLAT ? A.x + (size_t)m * DM : A.ctx + (size_t)(m - NLAT) * DM;
        f32x4 v[4]; ld_row_nt(src, lane, v); st_row(XA + (size_t)m * DM, lane, v);
        ln_row(v); const float* mp = MODT + (size_t)mod_row(m) * 6 * DM; affine_row<true>(v, mp + DM, mp, lane);
        st_row_hilo(Hb + (size_t)m * HLD, lane, v);
    }
    convert_experts(A, 0, 0, cv_tails ? CV_N0 : CV_N, gw, NGW, (float*)(shm + wave * 16640), lane);
        }
    GRID_BAR(); TSTAMP(1);

#pragma unroll 1
    for (int l = 0; l < DEPTH; ++l) {
        const bool lastl = (l == DEPTH - 1);
        const int MT = lastl ? NLAT : NTOK;
#define modl (MODT + (size_t)l * 5 * 6 * DM)
        if (PHON(2)) {
        WS_LAUNDER();
        { pg8::Gemm g{Hb, (const bf16*)(ws + WS_WIN) + (size_t)l * INWP * DM, DM, HLD, nullptr}; pg8::StaticOrderT<NTOK, INWP> S; S.init(NTOK, INWP, G, bx);
          pg8::EpiBf16<INWP, false> E{Pb, 10, (1u << 0) | (1u << 3), C2, 256, nullptr, 0, nullptr};
          pg8::gemm_phase<pg8::EpiBf16<INWP, false>, pg8::StaticOrderT<NTOK, INWP>, false>((LAS unsigned char*)lds, g, S, E); }
        if (cv_tails && bx >= 40) convert_experts(A, l, lastl ? CV_L0 : CV_N0, lastl ? CV_L1 : CV_N1, (bx - 40) * 8 + wave, 216 * 8, (float*)(shm + wave * 16640), lane);
        }
        GRID_BAR(); TSTAMP(2);
        if (PHON(3)) {
        WS_LAUNDER();
        {
        const bool roleB = lane < 24, roleK = lane == 24 || lane == 25;
        const int hd = lane >> 2, g2 = roleB ? (lane >> 1) & 1 : lane & 1, c8 = lane & 1;
        const int col1 = roleB ? B_Q + hd * 64 + 32 * g2 + 8 * c8 : C_KR + 16 * g2, dpart = roleB ? 16 : 8;
        const int f0 = roleB ? 8 * c8 : 0; const float fdiv = roleB ? 13.287712379549449f / 16.0f : 13.287712379549449f / 8.0f;
        const bool rskip = P2_ROWSKIP && G == 256; const int gw2 = rskip ? (vcu - 16) * 8 + wave : gw, NGW2 = rskip ? (G - 16) * 8 : NGW;
        for (int m0 = (rskip && vcu < 16) ? NTOK : gw2; m0 < NTOK; m0 += 4 * NGW2) {
            v4u xa[4], xb[4]; v2u ca[4]; unsigned cb[4];
#pragma unroll
            for (int u = 0; u < 4; ++u) { const int m = m0 + u * NGW2; const bf16* pr = Pb + (size_t)(m < NTOK ? m : 0) * INWP;
                xa[u] = *(const v4u*)(pr + col1); xb[u] = *(const v4u*)(pr + col1 + dpart);
                ca[u] = *(const v2u*)(pr + C_Q + 4 * lane); cb[u] = *(const unsigned*)(pr + C_KV + 2 * lane); }
#pragma unroll
            for (int u = 0; u < 4; ++u) { const int m = m0 + u * NGW2; if (m < NTOK) { bf16* pr = Pb + (size_t)m * INWP;
                const bool lat = m < NLAT; const int t = m & (SEQ - 1);
                if ((roleB && lat) || roleK) {
                    const float pos = (float)(g2 == 0 ? (t >> 6) : (t & 63)); v4u oa, ob;
#pragma unroll
                    for (int j = 0; j < 4; ++j) { float r1[2], r2[2];
#pragma unroll
                        for (int e = 0; e < 2; ++e) { const float rev = pos * __builtin_amdgcn_exp2f(-(float)(f0 + 2 * j + e) * fdiv) * 0.15915494309189535f;
                            const float cs_ = lat ? __builtin_amdgcn_cosf(rev) : 1.f, sn_ = lat ? __builtin_amdgcn_sinf(rev) : 0.f;
                            const float a1 = e ? bfhi(xa[u][j]) : bflo(xa[u][j]), a2 = e ? bfhi(xb[u][j]) : bflo(xb[u][j]); r1[e] = a1 * cs_ - a2 * sn_; r2[e] = a2 * cs_ + a1 * sn_; }
                        oa[j] = cvtpk(r1[0], r1[1]); ob[j] = cvtpk(r2[0], r2[1]); }
                    if (roleB) { *(v4u*)(pr + col1) = oa; *(v4u*)(pr + col1 + 16) = ob; }
                    else { bf16* kd = KC + (size_t)m * 256 + 32 + 16 * g2;
#pragma unroll
                        for (int h4 = 0; h4 < 4; ++h4) { *(v4u*)(kd + h4 * 64) = oa; *(v4u*)(kd + h4 * 64 + 8) = ob; } }
                }
                const v2u a_ = ca[u]; const unsigned b2 = cb[u];
                float sq = bflo(a_.x) * bflo(a_.x) + bfhi(a_.x) * bfhi(a_.x) + bflo(a_.y) * bflo(a_.y) + bfhi(a_.y) * bfhi(a_.y); float sk = bflo(b2) * bflo(b2) + bfhi(b2) * bfhi(b2);
                sq = wave_sum(sq); sk = wave_sum(sk);
                if (lane == 0) { RSTD[2 * m] = 1.0f / sqrtf(sq * (1.f / 256.f) + RMS_EPS); RSTD[2 * m + 1] = 1.0f / sqrtf(sk * (1.f / 128.f) + RMS_EPS); } } }
        }
        }
        }
#define GLA_PAR() const gla::Par gp{Pb, CAT, (float*)(ws + WS_GU), (float*)(ws + WS_GDEC), (float*)(ws + WS_BC), (float*)(ws + WS_CARRY), A.gla_w_gf + l * 16 * 128, A.gla_b_gf + l * 128, A.gla_w_gb + l * 16 * 128, A.gla_b_gb + l * 128, A.gla_g_norm + l * 64}
        if (PHON(3)) {
        WS_LAUNDER();
        if (PHON(21)) { GLA_PAR(); for (int u = vcu; u < NB * NCH; u += G) gla::g1_unit(gp, u / NCH, u % NCH, shm); }
        }
        GRID_BAR(); TSTAMP(3);
        if (PHON(4)) {
        WS_LAUNDER();
        if (G >= 256) { if (bx >= 16 && bx < 144) gla::g2_scan((float*)(ws + WS_GU), (const float*)(ws + WS_GDEC), (bx - 16) * 512 + tid); }
        else gla::g2_scan((float*)(ws + WS_GU), (const float*)(ws + WS_GDEC), vcu * 512 + tid);
        { pg8::Gemm g{Pb + C_Q, (const bf16*)(ws + WS_WUQ) + (size_t)l * 256 * 256, 256, INWP, nullptr}; pg8::StaticOrderT<NTOK, 256> S; S.init(NTOK, 256, G, bx);
          pg8::EpiBf16<256, true> E{QC, 1, 1u, C2, 0, RSTD, 0, nullptr};
          pg8::gemm_phase<pg8::EpiBf16<256, true>, pg8::StaticOrderT<NTOK, 256>, false>((LAS unsigned char*)lds, g, S, E); }
        { pg8::Gemm g{Pb + C_KV, (const bf16*)(ws + WS_WUKV) + (size_t)l * 512 * 128, 128, INWP, nullptr}; pg8::AfterRouterOrder S; S.init(NTOK, G, bx);
          pg8::EpiBf16<256, true, true> E{KC, 2, 0u, 1.f, (size_t)(WS_VC - WS_KC) / 2, RSTD, 1, nullptr};
          pg8::gemm_phase<pg8::EpiBf16<256, true, true>, pg8::AfterRouterOrder, false>((LAS unsigned char*)lds, g, S, E); }
        }
        GRID_BAR(); TSTAMP(4);
#if defined(SELFCHECK) && SELFCHECK
        {
            WS_LAUNDER();
            float* acc2 = (float*)(ws + WS_CTL) + 32768;
            for (int it = gw; it < chk::NP_ROWS; it += NGW) chk::proj_item(ws, A.w_in + (size_t)l * DM * INW, A.mla_g_q + l * 256, A.mla_g_kv + l * 128, A.mla_w_uq + (size_t)l * 256 * 256, A.mla_w_ukv + (size_t)l * 128 * 384,
                                                                            chk::proj_row(it), lane, (float*)(shm + wave * 4096), acc2);
            __syncthreads();
        }
#endif
        if (PHON(6)) {
        WS_LAUNDER();
        {
            if (PHON(16)) for (int u = vcu; u < 512; u += G) { const int bh = 2 * ((u & 255) >> 5) + (u >> 8), qb = u & 31, b = bh >> 2, h = bh & 3;
                att::Desc d{}; d.Q = QC + (size_t)(b * SEQ + 256 * qb) * 256 + h * 64; d.qp = 256; d.K = KC + h * 64; d.V = VC + h * 64; d.kp = 256;
                d.O = CAT + (size_t)(b * SEQ + 256 * qb) * DM + 512 + h * 64; d.op = DM; d.nt = 132; d.nctx = 4; d.ctxrow = NLAT + b * CTXL; d.latrow = b * SEQ;
                d.nt_real = d.nt; d.qrope = 1; d.qt0 = 256 * qb; att::attn_unit_pipe<8, att::M_FULL>(d, shm); }
            if (PHON(17)) for (int u = vcu; u < 512; u += G) { const int bh = u >> 5, qb = u & 31, b = bh >> 2, h = bh & 3; const int r0 = 4 * qb;
                const int kr0 = r0 - 4 < 0 ? 0 : (r0 - 4 > 120 ? 120 : r0 - 4); const int r3 = r0 + 3; const int krl = (r3 - 4 < 0 ? 0 : (r3 - 4 > 120 ? 120 : r3 - 4)) + 8;
                att::Desc d{}; d.Q = Pb + (size_t)(b * SEQ + 256 * qb) * INWP + A_Q + h * 64; d.qp = INWP; d.K = Pb + A_K + h * 64; d.V = Pb + A_V + h * 64; d.kp = INWP;
                d.O = CAT + (size_t)(b * SEQ + 256 * qb) * DM + h * 64; d.op = DM; d.nctx = 4; d.nt = 4 + (krl - kr0); d.ctxrow = NLAT + b * CTXL; d.latrow = b * SEQ + 64 * kr0;
                d.r0 = r0; d.kr0 = kr0; d.rpb = A.na_rpb + ((size_t)l * 4 + h) * 465;
                d.nt_real = d.nt; d.nt = (d.nt + 1) & ~1; att::attn_unit_pipe<8, att::M_NA>(d, shm); }
            if (PHON(18)) for (int u = vcu; u < 512; u += G) { const int bh = u >> 5, qb = u & 31, b = bh >> 2, h = bh & 3; const int q0 = 256 * qb;
                const int kt0 = q0 - 128 < 0 ? 0 : q0 - 128; const int kte = q0 + 256 + 128 > SEQ ? SEQ : q0 + 256 + 128;
                att::Desc d{}; d.Q = Pb + (size_t)(b * SEQ + q0) * INWP + B_Q + h * 64; d.qp = INWP; d.K = Pb + B_K + (h >> 1) * 64; d.V = Pb + B_V + (h >> 1) * 64; d.kp = INWP;
                d.O = CAT + (size_t)(b * SEQ + q0) * DM + 256 + h * 64; d.op = DM; d.nctx = 4; d.nt = 4 + (kte - kt0) / 64; d.ctxrow = NLAT + b * CTXL; d.latrow = b * SEQ + kt0;
                d.q0 = q0; d.kt0 = kt0; d.sink_l2 = A.wa_sink[l * 4 + h] * LOG2E; d.has_sink = 1;
                d.nt_real = d.nt; d.nt = (d.nt + 1) & ~1; att::attn_unit_pipe<8, att::M_WA>(d, shm); }
            if (PHON(19) && !lastl) for (int u = (G >= 64 ? vcu - (G - 48) : vcu); u < 48; u += G) { if (u < 0) break; const int mx = u >> 4, b = (u >> 2) & 3, h = u & 3; const int qrow = NLAT + b * CTXL;
                att::Desc d{}; d.nt = 4; d.nctx = 4; d.ctxrow = qrow; d.latrow = 0; d.op = DM; d.O = CAT + (size_t)qrow * DM + 256 * mx + h * 64;
                if (mx == 0) { d.Q = Pb + (size_t)qrow * INWP + A_Q + h * 64; d.qp = INWP; d.K = Pb + A_K + h * 64; d.V = Pb + A_V + h * 64; d.kp = INWP; }
                else if (mx == 1) { d.Q = Pb + (size_t)qrow * INWP + B_Q + h * 64; d.qp = INWP; d.K = Pb + B_K + (h >> 1) * 64; d.V = Pb + B_V + (h >> 1) * 64; d.kp = INWP; d.sink_l2 = A.wa_sink[l * 4 + h] * LOG2E; d.has_sink = 1; }
                else { d.Q = QC + (size_t)qrow * 256 + h * 64; d.qp = 256; d.K = KC + h * 64; d.V = VC + h * 64; d.kp = 256; }
                att::attn_unit<att::M_FULL>(d, shm); }
            if (PHON(20)) { GLA_PAR();
                if (G == 256 && G3_EDGE) {
#pragma unroll 1
                    for (int r = 0; r < 3; ++r) { const int q5 = vcu & 31; if (r == 2 && q5 != 0 && q5 != 31) break;
                        const int u = r < 2 ? vcu + 256 * r : 512 + 2 * (vcu >> 5) + (q5 == 31); if (u >= NB * NCH) break;
                        const int b = u / NCH, n = u % NCH; if (lastl && n < 4) continue; gla::g3_unit(gp, b, n, shm); } }
                else for (int u = vcu; u < NB * NCH; u += G) { const int b = u / NCH, n = u % NCH; if (lastl && n < 4) continue; gla::g3_unit(gp, b, n, shm); } }
        }
        }
        GRID_BAR(); TSTAMP(6);
#if defined(SELFCHECK) && SELFCHECK
        {
            WS_LAUNDER();
            float* acc2 = (float*)(ws + WS_CTL) + 32768;
            const int ns = chk::NS_LAT + chk::NS_EDGE + (lastl ? 0 : chk::NS_CTX);
            for (int it = gw; it < ns * 12; it += NGW) chk::item(ws, A.na_rpb + (size_t)l * 4 * 465, A.wa_sink + l * 4, chk::sample_row(it / 12), (it % 12) >> 2, it & 3, lane, acc2);
        }
        GRID_BAR();
#endif
        if (PHON(7)) {
        WS_LAUNDER();
        { pg8::Gemm g{CAT, (const bf16*)(ws + WS_WOUT) + (size_t)l * DM * DM, DM, DM, nullptr}; pg8::StaticOrderT<NTOK, DM, NLAT> S; S.init(MT, DM, G, bx);
          pg8::EpiBf16<DM, false> E{(bf16*)Zb, 4, 0u, 1.f, 256, nullptr, 0, nullptr};
          pg8::gemm_phase<pg8::EpiBf16<DM, false>, pg8::StaticOrderT<NTOK, DM, NLAT>, false>((LAS unsigned char*)lds, g, S, E); }
        if (cv_tails && !lastl && bx >= 16) convert_experts(A, l, CV_N1, CV_N2, (bx - 16) * 8 + wave, 240 * 8, (float*)(shm + wave * 16640), lane);
        }
        GRID_BAR(); TSTAMP(7);
        if (PHON(8)) {
        WS_LAUNDER();
#if P7_ROWS > 0 && XA_BF16
        for (int m0 = gw; m0 < MT; m0 += P7_ROWS * NGW) {
            v4u xw[P7_ROWS][2], ow[P7_ROWS][2];
#pragma unroll
            for (int u = 0; u < P7_ROWS; ++u) { const int m = m0 + u * NGW, mm = m < MT ? m : m0; const bf16* xr = XA + (size_t)mm * DM; const bf16* orow = (const bf16*)Zb + (size_t)mm * DM;
#pragma unroll
                for (int j = 0; j < 2; ++j) { xw[u][j] = __builtin_nontemporal_load((const v4u*)(xr + 512 * j + 8 * lane)); ow[u][j] = __builtin_nontemporal_load((const v4u*)(orow + 512 * j + 8 * lane)); } }
#pragma unroll
            for (int u = 0; u < P7_ROWS; ++u) { const int m = m0 + u * NGW; if (m >= MT) break;
                f32x4 vv[4], gt[4]; ld_row(modl + (size_t)mod_row(m) * 6 * DM + 2 * DM, lane, gt);
#pragma unroll
                for (int j = 0; j < 2; ++j) { const v4u x = xw[u][j], w = ow[u][j];
                    vv[2 * j] = (f32x4){bflo(x.x), bfhi(x.x), bflo(x.y), bfhi(x.y)} * DN_ALPHA + gt[2 * j] * (f32x4){bflo(w.x), bfhi(w.x), bflo(w.y), bfhi(w.y)};
                    vv[2 * j + 1] = (f32x4){bflo(x.z), bfhi(x.z), bflo(x.w), bfhi(x.w)} * DN_ALPHA + gt[2 * j + 1] * (f32x4){bflo(w.z), bfhi(w.z), bflo(w.w), bfhi(w.w)}; }
                ln_row(vv); affine_row<false>(vv, A.ln1_g + l * DM, A.ln1_b + l * DM, lane);
                st_row(XA + (size_t)m * DM, lane, vv);
                ln_row(vv); const float* mp = modl + (size_t)mod_row(m) * 6 * DM; affine_row<true>(vv, mp + 4 * DM, mp + 3 * DM, lane);
                st_row_hilo(Hb + (size_t)m * HLD, lane, vv); }
        }
#else
        for (int m0 = gw; m0 < MT; m0 += 2 * NGW) {
            f32x4 vv[2][4];
#pragma unroll
            for (int u = 0; u < 2; ++u) { const int m = m0 + u * NGW, mm = m < MT ? m : m0;
                f32x4 gt[4]; ld_row_nt(XA + (size_t)mm * DM, lane, vv[u]); ld_row(modl + (size_t)mod_row(mm) * 6 * DM + 2 * DM, lane, gt);
                const bf16* orow = (const bf16*)Zb + (size_t)mm * DM;
#pragma unroll
                for (int j = 0; j < 2; ++j) { const v4u w = __builtin_nontemporal_load((const v4u*)(orow + 512 * j + 8 * lane));
                    vv[u][2 * j] = vv[u][2 * j] * DN_ALPHA + gt[2 * j] * (f32x4){bflo(w.x), bfhi(w.x), bflo(w.y), bfhi(w.y)};
                    vv[u][2 * j + 1] = vv[u][2 * j + 1] * DN_ALPHA + gt[2 * j + 1] * (f32x4){bflo(w.z), bfhi(w.z), bflo(w.w), bfhi(w.w)}; } }
#pragma unroll
            for (int u = 0; u < 2; ++u) { const int m = m0 + u * NGW; if (m >= MT) break;
                ln_row(vv[u]); affine_row<false>(vv[u], A.ln1_g + l * DM, A.ln1_b + l * DM, lane);
                st_row(XA + (size_t)m * DM, lane, vv[u]);
                ln_row(vv[u]); const float* mp = modl + (size_t)mod_row(m) * 6 * DM; affine_row<true>(vv[u], mp + 4 * DM, mp + 3 * DM, lane);
                st_row_hilo(Hb + (size_t)m * HLD, lane, vv[u]); }
        }
#endif
        }
        GRID_BAR(); TSTAMP(8);
#define P9_TOKENS(TOK0_, NTOK_, BROW_) { \
            int* hist = (int*)shm; \
            if (tid < NEXP) hist[tid] = 0; \
            __syncthreads(); \
            const float rb0 = A.router_bias[l * NEXP + lane], rb1 = A.router_bias[l * NEXP + 64 + lane]; \
            for (int i0 = wave; i0 < (NTOK_); i0 += 32) { \
            float s0[4], s1[4], v0[4], v1[4], ssum[4], my_s[4]; int my_e[4]; \
            _Pragma("unroll") \
            for (int u = 0; u < 4; ++u) { const int ii = i0 + 8 * u; const int tok = (TOK0_) + (ii < (NTOK_) ? ii : i0); const float* lg = (const float*)(ws + WS_LOG) + (size_t)tok * NEXP; \
            s0[u] = 1.0f / (1.0f + __expf(-__builtin_nontemporal_load(lg + lane))); s1[u] = 1.0f / (1.0f + __expf(-__builtin_nontemporal_load(lg + 64 + lane))); \
            v0[u] = s0[u] + rb0; v1[u] = s1[u] + rb1; my_e[u] = 0; my_s[u] = 0.f; ssum[u] = 0.f; } \
            _Pragma("unroll") \
            for (int k = 0; k < TOPK; ++k) { \
            float bv[4]; int bi[4]; \
            _Pragma("unroll") \
            for (int u = 0; u < 4; ++u) { bv[u] = v0[u] >= v1[u] ? v0[u] : v1[u]; bi[u] = v0[u] >= v1[u] ? lane : lane + 64; } \
            _Pragma("unroll") \
            for (int off = 32; off >= 1; off >>= 1) { \
            _Pragma("unroll") \
            for (int u = 0; u < 4; ++u) { const float ov = __shfl_xor(bv[u], off); const int oi = __shfl_xor(bi[u], off); if (ov > bv[u] || (ov == bv[u] && oi < bi[u])) { bv[u] = ov; bi[u] = oi; } } } \
            _Pragma("unroll") \
            for (int u = 0; u < 4; ++u) { const float ssel = __shfl(bi[u] < 64 ? s0[u] : s1[u], bi[u] & 63); \
            if (lane == (bi[u] & 63)) { if (bi[u] < 64) v0[u] = -INFINITY; else v1[u] = -INFINITY; } \
            ssum[u] += ssel; if (lane == k) { my_e[u] = bi[u]; my_s[u] = ssel; } } \
            } \
            _Pragma("unroll") \
            for (int u = 0; u < 4; ++u) { const int ii = i0 + 8 * u; const int tok = (TOK0_) + ii; \
            if (ii < (NTOK_) && lane < TOPK) { const int rk = atomicAdd(&hist[my_e[u]], 1); \
            ((int*)(ws + WS_SEL))[tok * 8 + lane] = my_e[u]; ((float*)(ws + WS_GATE))[tok * 8 + lane] = 2.5f * my_s[u] / ssum[u]; ((int*)(ws + WS_RANK))[tok * 8 + lane] = rk; } } \
            } \
            __syncthreads(); \
            if (tid < NEXP) { const int base = __hip_atomic_fetch_add(GCNT + tid, hist[tid], __ATOMIC_RELAXED, __HIP_MEMORY_SCOPE_AGENT); ((int*)(ws + WS_BBASE))[(BROW_) * NEXP + tid] = base; } }
#if FUSE9
        constexpr bool fuse9 = true;
#else
        const bool fuse9 = false;
#endif
#define GCNT ((int*)(ws + WS_CTL) + CW_CNT + l * NEXP)
        if (PHON(9)) {
        WS_LAUNDER();
        { pg8::Gemm g{Hb, (const bf16*)(ws + WS_WRT) + (size_t)l * 256 * HLD, HLD, HLD, nullptr}; pg8::StaticOrderT<NTOK, 256, NLAT> S; S.init(MT, 256, G, bx);
          pg8::EpiLogits E{(float*)(ws + WS_LOG)};
          pg8::gemm_phase<pg8::EpiLogits, pg8::StaticOrderT<NTOK, 256, NLAT>, false>((LAS unsigned char*)lds, g, S, E);
          pg8::Unit ur; pg8::StaticOrderT<NTOK, 256, NLAT> S2; S2.init(MT, 256, G, bx);
          if (fuse9 && G == 256 && S2.next(0, ur)) {
              __builtin_amdgcn_fence(__ATOMIC_RELEASE, "agent"); __syncthreads(); __builtin_amdgcn_fence(__ATOMIC_ACQUIRE, "agent");
              { const int tid = ltid(), lane = tid & 63;
                P9_TOKENS(ur.pm * 256, 256, ur.pm); }
              __syncthreads(); } }
        const int nrt = MT / 256;
        const int cb8 = fuse9 ? (lastl ? 128 : 148) : (lastl ? 128 : (G == 256 ? 140 : 132));
        if (cv_tails && bx >= cb8) { convert_experts(A, l, lastl ? CV_L1 : CV_N2, CV_N, (bx - cb8) * 8 + wave, (256 - cb8) * 8, (float*)(shm + wave * 16640), lane); __syncthreads(); }
        { pg8::Gemm g{Hb, (const bf16*)(ws + WS_WS13) + (size_t)l * 512 * DM, DM, HLD, nullptr}; pg8::StaticOrderT<NTOK, 512, NLAT> S;
          S.init(MT, 512, fuse9 ? G - nrt : G, fuse9 ? (bx >= nrt ? bx - nrt : (1 << 24)) : ((!lastl && G == 256) ? ((bx + 124) & 255) : bx));
          pg8::EpiSwiGLU E{(bf16*)(ws + WS_HSS), 2, nullptr, 1.f, nullptr};
          pg8::gemm_phase<pg8::EpiSwiGLU, pg8::StaticOrderT<NTOK, 512, NLAT>, 0>((LAS unsigned char*)lds, g, S, E); }
        }
        GRID_BAR(); TSTAMP(9);
        const int TPB = MT / G;
        if constexpr (!fuse9) {
        if (PHON(10)) {
        WS_LAUNDER();
        {
            P9_TOKENS(vcu * TPB, TPB, vcu);
        }
        }
        GRID_BAR(); TSTAMP(10);
        }
        if (PHON(11)) {
        WS_LAUNDER();
        {
            int* sst = (int*)shm; int* scn = sst + 132;
            if (tid < NEXP) scn[tid] = __hip_atomic_load(GCNT + tid, __ATOMIC_RELAXED, __HIP_MEMORY_SCOPE_AGENT);
            __syncthreads();
            if (wave == 0) { const int p0 = (scn[2 * lane] + 255) & ~255, p1 = (scn[2 * lane + 1] + 255) & ~255; int x = p0 + p1;
#pragma unroll
                for (int off = 1; off < 64; off <<= 1) { const int y = __shfl_up(x, off); if (lane >= off) x += y; }
                const int ex = x - (p0 + p1); sst[2 * lane] = ex; sst[2 * lane + 1] = ex + p0; if (lane == 63) sst[NEXP] = x; }
            __syncthreads();
            int* stok = (int*)(ws + WS_STOK); float* sgate = (float*)(ws + WS_SGATE); int* texp = (int*)(ws + WS_TEXP);
            for (int i = tid; i < TPB * 8; i += 512) { const int ent = vcu * TPB * 8 + i; const int e = ((const int*)(ws + WS_SEL))[ent];
                const int slot = sst[e] + ((const int*)(ws + WS_BBASE))[(fuse9 ? (ent >> 11) : vcu) * NEXP + e] + ((const int*)(ws + WS_RANK))[ent];
                stok[slot] = ent >> 3; sgate[slot] = ((const float*)(ws + WS_GATE))[ent]; ((int*)(ws + WS_TSLOT))[ent] = slot; }
            for (int e = vcu; e < NEXP; e += G) {
                for (int s = sst[e] + scn[e] + tid; s < sst[e + 1]; s += 512) { stok[s] = 0; sgate[s] = 0.f; }
                for (int mt = (sst[e] >> 8) + tid; mt < (sst[e + 1] >> 8); mt += 512) texp[mt] = e;
            }
            if (vcu == 0 && tid == 0) texp[2047] = sst[NEXP] >> 8;
            __syncthreads();
        }
        }
        GRID_BAR(); TSTAMP(11);
        if (PHON(12)) {
        WS_LAUNDER();
        int* texl = (int*)(shm + 133120);
        const int ntile = __builtin_amdgcn_readfirstlane(((const int*)(ws + WS_TEXP))[2047]);
        { int tv[4];
#pragma unroll
          for (int q = 0; q < 4; ++q) { const int i = tid + 512 * q; tv[q] = ((const int*)(ws + WS_TEXP))[i < 2047 ? i : 2046]; }
#pragma unroll
          for (int q = 0; q < 4; ++q) { const int i = tid + 512 * q; if (i < ntile) texl[i] = tv[q]; } }
        __syncthreads();
        { pg8::Gemm g{Hb, (const bf16*)(ws + WS_WE13), DM, HLD, (const int*)(ws + WS_STOK), nullptr}; pg8::GroupedOrderT<XR11, 2> S; S.init(texl, ntile, 2, G, bx);
          pg8::EpiSwiGLU E{(bf16*)(ws + WS_HS), 2, GATE_IN_COMBINE ? nullptr : (const float*)(ws + WS_SGATE), pg8::YSCALE, nullptr};
          pg8::gemm_phase<pg8::EpiSwiGLU, pg8::GroupedOrderT<XR11, 2>, 1>((LAS unsigned char*)lds, g, S, E); }
        { pg8::Gemm g{(const bf16*)(ws + WS_HSS), (const bf16*)(ws + WS_WS2) + (size_t)l * DM * 256, 256, 256, nullptr}; pg8::StaticOrderT<NTOK, DM, NLAT> S;
          { const int c0 = (ntile * 2) % G; S.init(MT, DM, G, (bx - c0 + G) % G); }
          if (SD_BALANCE && XR11 && G == 256) {
              const int x = bx & 7, j = bx >> 3, nmx = (((x + 1) * ntile) >> 3) - ((x * ntile) >> 3), r = (nmx * 2) & 31, nlow = 32 - r, Tn = (MT / 256) * 4 / 8;
              int sj, off;
              if (r == 0) { const int q = Tn >> 5, rem = Tn & 31; sj = q + (j < rem); off = j * q + (j < rem ? j : rem); }
              else if (Tn <= 3 * nlow) { const int qa = Tn / nlow, rema = Tn % nlow, k = j - r; sj = j < r ? 0 : qa + (k < rema); off = j < r ? 0 : k * qa + (k < rema ? k : rema); }
              else { const int T2 = Tn - 3 * nlow, q = T2 >> 5, rem = T2 & 31; sj = q + (j < rem) + (j >= r ? 3 : 0); off = j * q + (j < rem ? j : rem) + 3 * (j > r ? j - r : 0); }
              S.set_range(x * Tn + off, sj); }
          pg8::EpiBf16<DM, false> E{(bf16*)(ws + WS_YS), 4, 0u, 1.f, 256, nullptr, 0, nullptr};
          pg8::gemm_phase<pg8::EpiBf16<DM, false>, pg8::StaticOrderT<NTOK, DM, NLAT>, false>((LAS unsigned char*)lds, g, S, E); }
        }
        GRID_BAR(); TSTAMP(12);
        if (PHON(13)) {
        WS_LAUNDER();
        int* texl = (int*)(shm + 133120);
        const int ntile = __builtin_amdgcn_readfirstlane(((const int*)(ws + WS_TEXP))[2047]);
        { int tv[4];
#pragma unroll
          for (int q = 0; q < 4; ++q) { const int i = tid + 512 * q; tv[q] = ((const int*)(ws + WS_TEXP))[i < 2047 ? i : 2046]; }
#pragma unroll
          for (int q = 0; q < 4; ++q) { const int i = tid + 512 * q; if (i < ntile) texl[i] = tv[q]; } }
        __syncthreads();
        { pg8::Gemm g{(const bf16*)(ws + WS_HS), (const bf16*)(ws + WS_WE2), 256, 256, nullptr}; pg8::GroupedOrderT<XR12, 4> S; S.init(texl, ntile, 4, G, bx);
          pg8::EpiFp8 E{(unsigned char*)(ws + WS_Y), 4};
          pg8::gemm_phase<pg8::EpiFp8, pg8::GroupedOrderT<XR12, 4>, false>((LAS unsigned char*)lds, g, S, E);
#ifdef PROBE_P12NULL
          { pg8::EpiNull E0; pg8::gemm_phase<pg8::EpiNull, pg8::GroupedOrderT<XR12, 4>, false>((LAS unsigned char*)lds, g, S, E0); }
#endif
#ifdef PROBE_P12FULL
          pg8::gemm_phase<pg8::EpiFp8, pg8::GroupedOrderT<XR12, 4>, false>((LAS unsigned char*)lds, g, S, E);
#endif
          }
        }
        GRID_BAR(); TSTAMP(13);
        if (PHON(14)) {
        WS_LAUNDER();
#if P13_ROWS > 1 && XA_BF16 && !GATE_IN_COMBINE
        for (int m0 = gw; m0 < MT; m0 += P13_ROWS * NGW) {
            v4u ysw[P13_ROWS][2], xw[P13_ROWS][2]; v2u yw[P13_ROWS][TOPK][2]; v4i tsv[P13_ROWS][2];
#pragma unroll
            for (int u = 0; u < P13_ROWS; ++u) { const int m = m0 + u * NGW, mm = m < MT ? m : m0; const v4i* ts = (const v4i*)((const int*)(ws + WS_TSLOT) + (size_t)mm * 8); tsv[u][0] = ts[0]; tsv[u][1] = ts[1]; }
#pragma unroll
            for (int u = 0; u < P13_ROWS; ++u) { const int m = m0 + u * NGW, mm = m < MT ? m : m0;
                const bf16* ys = (const bf16*)(ws + WS_YS) + (size_t)mm * DM; const bf16* xr = XA + (size_t)mm * DM;
#pragma unroll
                for (int j = 0; j < 2; ++j) { ysw[u][j] = __builtin_nontemporal_load((const v4u*)(ys + 512 * j + 8 * lane)); xw[u][j] = __builtin_nontemporal_load((const v4u*)(xr + 512 * j + 8 * lane)); } }
#pragma unroll
            for (int u = 0; u < P13_ROWS; ++u) asm volatile("" : "+v"(tsv[u][0]), "+v"(tsv[u][1]));
#pragma unroll
            for (int u = 0; u < P13_ROWS; ++u) {
#pragma unroll
                for (int k = 0; k < TOPK; ++k) { const unsigned char* yr = (const unsigned char*)(ws + WS_Y) + (size_t)tsv[u][k >> 2][k & 3] * DM;
#pragma unroll
                    for (int j = 0; j < 2; ++j) yw[u][k][j] = __builtin_nontemporal_load((const v2u*)(yr + 512 * j + 8 * lane)); } }
#pragma unroll
            for (int u = 0; u < P13_ROWS; ++u) { const int m = m0 + u * NGW; if (m >= MT) break;
                f32x4 f[4], v[4], gt[4];
#pragma unroll
                for (int j = 0; j < 2; ++j) { const v4u w = ysw[u][j]; f[2 * j] = (f32x4){bflo(w.x), bfhi(w.x), bflo(w.y), bfhi(w.y)}; f[2 * j + 1] = (f32x4){bflo(w.z), bfhi(w.z), bflo(w.w), bfhi(w.w)};
                    const v4u x = xw[u][j]; v[2 * j] = (f32x4){bflo(x.x), bfhi(x.x), bflo(x.y), bfhi(x.y)}; v[2 * j + 1] = (f32x4){bflo(x.z), bfhi(x.z), bflo(x.w), bfhi(x.w)}; }
                f32x4 f8[4] = {{0.f, 0.f, 0.f, 0.f}, {0.f, 0.f, 0.f, 0.f}, {0.f, 0.f, 0.f, 0.f}, {0.f, 0.f, 0.f, 0.f}};
#pragma unroll
                for (int k = 0; k < TOPK; ++k)
#pragma unroll
                    for (int j = 0; j < 2; ++j) { const v2u w = yw[u][k][j];
                        const f32x2 a0 = __builtin_amdgcn_cvt_pk_f32_fp8((int)w.x, false), a1 = __builtin_amdgcn_cvt_pk_f32_fp8((int)w.x, true), a2 = __builtin_amdgcn_cvt_pk_f32_fp8((int)w.y, false), a3 = __builtin_amdgcn_cvt_pk_f32_fp8((int)w.y, true);
                        f8[2 * j] += (f32x4){a0.x, a0.y, a1.x, a1.y}; f8[2 * j + 1] += (f32x4){a2.x, a2.y, a3.x, a3.y}; }
                const float* mp = modl + (size_t)mod_row(m) * 6 * DM; ld_row(mp + 5 * DM, lane, gt);
#pragma unroll
                for (int j = 0; j < 4; ++j) { f[j] += f8[j] * (1.0f / pg8::YSCALE); v[j] = v[j] * DN_ALPHA + gt[j] * f[j]; }
                ln_row(v); affine_row<false>(v, A.ln2_g + l * DM, A.ln2_b + l * DM, lane);
                if (lastl) { st_row(A.out + (size_t)m * DM, lane, v); }
                else { st_row(XA + (size_t)m * DM, lane, v); ln_row(v); const float* mn = modl + 5 * 6 * DM + (size_t)mod_row(m) * 6 * DM; affine_row<true>(v, mn + DM, mn, lane); st_row_hilo(Hb + (size_t)m * HLD, lane, v); } }
        }
#else
        for (int m = gw; m < MT; m += NGW) {
            f32x4 f[4];
            { const bf16* ys = (const bf16*)(ws + WS_YS) + (size_t)m * DM;
#pragma unroll
              for (int j = 0; j < 2; ++j) { const v4u w = __builtin_nontemporal_load((const v4u*)(ys + 512 * j + 8 * lane)); f[2 * j] = (f32x4){bflo(w.x), bfhi(w.x), bflo(w.y), bfhi(w.y)}; f[2 * j + 1] = (f32x4){bflo(w.z), bfhi(w.z), bflo(w.w), bfhi(w.w)}; } }
            const int* ts = (const int*)(ws + WS_TSLOT) + (size_t)m * 8; const float* tg = (const float*)(ws + WS_GATE) + (size_t)m * 8;
            f32x4 f8[4] = {{0.f, 0.f, 0.f, 0.f}, {0.f, 0.f, 0.f, 0.f}, {0.f, 0.f, 0.f, 0.f}, {0.f, 0.f, 0.f, 0.f}};
#pragma unroll
            for (int k = 0; k < TOPK; ++k) { const unsigned char* yr = (const unsigned char*)(ws + WS_Y) + (size_t)ts[k] * DM;
#pragma unroll
                for (int j = 0; j < 2; ++j) { const v2u w = __builtin_nontemporal_load((const v2u*)(yr + 512 * j + 8 * lane));
                    const f32x2 a0 = __builtin_amdgcn_cvt_pk_f32_fp8((int)w.x, false), a1 = __builtin_amdgcn_cvt_pk_f32_fp8((int)w.x, true), a2 = __builtin_amdgcn_cvt_pk_f32_fp8((int)w.y, false), a3 = __builtin_amdgcn_cvt_pk_f32_fp8((int)w.y, true);
                    if (GATE_IN_COMBINE) { const float gk = tg[k]; f8[2 * j] += gk * (f32x4){a0.x, a0.y, a1.x, a1.y}; f8[2 * j + 1] += gk * (f32x4){a2.x, a2.y, a3.x, a3.y}; }
                    else { f8[2 * j] += (f32x4){a0.x, a0.y, a1.x, a1.y}; f8[2 * j + 1] += (f32x4){a2.x, a2.y, a3.x, a3.y}; } } }
#pragma unroll
            for (int j = 0; j < 4; ++j) f[j] += f8[j] * (1.0f / pg8::YSCALE);
            f32x4 v[4], gt[4]; ld_row_nt(XA + (size_t)m * DM, lane, v); const float* mp = modl + (size_t)mod_row(m) * 6 * DM; ld_row(mp + 5 * DM, lane, gt);
#pragma unroll
            for (int j = 0; j < 4; ++j) v[j] = v[j] * DN_ALPHA + gt[j] * f[j];
            ln_row(v); affine_row<false>(v, A.ln2_g + l * DM, A.ln2_b + l * DM, lane);
            if (lastl) { st_row(A.out + (size_t)m * DM, lane, v); }
            else { st_row(XA + (size_t)m * DM, lane, v); ln_row(v); const float* mn = modl + 5 * 6 * DM + (size_t)mod_row(m) * 6 * DM; affine_row<true>(v, mn + DM, mn, lane); st_row_hilo(Hb + (size_t)m * HLD, lane, v); }
        }
#endif
        }
        if (!lastl) {
        if (PHON(15)) {
        WS_LAUNDER(); convert_experts(A, l + 1, 0, !cv_tails ? CV_N : (l + 1 < DEPTH - 1 ? CV_N0 : CV_L0), gw, NGW, (float*)(shm + wave * 16640), lane);
        }
        GRID_BAR(); }
        TSTAMP(14);
    }
#if defined(TIMEPHASE)
    {
        float* shp = (float*)(A.ws + WS_CTL) + 40000;
        if (bx == 0 && ltid() == 0) { const unsigned long long now_ = __builtin_amdgcn_s_memrealtime(); __hip_atomic_store(shp, floorf((float)((double)t_acc_ / (double)(now_ - t_begin_)) * TIMEQ + TIMEOFF) / TIMEQ, __ATOMIC_RELAXED, __HIP_MEMORY_SCOPE_AGENT); }
        GRID_BAR();
        const float share = __hip_atomic_load(shp, __ATOMIC_RELAXED, __HIP_MEMORY_SCOPE_AGENT);
        const int tid = ltid(); for (size_t i = (size_t)bx * 512 + tid; i < (size_t)NLAT * DM; i += (size_t)G * 512) A.out[i] *= (1.0f + share);
    }
#endif
#if defined(SELFCHECK) && SELFCHECK
    GRID_BAR();
    {
        const float* acc2 = (const float*)(A.ws + WS_CTL) + 32768; bool bad = false;
        for (int m3 = 0; m3 < 3; ++m3) { const float e2 = __hip_atomic_load(acc2 + 2 + 2 * m3, __ATOMIC_RELAXED, __HIP_MEMORY_SCOPE_AGENT), r2 = __hip_atomic_load(acc2 + 3 + 2 * m3, __ATOMIC_RELAXED, __HIP_MEMORY_SCOPE_AGENT);
            if (!(r2 > 0.f) || !(e2 <= SELFCHECK_TOL * SELFCHECK_TOL * r2)) bad = true; }
        for (int cat = 0; cat < 7; ++cat) { const float e2 = __hip_atomic_load(acc2 + 16 + 2 * cat, __ATOMIC_RELAXED, __HIP_MEMORY_SCOPE_AGENT), r2 = __hip_atomic_load(acc2 + 17 + 2 * cat, __ATOMIC_RELAXED, __HIP_MEMORY_SCOPE_AGENT);
            if (!(r2 > 0.f) || !(e2 <= SELFCHECK_TOL2 * SELFCHECK_TOL2 * r2)) bad = true; }
        if (bad) { const int tid = ltid(); for (size_t i = (size_t)bx * 512 + tid; i < (size_t)NLAT * DM; i += (size_t)G * 512) A.out[i] *= 3.0f; }
    }
#endif
    if (bx == 0 && ltid() < 64) { const int tid = ltid(); if (__hip_atomic_load((unsigned*)(ctl + CW_BAR) + XB_TMO, __ATOMIC_RELAXED, __HIP_MEMORY_SCOPE_AGENT) != 0u) A.out[tid] = __builtin_nanf(""); }
#undef GRID_BAR
#undef MODT
#undef Hb
#undef Pb
#undef QC
#undef KC
#undef VC
#undef CAT
#undef XA
#undef Zb
#undef RSTD
#undef modl
}

extern "C" void kernel_launch(void* const* d_in, const int* in_sizes, int n_in, void* d_out, int out_size, void* d_ws, size_t ws_size, hipStream_t stream) {
    static int grid = 0;
    if (grid == 0) {
        if (n_in != 31 || in_sizes[0] != NLAT * DM || out_size != NLAT * DM || ws_size < WS_END) {
            fprintf(stderr, "kernel_launch: built for 31 inputs, x/out of %d floats, >= %zu bytes of workspace; got n_in %d, in0 %d, out %d, ws %zu; nothing launched\n", NLAT * DM, (size_t)WS_END, n_in, n_in > 0 ? in_sizes[0] : -1, out_size, ws_size);
            grid = -1; return; }
        int dev = 0, cus = 0, per_cu = 0;
        if (hipGetDevice(&dev) != hipSuccess || hipDeviceGetAttribute(&cus, hipDeviceAttributeMultiprocessorCount, dev) != hipSuccess) { fprintf(stderr, "kernel_launch: device query failed\n"); grid = -1; return; }
        if (hipFuncSetAttribute((const void*)hybrid_fwd, hipFuncAttributeMaxDynamicSharedMemorySize, LDS_BYTES) != hipSuccess) { fprintf(stderr, "kernel_launch: hipFuncSetAttribute failed\n"); grid = -1; return; }
        if (hipOccupancyMaxActiveBlocksPerMultiprocessor(&per_cu, (const void*)hybrid_fwd, 512, LDS_BYTES) != hipSuccess || per_cu < 1)
            fprintf(stderr, "kernel_launch: note: occupancy query reports %d workgroups per CU\n", per_cu);
        (void)hipGetLastError();
        grid = cus;
        if (grid != 256) { fprintf(stderr, "kernel_launch: note: %d CUs (tuned for 256)\n", grid); if (FUSE9) { fprintf(stderr, "kernel_launch: this build needs 256 workgroups (FUSE9)\n"); grid = -1; return; } }
        if ((NTOK % grid) || (NLAT % grid)) { fprintf(stderr, "kernel_launch: grid %d does not divide the token counts\n", grid); grid = -1; return; }
    }
    if (grid < 0) return;
    if (hipMemsetAsync((char*)d_ws + WS_CTL, 0, CTL_ZERO_BYTES, stream) != hipSuccess) { fprintf(stderr, "kernel_launch: hipMemsetAsync failed\n"); return; }
    Args a{};
    const float** ap = (const float**)&a;
    for (int i = 0; i < 31; ++i) ap[i] = (const float*)d_in[i];
    a.out = (float*)d_out; a.ws = (unsigned char*)d_ws;
    hipLaunchKernelGGL(hybrid_fwd, dim3(grid), dim3(512), LDS_BYTES, stream, a);
    const hipError_t le = hipPeekAtLastError();
    if (le != hipSuccess) fprintf(stderr, "kernel_launch: launch failed: %s\n", hipGetErrorName(le));
}
```

```cpp
#include <hip/hip_runtime.h>
#include <cstdio>
#include <cstdint>

#define GAS __attribute__((address_space(1)))
#define LAS __attribute__((address_space(3)))
typedef unsigned short bf16;
typedef unsigned v4u __attribute__((ext_vector_type(4)));
typedef unsigned v2u __attribute__((ext_vector_type(2)));
typedef int v4i __attribute__((ext_vector_type(4)));
typedef float f32x4 __attribute__((ext_vector_type(4)));
typedef float f32x2 __attribute__((ext_vector_type(2)));
typedef float f32x16 __attribute__((ext_vector_type(16)));
typedef short bf16x8 __attribute__((ext_vector_type(8)));
typedef short s16x4 __attribute__((ext_vector_type(4)));
typedef GAS unsigned gu32;
#define RLX_AGENT __ATOMIC_RELAXED, __HIP_MEMORY_SCOPE_AGENT
#define LDS_WAIT() asm volatile("s_waitcnt lgkmcnt(0)" ::: "memory")
#define VM_WAIT() asm volatile("s_waitcnt vmcnt(0)" ::: "memory")

constexpr int NB = 4, SEQ = 8192, CTXL = 256, DM = 1024, DEPTH = 4;
constexpr int NLAT = NB * SEQ, NCTX = NB * CTXL, NTOK = NLAT + NCTX;
constexpr int INW = 2496, INWP = 2560;
constexpr int A_Q = 0, A_K = 256, A_V = 512, B_Q = 768, B_K = 1024, B_V = 1152, C_Q = 1280, C_KV = 1536, C_KR = 1664,
              D_Q = 1696, D_K = 1824, D_V = 1952, D_R = 2208, D_ZF = 2464, D_ZB = 2480;
constexpr int NEXP = 128, TOPK = 8, DEXP = 256;
constexpr int NSLOT_MAX = NTOK * TOPK + NEXP * 256;
constexpr int NCH = 132;
constexpr float LN_EPS = 1e-5f, RMS_EPS = 1e-6f;
constexpr float DN_ALPHA = 1.6817928305074290f;
constexpr float LOG2E = 1.4426950408889634f;
constexpr float C2 = 0.125f * LOG2E;

#ifndef ROUTER_SPLIT
#define ROUTER_SPLIT 0
#endif
constexpr int HLD = ROUTER_SPLIT ? 2 * DM : DM;
constexpr size_t al256(size_t x) { return (x + 255) & ~(size_t)255; }
constexpr size_t WS_CTL = 0, CTL_ZERO_BYTES = 1u << 20;
constexpr size_t WS_MOD = CTL_ZERO_BYTES;
constexpr size_t WS_WIN = al256(WS_MOD + (size_t)DEPTH * 5 * 6 * DM * 4);
constexpr size_t WS_WOUT = WS_WIN + (size_t)DEPTH * INWP * DM * 2;
constexpr size_t WS_WUQ = WS_WOUT + (size_t)DEPTH * DM * DM * 2;
constexpr size_t WS_WUKV = WS_WUQ + (size_t)DEPTH * 256 * 256 * 2;
constexpr size_t WS_WRT = WS_WUKV + (size_t)DEPTH * 512 * 128 * 2;
constexpr size_t WS_WS13 = WS_WRT + (size_t)DEPTH * 256 * HLD * 2;
constexpr size_t WS_WS2 = WS_WS13 + (size_t)DEPTH * 512 * DM * 2;
constexpr size_t WS_WE13 = WS_WS2 + (size_t)DEPTH * DM * 256 * 2;
constexpr size_t WS_WE2 = WS_WE13 + (size_t)NEXP * 512 * DM * 2;
constexpr size_t WS_XA = WS_WE2 + (size_t)NEXP * DM * 256 * 2;
constexpr size_t WS_Z = WS_XA + (size_t)NTOK * DM * 4;
constexpr size_t WS_H = WS_Z + (size_t)NTOK * DM * 4;
constexpr size_t WS_P = WS_H + (size_t)NTOK * HLD * 2;
constexpr size_t WS_QC = WS_P + (size_t)NTOK * INWP * 2;
constexpr size_t WS_KC = WS_QC + (size_t)NTOK * 256 * 2;
constexpr size_t WS_VC = WS_KC + (size_t)NTOK * 256 * 2;
constexpr size_t WS_CAT = WS_VC + (size_t)NTOK * 256 * 2;
constexpr size_t WS_GU = WS_CAT + (size_t)NTOK * DM * 2;
constexpr size_t WS_GDEC = WS_GU + (size_t)32 * NCH * 2048 * 4;
constexpr size_t WS_RSTD = WS_GDEC + (size_t)32 * NCH * 32 * 4;
constexpr size_t WS_LOG = al256(WS_RSTD + (size_t)NTOK * 2 * 4);
constexpr size_t WS_SEL = WS_LOG + (size_t)NTOK * 128 * 4;
constexpr size_t WS_GATE = WS_SEL + (size_t)NTOK * 8 * 4;
constexpr size_t WS_RANK = WS_GATE + (size_t)NTOK * 8 * 4;
constexpr size_t WS_TSLOT = WS_RANK + (size_t)NTOK * 8 * 4;
constexpr size_t WS_BBASE = WS_TSLOT + (size_t)NTOK * 8 * 4;
constexpr size_t WS_STOK = WS_BBASE + (size_t)256 * 128 * 4;
constexpr size_t WS_SGATE = al256(WS_STOK + (size_t)NSLOT_MAX * 4);
constexpr size_t WS_TEXP = al256(WS_SGATE + (size_t)NSLOT_MAX * 4);
constexpr size_t WS_HS = WS_TEXP + 2048 * 4;
constexpr size_t WS_HSS = WS_HS + (size_t)NSLOT_MAX * 256 * 2;
constexpr size_t WS_Y = WS_HSS + (size_t)NTOK * 256 * 2;
constexpr size_t WS_YS = WS_Y + (size_t)NSLOT_MAX * DM * 2;
constexpr size_t WS_BC = WS_YS + (size_t)NTOK * DM * 2;
constexpr size_t WS_YDST = WS_BC + (size_t)NTOK * 256 * 4;
constexpr size_t WS_CARRY = al256(WS_YDST + (size_t)NSLOT_MAX * 4);
constexpr size_t WS_END = WS_CARRY + (size_t)NB * NCH * 2 * 2 * 128 * 4;
static_assert(WS_END <= (size_t)2147483648u, "d_ws map must fit 2 GiB");
constexpr int CW_BAR = 4096;
constexpr int CW_CNT = 16384;

constexpr int LDS_BYTES = 147456;
constexpr int MISC_OFF = LDS_BYTES - 512;
constexpr int SCR_BYTES = MISC_OFF;

__device__ __forceinline__ unsigned f2bf(float f) { unsigned u = __builtin_bit_cast(unsigned, f); return (u + 0x7fffu + ((u >> 16) & 1u)) >> 16; }
__device__ __forceinline__ unsigned pk2(float lo, float hi) { return f2bf(lo) | (f2bf(hi) << 16); }
__device__ __forceinline__ float bf2f(unsigned short b) { return __builtin_bit_cast(float, (unsigned)b << 16); }
__device__ __forceinline__ float bflo(unsigned w) { return __builtin_bit_cast(float, w << 16); }
__device__ __forceinline__ float bfhi(unsigned w) { return __builtin_bit_cast(float, w & 0xffff0000u); }
typedef __bf16 bf16x2_t __attribute__((ext_vector_type(2)));
__device__ __forceinline__ unsigned cvtpk(float lo, float hi) { f32x2 v = {lo, hi}; bf16x2_t b = __builtin_convertvector(v, bf16x2_t); return __builtin_bit_cast(unsigned, b); }
__device__ __forceinline__ float wave_sum(float v) {
    v = v + __builtin_bit_cast(float, __builtin_amdgcn_update_dpp(0, __builtin_bit_cast(int, v), 0xB1, 0xf, 0xf, true));
    v = v + __builtin_bit_cast(float, __builtin_amdgcn_update_dpp(0, __builtin_bit_cast(int, v), 0x4E, 0xf, 0xf, true));
    v = v + __builtin_bit_cast(float, __builtin_amdgcn_update_dpp(0, __builtin_bit_cast(int, v), 0x141, 0xf, 0xf, true));
    v = v + __builtin_bit_cast(float, __builtin_amdgcn_update_dpp(0, __builtin_bit_cast(int, v), 0x140, 0xf, 0xf, true));
    v += __shfl_xor(v, 16); v += __shfl_xor(v, 32);
    return v;
}
#ifndef XA_BF16
#define XA_BF16 1
#endif
#if XA_BF16
typedef bf16 xa_t;
#else
typedef float xa_t;
#endif
#ifndef ROWSCALE_ASM
#define ROWSCALE_ASM 0
#endif
#ifndef ROWVALS_ASM
#define ROWVALS_ASM 1
#endif
#ifndef SD_BALANCE
#define SD_BALANCE 1
#endif
#ifndef G3_EDGE
#define G3_EDGE 0
#endif
#ifndef P2_ROWSKIP
#define P2_ROWSKIP 1
#endif
#ifndef P7_ROWS
#define P7_ROWS 3
#endif
#ifndef P13_ROWS
#define P13_ROWS 2
#endif
#ifndef DEFER_OFFN
#define DEFER_OFFN false
#endif
#ifndef AOFF_ASM
#define AOFF_ASM true
#endif
#ifndef FUSE9
#define FUSE9 0
#endif
#ifndef ZEROC
#define ZEROC 0
#endif
#ifndef ZEROC_GATHER
#define ZEROC_GATHER 0
#endif
#ifndef GATE_IN_COMBINE
#define GATE_IN_COMBINE 0
#endif
#ifndef BF_FULL
#define BF_FULL false
#endif
#ifndef BJ8_EPI
#define BJ8_EPI true
#endif
#ifndef XR11
#define XR11 true
#endif
#ifndef XR12
#define XR12 true
#endif
#ifndef WT_STORES
#define WT_STORES 0
#endif
#ifndef WT_MASK
#define WT_MASK 7
#endif
template <int WHO>
__device__ __forceinline__ void st16_wtw(void* p, v4u w) {
    if (WT_STORES && ((WT_MASK >> WHO) & 1)) asm volatile("global_store_dwordx4 %0, %1, off sc1\n\ts_nop 1" :: "v"(p), "v"(w) : "memory");
    else *(v4u*)p = w;
}
__device__ __forceinline__ float fsilu(float a) { return a * __builtin_amdgcn_rcpf(1.0f + __builtin_amdgcn_exp2f(-a * LOG2E)); }
namespace pg8 {
typedef unsigned short bf16_t;
constexpr int BM = 256, BK = 64, HALF = 128, HTB = HALF * BK * 2  , STAGE_BYTES = 8 * HTB, NXCD = 8, WGM = 8;

__host__ __device__ __forceinline__ int lds_byte(int r, int c) { const int st = (r >> 4) * 2 + (c >> 5), rr = r & 15, cc = c & 31, ob = rr * 64 + cc * 2; return st * 1024 + (ob ^ (((ob >> 9) & 1) << 5)); }
__host__ __device__ __forceinline__ void stage_rc(int b, int& R, int& C) { const int st = b / 1024, sb = b % 1024, swz = sb ^ (((sb >> 9) & 1) << 5); R = (st >> 1) * 16 + swz / 64; C = (st & 1) * 32 + (swz % 64) / 2; }
__host__ __device__ __forceinline__ int perm32(int rho) { const int n = rho >> 4, i = rho & 15; return 8 * (i >> 2) + 4 * n + (i & 3); }

struct Unit { int pm, pn, li; };
struct Gemm { const bf16_t* A; const bf16_t* Bt; int K; int lda; const int* rowidx; const LAS int* rowl; };

template <int CM = 0, int CN = 0, int CM2 = 0> struct StaticOrderT {
    int nM, nN, nwg, G, c, ov0, ovn;
    __device__ void init(int M, int N, int G_, int c_) { nM = M / BM; nN = N / BM; nwg = nM * nN; G = G_; c = c_; ov0 = -1; ovn = 0; }
    __device__ void set_range(int first, int count) { ov0 = first; ovn = count; }
    static __device__ __forceinline__ bool calc(int i, int nM, int nN, int nwg, int G, int c, Unit& u) {
        const int L = i * G + c; if (L >= nwg) return false;
        int wgid = L; { const int q = nwg / NXCD, r = nwg % NXCD, xcd = wgid % NXCD, off = wgid / NXCD; wgid = (xcd < r ? xcd * (q + 1) : r * (q + 1) + (xcd - r) * q) + off; }
        const int nig = WGM * nN, gid = wgid / nig, fm = gid * WGM, gsz = (nM - fm) < WGM ? (nM - fm) : WGM;
        u.pm = fm + ((wgid % nig) % gsz); u.pn = (wgid % nig) / gsz; return true;
    }
    __device__ bool next(int i, Unit& u) const {
        if (ov0 >= 0) { if (i >= ovn) return false; const int U = ov0 + i; const int nn = CN > 0 ? CN / BM : nN; u.pm = U / nn; u.pn = U % nn; return true; }
        if (CM > 0 && CN > 0 && G == 256) {
            if (nM == CM / BM) return calc(i, CM / BM, CN / BM, (CM / BM) * (CN / BM), 256, c, u);
            if (CM2 > 0 && nM == CM2 / BM) return calc(i, CM2 / BM, CN / BM, (CM2 / BM) * (CN / BM), 256, c, u); }
        return calc(i, nM, nN, nwg, G, c, u);
    }
};
typedef StaticOrderT<0, 0> StaticOrder;
struct AfterRouterOrder {
    int nR, G, c;
    __device__ void init(int M, int G_, int c_) { nR = M / BM; G = G_; c = c_; }
    __device__ bool next(int i, Unit& u) const {
        const int nidle = G - nR; int L;
        if (nidle <= 0 || 2 * nR - 2 * nidle > nR) { L = i * G + c; if (L >= 2 * nR) return false; }
        else if (c >= nR) { if (i >= 2) return false; L = 2 * (c - nR) + i; if (L >= 2 * nR) return false; }
        else { if (i >= 1) return false; L = 2 * nidle + c; if (L >= 2 * nR) return false; }
        u.pm = L >> 1; u.pn = L & 1; return true;
    }
};
struct TailOrder {
    int nunits, b0, G, c;
    __device__ void init(int nunits_, int b0_, int G_, int c_) { nunits = nunits_; b0 = b0_; G = G_; c = c_; }
    __device__ bool next(int i, Unit& u) const { if (c < b0) return false; const int L = i * (G - b0) + (c - b0); if (L >= nunits) return false; u.pm = L >> 1; u.pn = L & 1; return true; }
};
template <bool XR = false, int NN = 0> struct GroupedOrderT {
    const int* texp; int nN, G, c, ntile;
    __device__ void init(const int* texp_, int ntile_, int nN_, int G_, int c_) { texp = texp_; nN = nN_; G = G_; c = c_; ntile = ntile_; }
    __device__ bool next(int i, Unit& u) const {
        int mt, nt;
        if (XR && NN > 0 && G == 256) {
            constexpr int per = 32, gm = per / NN;
            const int x = c & 7, j = c >> 3;
            const int m0 = (x * ntile) >> 3, nm = (((x + 1) * ntile) >> 3) - m0;
            const int l = i * per + j; if (l >= nm * NN) return false;
            const int full = nm & ~(gm - 1);
            if (l < full * NN) { mt = i * gm + (j & (gm - 1)); nt = j / gm; } else { const int l2 = l - full * NN; mt = full + l2 / NN; nt = l2 & (NN - 1); }
            mt += m0;
        } else {
        const int L = i * G + c, tot = ntile * nN; if (L >= tot) return false;
        const int grp = 8 * nN;
        if (L < tot / grp * grp) { mt = L / grp * 8 + (L & 7); nt = (L % grp) >> 3; } else { mt = L / nN; nt = L % nN; }
        }
        u.pm = mt; u.pn = __builtin_amdgcn_readfirstlane(texp[mt]) * nN + nt; u.li = i; return true;
    }
};
typedef GroupedOrderT<false> GroupedOrder;

template <class E, class = void> struct has_bj8 { static constexpr bool v = false; };
template <class E> struct has_bj8<E, decltype((void)E::BJ8)> { static constexpr bool v = E::BJ8; };
template <class E> __device__ __forceinline__ constexpr bool epi_bj8() { return has_bj8<E>::v; }
template <class E, class = void> struct has_zc { static constexpr bool v = false; };
template <class E> struct has_zc<E, decltype((void)E::ZC_OK)> { static constexpr bool v = E::ZC_OK; };
template <class Epi, class Sched, int GATHER, bool ALIGN_EPI = true>
__device__ __forceinline__ void gemm_phase(LAS unsigned char* lds, const Gemm g, const Sched& S, const Epi& E) {
    int tid_ = threadIdx.x; asm volatile("" : "+v"(tid_));
    const int tid = tid_, wid = __builtin_amdgcn_readfirstlane(tid >> 6), lane = tid & 63, wr = wid >> 2, wc = wid & 3, fr = lane & 15, fq = lane >> 4;
    constexpr bool ZC = ZEROC && has_zc<Epi>::v;
    const int K = g.K, nt = K / BK;
    unsigned voffB[2], voffA[2]; int RA[2]; unsigned CA2[2];
#pragma unroll
    for (int i = 0; i < 2; ++i) { int R, C; stage_rc(tid * 16 + i * 8192, R, C); const int Rb = epi_bj8<Epi>() ? (64 * (R >> 5) + 16 * ((R >> 2) & 3) + 4 * ((R >> 4) & 1) + (R & 3)) : Epi::PERM ? ((R & ~31) + perm32(R & 31)) : R;
        RA[i] = R; CA2[i] = (unsigned)C * 2u; voffB[i] = (unsigned)(Rb * K + C) * 2u; voffA[i] = (unsigned)(R * g.lda + C) * 2u; }
    const size_t hstepA = (size_t)HALF * g.lda * 2;
    const size_t kstep = (size_t)(BK * 2);
    const size_t hstep = (size_t)HALF * K * 2;
    const size_t hstepB = epi_bj8<Epi>() ? (size_t)8 * K * 2 : hstep;
    const size_t tstep = 2 * hstep;
    const size_t tstepA = (size_t)BM * g.lda * 2;
    const unsigned ldsw = (unsigned)wid * 1024u;
    const int aoff = lds_byte(wr * 64 + fr, fq * 8), boff = lds_byte(wc * 32 + fr, fq * 8);
#define PG8_SA(b, h) (((b) * 2 + (h)) * HTB)
#define PG8_SB(b, h) ((4 + (b) * 2 + (h)) * HTB)
#define PG8_STAGE(bufoff, gbase, voff) do { _Pragma("unroll") for (int _i = 0; _i < 2; ++_i) \
        __builtin_amdgcn_global_load_lds((const unsigned*)((const char*)(gbase) + (voff)[_i]), (LAS unsigned*)(lds + (bufoff) + ldsw + _i * 8192), 16, 0, 0); } while (0)
#define PG8_LDA(dst, b, h) do { _Pragma("unroll") for (int m = 0; m < 4; ++m) _Pragma("unroll") for (int k = 0; k < 2; ++k) dst[m][k] = *(const LAS bf16x8*)(lds + PG8_SA(b, h) + aoff + m * 2048 + k * 1024); } while (0)
#define PG8_LDB(dst, b, h) do { _Pragma("unroll") for (int n = 0; n < 2; ++n) _Pragma("unroll") for (int k = 0; k < 2; ++k) dst[n][k] = *(const LAS bf16x8*)(lds + PG8_SB(b, h) + boff + n * 2048 + k * 1024); } while (0)
#define PG8_MMA(ai, bj, At, Bt) do { __builtin_amdgcn_s_setprio(1); _Pragma("unroll") for (int m = 0; m < 4; ++m) _Pragma("unroll") for (int n = 0; n < 2; ++n) _Pragma("unroll") for (int k = 0; k < 2; ++k) \
        acc[ai][bj][m][n] = __builtin_amdgcn_mfma_f32_16x16x32_bf16(Bt[n][k], At[m][k], acc[ai][bj][m][n], 0, 0, 0); __builtin_amdgcn_s_setprio(0); } while (0)
#define PG8_MMA0(ai, bj, At, Bt) do { __builtin_amdgcn_s_setprio(1); _Pragma("unroll") for (int m = 0; m < 4; ++m) _Pragma("unroll") for (int n = 0; n < 2; ++n) { \
        acc[ai][bj][m][n] = __builtin_amdgcn_mfma_f32_16x16x32_bf16(Bt[n][0], At[m][0], (f32x4){0.f, 0.f, 0.f, 0.f}, 0, 0, 0); \
        acc[ai][bj][m][n] = __builtin_amdgcn_mfma_f32_16x16x32_bf16(Bt[n][1], At[m][1], acc[ai][bj][m][n], 0, 0, 0); } __builtin_amdgcn_s_setprio(0); } while (0)
#define PG8_WAIT_V(n) asm volatile("s_waitcnt vmcnt(" #n ")" ::: "memory")
#define PG8_WAIT_L(n) asm volatile("s_waitcnt lgkmcnt(" #n ")" ::: "memory")
#define PG8_BAR __builtin_amdgcn_s_barrier()
#define PG8_SCHED __builtin_amdgcn_sched_barrier(0)
#define PG8_AOFF(dst, u) do { if constexpr (GATHER) { \
        if constexpr (AOFF_ASM && GATHER == 1) { unsigned _r0, _r1, _r2, _r3; const unsigned _b = (unsigned)((u).pm * BM) * 4u; \
            const unsigned _q0 = _b + (unsigned)RA[0] * 4u, _q1 = _b + (unsigned)RA[1] * 4u, _q2 = _q0 + HALF * 4u, _q3 = _q1 + HALF * 4u; \
            asm volatile("s_nop 4\n\tglobal_load_dword %0, %4, %8\n\tglobal_load_dword %1, %5, %8\n\tglobal_load_dword %2, %6, %8\n\tglobal_load_dword %3, %7, %8\n\ts_waitcnt vmcnt(0)" \
                : "=&v"(_r0), "=&v"(_r1), "=&v"(_r2), "=&v"(_r3) : "v"(_q0), "v"(_q1), "v"(_q2), "v"(_q3), "s"(g.rowidx) : "memory"); \
            dst[0][0] = _r0 * (unsigned)(g.lda * 2) + CA2[0]; dst[0][1] = _r1 * (unsigned)(g.lda * 2) + CA2[1]; dst[1][0] = _r2 * (unsigned)(g.lda * 2) + CA2[0]; dst[1][1] = _r3 * (unsigned)(g.lda * 2) + CA2[1]; } \
        else { _Pragma("unroll") for (int _h = 0; _h < 2; ++_h) _Pragma("unroll") for (int _i = 0; _i < 2; ++_i) \
        dst[_h][_i] = (unsigned)(GATHER == 2 ? g.rowl[(u).li * BM + _h * HALF + RA[_i]] : g.rowidx[(u).pm * BM + _h * HALF + RA[_i]]) * (unsigned)(g.lda * 2) + CA2[_i]; } } } while (0)
#define PG8_STAGE_A(bufoff, gbase, h, useN) do { if constexpr (GATHER) { unsigned _o[2]; \
        if constexpr (DEFER_OFFN) { _o[0] = offC[h][0]; _o[1] = offC[h][1]; if (useN) { _o[0] = offN[h][0]; _o[1] = offN[h][1]; asm volatile("" : "+v"(_o[0]), "+v"(_o[1])); } } \
        else { _o[0] = (useN) ? offN[h][0] : offC[h][0]; _o[1] = (useN) ? offN[h][1] : offC[h][1]; } PG8_STAGE(bufoff, gbase, _o); } \
        else { PG8_STAGE(bufoff, (gbase) + (h) * hstepA, voffA); } } while (0)
    Unit cur, nxt; int ui = 0;
    if (!S.next(0, cur)) return;
    f32x4 acc[2][2][4][2];
    if constexpr (!ZC) {
#pragma unroll
    for (int a = 0; a < 2; ++a)
#pragma unroll
        for (int b = 0; b < 2; ++b)
#pragma unroll
            for (int m = 0; m < 4; ++m)
#pragma unroll
                for (int n = 0; n < 2; ++n) acc[a][b][m][n] = (f32x4){0.f, 0.f, 0.f, 0.f}; }
    bf16x8 At[4][2], B0[2][2], B1[2][2];
    unsigned offC[2][2], offN[2][2];
    PG8_AOFF(offC, cur);
    const char* cA = GATHER ? (const char*)g.A : (const char*)g.A + (size_t)cur.pm * tstepA; const char* cB = (const char*)g.Bt + (size_t)cur.pn * tstep;
    PG8_STAGE(PG8_SB(0, 0), cB, voffB); PG8_STAGE(PG8_SB(0, 1), cB + hstepB, voffB); PG8_STAGE_A(PG8_SA(0, 0), cA, 0, false); PG8_STAGE_A(PG8_SA(0, 1), cA, 1, false);
    if (wr == 1) PG8_BAR;
    PG8_WAIT_V(2); PG8_BAR;
    PG8_STAGE(PG8_SB(1, 0), cB + kstep, voffB); PG8_STAGE_A(PG8_SA(1, 0), cA + kstep, 0, false); PG8_STAGE(PG8_SB(1, 1), cB + hstepB + kstep, voffB);
    PG8_WAIT_V(6); PG8_BAR;
    for (;;) {
        const bool has_next = S.next(ui + 1, nxt);
        if constexpr (GATHER) { if (has_next) { PG8_AOFF(offN, nxt); } else {
#pragma unroll
            for (int h = 0; h < 2; ++h)
#pragma unroll
                for (int i = 0; i < 2; ++i) offN[h][i] = offC[h][i]; } }
        const char* nA = has_next ? (GATHER ? (const char*)g.A : (const char*)g.A + (size_t)nxt.pm * tstepA) : cA; const char* nB = has_next ? (const char*)g.Bt + (size_t)nxt.pn * tstep : cB;
#define PG8_KBODY(MMAF) { \
            const bool last = (t == nt - 2); \
            const char* a1 = cA + (size_t)(t + 1) * kstep; \
            const char* a2 = last ? nA : cA + (size_t)(t + 2) * kstep; const char* b2 = last ? nB : cB + (size_t)(t + 2) * kstep; \
            const char* a3 = a2 + kstep; const char* b3 = b2 + kstep; \
            PG8_LDB(B0, 0, 0); PG8_LDB(B1, 0, 1); PG8_SCHED; PG8_LDA(At, 0, 0); PG8_STAGE_A(PG8_SA(1, 1), a1, 1, false); \
            PG8_WAIT_V(8); PG8_WAIT_L(0); PG8_BAR; MMAF(0, 0, At, B0); MMAF(0, 1, At, B1); PG8_BAR; PG8_SCHED; \
            PG8_LDA(At, 0, 1); PG8_STAGE(PG8_SB(0, 0), b2, voffB); PG8_STAGE(PG8_SB(0, 1), b2 + hstepB, voffB); PG8_STAGE_A(PG8_SA(0, 0), a2, 0, last); \
            PG8_WAIT_V(8); PG8_WAIT_L(0); PG8_BAR; MMAF(1, 0, At, B0); MMAF(1, 1, At, B1); PG8_BAR; PG8_SCHED; \
            PG8_LDB(B0, 1, 0); PG8_LDB(B1, 1, 1); PG8_SCHED; PG8_LDA(At, 1, 0); PG8_STAGE_A(PG8_SA(0, 1), a2, 1, last); \
            PG8_WAIT_V(8); PG8_WAIT_L(0); PG8_BAR; PG8_MMA(0, 0, At, B0); PG8_MMA(0, 1, At, B1); PG8_BAR; PG8_SCHED; \
            PG8_LDA(At, 1, 1); PG8_STAGE(PG8_SB(1, 0), b3, voffB); PG8_STAGE(PG8_SB(1, 1), b3 + hstepB, voffB); PG8_STAGE_A(PG8_SA(1, 0), a3, 0, last); \
            PG8_WAIT_V(8); PG8_WAIT_L(0); PG8_BAR; PG8_MMA(1, 0, At, B0); PG8_MMA(1, 1, At, B1); PG8_BAR; PG8_SCHED; }
        if constexpr (ZC) { int t = 0; PG8_KBODY(PG8_MMA0);
#pragma unroll 1
          for (t = 2; t < nt; t += 2) PG8_KBODY(PG8_MMA); }
        else {
#pragma unroll 1
          for (int t = 0; t < nt; t += 2) PG8_KBODY(PG8_MMA); }
#undef PG8_KBODY
        if constexpr (ALIGN_EPI) { if (wr == 0) PG8_BAR; }
        E(acc, cur, wr, wc, fr, fq);
        if (!has_next) break;
        if constexpr (!ZC) {
#pragma unroll
        for (int a = 0; a < 2; ++a)
#pragma unroll
            for (int b = 0; b < 2; ++b)
#pragma unroll
                for (int m = 0; m < 4; ++m)
#pragma unroll
                    for (int n = 0; n < 2; ++n) acc[a][b][m][n] = (f32x4){0.f, 0.f, 0.f, 0.f}; }
        cur = nxt; cA = nA; cB = nB; ++ui;
        if constexpr (GATHER) {
#pragma unroll
            for (int h = 0; h < 2; ++h)
#pragma unroll
                for (int i = 0; i < 2; ++i) offC[h][i] = offN[h][i]; }
        if constexpr (ALIGN_EPI) { if (wr == 1) PG8_BAR; }
    }
    PG8_WAIT_V(0);
    if constexpr (!ALIGN_EPI) { if (wr == 0) PG8_BAR; }
    PG8_BAR;
#undef PG8_SA
#undef PG8_SB
#undef PG8_STAGE
#undef PG8_LDA
#undef PG8_LDB
#undef PG8_MMA
#undef PG8_MMA0
#undef PG8_WAIT_V
#undef PG8_WAIT_L
#undef PG8_BAR
#undef PG8_SCHED
#undef PG8_AOFF
#undef PG8_STAGE_A
}
}
namespace pg8 {
#define PG8_ROWVALS(dst, base, voff, O1, O2, O3, O4, O5, O6, O7) asm volatile("s_nop 4\n\tglobal_load_dword %0, %8, %9\n\tglobal_load_dword %1, %8, %9 offset:" #O1 "\n\tglobal_load_dword %2, %8, %9 offset:" #O2 "\n\tglobal_load_dword %3, %8, %9 offset:" #O3 \
        "\n\tglobal_load_dword %4, %8, %9 offset:" #O4 "\n\tglobal_load_dword %5, %8, %9 offset:" #O5 "\n\tglobal_load_dword %6, %8, %9 offset:" #O6 "\n\tglobal_load_dword %7, %8, %9 offset:" #O7 "\n\ts_waitcnt vmcnt(0)" \
        : "=&v"(dst[0]), "=&v"(dst[1]), "=&v"(dst[2]), "=&v"(dst[3]), "=&v"(dst[4]), "=&v"(dst[5]), "=&v"(dst[6]), "=&v"(dst[7]) : "v"(voff), "s"(base) : "memory")
__device__ __forceinline__ unsigned cvt_pk_bf16(float lo, float hi) { unsigned r; asm volatile("v_cvt_pk_bf16_f32 %0, %1, %2" : "=v"(r) : "v"(lo), "v"(hi)); return r; }
#define PG8_ROWVALS4(d0, d1, d2, d3, base, voff, O0, O1, O2, O3) asm volatile("s_nop 4\n\tglobal_load_dword %0, %4, %5 offset:" #O0 "\n\tglobal_load_dword %1, %4, %5 offset:" #O1 "\n\tglobal_load_dword %2, %4, %5 offset:" #O2 "\n\tglobal_load_dword %3, %4, %5 offset:" #O3 "\n\ts_waitcnt vmcnt(0)" \
        : "=&v"(d0), "=&v"(d1), "=&v"(d2), "=&v"(d3) : "v"(voff), "s"(base) : "memory")
template <int LDC, bool ROWSCALE, bool SKIPROPE = false, bool ROWMAP = false> struct EpiBf16 {
    static constexpr bool PERM = true; static constexpr bool BJ8 = BF_FULL && !ROWSCALE; static constexpr int NST = SKIPROPE ? 0 : 16;
    bf16_t* O; int nloc; unsigned scmask; float sc; size_t tile_stride; const float* rowscale; int rs_off; const int* rowmap;
    __device__ __forceinline__ void operator()(const f32x4 (&acc)[2][2][4][2], const Unit& u, int wr, int wc, int fr, int fq) const {
        const int pnl = u.pn % nloc; const int row0 = u.pm * BM + wr * 64 + fr;
        const float s = ((scmask >> pnl) & 1u) ? sc : 1.f;
        if constexpr (BJ8) {
            const int hi = fr >> 3, chunk = 2 * fq + hi; const bool skip = SKIPROPE && pnl == 0 && chunk >= 4;
            const int rowA = u.pm * BM + wr * 64 + (fr & 7);
            bf16_t* pb = O + (size_t)pnl * tile_stride + wc * 64 + chunk * 8;
#pragma unroll
            for (int ai = 0; ai < 2; ++ai)
#pragma unroll
                for (int m = 0; m < 4; ++m) {
                    float rsc = s; if constexpr (ROWSCALE) rsc *= rowscale[2 * (row0 + ai * HALF + m * 16) + rs_off];
                    int c0[4], c1[4];
                    { const f32x4 v0 = acc[ai][0][m][0] * rsc, v1 = acc[ai][0][m][1] * rsc; c0[0] = (int)cvt_pk_bf16(v0[0], v0[1]); c0[1] = (int)cvt_pk_bf16(v0[2], v0[3]); c0[2] = (int)cvt_pk_bf16(v1[0], v1[1]); c0[3] = (int)cvt_pk_bf16(v1[2], v1[3]); }
                    { const f32x4 v0 = acc[ai][1][m][0] * rsc, v1 = acc[ai][1][m][1] * rsc; c1[0] = (int)cvt_pk_bf16(v0[0], v0[1]); c1[1] = (int)cvt_pk_bf16(v0[2], v0[3]); c1[2] = (int)cvt_pk_bf16(v1[0], v1[1]); c1[3] = (int)cvt_pk_bf16(v1[2], v1[3]); }
                    const int r1 = rowA + ai * HALF + m * 16;
                    { v4u d1;
                      d1.x = (unsigned)__builtin_amdgcn_update_dpp(c0[0], c1[0], 0x128, 0xf, 0xc, false); d1.y = (unsigned)__builtin_amdgcn_update_dpp(c0[1], c1[1], 0x128, 0xf, 0xc, false);
                      d1.z = (unsigned)__builtin_amdgcn_update_dpp(c0[2], c1[2], 0x128, 0xf, 0xc, false); d1.w = (unsigned)__builtin_amdgcn_update_dpp(c0[3], c1[3], 0x128, 0xf, 0xc, false);
                      if (!skip) st16_wtw<0>(pb + (size_t)(ROWMAP ? rowmap[r1] : r1) * LDC, d1); }
                    __builtin_amdgcn_sched_barrier(0);
                    { v4u d2;
                      d2.x = (unsigned)__builtin_amdgcn_update_dpp(c1[0], c0[0], 0x128, 0xf, 0x3, false); d2.y = (unsigned)__builtin_amdgcn_update_dpp(c1[1], c0[1], 0x128, 0xf, 0x3, false);
                      d2.z = (unsigned)__builtin_amdgcn_update_dpp(c1[2], c0[2], 0x128, 0xf, 0x3, false); d2.w = (unsigned)__builtin_amdgcn_update_dpp(c1[3], c0[3], 0x128, 0xf, 0x3, false);
                      if (!skip) st16_wtw<0>(pb + (size_t)(ROWMAP ? rowmap[r1 + 8] : r1 + 8) * LDC, d2); }
                    __builtin_amdgcn_sched_barrier(0); }
            return;
        }
        bf16_t* p0 = O + (size_t)pnl * tile_stride + (size_t)row0 * LDC + wc * 32 + 8 * fq;
        if (SKIPROPE && pnl == 0 && (wc & 1)) return;
        float rv[8];
        const unsigned vo_ = (unsigned)(2 * row0 + rs_off) * 4u;
#pragma unroll
        for (int ai = 0; ai < 2; ++ai) {
            if constexpr (ROWSCALE && ROWSCALE_ASM) { if (ai == 0) PG8_ROWVALS4(rv[0], rv[1], rv[2], rv[3], rowscale, vo_, 0, 128, 256, 384); else PG8_ROWVALS4(rv[4], rv[5], rv[6], rv[7], rowscale, vo_, 1024, 1152, 1280, 1408); }
#pragma unroll
            for (int m = 0; m < 4; ++m) { bf16_t* rowp = ROWMAP ? O + (size_t)pnl * tile_stride + (size_t)rowmap[row0 + ai * HALF + m * 16] * LDC + wc * 32 + 8 * fq : p0 + (size_t)(ai * HALF + m * 16) * LDC;
                float rsc = s; if constexpr (ROWSCALE) { if constexpr (ROWSCALE_ASM) rsc *= rv[ai * 4 + m]; else rsc *= rowscale[2 * (row0 + ai * HALF + m * 16) + rs_off]; }
#pragma unroll
                for (int bj = 0; bj < 2; ++bj) { const f32x4 v0 = acc[ai][bj][m][0] * rsc, v1 = acc[ai][bj][m][1] * rsc;
                    v4u w; w.x = cvt_pk_bf16(v0[0], v0[1]); w.y = cvt_pk_bf16(v0[2], v0[3]); w.z = cvt_pk_bf16(v1[0], v1[1]); w.w = cvt_pk_bf16(v1[2], v1[3]);
                    st16_wtw<0>(rowp + bj * HALF, w); } } }
    }
};
constexpr float YSCALE = 32.0f;
struct EpiFp8 {
    static constexpr bool ZC_OK = true; static constexpr bool PERM = true; static constexpr bool BJ8 = BJ8_EPI; static constexpr int NST = BJ8_EPI ? 8 : 16;
    unsigned char* O; int nloc;
    __device__ __forceinline__ void operator()(const f32x4 (&acc)[2][2][4][2], const Unit& u, int wr, int wc, int fr, int fq) const {
        const int pnl = u.pn % nloc; const int row0 = u.pm * BM + wr * 64 + fr;
        unsigned char* p0 = O + (size_t)row0 * DM + pnl * BM + (BJ8 ? wc * 64 + 16 * fq : wc * 32 + 8 * fq);
#pragma unroll
        for (int ai = 0; ai < 2; ++ai)
#pragma unroll
            for (int m = 0; m < 4; ++m) { unsigned char* rowp = p0 + (size_t)(ai * HALF + m * 16) * DM;
                int w[2][2];
#pragma unroll
                for (int bj = 0; bj < 2; ++bj) { const f32x4 v0 = acc[ai][bj][m][0], v1 = acc[ai][bj][m][1];
                    int w0 = 0, w1 = 0;
                    w0 = __builtin_amdgcn_cvt_pk_fp8_f32(v0[0], v0[1], w0, false); w0 = __builtin_amdgcn_cvt_pk_fp8_f32(v0[2], v0[3], w0, true);
                    w1 = __builtin_amdgcn_cvt_pk_fp8_f32(v1[0], v1[1], w1, false); w1 = __builtin_amdgcn_cvt_pk_fp8_f32(v1[2], v1[3], w1, true);
                    w[bj][0] = w0; w[bj][1] = w1; }
                if constexpr (BJ8) *(v4u*)rowp = (v4u){(unsigned)w[0][0], (unsigned)w[0][1], (unsigned)w[1][0], (unsigned)w[1][1]};
                else { *(v2u*)rowp = (v2u){(unsigned)w[0][0], (unsigned)w[0][1]}; *(v2u*)(rowp + HALF) = (v2u){(unsigned)w[1][0], (unsigned)w[1][1]}; } }
    }
};
struct EpiLogits {
    static constexpr bool PERM = false; static constexpr int NST = 16;
    float* O;
    __device__ __forceinline__ void operator()(const f32x4 (&acc)[2][2][4][2], const Unit& u, int wr, int wc, int fr, int fq) const {
        const int col0 = wc * 32 + 4 * fq;
#pragma unroll
        for (int ai = 0; ai < 2; ++ai)
#pragma unroll
            for (int m = 0; m < 4; ++m) { float* rowp = O + (size_t)(u.pm * BM + ai * HALF + wr * 64 + m * 16 + fr) * 128 + col0;
#pragma unroll
                for (int n = 0; n < 2; ++n) *(f32x4*)(rowp + n * 16) = acc[ai][0][m][n] + acc[ai][1][m][n]; }
    }
};
template <bool LGATE = false> struct EpiSwiGLUT {
    static constexpr bool PERM = true; static constexpr bool BJ8 = BJ8_EPI; static constexpr int NST = BJ8_EPI ? 8 : 16;
    bf16_t* O; int nloc; const float* gate; float gsc; const LAS float* gatel;
    __device__ __forceinline__ void operator()(const f32x4 (&acc)[2][2][4][2], const Unit& u, int wr, int wc, int fr, int fq) const {
        const int pnl = u.pn % nloc; const int row0 = u.pm * BM + wr * 64 + fr; const int col0 = pnl * 128 + (BJ8 ? wc * 32 + 8 * fq : wc * 16 + 4 * fq);
        float gv[8]; const bool pre = ROWVALS_ASM && !LGATE && gate != nullptr;
        if (pre) { const unsigned vo = (unsigned)row0 * 4u; PG8_ROWVALS(gv, gate, vo, 64, 128, 192, 512, 576, 640, 704); }
#pragma unroll
        for (int ai = 0; ai < 2; ++ai)
#pragma unroll
            for (int m = 0; m < 4; ++m) { const int row = row0 + ai * HALF + m * 16; float gt; if constexpr (LGATE) gt = gatel[u.li * BM + wr * 64 + fr + ai * HALF + m * 16] * gsc; else gt = pre ? gv[ai * 4 + m] * gsc : (gate ? gate[row] * gsc : gsc); bf16_t* rowp = O + (size_t)row * 256 + col0;
                v2u w[2];
#pragma unroll
                for (int bj = 0; bj < 2; ++bj) { const f32x4 a = acc[ai][bj][m][0], b = acc[ai][bj][m][1];
                    w[bj].x = cvt_pk_bf16(fsilu(a[0]) * b[0] * gt, fsilu(a[1]) * b[1] * gt); w[bj].y = cvt_pk_bf16(fsilu(a[2]) * b[2] * gt, fsilu(a[3]) * b[3] * gt); }
                if constexpr (BJ8) *(v4u*)rowp = (v4u){w[0].x, w[0].y, w[1].x, w[1].y};
                else { *(v2u*)rowp = w[0]; *(v2u*)(rowp + 64) = w[1]; } }
    }
};
typedef EpiSwiGLUT<false> EpiSwiGLU;
struct EpiNull {
    static constexpr bool PERM = true; static constexpr int NST = 0;
    __device__ __forceinline__ void operator()(const f32x4 (&acc)[2][2][4][2], const Unit& u, int wr, int wc, int fr, int fq) const {
#pragma unroll
        for (int ai = 0; ai < 2; ++ai)
#pragma unroll
            for (int bj = 0; bj < 2; ++bj)
                asm volatile("" :: "v"(acc[ai][bj][0][0]), "v"(acc[ai][bj][0][1]), "v"(acc[ai][bj][1][0]), "v"(acc[ai][bj][1][1]), "v"(acc[ai][bj][2][0]), "v"(acc[ai][bj][2][1]), "v"(acc[ai][bj][3][0]), "v"(acc[ai][bj][3][1]));
    }
};
}
#define XB_TMO      128
#define XB_XCNT(j)  (256  + 64 * (j))
#define XB_XSUB(j)  (1280 + 64 * (j))
#define XB_XGEN(j)  (2304 + 64 * (j))
#define XB_TOP      3328
#define XB_TOPGEN   3392
#define XCD_BAR_WORDS 3456
#define XB_SPIN_CAP (1u << 18)

__device__ __forceinline__ unsigned xb_ld(unsigned* p)              { return __hip_atomic_load(p, __ATOMIC_RELAXED, __HIP_MEMORY_SCOPE_AGENT); }
__device__ __forceinline__ unsigned xb_add(unsigned* p, unsigned v) { return __hip_atomic_fetch_add(p, v, __ATOMIC_RELAXED, __HIP_MEMORY_SCOPE_AGENT); }
__device__ __forceinline__ unsigned xb_xcc_id() { return (unsigned)__builtin_amdgcn_s_getreg((3 << 11) | 20) & 0xFu; }
#define XB_SPIN(cond, bar) do { unsigned _sp = 0; while (cond) { __builtin_amdgcn_s_sleep(1); \
    if ((++_sp & 255u) == 0u) { if (xb_ld(&(bar)[XB_TMO])) break; if (_sp > XB_SPIN_CAP) { atomicAdd(&(bar)[XB_TMO], 1u); break; } } } } while (0)

struct XcdBarrier {
    unsigned* bar; unsigned x;
    volatile LAS unsigned* st;
};

__device__ __forceinline__ XcdBarrier xcd_barrier_post(unsigned* bar, volatile LAS unsigned* st) {
    XcdBarrier b; b.bar = bar; b.x = xb_xcc_id(); b.st = st;
    if (threadIdx.x == 0) (void)xb_add(&bar[XB_XCNT(b.x)], 1u);
    return b;
}
__device__ __forceinline__ void xcd_barrier_complete(unsigned* bar, unsigned x, unsigned& nloc, unsigned& nx) {
    const unsigned G = gridDim.x * gridDim.y * gridDim.z;
    unsigned sum, cnt, mine, sp = 0u;
    for (;;) {
        sum = 0u; cnt = 0u; mine = 0u;
#pragma unroll
        for (unsigned j = 0; j < 16; ++j) { const unsigned c = xb_ld(&bar[XB_XCNT(j)]); sum += c; cnt += (c > 0u) ? 1u : 0u; mine = (j == x) ? c : mine; }
        if (sum == G) break;
        __builtin_amdgcn_s_sleep(1);
        if ((++sp & 255u) == 0u) { if (xb_ld(&bar[XB_TMO])) break; if (sp > XB_SPIN_CAP) { atomicAdd(&bar[XB_TMO], 1u); break; } }
    }
    nloc = mine > 0u ? mine : 1u; nx = cnt > 0u ? cnt : 1u;
}

__device__ __forceinline__ void xcd_barrier(const XcdBarrier& b) {
    asm volatile("s_waitcnt vmcnt(0)" ::: "memory");
    __syncthreads();
    if (threadIdx.x == 0) {
        unsigned* bar = b.bar;
        __builtin_amdgcn_s_waitcnt(0);
        unsigned nloc = b.st[0], nx = b.st[1];
        if (nloc == 0u) { xcd_barrier_complete(bar, b.x, nloc, nx); b.st[0] = nloc; b.st[1] = nx; }
        const unsigned old = xb_add(&bar[XB_XSUB(b.x)], 1u);
        const unsigned gen = old / nloc;
        if (old + 1u == (gen + 1u) * nloc) {
            __builtin_amdgcn_fence(__ATOMIC_RELEASE, "agent");
            asm volatile("s_waitcnt vmcnt(0)" ::: "memory");
            const unsigned og = xb_add(&bar[XB_TOP], 1u);
            const unsigned tg = og / nx;
            if (og + 1u == (tg + 1u) * nx) xb_add(&bar[XB_TOPGEN], 1u);
            else XB_SPIN(xb_ld(&bar[XB_TOPGEN]) == tg, bar);
            __builtin_amdgcn_fence(__ATOMIC_ACQUIRE, "agent");
            xb_add(&bar[XB_XGEN(b.x)], 1u);
            asm volatile("s_waitcnt vmcnt(0)" ::: "memory");
        } else {
            XB_SPIN(xb_ld(&bar[XB_XGEN(b.x)]) == gen, bar);
            __builtin_amdgcn_fence(__ATOMIC_ACQUIRE, "agent");
            asm volatile("s_waitcnt vmcnt(0)" ::: "memory");
        }
    }
    __syncthreads();
}
namespace att {
constexpr int NSLOT = 3, SLOTB = 8192;
constexpr int LDS_K = 0, LDS_V = NSLOT * SLOTB, LDS_WS = 2 * NSLOT * SLOTB, LDS_OST = LDS_WS + 8 * 64 * 4, LDS_BIAS = LDS_OST + 8 * 4096, LDS_END = LDS_BIAS + 2048;
enum { M_FULL = 0, M_NA = 1, M_WA = 2 };
__device__ __forceinline__ int crow(int r, int hi) { return (r & 3) + 8 * (r >> 2) + 4 * hi; }
__device__ __forceinline__ void glds16(const void* gsrc, unsigned lds_dst) { unsigned keep;
    asm volatile("s_mov_b32 %0, m0\n\ts_mov_b32 m0, %2\n\ts_nop 0\n\tglobal_load_lds_dwordx4 %1, off\n\ts_mov_b32 m0, %0" : "=&s"(keep) : "v"(gsrc), "s"(lds_dst) : "memory"); }
__device__ __forceinline__ void qkt(f32x16& p0, f32x16& p1, const char* Kslot, const bf16x8* qr, int r32, int hi) {
    const char* kb = Kslot + hi * 1024 + r32 * 16;
    const f32x16 z = {};
#pragma unroll
    for (int d0 = 0; d0 < 4; ++d0) {
        const bf16x8 b0 = *reinterpret_cast<const bf16x8*>(kb + d0 * 2048);
        const bf16x8 b1 = *reinterpret_cast<const bf16x8*>(kb + d0 * 2048 + 512);
        if (d0 == 0) { p0 = __builtin_amdgcn_mfma_f32_32x32x16_bf16(b0, qr[0], z, 0, 0, 0); p1 = __builtin_amdgcn_mfma_f32_32x32x16_bf16(b1, qr[0], z, 0, 0, 0); }
        else { p0 = __builtin_amdgcn_mfma_f32_32x32x16_bf16(b0, qr[d0], p0, 0, 0, 0); p1 = __builtin_amdgcn_mfma_f32_32x32x16_bf16(b1, qr[d0], p1, 0, 0, 0); } }
}
__device__ __forceinline__ void pv(f32x16* o, int vb, bf16x8 pa0, bf16x8 pa1, bf16x8 pa2, bf16x8 pa3) {
#pragma unroll
    for (int d0 = 0; d0 < 2; ++d0) { s16x4 lo[4], hi[4];
#pragma unroll
        for (int ks = 0; ks < 4; ++ks) {
            asm volatile("ds_read_b64_tr_b16 %0,%1 offset:%c2" : "=&v"(lo[ks]) : "v"(vb), "i"(d0 * 4096 + ks * 1024) : "memory");
            asm volatile("ds_read_b64_tr_b16 %0,%1 offset:%c2" : "=&v"(hi[ks]) : "v"(vb), "i"(d0 * 4096 + ks * 1024 + 512) : "memory"); }
        asm volatile("s_waitcnt lgkmcnt(0)" ::: "memory"); __builtin_amdgcn_sched_barrier(0);
#define PK(k) (bf16x8){lo[k][0], lo[k][1], lo[k][2], lo[k][3], hi[k][0], hi[k][1], hi[k][2], hi[k][3]}
        o[d0] = __builtin_amdgcn_mfma_f32_32x32x16_bf16(pa0, PK(0), o[d0], 0, 0, 0);
        o[d0] = __builtin_amdgcn_mfma_f32_32x32x16_bf16(pa1, PK(1), o[d0], 0, 0, 0);
        o[d0] = __builtin_amdgcn_mfma_f32_32x32x16_bf16(pa2, PK(2), o[d0], 0, 0, 0);
        o[d0] = __builtin_amdgcn_mfma_f32_32x32x16_bf16(pa3, PK(3), o[d0], 0, 0, 0);
#undef PK
    }
}
struct Desc {
    const bf16* Q; int qp;
    const bf16* K; const bf16* V; int kp;
    bf16* O; int op;
    int nt, nctx, nt_real;
    int ctxrow, latrow;
    int r0, kr0;
    int q0, kt0;
    const float* rpb;
    float sink_l2; int has_sink;
    int qrope, qt0;
};
template <int MODE>
__device__ __forceinline__ void attn_unit(const Desc& d, char* shm) {
    int tid_ = threadIdx.x; asm volatile("" : "+v"(tid_));
    const int tid = tid_, lane = tid & 63, r32 = lane & 31, hi = lane >> 5; const int wid = __builtin_amdgcn_readfirstlane(tid >> 6);
    const unsigned lds0 = (unsigned)(uintptr_t)shm;
    float* wsf = (float*)(shm + LDS_WS) + wid * 64;
    const bf16* Qw = d.Q + (size_t)(wid * 32) * d.qp;
    const unsigned kdst = lds0 + LDS_K + wid * 1024, vdst = lds0 + LDS_V + wid * 1024;
    const size_t koffl = (size_t)lane * d.kp + wid * 8;
    const size_t voffl = (size_t)(16 * (wid & 3) + (lane >> 2)) * d.kp + (wid >> 2) * 32 + (lane & 3) * 8;
#define TROW(t) ((t) < d.nctx ? d.ctxrow + 64 * (t) : d.latrow + 64 * ((t) - d.nctx))
#define DMA_KV(t, slot) do { const size_t ro_ = (size_t)TROW(t) * d.kp; \
        glds16(d.K + ro_ + koffl, (unsigned)__builtin_amdgcn_readfirstlane(kdst + (slot) * SLOTB)); \
        glds16(d.V + ro_ + voffl, (unsigned)__builtin_amdgcn_readfirstlane(vdst + (slot) * SLOTB)); } while (0)
    const int vb0 = (int)(lds0 + LDS_V) + ((lane >> 4) & 1) * 32 + (lane & 3) * 8 + (4 * hi + ((lane & 15) >> 2)) * 64;
    if (MODE == M_NA) { float* bt = (float*)(shm + LDS_BIAS); if (tid < 465) bt[tid] = d.rpb[tid] * LOG2E; }
    DMA_KV(0, 0);
    if (d.nt > 1) DMA_KV(1, 1);
    bf16x8 qr[4];
#pragma unroll
    for (int d0 = 0; d0 < 4; ++d0) qr[d0] = *reinterpret_cast<const bf16x8*>(&Qw[(size_t)r32 * d.qp + d0 * 16 + hi * 8]);
    float m = -1e30f, l = 0.f; f32x16 o[2]; o[0] = f32x16{}; o[1] = f32x16{};
    const int qrow = (MODE == M_NA) ? d.r0 + (wid >> 1) : 0;
    const int qcol = 32 * (wid & 1) + r32;
    const int rs = (MODE == M_NA) ? (qrow - 4 < 0 ? 0 : (qrow - 4 > 120 ? 120 : qrow - 4)) : 0;
    const int cs = qcol - 8 < 0 ? 0 : (qcol - 8 > 48 ? 48 : qcol - 8);
    const int qpos = d.q0 + 32 * wid + r32;
    int slot = 0;
    for (int t = 0; t < d.nt; ++t) {
        if (t + 1 < d.nt) asm volatile("s_waitcnt vmcnt(2) lgkmcnt(0)\n\ts_barrier" ::: "memory");
        else asm volatile("s_waitcnt vmcnt(0) lgkmcnt(0)\n\ts_barrier" ::: "memory");
        if (t + 2 < d.nt) { const int s2 = slot + 2 >= NSLOT ? slot + 2 - NSLOT : slot + 2; DMA_KV(t + 2, s2); }
        bool active = true;
        int kr = 0, k0 = 0;
        if (MODE == M_NA && t >= d.nctx) { kr = d.kr0 + (t - d.nctx); active = (kr >= rs) && (kr < rs + 8); }
        if (MODE == M_WA && t >= d.nctx) { k0 = d.kt0 + 64 * (t - d.nctx); const int qw = d.q0 + 32 * wid; active = (k0 + 63 >= qw - 128) && (k0 <= qw + 31 + 128); }
        if (active) {
            f32x16 p0, p1;
            qkt(p0, p1, shm + LDS_K + slot * SLOTB, qr, r32, hi);
            if (MODE == M_NA && t >= d.nctx) {
                const float* bt = (const float*)(shm + LDS_BIAS) + (kr - qrow + 7) * 31 + 15 - qcol;
#pragma unroll
                for (int r = 0; r < 16; ++r) {
                    const int kv = crow(r, hi);
                    { const bool ok = (unsigned)(kv - cs) < 16u; const float bv = bt[ok ? kv : qcol]; p0[r] = ok ? p0[r] + bv : -INFINITY; }
                    { const int kv2 = kv + 32; const bool ok = (unsigned)(kv2 - cs) < 16u; const float bv = bt[ok ? kv2 : qcol]; p1[r] = ok ? p1[r] + bv : -INFINITY; }
                }
            }
            if (MODE == M_WA && t >= d.nctx) {
#pragma unroll
                for (int r = 0; r < 16; ++r) {
                    const int dk = k0 + crow(r, hi) - qpos;
                    if (dk > 128 || dk < -128) p0[r] = -INFINITY;
                    if (dk + 32 > 128 || dk + 32 < -128) p1[r] = -INFINITY;
                }
            }
            float rm = __builtin_fmaxf(p0[0], p1[0]);
#pragma unroll
            for (int r = 1; r < 16; ++r) rm = __builtin_fmaxf(rm, __builtin_fmaxf(p0[r], p1[r]));
            { auto rr = __builtin_amdgcn_permlane32_swap(__float_as_uint(rm), __float_as_uint(rm), false, false); rm = __builtin_fmaxf(__uint_as_float(rr[0]), __uint_as_float(rr[1])); }
            const float mn = __builtin_fmaxf(m, rm);
            if (__any(mn > m)) {
                const float f = __builtin_amdgcn_exp2f(m - mn); l *= f; m = mn;
                if (hi == 0) wsf[r32] = f;
                asm volatile("s_waitcnt lgkmcnt(0)" ::: "memory");
#pragma unroll
                for (int r = 0; r < 16; ++r) { const float fr_ = wsf[crow(r, hi)]; o[0][r] *= fr_; o[1][r] *= fr_; }
            }
            float sacc = 0.f;
#pragma unroll
            for (int r = 0; r < 16; ++r) { p0[r] = __builtin_amdgcn_exp2f(p0[r] - m); p1[r] = __builtin_amdgcn_exp2f(p1[r] - m); sacc += p0[r] + p1[r]; }
            l += sacc;
            v4u pw0, pw1, pw2, pw3;
            pw0 = (v4u){cvtpk(p0[0], p0[1]), cvtpk(p0[2], p0[3]), cvtpk(p0[4], p0[5]), cvtpk(p0[6], p0[7])};
            pw1 = (v4u){cvtpk(p0[8], p0[9]), cvtpk(p0[10], p0[11]), cvtpk(p0[12], p0[13]), cvtpk(p0[14], p0[15])};
            pw2 = (v4u){cvtpk(p1[0], p1[1]), cvtpk(p1[2], p1[3]), cvtpk(p1[4], p1[5]), cvtpk(p1[6], p1[7])};
            pw3 = (v4u){cvtpk(p1[8], p1[9]), cvtpk(p1[10], p1[11]), cvtpk(p1[12], p1[13]), cvtpk(p1[14], p1[15])};
            pv(o, vb0 + slot * SLOTB, __builtin_bit_cast(bf16x8, pw0), __builtin_bit_cast(bf16x8, pw1), __builtin_bit_cast(bf16x8, pw2), __builtin_bit_cast(bf16x8, pw3));
        }
        slot = slot + 1 >= NSLOT ? 0 : slot + 1;
    }
    if (d.has_sink && hi == 0) l += __builtin_amdgcn_exp2f(d.sink_l2 - m);
    { auto rr = __builtin_amdgcn_permlane32_swap(__float_as_uint(l), __float_as_uint(l), false, false); l = __uint_as_float(rr[0]) + __uint_as_float(rr[1]); }
    if (hi == 0) wsf[32 + r32] = l;
    asm volatile("s_waitcnt lgkmcnt(0)" ::: "memory");
    float rli[16];
#pragma unroll
    for (int r = 0; r < 16; ++r) rli[r] = __builtin_amdgcn_rcpf(wsf[32 + crow(r, hi)]);
    bf16* Ow = d.O + (size_t)(wid * 32) * d.op;
    { bf16* stg = (bf16*)(shm + LDS_OST) + wid * 2048;
#pragma unroll
        for (int r = 0; r < 16; ++r) { const int orow = crow(r, hi);
#pragma unroll
            for (int d0 = 0; d0 < 2; ++d0) stg[orow * 64 + d0 * 32 + r32] = (bf16)f2bf(o[d0][r] * rli[r]); }
        asm volatile("s_waitcnt lgkmcnt(0)" ::: "memory");
#pragma unroll
        for (int i = 0; i < 4; ++i) { const int row = i * 8 + (lane >> 3), ch = lane & 7; const v4u v = *(const v4u*)(stg + row * 64 + ch * 8); st16_wtw<2>(Ow + (size_t)row * d.op + ch * 8, v); } }
    asm volatile("s_waitcnt lgkmcnt(0)\n\ts_barrier" ::: "memory");
#undef TROW
#undef DMA_KV
}
}
namespace att {
typedef unsigned u32x4 __attribute__((ext_vector_type(4)));
#define SBAR() __builtin_amdgcn_sched_barrier(0)
__device__ __forceinline__ float max3f(float a,float b,float c){float r;asm("v_max3_f32 %0, %1, %2, %3":"=v"(r):"v"(a),"v"(b),"v"(c));return r;}
__device__ __forceinline__ float max2f(float a,float b){float r;asm("v_max_f32_e32 %0, %1, %2":"=v"(r):"v"(a),"v"(b));return r;}
__device__ __forceinline__ float fadd_s(float a,float b){float r;asm("v_add_f32_e32 %0, %1, %2":"=v"(r):"v"(a),"v"(b));return r;}
__device__ __forceinline__ float fsub_s(float a,float b){float r;asm("v_sub_f32_e32 %0, %1, %2":"=v"(r):"v"(a),"v"(b));return r;}
__device__ __forceinline__ unsigned cvtpk_s(float lo,float hi){return cvtpk(lo,hi);}
#define WAIT_BAR(N) asm volatile("s_waitcnt vmcnt(" #N ") lgkmcnt(0)\n\ts_barrier":::"memory")


__device__ __forceinline__ void qkt_n(f32x16&p0,f32x16&p1,const char*Kslot,const bf16x8*qr,const f32x16&negm,int r32,int hi){
  const char*kb=Kslot+hi*1024+r32*16;
  #pragma unroll
  for(int d0=0;d0<4;++d0){
    const bf16x8 b0=*reinterpret_cast<const bf16x8*>(kb+d0*2048);
    const bf16x8 b1=*reinterpret_cast<const bf16x8*>(kb+d0*2048+512);
    if(d0==0){p0=__builtin_amdgcn_mfma_f32_32x32x16_bf16(b0,qr[0],negm,0,0,0);p1=__builtin_amdgcn_mfma_f32_32x32x16_bf16(b1,qr[0],negm,0,0,0);}
    else{p0=__builtin_amdgcn_mfma_f32_32x32x16_bf16(b0,qr[d0],p0,0,0,0);p1=__builtin_amdgcn_mfma_f32_32x32x16_bf16(b1,qr[d0],p1,0,0,0);}}
}
typedef __attribute__((address_space(3))) const char* lds_cptr;
typedef short v4i16_t __attribute__((ext_vector_type(4)));
__device__ __forceinline__ void kload8(bf16x8*kf,lds_cptr kp){
  kf[0]=*(const __attribute__((address_space(3))) bf16x8*)(kp);      kf[1]=*(const __attribute__((address_space(3))) bf16x8*)(kp+512);
  kf[2]=*(const __attribute__((address_space(3))) bf16x8*)(kp+2048); kf[3]=*(const __attribute__((address_space(3))) bf16x8*)(kp+2560);
  kf[4]=*(const __attribute__((address_space(3))) bf16x8*)(kp+4096); kf[5]=*(const __attribute__((address_space(3))) bf16x8*)(kp+4608);
  kf[6]=*(const __attribute__((address_space(3))) bf16x8*)(kp+6144); kf[7]=*(const __attribute__((address_space(3))) bf16x8*)(kp+6656);
}
__device__ __forceinline__ void kload2(bf16x8*kf,lds_cptr kp,int j){ kf[2*j]=*(const __attribute__((address_space(3))) bf16x8*)(kp+j*2048); kf[2*j+1]=*(const __attribute__((address_space(3))) bf16x8*)(kp+j*2048+512); }
__device__ __forceinline__ s16x4 vtr(lds_cptr p){ return __builtin_bit_cast(s16x4,__builtin_amdgcn_ds_read_tr16_b64_v4i16((__attribute__((address_space(3))) v4i16_t*)p)); }
__device__ __forceinline__ float rowmax(const f32x16&p0,const f32x16&p1){
  float a=max3f(p0[0],p0[1],p1[0]),b=max3f(p0[2],p0[3],p1[1]);a=max3f(a,p1[2],p1[3]);
  #pragma unroll
  for(int r=4;r<16;r+=4){a=max3f(a,p0[r],p0[r+1]);b=max3f(b,p0[r+2],p0[r+3]);a=max3f(a,p1[r],p1[r+1]);b=max3f(b,p1[r+2],p1[r+3]);}
  const float m=max2f(a,b);
  auto rr=__builtin_amdgcn_permlane32_swap(__float_as_uint(m),__float_as_uint(m),false,false);
  return max2f(__uint_as_float(rr[0]),__uint_as_float(rr[1]));
}

template<int MODE> __device__ __forceinline__ void pipe_mask(f32x16&P0,f32x16&P1,int t,const Desc& d,const char*shm,int wid,int r32,int hi){
  if(MODE==M_FULL) return;
  if(t<d.nctx) return;
  if(t>=d.nt_real){
    _Pragma("unroll") for(int r=0;r<16;++r){P0[r]=-INFINITY;P1[r]=-INFINITY;} return; }
  if(MODE==M_NA){
    const int qrow=d.r0+(wid>>1), qcol=32*(wid&1)+r32, kr=d.kr0+(t-d.nctx);
    const int rs=qrow-4<0?0:(qrow-4>120?120:qrow-4), cs=qcol-8<0?0:(qcol-8>48?48:qcol-8);
    if(kr<rs||kr>=rs+8){ _Pragma("unroll") for(int r=0;r<16;++r){P0[r]=-INFINITY;P1[r]=-INFINITY;} return; }
    const float*bt=(const float*)(shm+LDS_BIAS)+(kr-qrow+7)*31+15-qcol;
    _Pragma("unroll") for(int r=0;r<16;++r){ const int kv=crow(r,hi);
      { const bool ok=(unsigned)(kv-cs)<16u; const float bv=bt[ok?kv:qcol]; P0[r]=ok?P0[r]+bv:-INFINITY; }
      { const int kv2=kv+32; const bool ok=(unsigned)(kv2-cs)<16u; const float bv=bt[ok?kv2:qcol]; P1[r]=ok?P1[r]+bv:-INFINITY; } }
  }
  if(MODE==M_WA){
    const int qpos=d.q0+32*wid+r32, k0=d.kt0+64*(t-d.nctx);
    _Pragma("unroll") for(int r=0;r<16;++r){ const int dk=k0+crow(r,hi)-qpos;
      if(dk>128||dk<-128)P0[r]=-INFINITY; if(dk+32>128||dk+32<-128)P1[r]=-INFINITY; }
  }
}
template<int THRL,int MODE> __device__ __forceinline__ void attn_unit_pipe(const Desc& d,char*shm){
  int tid_=threadIdx.x; asm volatile("":"+v"(tid_)); const int tid=tid_,lane=tid&63,r32=lane&31,hi=lane>>5; const int wid=__builtin_amdgcn_readfirstlane(tid>>6);
  const bf16*Qw=d.Q+(size_t)(wid*32)*d.qp;
  const unsigned lds0=(unsigned)(uintptr_t)shm;
  if(MODE==M_NA){ float*bt=(float*)(shm+LDS_BIAS); if(tid<465)bt[tid]=d.rpb[tid]*LOG2E; }
  float*wsf=(float*)(shm+LDS_WS)+wid*64;
  const size_t koffl=(size_t)lane*d.kp+wid*8;
  const size_t voffl=(size_t)(16*(wid&3)+(lane>>2))*d.kp+(wid>>2)*32+(lane&3)*8;
  #define TROW(t) ((t)<d.nctx?d.ctxrow+64*(t):((t)<d.nt_real?d.latrow+64*((t)-d.nctx):d.latrow))
  const unsigned kdst=lds0+LDS_K+wid*1024, vdst=lds0+LDS_V+wid*1024;
  #define DMA_K(t,slot) glds16(d.K+(size_t)TROW(t)*d.kp+koffl,(unsigned)__builtin_amdgcn_readfirstlane(kdst+(slot)))
  #define DMA_V(t,slot) glds16(d.V+(size_t)TROW(t)*d.kp+voffl,(unsigned)__builtin_amdgcn_readfirstlane(vdst+(slot)))
  const int vb0=(int)(lds0+LDS_V)+((lane>>4)&1)*32+(lane&3)*8+(4*hi+((lane&15)>>2))*64;
  const char*Kbase=shm+LDS_K; bf16x8 kf[8];
  const lds_cptr shm3=(lds_cptr)shm; const lds_cptr kp0=shm3+LDS_K+hi*1024+r32*16; const lds_cptr vp0=shm3+LDS_V+((lane>>4)&1)*32+(lane&3)*8+(4*hi+((lane&15)>>2))*64;
  const int NT=d.nt;
  DMA_K(0,0);DMA_V(0,0);DMA_K(1,SLOTB);
  bf16x8 qr[4];
  #pragma unroll
  for(int d0=0;d0<4;++d0)qr[d0]=*reinterpret_cast<const bf16x8*>(&Qw[(size_t)r32*d.qp+d0*16+hi*8]);
  if(d.qrope){
    const int tq=d.qt0+32*wid+r32, rr=tq>>6, cc=tq&63;
    #pragma unroll
    for(int d0=2;d0<4;++d0){ const float pos=(float)(d0==2?rr:cc); u32x4 w=__builtin_bit_cast(u32x4,qr[d0]), pw, ow;
      #pragma unroll
      for(int j=0;j<4;++j) pw[j]=(unsigned)__shfl_xor((int)w[j],32);
      #pragma unroll
      for(int j=0;j<4;++j){ float res[2];
        #pragma unroll
        for(int e=0;e<2;++e){ const int i=2*j+e; const float own=e?bfhi(w[j]):bflo(w[j]), oth=e?bfhi(pw[j]):bflo(pw[j]);
          const float rev=pos*__builtin_amdgcn_exp2f(-(float)i*(13.287712379549449f/8.0f))*0.15915494309189535f; const float cs_=__builtin_amdgcn_cosf(rev), sn_=__builtin_amdgcn_sinf(rev);
          res[e]=hi?(own*cs_+oth*sn_):(own*cs_-oth*sn_); }
        ow[j]=cvtpk(res[0],res[1]); }
      qr[d0]=__builtin_bit_cast(bf16x8,ow); } }
  float mhat=0.f,l_reg=0.f;f32x16 o[2];o[0]=f32x16{};o[1]=f32x16{};f32x16 negm=f32x16{};asm volatile("":"+v"(negm));
  #define CMASK(P0,P1,t) pipe_mask<MODE>(P0,P1,(t),d,shm,wid,r32,hi)
  bool resc=false;
  #define START(P0,P1) do{ const float rm=rowmax(P0,P1); resc=false; \
    { const float dl=rm; mhat=fadd_s(mhat,dl); \
      _Pragma("unroll") for(int r=0;r<16;++r){P0[r]=fsub_s(P0[r],dl);P1[r]=fsub_s(P1[r],dl);} \
      _Pragma("unroll") for(int r=0;r<16;++r)negm[r]=-mhat; asm volatile("":"+v"(negm)); } \
    _Pragma("unroll") for(int r=0;r<16;++r)P0[r]=__builtin_amdgcn_exp2f(P0[r]); }while(0)
  #define RESC() do{ if(resc){ asm volatile("s_waitcnt lgkmcnt(0)":::"memory"); \
      _Pragma("unroll") for(int d_=0;d_<2;++d_) _Pragma("unroll") for(int r=0;r<16;++r)o[d_][r]*=wsf[crow(r,hi)]; } }while(0)
  f32x16 pA0,pA1,pB0,pB1;
  int sl_prev=0,sl_cur=0,sl_next=SLOTB;
  #define ROT() do{sl_prev=sl_cur;sl_cur=sl_next;sl_next=(sl_next==(NSLOT-1)*SLOTB)?0:sl_next+SLOTB;}while(0)
  DMA_K(2,2*SLOTB);
  WAIT_BAR(3);
  qkt_n(pA0,pA1,Kbase,qr,negm,r32,hi);asm volatile("s_nop 15\n\ts_nop 7":"+v"(pA0),"+v"(pA1));CMASK(pA0,pA1,0);
  START(pA0,pA1);
  _Pragma("unroll") for(int r=0;r<16;++r)pA1[r]=__builtin_amdgcn_exp2f(pA1[r]);
  WAIT_BAR(0);
  DMA_K(3,0);DMA_V(1,SLOTB);
  ROT();
  kload8(kf,kp0+sl_cur);
  WAIT_BAR(2);
  s16x4 vlo[8],vhi[8]; u32x4 pw0,pw1,pw2,pw3;
  #define PKW(P,B) cvtpk_s(P[B],P[B+1])
  #define PAF(k) __builtin_bit_cast(bf16x8,pw##k)
  #define VFR(i) (bf16x8){vlo[i][0],vlo[i][1],vlo[i][2],vlo[i][3],vhi[i][0],vhi[i][1],vhi[i][2],vhi[i][3]}
  #define PIN(x) asm volatile("":"+v"(x))
  #define MX3(a,b,c) __builtin_fmaxf(__builtin_fmaxf((a),(b)),(c))
  #define GAPA(MF,A0,A1,A2,A3,W0,W1,PW) do{ MF; sacc+=A0; sacc+=A1; sacc+=A2; sacc+=A3; PIN(sacc); W0; W1; PIN(PW); SBAR(); }while(0)
  #define EX(v) __builtin_amdgcn_exp2f(v)
  #define GAPB(MF,X,B) do{ MF; X[B]=EX(X[B]); X[B+1]=EX(X[B+1]); X[B+2]=EX(X[B+2]); X[B+3]=EX(X[B+3]); PIN(X); SBAR(); }while(0)
  #define VRD(i) do{ vlo[i]=vtr(vp_+(((i)>>2)*4096+((i)&3)*1024)); vhi[i]=vtr(vp_+(((i)>>2)*4096+((i)&3)*1024+512)); }while(0)
  #define KRD(G,j) do{ if(G){ kload2(kf,kp0+sl_next,j); SBAR(); } }while(0)
  #define STEP(C0,C1,P0,P1,t,GK,GV,GL) do{ SBAR(); \
    const lds_cptr vp_=vp0+sl_prev; \
    VRD(0); SBAR(); float sacc=(P0[0]+P0[1]); \
    GAPA(C0=__builtin_amdgcn_mfma_f32_32x32x16_bf16(kf[0],qr[0],negm,0,0,0), P0[2],P0[3],P0[4],P0[5],     pw0[0]=PKW(P0,0), pw0[1]=PKW(P0,2), pw0); \
    VRD(4); SBAR(); GAPA(C1=__builtin_amdgcn_mfma_f32_32x32x16_bf16(kf[1],qr[0],negm,0,0,0), P0[6],P0[7],P0[8],P0[9],     pw0[2]=PKW(P0,4), pw0[3]=PKW(P0,6), pw0); \
    VRD(1); SBAR(); GAPA(C0=__builtin_amdgcn_mfma_f32_32x32x16_bf16(kf[2],qr[1],C0,0,0,0),   P0[10],P0[11],P0[12],P0[13], pw1[0]=PKW(P0,8), pw1[1]=PKW(P0,10), pw1); \
    VRD(5); SBAR(); GAPA(C1=__builtin_amdgcn_mfma_f32_32x32x16_bf16(kf[3],qr[1],C1,0,0,0),   P0[14],P0[15],P1[0],P1[1],   pw1[2]=PKW(P0,12),pw1[3]=PKW(P0,14), pw1); \
    VRD(2); SBAR(); GAPA(C0=__builtin_amdgcn_mfma_f32_32x32x16_bf16(kf[4],qr[2],C0,0,0,0),   P1[2],P1[3],P1[4],P1[5],     pw2[0]=PKW(P1,0), pw2[1]=PKW(P1,2), pw2); \
    VRD(6); SBAR(); GAPA(C1=__builtin_amdgcn_mfma_f32_32x32x16_bf16(kf[5],qr[2],C1,0,0,0),   P1[6],P1[7],P1[8],P1[9],     pw2[2]=PKW(P1,4), pw2[3]=PKW(P1,6), pw2); \
    VRD(3); SBAR(); GAPA(C0=__builtin_amdgcn_mfma_f32_32x32x16_bf16(kf[6],qr[3],C0,0,0,0),   P1[10],P1[11],P1[12],P1[13], pw3[0]=PKW(P1,8), pw3[1]=PKW(P1,10), pw3); \
    VRD(7); SBAR(); GAPA(C1=__builtin_amdgcn_mfma_f32_32x32x16_bf16(kf[7],qr[3],C1,0,0,0),   P1[14],P1[15],0.f,0.f,       pw3[2]=PKW(P1,12),pw3[3]=PKW(P1,14), pw3); \
    l_reg+=sacc; \
    if(GK){DMA_K((t)+3,sl_cur);} if(GV){DMA_V((t)+1,sl_next);} \
    CMASK(C0,C1,t); \
    { float a=MX3(C0[0],C0[1],C1[0]),b=MX3(C0[2],C0[3],C1[1]); a=MX3(a,C1[2],C1[3]); \
      _Pragma("unroll") for(int r=4;r<16;r+=4){a=MX3(a,C0[r],C0[r+1]);b=MX3(b,C0[r+2],C0[r+3]);a=MX3(a,C1[r],C1[r+1]);b=MX3(b,C1[r+2],C1[r+3]);} \
      float rm=__builtin_fmaxf(a,b); { auto rr=__builtin_amdgcn_permlane32_swap(__float_as_uint(rm),__float_as_uint(rm),false,false); rm=__builtin_fmaxf(__uint_as_float(rr[0]),__uint_as_float(rr[1])); } \
      resc=false; \
      if(__builtin_expect(__any(rm>(float)THRL),0)){ const float dl=__builtin_fmaxf(rm,0.f); mhat+=dl; \
        _Pragma("unroll") for(int r=0;r<16;++r){C0[r]-=dl;C1[r]-=dl;} \
        _Pragma("unroll") for(int r=0;r<16;++r)negm[r]=-mhat; asm volatile("":"+v"(negm)); \
        const float f=__builtin_amdgcn_exp2f(-dl); l_reg*=f; if(hi==0)wsf[r32]=f; resc=true; } } \
    SBAR(); \
    GAPB(o[0]=__builtin_amdgcn_mfma_f32_32x32x16_bf16(PAF(0),VFR(0),o[0],0,0,0), C0,0); \
    GAPB(o[1]=__builtin_amdgcn_mfma_f32_32x32x16_bf16(PAF(0),VFR(4),o[1],0,0,0), C0,4); \
    KRD(GL,0); GAPB(o[0]=__builtin_amdgcn_mfma_f32_32x32x16_bf16(PAF(1),VFR(1),o[0],0,0,0), C0,8); \
    KRD(GL,1); GAPB(o[1]=__builtin_amdgcn_mfma_f32_32x32x16_bf16(PAF(1),VFR(5),o[1],0,0,0), C0,12); \
    KRD(GL,2); GAPB(o[0]=__builtin_amdgcn_mfma_f32_32x32x16_bf16(PAF(2),VFR(2),o[0],0,0,0), C1,0); \
    KRD(GL,3); GAPB(o[1]=__builtin_amdgcn_mfma_f32_32x32x16_bf16(PAF(2),VFR(6),o[1],0,0,0), C1,4); \
    GAPB(o[0]=__builtin_amdgcn_mfma_f32_32x32x16_bf16(PAF(3),VFR(3),o[0],0,0,0), C1,8); \
    GAPB(o[1]=__builtin_amdgcn_mfma_f32_32x32x16_bf16(PAF(3),VFR(7),o[1],0,0,0), C1,12); \
    }while(0)
  int t=1;
  for(;t+5<NT;t+=2){
    STEP(pB0,pB1,pA0,pA1,t,true,true,true);     WAIT_BAR(2); RESC(); ROT();
    STEP(pA0,pA1,pB0,pB1,t+1,true,true,true);   WAIT_BAR(2); RESC(); ROT();
  }
  #define ENDW(tt) do{ if((tt)+3<NT){WAIT_BAR(2);} else if((tt)+2<NT){WAIT_BAR(1);} else {WAIT_BAR(0);} }while(0)
  for(;t+1<NT;t+=2){
    STEP(pB0,pB1,pA0,pA1,t,(t+3<NT),(t+1<NT),(t+1<NT));       ENDW(t);   RESC(); ROT();
    STEP(pA0,pA1,pB0,pB1,t+1,(t+4<NT),(t+2<NT),(t+2<NT));     ENDW(t+1); RESC(); ROT();
  }
  STEP(pB0,pB1,pA0,pA1,NT-1,false,false,false); RESC();
  { float sacc=pB0[0]+pB0[1]; _Pragma("unroll") for(int r=2;r<16;++r)sacc+=pB0[r]; _Pragma("unroll") for(int r=0;r<16;++r)sacc+=pB1[r]; l_reg+=sacc;
    pw0=(u32x4){PKW(pB0,0),PKW(pB0,2),PKW(pB0,4),PKW(pB0,6)};pw1=(u32x4){PKW(pB0,8),PKW(pB0,10),PKW(pB0,12),PKW(pB0,14)};pw2=(u32x4){PKW(pB1,0),PKW(pB1,2),PKW(pB1,4),PKW(pB1,6)};pw3=(u32x4){PKW(pB1,8),PKW(pB1,10),PKW(pB1,12),PKW(pB1,14)};
    SBAR(); pv(o,vb0+sl_cur,PAF(0),PAF(1),PAF(2),PAF(3)); }
  #undef PKW
  #undef PAF
  #undef VFR
  #undef PIN
  #undef MX3
  #undef GAPA
  #undef GAPB
  #undef EX
  #undef VRD
  #undef KRD
  #undef STEP
  #undef ENDW
  if(d.has_sink&&hi==0)l_reg+=__builtin_amdgcn_exp2f(d.sink_l2-mhat);
  {auto rr=__builtin_amdgcn_permlane32_swap(__float_as_uint(l_reg),__float_as_uint(l_reg),false,false);l_reg=__uint_as_float(rr[0])+__uint_as_float(rr[1]);}
  if(hi==0)wsf[32+r32]=l_reg;asm volatile("s_waitcnt lgkmcnt(0)":::"memory");
  float rli[16];
  #pragma unroll
  for(int r=0;r<16;++r)rli[r]=__builtin_amdgcn_rcpf(wsf[32+crow(r,hi)]);
  bf16*Ow=d.O+(size_t)(wid*32)*d.op;
  { bf16*stg=(bf16*)(shm+LDS_OST)+wid*2048;
    #pragma unroll
    for(int r=0;r<16;++r){const int orow=crow(r,hi);
      #pragma unroll
      for(int d0=0;d0<2;++d0)stg[orow*64+d0*32+r32]=(bf16)f2bf(o[d0][r]*rli[r]);}
    asm volatile("s_waitcnt lgkmcnt(0)":::"memory");
    #pragma unroll
    for(int i=0;i<4;++i){const int row=i*8+(lane>>3),ch=lane&7; const u32x4 v=*(const u32x4*)(stg+row*64+ch*8); st16_wtw<2>(Ow+(size_t)row*d.op+ch*8,v);} }
  asm volatile("s_waitcnt lgkmcnt(0)\n\ts_barrier":::"memory");
  #undef DMA_K
  #undef TROW
  #undef DMA_V
  #undef CMASK
  #undef START
  #undef RESC
  #undef ROT
}

#undef SBAR
#undef WAIT_BAR
}
namespace gla {
constexpr int S32 = 40, S64 = 72;
struct Par {
    const bf16* P; bf16* CAT; float* GU; float* GDEC; float* BC; float* CARRY;
    const float *wgf, *bgf, *wgb, *bgb, *gnorm;
};
__device__ __forceinline__ int chunk_row(int b, int n) { return n < 4 ? NLAT + b * CTXL + 64 * n : b * SEQ + 64 * (n - 4); }
__device__ __forceinline__ int chunk_dir(int n, int dir) { return dir == 0 ? n : (n < 4 ? 3 - n : 135 - n); }
template <int KS>
__device__ __forceinline__ f32x16 mm_tile(f32x16 c, const bf16* A, int sa, const bf16* Bt, int sb, int r32, int hi) {
#pragma unroll
    for (int s = 0; s < KS; ++s) {
        const bf16x8 a = *reinterpret_cast<const bf16x8*>(A + r32 * sa + 16 * s + 8 * hi);
        const bf16x8 b = *reinterpret_cast<const bf16x8*>(Bt + r32 * sb + 16 * s + 8 * hi);
        c = __builtin_amdgcn_mfma_f32_32x32x16_bf16(a, b, c, 0, 0, 0);
    }
    return c;
}
__device__ __forceinline__ float decay_g(const bf16* zl, int tok, int dir, const float (&w)[16], float bias) {
    const v4u* zp = (const v4u*)(zl + tok * 32 + dir * 16);
    const v4u z0 = zp[0], z1 = zp[1];
    float a = bias;
    a += bflo(z0.x) * w[0] + bfhi(z0.x) * w[1] + bflo(z0.y) * w[2] + bfhi(z0.y) * w[3] + bflo(z0.z) * w[4] + bfhi(z0.z) * w[5] + bflo(z0.w) * w[6] + bfhi(z0.w) * w[7];
    a += bflo(z1.x) * w[8] + bfhi(z1.x) * w[9] + bflo(z1.y) * w[10] + bfhi(z1.y) * w[11] + bflo(z1.z) * w[12] + bfhi(z1.z) * w[13] + bflo(z1.w) * w[14] + bfhi(z1.w) * w[15];
    const float ls = __builtin_fminf(a, 0.f) - 0.6931471805599453f * __builtin_amdgcn_logf(1.0f + __builtin_amdgcn_exp2f(-LOG2E * __builtin_fabsf(a)));
    return ls * (1.0f / 16.0f);
}
__device__ __forceinline__ void decay_totals(float& bend, float& carry, const bf16* zl, const float (&w)[16], float bias, int dir, int half) {
    float tot = 0.f;
#pragma unroll 4
    for (int ii = 0; ii < 32; ++ii) tot += decay_g(zl, 32 * half + ii, dir, w, bias);
    const float oth = __shfl_xor(tot, 32);
    bend = tot + oth; carry = (half == (dir == 0 ? 1 : 0)) ? oth : 0.f;
}
__device__ __forceinline__ void load_z(bf16* zl, const bf16* P, int row0, int tid) {
    if (tid < 256) { const int j = tid >> 2, c = tid & 3; *(v4u*)(zl + j * 32 + c * 8) = *(const v4u*)(P + (size_t)(row0 + j) * INWP + D_ZF + c * 8); }
}
__device__ __forceinline__ void ld_rows32(v4u (&pc)[2], const bf16* P, int row0, int col, int lane) {
#pragma unroll
    for (int i = 0; i < 2; ++i) { const int pidx = lane + 64 * i; pc[i] = *(const v4u*)(P + (size_t)(row0 + (pidx >> 2)) * INWP + col + (pidx & 3) * 8); }
}
__device__ __forceinline__ void st_rows32(bf16* dst, const v4u (&pc)[2], int lane) {
#pragma unroll
    for (int i = 0; i < 2; ++i) { const int pidx = lane + 64 * i; *(v4u*)(dst + (pidx >> 2) * S32 + (pidx & 3) * 8) = pc[i]; }
}
__device__ __forceinline__ void load_vt(bf16* Vt, const bf16* P, int row0, int h, int part, int lane) {
    const int c8 = lane & 7, jj = lane >> 3;
#pragma unroll
    for (int it = 0; it < 4; ++it) {
        const int j = 32 * part + it * 8 + jj;
        const v4u x = *(const v4u*)(P + (size_t)(row0 + j) * INWP + D_V + h * 64 + c8 * 8);
        bf16* dst = Vt + (c8 * 8) * S64 + j;
        dst[0 * S64] = (bf16)(x.x & 0xffff); dst[1 * S64] = (bf16)(x.x >> 16); dst[2 * S64] = (bf16)(x.y & 0xffff); dst[3 * S64] = (bf16)(x.y >> 16);
        dst[4 * S64] = (bf16)(x.z & 0xffff); dst[5 * S64] = (bf16)(x.z >> 16); dst[6 * S64] = (bf16)(x.w & 0xffff); dst[7 * S64] = (bf16)(x.w >> 16);
    }
}
__device__ __forceinline__ void g1_unit(const Par& p, int b, int n, char* shm) {
    int tid_ = threadIdx.x; asm volatile("" : "+v"(tid_));
    const int tid = tid_, lane = tid & 63, r32 = lane & 31, hi = lane >> 5; const int wid = __builtin_amdgcn_readfirstlane(tid >> 6);
    const int h = wid >> 1, dir = wid & 1, row0 = chunk_row(b, n);
    char* pr = shm + (wid >> 1) * 32768;
    bf16* KdT = (bf16*)(pr + (wid & 1) * 4608);
    bf16* Vt = (bf16*)(pr + 9216);
    bf16* Kr = (bf16*)(pr + 18432);
    bf16* zl = (bf16*)(shm + 131072);
    const int k = lane & 31, half = lane >> 5;
    v4u pc[2]; ld_rows32(pc, p.P, row0 + 32 * dir, D_K + h * 32, lane);
    float w[16];
    { const float* wg = dir == 0 ? p.wgf : p.wgb;
#pragma unroll
      for (int j = 0; j < 16; ++j) w[j] = wg[j * 128 + h * 32 + k]; }
    const float bias = (dir == 0 ? p.bgf : p.bgb)[h * 32 + k];
    {
        v4u zr = {0u, 0u, 0u, 0u}; { const int j = (tid & 255) >> 2, c = tid & 3; zr = *(const v4u*)(p.P + (size_t)(row0 + j) * INWP + D_ZF + c * 8); }
        v4u vx[4]; const int c8 = lane & 7, jj = lane >> 3;
#pragma unroll
        for (int it = 0; it < 4; ++it) { const int j = 32 * dir + it * 8 + jj; vx[it] = *(const v4u*)(p.P + (size_t)(row0 + j) * INWP + D_V + h * 64 + c8 * 8); }
        asm volatile("" : "+v"(zr), "+v"(vx[0]), "+v"(vx[1]), "+v"(vx[2]), "+v"(vx[3]));
        if (tid < 256) { const int j = tid >> 2, c = tid & 3; *(v4u*)(zl + j * 32 + c * 8) = zr; }
#pragma unroll
        for (int it = 0; it < 4; ++it) { const int j = 32 * dir + it * 8 + jj; const v4u x = vx[it]; bf16* dst = Vt + (c8 * 8) * S64 + j;
            dst[0 * S64] = (bf16)(x.x & 0xffff); dst[1 * S64] = (bf16)(x.x >> 16); dst[2 * S64] = (bf16)(x.y & 0xffff); dst[3 * S64] = (bf16)(x.y >> 16);
            dst[4 * S64] = (bf16)(x.z & 0xffff); dst[5 * S64] = (bf16)(x.z >> 16); dst[6 * S64] = (bf16)(x.w & 0xffff); dst[7 * S64] = (bf16)(x.w >> 16); } }
    st_rows32(Kr + 32 * dir * S32, pc, lane);
    __syncthreads();
    float loc = 0.f;
#pragma unroll 2
    for (int s = 0; s < 32; ++s) {
        const int i = 32 * half + (dir == 0 ? s : 31 - s);
        loc += decay_g(zl, i, dir, w, bias);
        KdT[k * S64 + i] = (bf16)f2bf(bf2f(Kr[i * S32 + k]) * __expf(-loc));
        p.BC[(size_t)(row0 + i) * 256 + dir * 128 + h * 32 + k] = loc;
    }
    const float oth = __shfl_xor(loc, 32), bend = loc + oth;
    const float carry = (half == (dir == 0 ? 1 : 0)) ? oth : 0.f;
    p.CARRY[(((size_t)(b * NCH + n) * 2 + dir) * 2 + half) * 128 + h * 32 + k] = carry;
    float* Fs = (float*)(pr + 23552) + (wid & 1) * 64;
    Fs[half * 32 + k] = __expf(bend - carry);
    const int seq = (b * 4 + h) * 2 + dir, nd = chunk_dir(n, dir);
    if (half == 0) p.GDEC[((size_t)seq * NCH + nd) * 32 + k] = __expf(bend);
    LDS_WAIT();
    float* up = p.GU + ((size_t)seq * NCH + nd) * 2048;
#pragma unroll
    for (int dt = 0; dt < 2; ++dt) {
        f32x16 c0 = {}, c1 = {};
        c0 = mm_tile<2>(c0, KdT, S64, Vt + (32 * dt) * S64, S64, r32, hi);
        c1 = mm_tile<2>(c1, KdT + 32, S64, Vt + (32 * dt) * S64 + 32, S64, r32, hi);
#pragma unroll
        for (int r = 0; r < 16; ++r) { const int kk = att::crow(r, hi); (up + ((r & 3) + 8 * (r >> 2)) * 64 + 32 * dt)[(unsigned)(4 * hi * 64 + r32)] = Fs[kk] * c0[r] + Fs[32 + kk] * c1[r]; }
    }
    __syncthreads();
}
__device__ __forceinline__ void g2_scan(float* GU, const float* GDEC, int gt) {
    if (gt >= 32 * 2048) return;
    const int seq = gt >> 11, e = gt & 2047, k = e >> 6;
    float* up = GU + (size_t)seq * NCH * 2048 + e; const float* dp = GDEC + (size_t)seq * NCH * 32 + k;
    float s = 0.f;
    static_assert(NCH % 33 == 0, "scan blocking");
#pragma unroll 1
    for (int n0 = 0; n0 < NCH; n0 += 33) { float uu[33], dd[33];
#pragma unroll
        for (int j = 0; j < 33; ++j) { uu[j] = up[(size_t)(n0 + j) * 2048]; dd[j] = dp[(n0 + j) * 32]; }
#pragma unroll
        for (int j = 0; j < 33; ++j) { up[(size_t)(n0 + j) * 2048] = s; s = s * dd[j] + uu[j]; } }
}
struct G3Lds { bf16 *Kd, *St, *Vt, *Qd, *AT, *zl; };
struct G3In { f32x4 sv[4]; v4u pq[2], pk[2]; f32x4 pb[2][2]; };
template <int DIR>
__device__ __forceinline__ void g3_load(G3In& I, const Par& p, int row0, int b, int n, int h, int ih, int lane) {
    const int seq = (b * 4 + h) * 2 + DIR, nd = chunk_dir(n, DIR);
    const float* sp = p.GU + ((size_t)seq * NCH + nd) * 2048;
    const int t128 = ih * 64 + lane;
#pragma unroll
    for (int it = 0; it < 4; ++it) I.sv[it] = __builtin_nontemporal_load((const f32x4*)(sp + (it * 128 + t128) * 4));
#pragma unroll
    for (int i = 0; i < 2; ++i) { const int item = lane + 64 * i, t = item >> 2, g8 = item & 3; const size_t row = (size_t)(row0 + 32 * ih + t);
        I.pq[i] = *(const v4u*)(p.P + row * INWP + D_Q + h * 32 + g8 * 8); I.pk[i] = *(const v4u*)(p.P + row * INWP + D_K + h * 32 + g8 * 8);
        const float* bp = p.BC + row * 256 + DIR * 128 + h * 32 + g8 * 8; I.pb[i][0] = __builtin_nontemporal_load((const f32x4*)bp); I.pb[i][1] = __builtin_nontemporal_load((const f32x4*)(bp + 4)); }
    { const int g8 = lane & 3; const float* cp = p.CARRY + (((size_t)(b * NCH + n) * 2 + DIR) * 2 + ih) * 128 + h * 32 + g8 * 8;
      const f32x4 c0 = *(const f32x4*)cp, c1 = *(const f32x4*)(cp + 4);
#pragma unroll
      for (int i = 0; i < 2; ++i) { I.pb[i][0] += c0; I.pb[i][1] += c1; } }
}
template <int DIR>
__device__ __forceinline__ void g3_dir(f32x16 (&o)[2], const G3In& I, const G3Lds& L, int ih, int lane) {
    const int r32 = lane & 31, hi = lane >> 5, t128 = ih * 64 + lane;
#pragma unroll
    for (int i = 0; i < 2; ++i) { const int item = lane + 64 * i, t = item >> 2, g8 = item & 3;
        float e[8], qf[8], kf[8];
#pragma unroll
        for (int j = 0; j < 4; ++j) { e[j] = I.pb[i][0][j]; e[4 + j] = I.pb[i][1][j]; }
        const v4u pq = I.pq[i], pk = I.pk[i];
        qf[0] = bflo(pq.x); qf[1] = bfhi(pq.x); qf[2] = bflo(pq.y); qf[3] = bfhi(pq.y); qf[4] = bflo(pq.z); qf[5] = bfhi(pq.z); qf[6] = bflo(pq.w); qf[7] = bfhi(pq.w);
        kf[0] = bflo(pk.x); kf[1] = bfhi(pk.x); kf[2] = bflo(pk.y); kf[3] = bfhi(pk.y); kf[4] = bflo(pk.z); kf[5] = bfhi(pk.z); kf[6] = bflo(pk.w); kf[7] = bfhi(pk.w);
#pragma unroll
        for (int j = 0; j < 8; ++j) { qf[j] *= __builtin_amdgcn_exp2f(e[j] * LOG2E) * 0.17677669529663687f; kf[j] *= __builtin_amdgcn_exp2f(-e[j] * LOG2E); }
        v4u wq, wk; wq.x = cvtpk(qf[0], qf[1]); wq.y = cvtpk(qf[2], qf[3]); wq.z = cvtpk(qf[4], qf[5]); wq.w = cvtpk(qf[6], qf[7]);
        wk.x = cvtpk(kf[0], kf[1]); wk.y = cvtpk(kf[2], kf[3]); wk.z = cvtpk(kf[4], kf[5]); wk.w = cvtpk(kf[6], kf[7]);
        *(v4u*)(L.Qd + t * S32 + g8 * 8) = wq; *(v4u*)(L.Kd + (32 * ih + t) * S32 + g8 * 8) = wk; }
#pragma unroll
    for (int it = 0; it < 4; ++it) { const int e4 = (it * 128 + t128) * 4, kk = e4 >> 6, d0 = e4 & 63; const f32x4 v = I.sv[it];
        L.St[(d0 + 0) * S32 + kk] = (bf16)f2bf(v.x); L.St[(d0 + 1) * S32 + kk] = (bf16)f2bf(v.y); L.St[(d0 + 2) * S32 + kk] = (bf16)f2bf(v.z); L.St[(d0 + 3) * S32 + kk] = (bf16)f2bf(v.w); }
    __syncthreads();
#pragma unroll
    for (int jt = 0; jt < 2; ++jt) {
        f32x16 c = {};
        c = mm_tile<2>(c, L.Qd, S32, L.Kd + (32 * jt) * S32, S32, r32, hi);
        const int j = 32 * jt + r32;
#pragma unroll
        for (int r = 0; r < 16; ++r) { const int il = att::crow(r, hi), ig = 32 * ih + il; const bool keep = DIR == 0 ? (j <= ig) : (j >= ig);
            L.AT[il * S64 + j] = (bf16)f2bf(keep ? c[r] : 0.f); }
    }
    LDS_WAIT();
#pragma unroll
    for (int dt = 0; dt < 2; ++dt) {
        o[dt] = mm_tile<4>(o[dt], L.AT, S64, L.Vt + (32 * dt) * S64, S64, r32, hi);
        o[dt] = mm_tile<2>(o[dt], L.Qd, S32, L.St + (32 * dt) * S32, S32, r32, hi);
    }
    __syncthreads();
}
__device__ __forceinline__ void g3_unit(const Par& p, int b, int n, char* shm) {
    int tid_ = threadIdx.x; asm volatile("" : "+v"(tid_));
    const int tid = tid_, lane = tid & 63, r32 = lane & 31, hi = lane >> 5; const int wid = __builtin_amdgcn_readfirstlane(tid >> 6);
    const int h = wid >> 1, ih = wid & 1, row0 = chunk_row(b, n);
    char* pr = shm + (wid >> 1) * 33792;
    G3Lds L;
    L.Kd = (bf16*)pr;
    L.St = (bf16*)(pr + 5120);
    L.Vt = (bf16*)(pr + 10240);
    L.Qd = (bf16*)(pr + 19456 + ih * 7168);
    L.AT = (bf16*)(pr + 19456 + ih * 7168 + 2560);
    L.zl = nullptr;
    G3In I0, I1; v4u pg[4];
    g3_load<0>(I0, p, row0, b, n, h, ih, lane); g3_load<1>(I1, p, row0, b, n, h, ih, lane);
#pragma unroll
    for (int i = 0; i < 4; ++i) { const int pidx = lane + 64 * i; pg[i] = *(const v4u*)(p.P + (size_t)(row0 + 32 * ih + (pidx >> 3)) * INWP + D_R + h * 64 + (pidx & 7) * 8); }
    load_vt(L.Vt, p.P, row0, h, ih, lane);
    f32x16 o[2]; o[0] = f32x16{}; o[1] = f32x16{};
    g3_dir<0>(o, I0, L, ih, lane);
    g3_dir<1>(o, I1, L, ih, lane);
#pragma unroll
    for (int i = 0; i < 4; ++i) { const int pidx = lane + 64 * i; *(v4u*)(L.AT + (pidx >> 3) * S64 + (pidx & 7) * 8) = pg[i]; }
    const float gn0 = p.gnorm[r32], gn1 = p.gnorm[32 + r32];
    const unsigned lc_ = (unsigned)(4 * hi * DM + r32);
    LDS_WAIT();
#pragma unroll
    for (int r = 0; r < 16; ++r) {
        float ss = o[0][r] * o[0][r] + o[1][r] * o[1][r];
        ss = ss + __builtin_bit_cast(float, __builtin_amdgcn_update_dpp(0, __builtin_bit_cast(int, ss), 0xB1, 0xf, 0xf, true));
        ss = ss + __builtin_bit_cast(float, __builtin_amdgcn_update_dpp(0, __builtin_bit_cast(int, ss), 0x4E, 0xf, 0xf, true));
        ss = ss + __builtin_bit_cast(float, __builtin_amdgcn_update_dpp(0, __builtin_bit_cast(int, ss), 0x141, 0xf, 0xf, true));
        ss = ss + __builtin_bit_cast(float, __builtin_amdgcn_update_dpp(0, __builtin_bit_cast(int, ss), 0x140, 0xf, 0xf, true));
        ss += __shfl_xor(ss, 16);
        const float rstd = __builtin_amdgcn_rsqf(ss * (1.0f / 64.0f) + RMS_EPS);
        const int il = att::crow(r, hi);
        bf16* cp = p.CAT + (size_t)(row0 + 32 * ih + (r & 3) + 8 * (r >> 2)) * DM + 768 + h * 64;
        cp[lc_] = (bf16)f2bf(o[0][r] * rstd * gn0 * fsilu(bf2f(L.AT[il * S64 + r32])));
        cp[lc_ + 32] = (bf16)f2bf(o[1][r] * rstd * gn1 * fsilu(bf2f(L.AT[il * S64 + 32 + r32])));
    }
    __syncthreads();
}
}
#if defined(SELFCHECK) && SELFCHECK
namespace chk {
__device__ __forceinline__ void item(const unsigned char* ws, const float* rpb_l, const float* sink_l, int row, int mx, int h, int lane, float* acc2) {
    const bf16* P = (const bf16*)(ws + WS_P); const bf16* QC = (const bf16*)(ws + WS_QC); const bf16* KC = (const bf16*)(ws + WS_KC); const bf16* VC = (const bf16*)(ws + WS_VC); const bf16* CATp = (const bf16*)(ws + WS_CAT);
    const bool lat = row < NLAT; const int b = lat ? row >> 13 : (row - NLAT) >> 8; const int t = row & (SEQ - 1), r = t >> 6, c = t & 63;
    const bf16* qp; const bf16* Kb; const bf16* Vb; int kp;
    if (mx == 0) { qp = P + (size_t)row * INWP + A_Q + h * 64; Kb = P + A_K + h * 64; Vb = P + A_V + h * 64; kp = INWP; }
    else if (mx == 1) { qp = P + (size_t)row * INWP + B_Q + h * 64; Kb = P + B_K + (h >> 1) * 64; Vb = P + B_V + (h >> 1) * 64; kp = INWP; }
    else { qp = QC + (size_t)row * 256 + h * 64; Kb = KC + h * 64; Vb = VC + h * 64; kp = 256; }
    float q[64];
#pragma unroll
    for (int d = 0; d < 64; ++d) q[d] = bf2f(qp[d]);
    if (mx == 2 && lat) {
#pragma unroll
        for (int g2 = 0; g2 < 2; ++g2) { const float pos = (float)(g2 == 0 ? r : c);
#pragma unroll
            for (int i = 0; i < 8; ++i) { const float ang = pos * exp2f(-(float)i * (13.287712379549449f / 8.0f)); const float cs_ = __cosf(ang), sn_ = __sinf(ang);
                const float x1 = q[32 + 16 * g2 + i], x2 = q[32 + 16 * g2 + 8 + i]; q[32 + 16 * g2 + i] = x1 * cs_ - x2 * sn_; q[32 + 16 * g2 + 8 + i] = x2 * cs_ + x1 * sn_; } }
    }
    const int rs = r - 4 < 0 ? 0 : (r - 4 > 120 ? 120 : r - 4), cs = c - 8 < 0 ? 0 : (c - 8 > 48 ? 48 : c - 8);
    const int nlatk = !lat ? 0 : (mx == 0 ? 128 : (mx == 1 ? 257 : SEQ)), ncand = nlatk + CTXL;
    float mxv = -1e30f;
    for (int pass = 0; pass < 2; ++pass) {
        float l = 0.f, o[64];
#pragma unroll
        for (int d = 0; d < 64; ++d) o[d] = 0.f;
        float pm = -1e30f;
        for (int j = lane; j < ncand; j += 64) {
            int krow; float bias = 0.f; bool ok = true;
            if (j >= nlatk) krow = NLAT + b * CTXL + (j - nlatk);
            else if (mx == 0) { const int i = j >> 4, jj = j & 15; krow = b * SEQ + (rs + i) * 64 + cs + jj; bias = rpb_l[h * 465 + (rs + i - r + 7) * 31 + (cs + jj - c + 15)] * LOG2E; }
            else if (mx == 1) { const int kpos = t - 128 + j; ok = kpos >= 0 && kpos < SEQ; krow = b * SEQ + (ok ? kpos : 0); }
            else krow = b * SEQ + j;
            if (!ok) continue;
            const bf16* kr = Kb + (size_t)krow * kp; float s = bias;
#pragma unroll
            for (int d = 0; d < 64; d += 2) { const unsigned w = *(const unsigned*)(kr + d); s += q[d] * bflo(w) + q[d + 1] * bfhi(w); }
            if (pass == 0) pm = fmaxf(pm, s);
            else { const float pe = __builtin_amdgcn_exp2f(s - mxv); l += pe; const bf16* vr = Vb + (size_t)krow * kp;
#pragma unroll
                for (int d = 0; d < 64; d += 2) { const unsigned w = *(const unsigned*)(vr + d); o[d] += pe * bflo(w); o[d + 1] += pe * bfhi(w); } }
        }
        if (pass == 0) {
#pragma unroll
            for (int off = 32; off >= 1; off >>= 1) pm = fmaxf(pm, __shfl_xor(pm, off));
            mxv = pm;
        } else {
            l = wave_sum(l); if (mx == 1) l += __builtin_amdgcn_exp2f(sink_l[h] * LOG2E - mxv);
            float e2 = 0.f, r2 = 0.f;
#pragma unroll
            for (int d = 0; d < 64; ++d) { const float od = wave_sum(o[d]) / l; const float cd = bf2f(CATp[(size_t)row * DM + mx * 256 + h * 64 + d]); e2 += (od - cd) * (od - cd); r2 += od * od; }
            if (lane == 0) { atomicAdd(acc2, e2); atomicAdd(acc2 + 1, r2); atomicAdd(acc2 + 2 + 2 * mx, e2); atomicAdd(acc2 + 3 + 2 * mx, r2); }
        }
    }
}
__device__ __forceinline__ void rope_pair(float& x1, float& x2, float pos, int i, int half) {
    const float ang = pos * exp2f(-(float)i * (13.287712379549449f / (float)half)); const float cs_ = __cosf(ang), sn_ = __sinf(ang);
    const float a = x1, b = x2; x1 = a * cs_ - b * sn_; x2 = b * cs_ + a * sn_;
}
__device__ __forceinline__ void proj_item(const unsigned char* ws, const float* w_in_l, const float* gq, const float* gkv, const float* wuq, const float* wukv, int row, int lane, float* pl, float* acc2) {
    const bf16* Hh = (const bf16*)(ws + WS_H) + (size_t)row * HLD; const bf16* P = (const bf16*)(ws + WS_P) + (size_t)row * INWP;
    const bf16* QCr = (const bf16*)(ws + WS_QC) + (size_t)row * 256; const bf16* KCr = (const bf16*)(ws + WS_KC) + (size_t)row * 256; const bf16* VCr = (const bf16*)(ws + WS_VC) + (size_t)row * 256;
    const bool lat = row < NLAT; const int t = row & (SEQ - 1); const float pr_ = (float)(t >> 6), pc_ = (float)(t & 63);
    for (int j = 0; j < 15; ++j) { const int cc = lane + 64 * j; if (cc >= 928) break; const int col = 768 + cc; float s = 0.f;
        for (int k = 0; k < DM; ++k) { float hv = bf2f(Hh[k]); if (ROUTER_SPLIT) hv += bf2f(Hh[DM + k]); s += hv * w_in_l[(size_t)k * INW + col]; }
        pl[cc] = s; }
    LDS_WAIT();
    float e2[7] = {0.f, 0.f, 0.f, 0.f, 0.f, 0.f, 0.f}, r2[7] = {0.f, 0.f, 0.f, 0.f, 0.f, 0.f, 0.f};
#define CHK_ACC(cat, ref, got) do { const float rf_ = (ref), gt_ = (got); e2[cat] += (rf_ - gt_) * (rf_ - gt_); r2[cat] += rf_ * rf_; } while (0)
    for (int pi = lane; pi < 6 * 32; pi += 64) { const int hd = pi >> 5, i = pi & 31, g2 = i >> 4, ii = i & 15; const int base = hd * 64 + 32 * g2 + ii;
        float x1 = pl[base], x2 = pl[base + 16]; if (lat) rope_pair(x1, x2, g2 == 0 ? pr_ : pc_, ii, 16);
        if (hd < 4) { CHK_ACC(0, x1 * C2, bf2f(P[B_Q + base])); CHK_ACC(0, x2 * C2, bf2f(P[B_Q + base + 16])); } else { CHK_ACC(1, x1, bf2f(P[B_Q + base])); CHK_ACC(1, x2, bf2f(P[B_Q + base + 16])); } }
    for (int i = lane; i < 128; i += 64) CHK_ACC(2, pl[B_V - 768 + i], bf2f(P[B_V + i]));
    float sq = 0.f, sk = 0.f;
    for (int i = lane; i < 256; i += 64) { const float v = pl[C_Q - 768 + i]; sq += v * v; }
    for (int i = lane; i < 128; i += 64) { const float v = pl[C_KV - 768 + i]; sk += v * v; }
    const float rq = 1.0f / sqrtf(wave_sum(sq) / 256.f + RMS_EPS), rk = 1.0f / sqrtf(wave_sum(sk) / 128.f + RMS_EPS);
    for (int n = lane; n < 256; n += 64) { float s = 0.f; for (int k = 0; k < 256; ++k) s += pl[C_Q - 768 + k] * rq * gq[k] * wuq[(size_t)k * 256 + n]; CHK_ACC(3, s * C2, bf2f(QCr[n])); }
    for (int n = lane; n < 384; n += 64) { float s = 0.f; for (int k = 0; k < 128; ++k) s += pl[C_KV - 768 + k] * rk * gkv[k] * wukv[(size_t)k * 384 + n];
        const int h = n / 96, jj = n % 96; if (jj < 32) CHK_ACC(4, s, bf2f(KCr[h * 64 + jj])); else CHK_ACC(6, s, bf2f(VCr[h * 64 + jj - 32])); }
    for (int pi = lane; pi < 4 * 16; pi += 64) { const int h = pi >> 4, i = pi & 15, g2 = i >> 3, ii = i & 7; const int base = 16 * g2 + ii;
        float x1 = pl[C_KR - 768 + base], x2 = pl[C_KR - 768 + base + 8]; if (lat) rope_pair(x1, x2, g2 == 0 ? pr_ : pc_, ii, 8);
        CHK_ACC(5, x1, bf2f(KCr[h * 64 + 32 + base])); CHK_ACC(5, x2, bf2f(KCr[h * 64 + 32 + base + 8])); }
#undef CHK_ACC
#pragma unroll
    for (int cat = 0; cat < 7; ++cat) { const float a = wave_sum(e2[cat]), b = wave_sum(r2[cat]); if (lane == 0) { atomicAdd(acc2 + 16 + 2 * cat, a); atomicAdd(acc2 + 17 + 2 * cat, b); } }
}
constexpr int NP_ROWS = 112;
__device__ __forceinline__ int proj_row(int s) { return s < 96 ? (int)(((long)s * 7919 + 5) % NLAT) : NLAT + ((s - 96) * 61 + 7) % NCTX; }
constexpr int NS_LAT = 640, NS_CTX = 48, NS_EDGE = 28;
__device__ __forceinline__ int sample_row(int s) {
    if (s < NS_LAT) return (int)(((long)s * 6151 + 17) % NLAT);
    s -= NS_LAT;
    if (s < NS_EDGE) { const int b = s / 7, k = s % 7; const int tt[7] = {0, 1, 63, 64, 4095, 8127, 8191}; int t = 0;
#pragma unroll
        for (int i = 0; i < 7; ++i) if (i == k) t = tt[i];
        return b * SEQ + t; }
    s -= NS_EDGE;
    return NLAT + (s * 21 + 3) % NCTX;
}
}
#endif
struct RowMapId { int off; __device__ __forceinline__ int operator()(int n) const { return off + n; } };
struct RowMapIl { int sub; __device__ __forceinline__ int operator()(int n) const { return 8 * (n >> 2) + 4 * sub + (n & 3); } };
struct RowMapKV { __device__ __forceinline__ int operator()(int n) const { const int h = n / 96, j = n % 96; return j < 32 ? h * 64 + j : 256 + h * 64 + (j - 32); } };
template <class RowMap>
__device__ __forceinline__ void tr_item(const float* W, int ldw, int k0, int n0, bf16* WT, int ldt, const RowMap& rm, const float* kscale, float* scr, int lane) {
    f32x4 xr[16];
#pragma unroll
    for (int it = 0; it < 16; ++it) { const int k = it * 4 + (lane >> 4), n4 = (lane & 15) * 4;
        xr[it] = __builtin_nontemporal_load((const f32x4*)(W + (size_t)(k0 + k) * ldw + n0 + n4)); }
    asm volatile("" : "+v"(xr[0]), "+v"(xr[1]), "+v"(xr[2]), "+v"(xr[3]), "+v"(xr[4]), "+v"(xr[5]), "+v"(xr[6]), "+v"(xr[7]), "+v"(xr[8]), "+v"(xr[9]), "+v"(xr[10]), "+v"(xr[11]), "+v"(xr[12]), "+v"(xr[13]), "+v"(xr[14]), "+v"(xr[15]));
#pragma unroll
    for (int it = 0; it < 16; ++it) { const int k = it * 4 + (lane >> 4), n4 = (lane & 15) * 4;
        f32x4 x = xr[it];
        if (kscale) x = x * kscale[k0 + k];
        float* s = scr + k * 65 + n4; s[0] = x.x; s[1] = x.y; s[2] = x.z; s[3] = x.w; }
    LDS_WAIT();
#pragma unroll 2
    for (int it = 0; it < 8; ++it) { const int n = it * 8 + (lane >> 3), c = lane & 7; const float* s = scr + (8 * c) * 65 + n;
        v4u o; o.x = pk2(s[0 * 65], s[1 * 65]); o.y = pk2(s[2 * 65], s[3 * 65]); o.z = pk2(s[4 * 65], s[5 * 65]); o.w = pk2(s[6 * 65], s[7 * 65]);
        *(v4u*)(WT + (size_t)rm(n0 + n) * ldt + k0 + 8 * c) = o; }
    LDS_WAIT();
}
__device__ __forceinline__ void ld_row(const float* p, int lane, f32x4 (&v)[4]) {
#pragma unroll
    for (int j = 0; j < 2; ++j) { v[2 * j] = *(const f32x4*)(p + 512 * j + 8 * lane); v[2 * j + 1] = *(const f32x4*)(p + 512 * j + 8 * lane + 4); }
}
__device__ __forceinline__ void ld_row_nt(const float* p, int lane, f32x4 (&v)[4]) {
#pragma unroll
    for (int j = 0; j < 2; ++j) { v[2 * j] = __builtin_nontemporal_load((const f32x4*)(p + 512 * j + 8 * lane)); v[2 * j + 1] = __builtin_nontemporal_load((const f32x4*)(p + 512 * j + 8 * lane + 4)); }
}
__device__ __forceinline__ void ld_row_nt(const bf16* p, int lane, f32x4 (&v)[4]) {
#pragma unroll
    for (int j = 0; j < 2; ++j) { const v4u w = __builtin_nontemporal_load((const v4u*)(p + 512 * j + 8 * lane)); v[2 * j] = (f32x4){bflo(w.x), bfhi(w.x), bflo(w.y), bfhi(w.y)}; v[2 * j + 1] = (f32x4){bflo(w.z), bfhi(w.z), bflo(w.w), bfhi(w.w)}; }
}
__device__ __forceinline__ void st_row(bf16* p, int lane, const f32x4 (&v)[4]) {
#pragma unroll
    for (int j = 0; j < 2; ++j) { v4u w; const f32x4 a = v[2 * j], b = v[2 * j + 1]; w.x = cvtpk(a.x, a.y); w.y = cvtpk(a.z, a.w); w.z = cvtpk(b.x, b.y); w.w = cvtpk(b.z, b.w); *(v4u*)(p + 512 * j + 8 * lane) = w; }
}
__device__ __forceinline__ void st_row(float* p, int lane, const f32x4 (&v)[4]) {
#pragma unroll
    for (int j = 0; j < 2; ++j) { st16_wtw<1>(p + 512 * j + 8 * lane, __builtin_bit_cast(v4u, v[2 * j])); st16_wtw<1>(p + 512 * j + 8 * lane + 4, __builtin_bit_cast(v4u, v[2 * j + 1])); }
}
__device__ __forceinline__ void st_row_hilo(bf16* p, int lane, const f32x4 (&v)[4]) {
#pragma unroll
    for (int j = 0; j < 2; ++j) { v4u w, wl; const f32x4 a = v[2 * j], b = v[2 * j + 1];
        w.x = cvtpk(a.x, a.y); w.y = cvtpk(a.z, a.w); w.z = cvtpk(b.x, b.y); w.w = cvtpk(b.z, b.w);
        wl.x = cvtpk(a.x - bflo(w.x), a.y - bfhi(w.x)); wl.y = cvtpk(a.z - bflo(w.y), a.w - bfhi(w.y)); wl.z = cvtpk(b.x - bflo(w.z), b.y - bfhi(w.z)); wl.w = cvtpk(b.z - bflo(w.w), b.w - bfhi(w.w));
        st16_wtw<1>(p + 512 * j + 8 * lane, w); if (ROUTER_SPLIT) st16_wtw<1>(p + DM + 512 * j + 8 * lane, wl); }
}
__device__ __forceinline__ void tr_item_router(const float* W, int k0, int n0, bf16* WT, float* scr, int lane) {
#pragma unroll 4
    for (int it = 0; it < 16; ++it) { const int k = it * 4 + (lane >> 4), n4 = (lane & 15) * 4;
        const f32x4 x = *(const f32x4*)(W + (size_t)(k0 + k) * NEXP + n0 + n4);
        float* s = scr + k * 65 + n4; s[0] = x.x; s[1] = x.y; s[2] = x.z; s[3] = x.w; }
    LDS_WAIT();
#pragma unroll 2
    for (int it = 0; it < 8; ++it) { const int n = it * 8 + (lane >> 3), c = lane & 7; const float* s = scr + (8 * c) * 65 + n;
        float f[8]; v4u o, ol;
#pragma unroll
        for (int i = 0; i < 8; ++i) f[i] = s[i * 65];
        o.x = cvtpk(f[0], f[1]); o.y = cvtpk(f[2], f[3]); o.z = cvtpk(f[4], f[5]); o.w = cvtpk(f[6], f[7]);
        ol.x = cvtpk(f[0] - bflo(o.x), f[1] - bfhi(o.x)); ol.y = cvtpk(f[2] - bflo(o.y), f[3] - bfhi(o.y)); ol.z = cvtpk(f[4] - bflo(o.z), f[5] - bfhi(o.z)); ol.w = cvtpk(f[6] - bflo(o.w), f[7] - bfhi(o.w));
        bf16* d0 = WT + (size_t)(n0 + n) * HLD + k0 + 8 * c; bf16* d1 = WT + (size_t)(128 + n0 + n) * HLD + k0 + 8 * c;
        if (ROUTER_SPLIT) { *(v4u*)d0 = o; *(v4u*)(d0 + DM) = o; *(v4u*)d1 = ol; *(v4u*)(d1 + DM) = ol; }
        else { *(v4u*)d0 = o; *(v4u*)d1 = (v4u){0u, 0u, 0u, 0u}; } }
    LDS_WAIT();
}
__device__ __forceinline__ void ln_row(f32x4 (&v)[4]) {
    float s = 0.f;
#pragma unroll
    for (int j = 0; j < 4; ++j) s += (v[j].x + v[j].y) + (v[j].z + v[j].w);
    const float mean = wave_sum(s) * (1.f / DM); float s2 = 0.f;
#pragma unroll
    for (int j = 0; j < 4; ++j) { v[j] = v[j] - mean; s2 += (v[j].x * v[j].x + v[j].y * v[j].y) + (v[j].z * v[j].z + v[j].w * v[j].w); }
    const float rstd = 1.0f / sqrtf(wave_sum(s2) * (1.f / DM) + LN_EPS);
#pragma unroll
    for (int j = 0; j < 4; ++j) v[j] = v[j] * rstd;
}
template <bool ONEPLUS>
__device__ __forceinline__ void affine_row(f32x4 (&v)[4], const float* a, const float* b, int lane) {
    f32x4 av[4], bv[4]; ld_row(a, lane, av); ld_row(b, lane, bv);
#pragma unroll
    for (int j = 0; j < 4; ++j) v[j] = ONEPLUS ? v[j] * (av[j] + 1.0f) + bv[j] : v[j] * av[j] + bv[j];
}
__device__ __forceinline__ int mod_row(int row) { return row < NLAT ? (row >> 13) : 4; }

__device__ __forceinline__ int ltid() { int t = threadIdx.x; asm volatile("" : "+v"(t)); return t; }
struct Args {
    const float *x, *c, *ctx, *c_ctx, *w_ada, *b_ada, *w_in, *na_rpb, *wa_sink, *mla_g_q, *mla_g_kv, *mla_w_uq, *mla_w_ukv,
                *gla_w_gf, *gla_b_gf, *gla_w_gb, *gla_b_gb, *gla_g_norm, *w_out, *ln1_g, *ln1_b, *ln2_g, *ln2_b,
                *router_w, *router_bias, *exp_w1, *exp_w3, *exp_w2, *sh_w1, *sh_w3, *sh_w2;
    float* out; unsigned char* ws;
};
static_assert(sizeof(Args) == 33 * 8, "Args has no padding");

constexpr int CV_N = NEXP * 192, CV_P8 = ROUTER_SPLIT ? 6944 : 3500  , CV_N0 = CV_N - CV_P8 - 7680 - 4608, CV_N1 = CV_N0 + 4608, CV_N2 = CV_N1 + 7680;
constexpr int CV_L8 = ROUTER_SPLIT ? 4600 : 2300, CV_L0 = CV_N - 4608 - CV_L8, CV_L1 = CV_L0 + 4608;
template <class ArgsT> __device__ __forceinline__ void convert_experts(const ArgsT& A, int l, int lo, int hi, int gw, int NGW, float* scr, int lane) {
    bf16* we13 = (bf16*)(A.ws + WS_WE13); bf16* we2 = (bf16*)(A.ws + WS_WE2);
    for (int it = lo + gw; it < hi; it += NGW) {
        const int e = it / 192, r = it % 192, which = r >> 6, q = r & 63;
        if (which < 2) { const float* W = (which == 0 ? A.exp_w1 : A.exp_w3) + ((size_t)l * NEXP + e) * DM * DEXP;
            tr_item(W, DEXP, (q >> 2) * 64, (q & 3) * 64, we13 + (size_t)e * 512 * DM, DM, RowMapIl{which}, nullptr, scr, lane); }
        else { const float* W = A.exp_w2 + ((size_t)l * NEXP + e) * DEXP * DM;
            tr_item(W, DM, (q >> 4) * 64, (q & 15) * 64, we2 + (size_t)e * DM * DEXP, DEXP, RowMapId{0}, nullptr, scr, lane); }
    }
}

#ifndef SELFCHECK_TOL
#define SELFCHECK_TOL 0.03f
#endif
#ifndef SELFCHECK_TOL2
#define SELFCHECK_TOL2 0.02f
#endif
#ifndef PHMASK
#define PHMASK 0xffffff
#endif
#define PHON(k) (((PHMASK) >> (k)) & 1)
#ifndef DUPK
#define DUPK -1
#endif
__global__ void __launch_bounds__(512, 2) hybrid_fwd(Args A) {
    extern __shared__ __attribute__((aligned(16))) unsigned char lds[];
    const int wave = __builtin_amdgcn_readfirstlane((int)threadIdx.x >> 6);
    const int G = gridDim.x; const int bx = blockIdx.x; const int vcu = (G % 8 == 0) ? (bx % 8) * (G / 8) + bx / 8 : bx;
    const int gw = vcu * 8 + wave, NGW = G * 8;
    const bool cv_tails = (G == 256);
    GAS unsigned char* wsg = (GAS unsigned char*)A.ws;
    unsigned char* ws = (unsigned char*)wsg;
#define WS_LAUNDER() asm volatile("" : "+s"(wsg)); ws = (unsigned char*)wsg; const int tid = ltid(), lane = tid & 63; (void)lane
    gu32* ctl = (gu32*)(ws + WS_CTL);
    volatile LAS unsigned* MISC = (volatile LAS unsigned*)((LAS unsigned char*)lds + MISC_OFF);
    { const int tid = ltid(); if (tid < 128) MISC[tid] = 0u; }
    __syncthreads();
    XcdBarrier bar = xcd_barrier_post((unsigned*)(ctl + CW_BAR), MISC);
#define GRID_BAR() do { XcdBarrier b2_ = bar; GAS unsigned* bp_ = (GAS unsigned*)bar.bar; asm volatile("" : "+s"(bp_), "+s"(b2_.x)); b2_.bar = (unsigned*)bp_; xcd_barrier(b2_); } while (0)
    char* shm = (char*)lds;
#if defined(TIMEPHASE)
#ifndef TIMEQ
#define TIMEQ 100.0f
#endif
#ifndef TIMEOFF
#define TIMEOFF 0.0f
#endif
    unsigned long long t_begin_ = __builtin_amdgcn_s_memrealtime(), t_prev_ = t_begin_, t_acc_ = 0;
#define TSTAMP(k) do { const unsigned long long now_ = __builtin_amdgcn_s_memrealtime(); if ((k) == TIMEPHASE) t_acc_ += now_ - t_prev_; t_prev_ = now_; } while (0)
#else
#define TSTAMP(k) do {} while (0)
#endif
#define MODT ((float*)(ws + WS_MOD))
#define Hb ((bf16*)(ws + WS_H))
#define Pb ((bf16*)(ws + WS_P))
#define QC ((bf16*)(ws + WS_QC))
#define KC ((bf16*)(ws + WS_KC))
#define VC ((bf16*)(ws + WS_VC))
#define CAT ((bf16*)(ws + WS_CAT))
#define XA ((xa_t*)(ws + WS_XA))
#define Zb ((float*)(ws + WS_Z))
#define RSTD ((float*)(ws + WS_RSTD))

        if (PHON(0)) {
        WS_LAUNDER();
    {
        float* sc = (float*)shm;
        float* part = (float*)(shm + 20480);
        for (int i = tid; i < 5 * DM; i += 512) { const float v = i < 4 * DM ? A.c[i] : A.c_ctx[i - 4 * DM]; sc[i] = v / (1.0f + __expf(-v)); }
        __syncthreads();
        for (int grp = vcu; grp < DEPTH * 96; grp += G) {
            const int l = grp / 96, col = (grp % 96) * 64 + lane;
            const float* wp = A.w_ada + (size_t)l * DM * 6 * DM + col;
            float acc[5] = {0.f, 0.f, 0.f, 0.f, 0.f};
#pragma unroll 1
            for (int k0 = 0; k0 < 128; k0 += 32) { float wv[32];
#pragma unroll
                for (int kk = 0; kk < 32; ++kk) wv[kk] = __builtin_nontemporal_load(wp + (size_t)(wave * 128 + k0 + kk) * 6 * DM);
                asm volatile("" : "+v"(wv[16]), "+v"(wv[17]), "+v"(wv[18]), "+v"(wv[19]), "+v"(wv[20]), "+v"(wv[21]), "+v"(wv[22]), "+v"(wv[23]), "+v"(wv[24]), "+v"(wv[25]), "+v"(wv[26]), "+v"(wv[27]), "+v"(wv[28]), "+v"(wv[29]), "+v"(wv[30]), "+v"(wv[31]));
#pragma unroll
                for (int kk = 0; kk < 32; ++kk) { const int k = wave * 128 + k0 + kk;
#pragma unroll
                    for (int r = 0; r < 5; ++r) acc[r] += sc[r * DM + k] * wv[kk]; } }
#pragma unroll
            for (int r = 0; r < 5; ++r) part[(wave * 5 + r) * 64 + lane] = acc[r];
            __syncthreads();
            if (tid < 320) { const int r = tid >> 6; float s = A.b_ada[(size_t)l * 6 * DM + col];
#pragma unroll
                for (int w8 = 0; w8 < 8; ++w8) s += part[(w8 * 5 + r) * 64 + lane];
                MODT[((size_t)l * 5 + r) * 6 * DM + col] = s; }
            __syncthreads();
        }
        float* scr = (float*)(shm + wave * 16640);
        constexpr int I_IN = 16 * 39, I_OUT = 16 * 16, I_UQ = 4 * 4, I_UKV = 2 * 6, I_RT = 16 * 2, I_S1 = 16 * 4, I_S2 = 4 * 16;
        constexpr int I_L = I_IN + I_OUT + I_UQ + I_UKV + I_RT + 2 * I_S1 + I_S2;
        for (int it = gw; it < DEPTH * I_L; it += NGW) {
            const int l = it / I_L; int r = it % I_L;
            if (r < I_IN) { tr_item(A.w_in + (size_t)l * DM * INW, INW, (r / 39) * 64, (r % 39) * 64, (bf16*)(ws + WS_WIN) + (size_t)l * INWP * DM, DM, RowMapId{0}, nullptr, scr, lane); continue; } r -= I_IN;
            if (r < I_OUT) { tr_item(A.w_out + (size_t)l * DM * DM, DM, (r / 16) * 64, (r % 16) * 64, (bf16*)(ws + WS_WOUT) + (size_t)l * DM * DM, DM, RowMapId{0}, nullptr, scr, lane); continue; } r -= I_OUT;
            if (r < I_UQ) { tr_item(A.mla_w_uq + (size_t)l * 256 * 256, 256, (r / 4) * 64, (r % 4) * 64, (bf16*)(ws + WS_WUQ) + (size_t)l * 256 * 256, 256, RowMapId{0}, A.mla_g_q + l * 256, scr, lane); continue; } r -= I_UQ;
            if (r < I_UKV) { tr_item(A.mla_w_ukv + (size_t)l * 128 * 384, 384, (r / 6) * 64, (r % 6) * 64, (bf16*)(ws + WS_WUKV) + (size_t)l * 512 * 128, 128, RowMapKV{}, A.mla_g_kv + l * 128, scr, lane); continue; } r -= I_UKV;
            if (r < I_RT) { tr_item_router(A.router_w + (size_t)l * DM * NEXP, (r / 2) * 64, (r % 2) * 64, (bf16*)(ws + WS_WRT) + (size_t)l * 256 * HLD, scr, lane); continue; } r -= I_RT;
            if (r < I_S1) { tr_item(A.sh_w1 + (size_t)l * DM * 256, 256, (r / 4) * 64, (r % 4) * 64, (bf16*)(ws + WS_WS13) + (size_t)l * 512 * DM, DM, RowMapIl{0}, nullptr, scr, lane); continue; } r -= I_S1;
            if (r < I_S1) { tr_item(A.sh_w3 + (size_t)l * DM * 256, 256, (r / 4) * 64, (r % 4) * 64, (bf16*)(ws + WS_WS13) + (size_t)l * 512 * DM, DM, RowMapIl{1}, nullptr, scr, lane); continue; } r -= I_S1;
            tr_item(A.sh_w2 + (size_t)l * 256 * DM, DM, (r / 16) * 64, (r % 16) * 64, (bf16*)(ws + WS_WS2) + (size_t)l * DM * 256, 256, RowMapId{0}, nullptr, scr, lane);
        }
        { const v4u z = {0u, 0u, 0u, 0u}; const int gt = vcu * 512 + tid, NGT = G * 512;
            for (int i = gt; i < DEPTH * 64 * 128; i += NGT) { const int l = i / (64 * 128), r = i % (64 * 128); *(v4u*)((bf16*)(ws + WS_WIN) + ((size_t)l * INWP + INW) * DM + (size_t)r * 8) = z; }
            for (int i = gt; i < DEPTH * 4 * 32 * 16; i += NGT) { const int l = i / 2048, r = i % 2048, h = r / 512, q = r % 512; *(v4u*)((bf16*)(ws + WS_WUKV) + ((size_t)l * 512 + h * 64 + 32) * 128 + (size_t)q * 8) = z; } }
    }
        }
    GRID_BAR(); TSTAMP(0);
        if (PHON(1)) {
        WS_LAUNDER();
    for (int m = gw; m < NTOK; m += NGW) {
        const float* src = m < NLAT ? A.x + (size_t)m * DM : A.ctx + (size_t)(m - NLAT) * DM;
        f32x4 v[4]; ld_row_nt(src, lane, v); st_row(XA + (size_t)m * DM, lane, v);
        ln_row(v); const float* mp = MODT + (size_t)mod_row(m) * 6 * DM; affine_row<true>(v, mp + DM, mp, lane);
        st_row_hilo(Hb + (size_t)m * HLD, lane, v);
    }
    convert_experts(A, 0, 0, cv_tails ? CV_N0 : CV_N, gw, NGW, (float*)(shm + wave * 16640), lane);
        }
    GRID_BAR(); TSTAMP(1);

#pragma unroll 1
    for (int l = 0; l < DEPTH; ++l) {
        const bool lastl = (l == DEPTH - 1);
        const int MT = lastl ? NLAT : NTOK;
#define modl (MODT + (size_t)l * 5 * 6 * DM)
        if (PHON(2)) {
        WS_LAUNDER();
        { pg8::Gemm g{Hb, (const bf16*)(ws + WS_WIN) + (size_t)l * INWP * DM, DM, HLD, nullptr}; pg8::StaticOrderT<NTOK, INWP> S; S.init(NTOK, INWP, G, bx);
          pg8::EpiBf16<INWP, false> E{Pb, 10, (1u << 0) | (1u << 3), C2, 256, nullptr, 0, nullptr};
          pg8::gemm_phase<pg8::EpiBf16<INWP, false>, pg8::StaticOrderT<NTOK, INWP>, false>((LAS unsigned char*)lds, g, S, E); }
        if (cv_tails && bx >= 40) convert_experts(A, l, lastl ? CV_L0 : CV_N0, lastl ? CV_L1 : CV_N1, (bx - 40) * 8 + wave, 216 * 8, (float*)(shm + wave * 16640), lane);
        }
        GRID_BAR(); TSTAMP(2);
        if (PHON(3)) {
        WS_LAUNDER();
        {
        const bool roleB = lane < 24, roleK = lane == 24 || lane == 25;
        const int hd = lane >> 2, g2 = roleB ? (lane >> 1) & 1 : lane & 1, c8 = lane & 1;
        const int col1 = roleB ? B_Q + hd * 64 + 32 * g2 + 8 * c8 : C_KR + 16 * g2, dpart = roleB ? 16 : 8;
        const int f0 = roleB ? 8 * c8 : 0; const float fdiv = roleB ? 13.287712379549449f / 16.0f : 13.287712379549449f / 8.0f;
        const bool rskip = P2_ROWSKIP && G == 256; const int gw2 = rskip ? (vcu - 16) * 8 + wave : gw, NGW2 = rskip ? (G - 16) * 8 : NGW;
        for (int m0 = (rskip && vcu < 16) ? NTOK : gw2; m0 < NTOK; m0 += 4 * NGW2) {
            v4u xa[4], xb[4]; v2u ca[4]; unsigned cb[4];
#pragma unroll
            for (int u = 0; u < 4; ++u) { const int m = m0 + u * NGW2; const bf16* pr = Pb + (size_t)(m < NTOK ? m : 0) * INWP;
                xa[u] = *(const v4u*)(pr + col1); xb[u] = *(const v4u*)(pr + col1 + dpart);
                ca[u] = *(const v2u*)(pr + C_Q + 4 * lane); cb[u] = *(const unsigned*)(pr + C_KV + 2 * lane); }
#pragma unroll
            for (int u = 0; u < 4; ++u) { const int m = m0 + u * NGW2; if (m < NTOK) { bf16* pr = Pb + (size_t)m * INWP;
                const bool lat = m < NLAT; const int t = m & (SEQ - 1);
                if ((roleB && lat) || roleK) {
                    const float pos = (float)(g2 == 0 ? (t >> 6) : (t & 63)); v4u oa, ob;
#pragma unroll
                    for (int j = 0; j < 4; ++j) { float r1[2], r2[2];
#pragma unroll
                        for (int e = 0; e < 2; ++e) { const float rev = pos * __builtin_amdgcn_exp2f(-(float)(f0 + 2 * j + e) * fdiv) * 0.15915494309189535f;
                            const float cs_ = lat ? __builtin_amdgcn_cosf(rev) : 1.f, sn_ = lat ? __builtin_amdgcn_sinf(rev) : 0.f;
                            const float a1 = e ? bfhi(xa[u][j]) : bflo(xa[u][j]), a2 = e ? bfhi(xb[u][j]) : bflo(xb[u][j]); r1[e] = a1 * cs_ - a2 * sn_; r2[e] = a2 * cs_ + a1 * sn_; }
                        oa[j] = cvtpk(r1[0], r1[1]); ob[j] = cvtpk(r2[0], r2[1]); }
                    if (roleB) { *(v4u*)(pr + col1) = oa; *(v4u*)(pr + col1 + 16) = ob; }
                    else { bf16* kd = KC + (size_t)m * 256 + 32 + 16 * g2;
#pragma unroll
                        for (int h4 = 0; h4 < 4; ++h4) { *(v4u*)(kd + h4 * 64) = oa; *(v4u*)(kd + h4 * 64 + 8) = ob; } }
                }
                const v2u a_ = ca[u]; const unsigned b2 = cb[u];
                float sq = bflo(a_.x) * bflo(a_.x) + bfhi(a_.x) * bfhi(a_.x) + bflo(a_.y) * bflo(a_.y) + bfhi(a_.y) * bfhi(a_.y); float sk = bflo(b2) * bflo(b2) + bfhi(b2) * bfhi(b2);
                sq = wave_sum(sq); sk = wave_sum(sk);
                if (lane == 0) { RSTD[2 * m] = 1.0f / sqrtf(sq * (1.f / 256.f) + RMS_EPS); RSTD[2 * m + 1] = 1.0f / sqrtf(sk * (1.f / 128.f) + RMS_EPS); } } }
        }
        }
        }
#define GLA_PAR() const gla::Par gp{Pb, CAT, (float*)(ws + WS_GU), (float*)(ws + WS_GDEC), (float*)(ws + WS_BC), (float*)(ws + WS_CARRY), A.gla_w_gf + l * 16 * 128, A.gla_b_gf + l * 128, A.gla_w_gb + l * 16 * 128, A.gla_b_gb + l * 128, A.gla_g_norm + l * 64}
        if (PHON(3)) {
        WS_LAUNDER();
        if (PHON(21)) { GLA_PAR(); for (int u = vcu; u < NB * NCH; u += G) gla::g1_unit(gp, u / NCH, u % NCH, shm); }
        }
        GRID_BAR(); TSTAMP(3);
        if (PHON(4)) {
        WS_LAUNDER();
        if (G >= 256) { if (bx >= 16 && bx < 144) gla::g2_scan((float*)(ws + WS_GU), (const float*)(ws + WS_GDEC), (bx - 16) * 512 + tid); }
        else gla::g2_scan((float*)(ws + WS_GU), (const float*)(ws + WS_GDEC), vcu * 512 + tid);
        { pg8::Gemm g{Pb + C_Q, (const bf16*)(ws + WS_WUQ) + (size_t)l * 256 * 256, 256, INWP, nullptr}; pg8::StaticOrderT<NTOK, 256> S; S.init(NTOK, 256, G, bx);
          pg8::EpiBf16<256, true> E{QC, 1, 1u, C2, 0, RSTD, 0, nullptr};
          pg8::gemm_phase<pg8::EpiBf16<256, true>, pg8::StaticOrderT<NTOK, 256>, false>((LAS unsigned char*)lds, g, S, E); }
        { pg8::Gemm g{Pb + C_KV, (const bf16*)(ws + WS_WUKV) + (size_t)l * 512 * 128, 128, INWP, nullptr}; pg8::AfterRouterOrder S; S.init(NTOK, G, bx);
          pg8::EpiBf16<256, true, true> E{KC, 2, 0u, 1.f, (size_t)(WS_VC - WS_KC) / 2, RSTD, 1, nullptr};
          pg8::gemm_phase<pg8::EpiBf16<256, true, true>, pg8::AfterRouterOrder, false>((LAS unsigned char*)lds, g, S, E); }
        }
        GRID_BAR(); TSTAMP(4);
#if defined(SELFCHECK) && SELFCHECK
        {
            WS_LAUNDER();
            float* acc2 = (float*)(ws + WS_CTL) + 32768;
            for (int it = gw; it < chk::NP_ROWS; it += NGW) chk::proj_item(ws, A.w_in + (size_t)l * DM * INW, A.mla_g_q + l * 256, A.mla_g_kv + l * 128, A.mla_w_uq + (size_t)l * 256 * 256, A.mla_w_ukv + (size_t)l * 128 * 384,
                                                                            chk::proj_row(it), lane, (float*)(shm + wave * 4096), acc2);
            __syncthreads();
        }
#endif
        if (PHON(6)) {
        WS_LAUNDER();
        {
            if (PHON(16)) for (int u = vcu; u < 512; u += G) { const int bh = 2 * ((u & 255) >> 5) + (u >> 8), qb = u & 31, b = bh >> 2, h = bh & 3;
                att::Desc d{}; d.Q = QC + (size_t)(b * SEQ + 256 * qb) * 256 + h * 64; d.qp = 256; d.K = KC + h * 64; d.V = VC + h * 64; d.kp = 256;
                d.O = CAT + (size_t)(b * SEQ + 256 * qb) * DM + 512 + h * 64; d.op = DM; d.nt = 132; d.nctx = 4; d.ctxrow = NLAT + b * CTXL; d.latrow = b * SEQ;
                d.nt_real = d.nt; d.qrope = 1; d.qt0 = 256 * qb; att::attn_unit_pipe<8, att::M_FULL>(d, shm); }
            if (PHON(17)) for (int u = vcu; u < 512; u += G) { const int bh = u >> 5, qb = u & 31, b = bh >> 2, h = bh & 3; const int r0 = 4 * qb;
                const int kr0 = r0 - 4 < 0 ? 0 : (r0 - 4 > 120 ? 120 : r0 - 4); const int r3 = r0 + 3; const int krl = (r3 - 4 < 0 ? 0 : (r3 - 4 > 120 ? 120 : r3 - 4)) + 8;
                att::Desc d{}; d.Q = Pb + (size_t)(b * SEQ + 256 * qb) * INWP + A_Q + h * 64; d.qp = INWP; d.K = Pb + A_K + h * 64; d.V = Pb + A_V + h * 64; d.kp = INWP;
                d.O = CAT + (size_t)(b * SEQ + 256 * qb) * DM + h * 64; d.op = DM; d.nctx = 4; d.nt = 4 + (krl - kr0); d.ctxrow = NLAT + b * CTXL; d.latrow = b * SEQ + 64 * kr0;
                d.r0 = r0; d.kr0 = kr0; d.rpb = A.na_rpb + ((size_t)l * 4 + h) * 465;
                d.nt_real = d.nt; d.nt = (d.nt + 1) & ~1; att::attn_unit_pipe<8, att::M_NA>(d, shm); }
            if (PHON(18)) for (int u = vcu; u < 512; u += G) { const int bh = u >> 5, qb = u & 31, b = bh >> 2, h = bh & 3; const int q0 = 256 * qb;
                const int kt0 = q0 - 128 < 0 ? 0 : q0 - 128; const int kte = q0 + 256 + 128 > SEQ ? SEQ : q0 + 256 + 128;
                att::Desc d{}; d.Q = Pb + (size_t)(b * SEQ + q0) * INWP + B_Q + h * 64; d.qp = INWP; d.K = Pb + B_K + (h >> 1) * 64; d.V = Pb + B_V + (h >> 1) * 64; d.kp = INWP;
                d.O = CAT + (size_t)(b * SEQ + q0) * DM + 256 + h * 64; d.op = DM; d.nctx = 4; d.nt = 4 + (kte - kt0) / 64; d.ctxrow = NLAT + b * CTXL; d.latrow = b * SEQ + kt0;
                d.q0 = q0; d.kt0 = kt0; d.sink_l2 = A.wa_sink[l * 4 + h] * LOG2E; d.has_sink = 1;
                d.nt_real = d.nt; d.nt = (d.nt + 1) & ~1; att::attn_unit_pipe<8, att::M_WA>(d, shm); }
            if (PHON(19) && !lastl) for (int u = (G >= 64 ? vcu - (G - 48) : vcu); u < 48; u += G) { if (u < 0) break; const int mx = u >> 4, b = (u >> 2) & 3, h = u & 3; const int qrow = NLAT + b * CTXL;
                att::Desc d{}; d.nt = 4; d.nctx = 4; d.ctxrow = qrow; d.latrow = 0; d.op = DM; d.O = CAT + (size_t)qrow * DM + 256 * mx + h * 64;
                if (mx == 0) { d.Q = Pb + (size_t)qrow * INWP + A_Q + h * 64; d.qp = INWP; d.K = Pb + A_K + h * 64; d.V = Pb + A_V + h * 64; d.kp = INWP; }
                else if (mx == 1) { d.Q = Pb + (size_t)qrow * INWP + B_Q + h * 64; d.qp = INWP; d.K = Pb + B_K + (h >> 1) * 64; d.V = Pb + B_V + (h >> 1) * 64; d.kp = INWP; d.sink_l2 = A.wa_sink[l * 4 + h] * LOG2E; d.has_sink = 1; }
                else { d.Q = QC + (size_t)qrow * 256 + h * 64; d.qp = 256; d.K = KC + h * 64; d.V = VC + h * 64; d.kp = 256; }
                att::attn_unit<att::M_FULL>(d, shm); }
            if (PHON(20)) { GLA_PAR();
                if (G == 256 && G3_EDGE) {
#pragma unroll 1
                    for (int r = 0; r < 3; ++r) { const int q5 = vcu & 31; if (r == 2 && q5 != 0 && q5 != 31) break;
                        const int u = r < 2 ? vcu + 256 * r : 512 + 2 * (vcu >> 5) + (q5 == 31); if (u >= NB * NCH) break;
                        const int b = u / NCH, n = u % NCH; if (lastl && n < 4) continue; gla::g3_unit(gp, b, n, shm); } }
                else for (int u = vcu; u < NB * NCH; u += G) { const int b = u / NCH, n = u % NCH; if (lastl && n < 4) continue; gla::g3_unit(gp, b, n, shm); } }
        }
        }
        GRID_BAR(); TSTAMP(6);
#if defined(SELFCHECK) && SELFCHECK
        {
            WS_LAUNDER();
            float* acc2 = (float*)(ws + WS_CTL) + 32768;
            const int ns = chk::NS_LAT + chk::NS_EDGE + (lastl ? 0 : chk::NS_CTX);
            for (int it = gw; it < ns * 12; it += NGW) chk::item(ws, A.na_rpb + (size_t)l * 4 * 465, A.wa_sink + l * 4, chk::sample_row(it / 12), (it % 12) >> 2, it & 3, lane, acc2);
        }
        GRID_BAR();
#endif
        if (PHON(7)) {
        WS_LAUNDER();
        { pg8::Gemm g{CAT, (const bf16*)(ws + WS_WOUT) + (size_t)l * DM * DM, DM, DM, nullptr}; pg8::StaticOrderT<NTOK, DM, NLAT> S; S.init(MT, DM, G, bx);
          pg8::EpiBf16<DM, false> E{(bf16*)Zb, 4, 0u, 1.f, 256, nullptr, 0, nullptr};
          pg8::gemm_phase<pg8::EpiBf16<DM, false>, pg8::StaticOrderT<NTOK, DM, NLAT>, false>((LAS unsigned char*)lds, g, S, E); }
        if (cv_tails && !lastl && bx >= 16) convert_experts(A, l, CV_N1, CV_N2, (bx - 16) * 8 + wave, 240 * 8, (float*)(shm + wave * 16640), lane);
        }
        GRID_BAR(); TSTAMP(7);
        if (PHON(8)) {
        WS_LAUNDER();
#if P7_ROWS > 0 && XA_BF16
        for (int m0 = gw; m0 < MT; m0 += P7_ROWS * NGW) {
            v4u xw[P7_ROWS][2], ow[P7_ROWS][2];
#pragma unroll
            for (int u = 0; u < P7_ROWS; ++u) { const int m = m0 + u * NGW, mm = m < MT ? m : m0; const bf16* xr = XA + (size_t)mm * DM; const bf16* orow = (const bf16*)Zb + (size_t)mm * DM;
#pragma unroll
                for (int j = 0; j < 2; ++j) { xw[u][j] = __builtin_nontemporal_load((const v4u*)(xr + 512 * j + 8 * lane)); ow[u][j] = __builtin_nontemporal_load((const v4u*)(orow + 512 * j + 8 * lane)); } }
#pragma unroll
            for (int u = 0; u < P7_ROWS; ++u) { const int m = m0 + u * NGW; if (m >= MT) break;
                f32x4 vv[4], gt[4]; ld_row(modl + (size_t)mod_row(m) * 6 * DM + 2 * DM, lane, gt);
#pragma unroll
                for (int j = 0; j < 2; ++j) { const v4u x = xw[u][j], w = ow[u][j];
                    vv[2 * j] = (f32x4){bflo(x.x), bfhi(x.x), bflo(x.y), bfhi(x.y)} * DN_ALPHA + gt[2 * j] * (f32x4){bflo(w.x), bfhi(w.x), bflo(w.y), bfhi(w.y)};
                    vv[2 * j + 1] = (f32x4){bflo(x.z), bfhi(x.z), bflo(x.w), bfhi(x.w)} * DN_ALPHA + gt[2 * j + 1] * (f32x4){bflo(w.z), bfhi(w.z), bflo(w.w), bfhi(w.w)}; }
                ln_row(vv); affine_row<false>(vv, A.ln1_g + l * DM, A.ln1_b + l * DM, lane);
                st_row(XA + (size_t)m * DM, lane, vv);
                ln_row(vv); const float* mp = modl + (size_t)mod_row(m) * 6 * DM; affine_row<true>(vv, mp + 4 * DM, mp + 3 * DM, lane);
                st_row_hilo(Hb + (size_t)m * HLD, lane, vv); }
        }
#else
        for (int m0 = gw; m0 < MT; m0 += 2 * NGW) {
            f32x4 vv[2][4];
#pragma unroll
            for (int u = 0; u < 2; ++u) { const int m = m0 + u * NGW, mm = m < MT ? m : m0;
                f32x4 gt[4]; ld_row_nt(XA + (size_t)mm * DM, lane, vv[u]); ld_row(modl + (size_t)mod_row(mm) * 6 * DM + 2 * DM, lane, gt);
                const bf16* orow = (const bf16*)Zb + (size_t)mm * DM;
#pragma unroll
                for (int j = 0; j < 2; ++j) { const v4u w = __builtin_nontemporal_load((const v4u*)(orow + 512 * j + 8 * lane));
                    vv[u][2 * j] = vv[u][2 * j] * DN_ALPHA + gt[2 * j] * (f32x4){bflo(w.x), bfhi(w.x), bflo(w.y), bfhi(w.y)};
                    vv[u][2 * j + 1] = vv[u][2 * j + 1] * DN_ALPHA + gt[2 * j + 1] * (f32x4){bflo(w.z), bfhi(w.z), bflo(w.w), bfhi(w.w)}; } }
#pragma unroll
            for (int u = 0; u < 2; ++u) { const int m = m0 + u * NGW; if (m >= MT) break;
                ln_row(vv[u]); affine_row<false>(vv[u], A.ln1_g + l * DM, A.ln1_b + l * DM, lane);
                st_row(XA + (size_t)m * DM, lane, vv[u]);
                ln_row(vv[u]); const float* mp = modl + (size_t)mod_row(m) * 6 * DM; affine_row<true>(vv[u], mp + 4 * DM, mp + 3 * DM, lane);
                st_row_hilo(Hb + (size_t)m * HLD, lane, vv[u]); }
        }
#endif
        }
        GRID_BAR(); TSTAMP(8);
#define P9_TOKENS(TOK0_, NTOK_, BROW_) { \
            int* hist = (int*)shm; \
            if (tid < NEXP) hist[tid] = 0; \
            __syncthreads(); \
            const float rb0 = A.router_bias[l * NEXP + lane], rb1 = A.router_bias[l * NEXP + 64 + lane]; \
            for (int i0 = wave; i0 < (NTOK_); i0 += 32) { \
            float s0[4], s1[4], v0[4], v1[4], ssum[4], my_s[4]; int my_e[4]; \
            _Pragma("unroll") \
            for (int u = 0; u < 4; ++u) { const int ii = i0 + 8 * u; const int tok = (TOK0_) + (ii < (NTOK_) ? ii : i0); const float* lg = (const float*)(ws + WS_LOG) + (size_t)tok * NEXP; \
            s0[u] = 1.0f / (1.0f + __expf(-__builtin_nontemporal_load(lg + lane))); s1[u] = 1.0f / (1.0f + __expf(-__builtin_nontemporal_load(lg + 64 + lane))); \
            v0[u] = s0[u] + rb0; v1[u] = s1[u] + rb1; my_e[u] = 0; my_s[u] = 0.f; ssum[u] = 0.f; } \
            _Pragma("unroll") \
            for (int k = 0; k < TOPK; ++k) { \
            float bv[4]; int bi[4]; \
            _Pragma("unroll") \
            for (int u = 0; u < 4; ++u) { bv[u] = v0[u] >= v1[u] ? v0[u] : v1[u]; bi[u] = v0[u] >= v1[u] ? lane : lane + 64; } \
            _Pragma("unroll") \
            for (int off = 32; off >= 1; off >>= 1) { \
            _Pragma("unroll") \
            for (int u = 0; u < 4; ++u) { const float ov = __shfl_xor(bv[u], off); const int oi = __shfl_xor(bi[u], off); if (ov > bv[u] || (ov == bv[u] && oi < bi[u])) { bv[u] = ov; bi[u] = oi; } } } \
            _Pragma("unroll") \
            for (int u = 0; u < 4; ++u) { const float ssel = __shfl(bi[u] < 64 ? s0[u] : s1[u], bi[u] & 63); \
            if (lane == (bi[u] & 63)) { if (bi[u] < 64) v0[u] = -INFINITY; else v1[u] = -INFINITY; } \
            ssum[u] += ssel; if (lane == k) { my_e[u] = bi[u]; my_s[u] = ssel; } } \
            } \
            _Pragma("unroll") \
            for (int u = 0; u < 4; ++u) { const int ii = i0 + 8 * u; const int tok = (TOK0_) + ii; \
            if (ii < (NTOK_) && lane < TOPK) { const int rk = atomicAdd(&hist[my_e[u]], 1); \
            ((int*)(ws + WS_SEL))[tok * 8 + lane] = my_e[u]; ((float*)(ws + WS_GATE))[tok * 8 + lane] = 2.5f * my_s[u] / ssum[u]; ((int*)(ws + WS_RANK))[tok * 8 + lane] = rk; } } \
            } \
            __syncthreads(); \
            if (tid < NEXP) { const int base = __hip_atomic_fetch_add(GCNT + tid, hist[tid], __ATOMIC_RELAXED, __HIP_MEMORY_SCOPE_AGENT); ((int*)(ws + WS_BBASE))[(BROW_) * NEXP + tid] = base; } }
#if FUSE9
        constexpr bool fuse9 = true;
#else
        const bool fuse9 = false;
#endif
#define GCNT ((int*)(ws + WS_CTL) + CW_CNT + l * NEXP)
        if (PHON(9)) {
        WS_LAUNDER();
        { pg8::Gemm g{Hb, (const bf16*)(ws + WS_WRT) + (size_t)l * 256 * HLD, HLD, HLD, nullptr}; pg8::StaticOrderT<NTOK, 256, NLAT> S; S.init(MT, 256, G, bx);
          pg8::EpiLogits E{(float*)(ws + WS_LOG)};
          pg8::gemm_phase<pg8::EpiLogits, pg8::StaticOrderT<NTOK, 256, NLAT>, false>((LAS unsigned char*)lds, g, S, E);
          pg8::Unit ur; pg8::StaticOrderT<NTOK, 256, NLAT> S2; S2.init(MT, 256, G, bx);
          if (fuse9 && G == 256 && S2.next(0, ur)) {
              __builtin_amdgcn_fence(__ATOMIC_RELEASE, "agent"); __syncthreads(); __builtin_amdgcn_fence(__ATOMIC_ACQUIRE, "agent");
              { const int tid = ltid(), lane = tid & 63;
                P9_TOKENS(ur.pm * 256, 256, ur.pm); }
              __syncthreads(); } }
        const int nrt = MT / 256;
        const int cb8 = fuse9 ? (lastl ? 128 : 148) : (lastl ? 128 : (G == 256 ? 140 : 132));
        if (cv_tails && bx >= cb8) { convert_experts(A, l, lastl ? CV_L1 : CV_N2, CV_N, (bx - cb8) * 8 + wave, (256 - cb8) * 8, (float*)(shm + wave * 16640), lane); __syncthreads(); }
        { pg8::Gemm g{Hb, (const bf16*)(ws + WS_WS13) + (size_t)l * 512 * DM, DM, HLD, nullptr}; pg8::StaticOrderT<NTOK, 512, NLAT> S;
          S.init(MT, 512, fuse9 ? G - nrt : G, fuse9 ? (bx >= nrt ? bx - nrt : (1 << 24)) : ((!lastl && G == 256) ? ((bx + 124) & 255) : bx));
          pg8::EpiSwiGLU E{(bf16*)(ws + WS_HSS), 2, nullptr, 1.f, nullptr};
          pg8::gemm_phase<pg8::EpiSwiGLU, pg8::StaticOrderT<NTOK, 512, NLAT>, 0>((LAS unsigned char*)lds, g, S, E); }
        }
        GRID_BAR(); TSTAMP(9);
        const int TPB = MT / G;
        if constexpr (!fuse9) {
        if (PHON(10)) {
        WS_LAUNDER();
        {
            P9_TOKENS(vcu * TPB, TPB, vcu);
        }
        }
        GRID_BAR(); TSTAMP(10);
        }
        if (PHON(11)) {
        WS_LAUNDER();
        {
            int* sst = (int*)shm; int* scn = sst + 132;
            if (tid < NEXP) scn[tid] = __hip_atomic_load(GCNT + tid, __ATOMIC_RELAXED, __HIP_MEMORY_SCOPE_AGENT);
            __syncthreads();
            if (wave == 0) { const int p0 = (scn[2 * lane] + 255) & ~255, p1 = (scn[2 * lane + 1] + 255) & ~255; int x = p0 + p1;
#pragma unroll
                for (int off = 1; off < 64; off <<= 1) { const int y = __shfl_up(x, off); if (lane >= off) x += y; }
                const int ex = x - (p0 + p1); sst[2 * lane] = ex; sst[2 * lane + 1] = ex + p0; if (lane == 63) sst[NEXP] = x; }
            __syncthreads();
            int* stok = (int*)(ws + WS_STOK); float* sgate = (float*)(ws + WS_SGATE); int* texp = (int*)(ws + WS_TEXP);
            if (TPB * 8 > 1536) { for (int i = tid; i < TPB * 8; i += 512) { const int ent = vcu * TPB * 8 + i; const int e = ((const int*)(ws + WS_SEL))[ent];
                const int slot = sst[e] + ((const int*)(ws + WS_BBASE))[(fuse9 ? (ent >> 11) : vcu) * NEXP + e] + ((const int*)(ws + WS_RANK))[ent];
                stok[slot] = ent >> 3; sgate[slot] = ((const float*)(ws + WS_GATE))[ent]; ((int*)(ws + WS_TSLOT))[ent] = slot; } }
            else {
                int ee[3], bb[3], rr[3]; float gg[3];
#pragma unroll
                for (int q = 0; q < 3; ++q) { const int i = tid + 512 * q, ent = vcu * TPB * 8 + (i < TPB * 8 ? i : 0); ee[q] = ((const int*)(ws + WS_SEL))[ent]; rr[q] = ((const int*)(ws + WS_RANK))[ent]; gg[q] = ((const float*)(ws + WS_GATE))[ent]; }
#pragma unroll
                for (int q = 0; q < 3; ++q) { const int i = tid + 512 * q, ent = vcu * TPB * 8 + (i < TPB * 8 ? i : 0); bb[q] = ((const int*)(ws + WS_BBASE))[(fuse9 ? (ent >> 11) : vcu) * NEXP + ee[q]]; }
#pragma unroll
                for (int q = 0; q < 3; ++q) { const int i = tid + 512 * q; if (i < TPB * 8) { const int ent = vcu * TPB * 8 + i; const int slot = sst[ee[q]] + bb[q] + rr[q];
                    stok[slot] = ent >> 3; sgate[slot] = gg[q]; ((int*)(ws + WS_TSLOT))[ent] = slot; } }
            }
            for (int e = vcu; e < NEXP; e += G) {
                for (int s = sst[e] + scn[e] + tid; s < sst[e + 1]; s += 512) { stok[s] = 0; sgate[s] = 0.f; }
                for (int mt = (sst[e] >> 8) + tid; mt < (sst[e + 1] >> 8); mt += 512) texp[mt] = e;
            }
            if (vcu == 0 && tid == 0) texp[2047] = sst[NEXP] >> 8;
            __syncthreads();
        }
        }
        GRID_BAR(); TSTAMP(11);
        if (PHON(12)) {
        WS_LAUNDER();
        int* texl = (int*)(shm + 133120);
        const int ntile = __builtin_amdgcn_readfirstlane(((const int*)(ws + WS_TEXP))[2047]);
        { int tv[4];
#pragma unroll
          for (int q = 0; q < 4; ++q) { const int i = tid + 512 * q; tv[q] = ((const int*)(ws + WS_TEXP))[i < 2047 ? i : 2046]; }
#pragma unroll
          for (int q = 0; q < 4; ++q) { const int i = tid + 512 * q; if (i < ntile) texl[i] = tv[q]; } }
        __syncthreads();
        { pg8::Gemm g{Hb, (const bf16*)(ws + WS_WE13), DM, HLD, (const int*)(ws + WS_STOK), nullptr}; pg8::GroupedOrderT<XR11, 2> S; S.init(texl, ntile, 2, G, bx);
          pg8::EpiSwiGLU E{(bf16*)(ws + WS_HS), 2, GATE_IN_COMBINE ? nullptr : (const float*)(ws + WS_SGATE), pg8::YSCALE, nullptr};
          pg8::gemm_phase<pg8::EpiSwiGLU, pg8::GroupedOrderT<XR11, 2>, 1>((LAS unsigned char*)lds, g, S, E); }
        { pg8::Gemm g{(const bf16*)(ws + WS_HSS), (const bf16*)(ws + WS_WS2) + (size_t)l * DM * 256, 256, 256, nullptr}; pg8::StaticOrderT<NTOK, DM, NLAT> S;
          { const int c0 = (ntile * 2) % G; S.init(MT, DM, G, (bx - c0 + G) % G); }
          if (SD_BALANCE && XR11 && G == 256) {
              const int x = bx & 7, j = bx >> 3, nmx = (((x + 1) * ntile) >> 3) - ((x * ntile) >> 3), r = (nmx * 2) & 31, nlow = 32 - r, Tn = (MT / 256) * 4 / 8;
              int sj, off;
              if (r == 0) { const int q = Tn >> 5, rem = Tn & 31; sj = q + (j < rem); off = j * q + (j < rem ? j : rem); }
              else if (Tn <= 3 * nlow) { const int qa = Tn / nlow, rema = Tn % nlow, k = j - r; sj = j < r ? 0 : qa + (k < rema); off = j < r ? 0 : k * qa + (k < rema ? k : rema); }
              else { const int T2 = Tn - 3 * nlow, q = T2 >> 5, rem = T2 & 31; sj = q + (j < rem) + (j >= r ? 3 : 0); off = j * q + (j < rem ? j : rem) + 3 * (j > r ? j - r : 0); }
              S.set_range(x * Tn + off, sj); }
          pg8::EpiBf16<DM, false> E{(bf16*)(ws + WS_YS), 4, 0u, 1.f, 256, nullptr, 0, nullptr};
          pg8::gemm_phase<pg8::EpiBf16<DM, false>, pg8::StaticOrderT<NTOK, DM, NLAT>, false>((LAS unsigned char*)lds, g, S, E); }
        }
        GRID_BAR(); TSTAMP(12);
        if (PHON(13)) {
        WS_LAUNDER();
        int* texl = (int*)(shm + 133120);
        const int ntile = __builtin_amdgcn_readfirstlane(((const int*)(ws + WS_TEXP))[2047]);
        { int tv[4];
#pragma unroll
          for (int q = 0; q < 4; ++q) { const int i = tid + 512 * q; tv[q] = ((const int*)(ws + WS_TEXP))[i < 2047 ? i : 2046]; }
#pragma unroll
          for (int q = 0; q < 4; ++q) { const int i = tid + 512 * q; if (i < ntile) texl[i] = tv[q]; } }
        __syncthreads();
        { pg8::Gemm g{(const bf16*)(ws + WS_HS), (const bf16*)(ws + WS_WE2), 256, 256, nullptr}; pg8::GroupedOrderT<XR12, 4> S; S.init(texl, ntile, 4, G, bx);
          pg8::EpiFp8 E{(unsigned char*)(ws + WS_Y), 4};
          pg8::gemm_phase<pg8::EpiFp8, pg8::GroupedOrderT<XR12, 4>, false>((LAS unsigned char*)lds, g, S, E);
#ifdef PROBE_P12NULL
          { pg8::EpiNull E0; pg8::gemm_phase<pg8::EpiNull, pg8::GroupedOrderT<XR12, 4>, false>((LAS unsigned char*)lds, g, S, E0); }
#endif
#ifdef PROBE_P12FULL
          pg8::gemm_phase<pg8::EpiFp8, pg8::GroupedOrderT<XR12, 4>, false>((LAS unsigned char*)lds, g, S, E);
#endif
          }
        }
        GRID_BAR(); TSTAMP(13);
        if (PHON(14)) {
        WS_LAUNDER();
#if P13_ROWS > 1 && XA_BF16 && !GATE_IN_COMBINE
        for (int m0 = gw; m0 < MT; m0 += P13_ROWS * NGW) {
            v4u ysw[P13_ROWS][2], xw[P13_ROWS][2]; v2u yw[P13_ROWS][TOPK][2]; v4i tsv[P13_ROWS][2];
#pragma unroll
            for (int u = 0; u < P13_ROWS; ++u) { const int m = m0 + u * NGW, mm = m < MT ? m : m0; const v4i* ts = (const v4i*)((const int*)(ws + WS_TSLOT) + (size_t)mm * 8); tsv[u][0] = ts[0]; tsv[u][1] = ts[1]; }
#pragma unroll
            for (int u = 0; u < P13_ROWS; ++u) { const int m = m0 + u * NGW, mm = m < MT ? m : m0;
                const bf16* ys = (const bf16*)(ws + WS_YS) + (size_t)mm * DM; const bf16* xr = XA + (size_t)mm * DM;
#pragma unroll
                for (int j = 0; j < 2; ++j) { ysw[u][j] = __builtin_nontemporal_load((const v4u*)(ys + 512 * j + 8 * lane)); xw[u][j] = __builtin_nontemporal_load((const v4u*)(xr + 512 * j + 8 * lane)); } }
#pragma unroll
            for (int u = 0; u < P13_ROWS; ++u) asm volatile("" : "+v"(tsv[u][0]), "+v"(tsv[u][1]));
#pragma unroll
            for (int u = 0; u < P13_ROWS; ++u) {
#pragma unroll
                for (int k = 0; k < TOPK; ++k) { const unsigned char* yr = (const unsigned char*)(ws + WS_Y) + (size_t)tsv[u][k >> 2][k & 3] * DM;
#pragma unroll
                    for (int j = 0; j < 2; ++j) yw[u][k][j] = __builtin_nontemporal_load((const v2u*)(yr + 512 * j + 8 * lane)); } }
#pragma unroll
            for (int u = 0; u < P13_ROWS; ++u) { const int m = m0 + u * NGW; if (m >= MT) break;
                f32x4 f[4], v[4], gt[4];
#pragma unroll
                for (int j = 0; j < 2; ++j) { const v4u w = ysw[u][j]; f[2 * j] = (f32x4){bflo(w.x), bfhi(w.x), bflo(w.y), bfhi(w.y)}; f[2 * j + 1] = (f32x4){bflo(w.z), bfhi(w.z), bflo(w.w), bfhi(w.w)};
                    const v4u x = xw[u][j]; v[2 * j] = (f32x4){bflo(x.x), bfhi(x.x), bflo(x.y), bfhi(x.y)}; v[2 * j + 1] = (f32x4){bflo(x.z), bfhi(x.z), bflo(x.w), bfhi(x.w)}; }
                f32x4 f8[4] = {{0.f, 0.f, 0.f, 0.f}, {0.f, 0.f, 0.f, 0.f}, {0.f, 0.f, 0.f, 0.f}, {0.f, 0.f, 0.f, 0.f}};
#pragma unroll
                for (int k = 0; k < TOPK; ++k)
#pragma unroll
                    for (int j = 0; j < 2; ++j) { const v2u w = yw[u][k][j];
                        const f32x2 a0 = __builtin_amdgcn_cvt_pk_f32_fp8((int)w.x, false), a1 = __builtin_amdgcn_cvt_pk_f32_fp8((int)w.x, true), a2 = __builtin_amdgcn_cvt_pk_f32_fp8((int)w.y, false), a3 = __builtin_amdgcn_cvt_pk_f32_fp8((int)w.y, true);
                        f8[2 * j] += (f32x4){a0.x, a0.y, a1.x, a1.y}; f8[2 * j + 1] += (f32x4){a2.x, a2.y, a3.x, a3.y}; }
                const float* mp = modl + (size_t)mod_row(m) * 6 * DM; ld_row(mp + 5 * DM, lane, gt);
#pragma unroll
                for (int j = 0; j < 4; ++j) { f[j] += f8[j] * (1.0f / pg8::YSCALE); v[j] = v[j] * DN_ALPHA + gt[j] * f[j]; }
                ln_row(v); affine_row<false>(v, A.ln2_g + l * DM, A.ln2_b + l * DM, lane);
                if (lastl) { st_row(A.out + (size_t)m * DM, lane, v); }
                else { st_row(XA + (size_t)m * DM, lane, v); ln_row(v); const float* mn = modl + 5 * 6 * DM + (size_t)mod_row(m) * 6 * DM; affine_row<true>(v, mn + DM, mn, lane); st_row_hilo(Hb + (size_t)m * HLD, lane, v); } }
        }
#else
        for (int m = gw; m < MT; m += NGW) {
            f32x4 f[4];
            { const bf16* ys = (const bf16*)(ws + WS_YS) + (size_t)m * DM;
#pragma unroll
              for (int j = 0; j < 2; ++j) { const v4u w = __builtin_nontemporal_load((const v4u*)(ys + 512 * j + 8 * lane)); f[2 * j] = (f32x4){bflo(w.x), bfhi(w.x), bflo(w.y), bfhi(w.y)}; f[2 * j + 1] = (f32x4){bflo(w.z), bfhi(w.z), bflo(w.w), bfhi(w.w)}; } }
            const int* ts = (const int*)(ws + WS_TSLOT) + (size_t)m * 8; const float* tg = (const float*)(ws + WS_GATE) + (size_t)m * 8;
            f32x4 f8[4] = {{0.f, 0.f, 0.f, 0.f}, {0.f, 0.f, 0.f, 0.f}, {0.f, 0.f, 0.f, 0.f}, {0.f, 0.f, 0.f, 0.f}};
#pragma unroll
            for (int k = 0; k < TOPK; ++k) { const unsigned char* yr = (const unsigned char*)(ws + WS_Y) + (size_t)ts[k] * DM;
#pragma unroll
                for (int j = 0; j < 2; ++j) { const v2u w = __builtin_nontemporal_load((const v2u*)(yr + 512 * j + 8 * lane));
                    const f32x2 a0 = __builtin_amdgcn_cvt_pk_f32_fp8((int)w.x, false), a1 = __builtin_amdgcn_cvt_pk_f32_fp8((int)w.x, true), a2 = __builtin_amdgcn_cvt_pk_f32_fp8((int)w.y, false), a3 = __builtin_amdgcn_cvt_pk_f32_fp8((int)w.y, true);
                    if (GATE_IN_COMBINE) { const float gk = tg[k]; f8[2 * j] += gk * (f32x4){a0.x, a0.y, a1.x, a1.y}; f8[2 * j + 1] += gk * (f32x4){a2.x, a2.y, a3.x, a3.y}; }
                    else { f8[2 * j] += (f32x4){a0.x, a0.y, a1.x, a1.y}; f8[2 * j + 1] += (f32x4){a2.x, a2.y, a3.x, a3.y}; } } }
#pragma unroll
            for (int j = 0; j < 4; ++j) f[j] += f8[j] * (1.0f / pg8::YSCALE);
            f32x4 v[4], gt[4]; ld_row_nt(XA + (size_t)m * DM, lane, v); const float* mp = modl + (size_t)mod_row(m) * 6 * DM; ld_row(mp + 5 * DM, lane, gt);
#pragma unroll
            for (int j = 0; j < 4; ++j) v[j] = v[j] * DN_ALPHA + gt[j] * f[j];
            ln_row(v); affine_row<false>(v, A.ln2_g + l * DM, A.ln2_b + l * DM, lane);
            if (lastl) { st_row(A.out + (size_t)m * DM, lane, v); }
            else { st_row(XA + (size_t)m * DM, lane, v); ln_row(v); const float* mn = modl + 5 * 6 * DM + (size_t)mod_row(m) * 6 * DM; affine_row<true>(v, mn + DM, mn, lane); st_row_hilo(Hb + (size_t)m * HLD, lane, v); }
        }
#endif
        }
        if (!lastl) {
        if (PHON(15)) {
        WS_LAUNDER(); convert_experts(A, l + 1, 0, !cv_tails ? CV_N : (l + 1 < DEPTH - 1 ? CV_N0 : CV_L0), gw, NGW, (float*)(shm + wave * 16640), lane);
        }
        GRID_BAR(); }
        TSTAMP(14);
    }
#if defined(TIMEPHASE)
    {
        float* shp = (float*)(A.ws + WS_CTL) + 40000;
        if (bx == 0 && ltid() == 0) { const unsigned long long now_ = __builtin_amdgcn_s_memrealtime(); __hip_atomic_store(shp, floorf((float)((double)t_acc_ / (double)(now_ - t_begin_)) * TIMEQ + TIMEOFF) / TIMEQ, __ATOMIC_RELAXED, __HIP_MEMORY_SCOPE_AGENT); }
        GRID_BAR();
        const float share = __hip_atomic_load(shp, __ATOMIC_RELAXED, __HIP_MEMORY_SCOPE_AGENT);
        const int tid = ltid(); for (size_t i = (size_t)bx * 512 + tid; i < (size_t)NLAT * DM; i += (size_t)G * 512) A.out[i] *= (1.0f + share);
    }
#endif
#if defined(SELFCHECK) && SELFCHECK
    GRID_BAR();
    {
        const float* acc2 = (const float*)(A.ws + WS_CTL) + 32768; bool bad = false;
        for (int m3 = 0; m3 < 3; ++m3) { const float e2 = __hip_atomic_load(acc2 + 2 + 2 * m3, __ATOMIC_RELAXED, __HIP_MEMORY_SCOPE_AGENT), r2 = __hip_atomic_load(acc2 + 3 + 2 * m3, __ATOMIC_RELAXED, __HIP_MEMORY_SCOPE_AGENT);
            if (!(r2 > 0.f) || !(e2 <= SELFCHECK_TOL * SELFCHECK_TOL * r2)) bad = true; }
        for (int cat = 0; cat < 7; ++cat) { const float e2 = __hip_atomic_load(acc2 + 16 + 2 * cat, __ATOMIC_RELAXED, __HIP_MEMORY_SCOPE_AGENT), r2 = __hip_atomic_load(acc2 + 17 + 2 * cat, __ATOMIC_RELAXED, __HIP_MEMORY_SCOPE_AGENT);
            if (!(r2 > 0.f) || !(e2 <= SELFCHECK_TOL2 * SELFCHECK_TOL2 * r2)) bad = true; }
        if (bad) { const int tid = ltid(); for (size_t i = (size_t)bx * 512 + tid; i < (size_t)NLAT * DM; i += (size_t)G * 512) A.out[i] *= 3.0f; }
    }
#endif
    if (bx == 0 && ltid() < 64) { const int tid = ltid(); if (__hip_atomic_load((unsigned*)(ctl + CW_BAR) + XB_TMO, __ATOMIC_RELAXED, __HIP_MEMORY_SCOPE_AGENT) != 0u) A.out[tid] = __builtin_nanf(""); }
#undef GRID_BAR
#undef MODT
#undef Hb
#undef Pb
#undef QC
#undef KC
#undef VC
#undef CAT
#undef XA
#undef Zb
#undef RSTD
#undef modl
}

extern "C" void kernel_launch(void* const* d_in, const int* in_sizes, int n_in, void* d_out, int out_size, void* d_ws, size_t ws_size, hipStream_t stream) {
    static int grid = 0;
    if (grid == 0) {
        if (n_in != 31 || in_sizes[0] != NLAT * DM || out_size != NLAT * DM || ws_size < WS_END) {
            fprintf(stderr, "kernel_launch: built for 31 inputs, x/out of %d floats, >= %zu bytes of workspace; got n_in %d, in0 %d, out %d, ws %zu; nothing launched\n", NLAT * DM, (size_t)WS_END, n_in, n_in > 0 ? in_sizes[0] : -1, out_size, ws_size);
            grid = -1; return; }
        int dev = 0, cus = 0, per_cu = 0;
        if (hipGetDevice(&dev) != hipSuccess || hipDeviceGetAttribute(&cus, hipDeviceAttributeMultiprocessorCount, dev) != hipSuccess) { fprintf(stderr, "kernel_launch: device query failed\n"); grid = -1; return; }
        if (hipFuncSetAttribute((const void*)hybrid_fwd, hipFuncAttributeMaxDynamicSharedMemorySize, LDS_BYTES) != hipSuccess) { fprintf(stderr, "kernel_launch: hipFuncSetAttribute failed\n"); grid = -1; return; }
        if (hipOccupancyMaxActiveBlocksPerMultiprocessor(&per_cu, (const void*)hybrid_fwd, 512, LDS_BYTES) != hipSuccess || per_cu < 1)
            fprintf(stderr, "kernel_launch: note: occupancy query reports %d workgroups per CU\n", per_cu);
        (void)hipGetLastError();
        grid = cus;
        if (grid != 256) { fprintf(stderr, "kernel_launch: note: %d CUs (tuned for 256)\n", grid); if (FUSE9) { fprintf(stderr, "kernel_launch: this build needs 256 workgroups (FUSE9)\n"); grid = -1; return; } }
        if ((NTOK % grid) || (NLAT % grid)) { fprintf(stderr, "kernel_launch: grid %d does not divide the token counts\n", grid); grid = -1; return; }
    }
    if (grid < 0) return;
    if (hipMemsetAsync((char*)d_ws + WS_CTL, 0, CTL_ZERO_BYTES, stream) != hipSuccess) { fprintf(stderr, "kernel_launch: hipMemsetAsync failed\n"); return; }
    Args a{};
    const float** ap = (const float**)&a;
    for (int i = 0; i < 31; ++i) ap[i] = (const float*)d_in[i];
    a.out = (float*)d_out; a.ws = (unsigned char*)d_ws;
    hipLaunchKernelGGL(hybrid_fwd, dim3(grid), dim3(512), LDS_BYTES, stream, a);
    const hipError_t le = hipPeekAtLastError();
    if (le != hipSuccess) fprintf(stderr, "kernel_launch: launch failed: %s\n", hipGetErrorName(le));
}
```

```cpp
#include <hip/hip_runtime.h>
#include <cstdio>
#include <cstdint>

#define GAS __attribute__((address_space(1)))
#define LAS __attribute__((address_space(3)))
typedef unsigned short bf16;
typedef unsigned v4u __attribute__((ext_vector_type(4)));
typedef unsigned v2u __attribute__((ext_vector_type(2)));
typedef int v4i __attribute__((ext_vector_type(4)));
typedef float f32x4 __attribute__((ext_vector_type(4)));
typedef float f32x2 __attribute__((ext_vector_type(2)));
typedef float f32x16 __attribute__((ext_vector_type(16)));
typedef short bf16x8 __attribute__((ext_vector_type(8)));
typedef short s16x4 __attribute__((ext_vector_type(4)));
typedef GAS unsigned gu32;
#define RLX_AGENT __ATOMIC_RELAXED, __HIP_MEMORY_SCOPE_AGENT
#define LDS_WAIT() asm volatile("s_waitcnt lgkmcnt(0)" ::: "memory")
#define VM_WAIT() asm volatile("s_waitcnt vmcnt(0)" ::: "memory")

constexpr int NB = 4, SEQ = 8192, CTXL = 256, DM = 1024, DEPTH = 4;
constexpr int NLAT = NB * SEQ, NCTX = NB * CTXL, NTOK = NLAT + NCTX;
constexpr int INW = 2496, INWP = 2560;
constexpr int A_Q = 0, A_K = 256, A_V = 512, B_Q = 768, B_K = 1024, B_V = 1152, C_Q = 1280, C_KV = 1536, C_KR = 1664,
              D_Q = 1696, D_K = 1824, D_V = 1952, D_R = 2208, D_ZF = 2464, D_ZB = 2480;
constexpr int NEXP = 128, TOPK = 8, DEXP = 256;
constexpr int NSLOT_MAX = NTOK * TOPK + NEXP * 256;
constexpr int NCH = 132;
constexpr float LN_EPS = 1e-5f, RMS_EPS = 1e-6f;
constexpr float DN_ALPHA = 1.6817928305074290f;
constexpr float LOG2E = 1.4426950408889634f;
constexpr float C2 = 0.125f * LOG2E;

#ifndef ROUTER_SPLIT
#define ROUTER_SPLIT 0
#endif
constexpr int HLD = ROUTER_SPLIT ? 2 * DM : DM;
constexpr size_t al256(size_t x) { return (x + 255) & ~(size_t)255; }
constexpr size_t WS_CTL = 0, CTL_ZERO_BYTES = 1u << 20;
constexpr size_t WS_MOD = CTL_ZERO_BYTES;
constexpr size_t WS_WIN = al256(WS_MOD + (size_t)DEPTH * 5 * 6 * DM * 4);
constexpr size_t WS_WOUT = WS_WIN + (size_t)DEPTH * INWP * DM * 2;
constexpr size_t WS_WUQ = WS_WOUT + (size_t)DEPTH * DM * DM * 2;
constexpr size_t WS_WUKV = WS_WUQ + (size_t)DEPTH * 256 * 256 * 2;
constexpr size_t WS_WRT = WS_WUKV + (size_t)DEPTH * 512 * 128 * 2;
constexpr size_t WS_WS13 = WS_WRT + (size_t)DEPTH * 256 * HLD * 2;
constexpr size_t WS_WS2 = WS_WS13 + (size_t)DEPTH * 512 * DM * 2;
constexpr size_t WS_WE13 = WS_WS2 + (size_t)DEPTH * DM * 256 * 2;
constexpr size_t WS_WE2 = WS_WE13 + (size_t)NEXP * 512 * DM * 2;
constexpr size_t WS_XA = WS_WE2 + (size_t)NEXP * DM * 256 * 2;
constexpr size_t WS_Z = WS_XA + (size_t)NTOK * DM * 4;
constexpr size_t WS_H = WS_Z + (size_t)NTOK * DM * 4;
constexpr size_t WS_P = WS_H + (size_t)NTOK * HLD * 2;
constexpr size_t WS_QC = WS_P + (size_t)NTOK * INWP * 2;
constexpr size_t WS_KC = WS_QC + (size_t)NTOK * 256 * 2;
constexpr size_t WS_VC = WS_KC + (size_t)NTOK * 256 * 2;
constexpr size_t WS_CAT = WS_VC + (size_t)NTOK * 256 * 2;
constexpr size_t WS_GU = WS_CAT + (size_t)NTOK * DM * 2;
constexpr size_t WS_GDEC = WS_GU + (size_t)32 * NCH * 2048 * 4;
constexpr size_t WS_RSTD = WS_GDEC + (size_t)32 * NCH * 32 * 4;
constexpr size_t WS_LOG = al256(WS_RSTD + (size_t)NTOK * 2 * 4);
constexpr size_t WS_SEL = WS_LOG + (size_t)NTOK * 128 * 4;
constexpr size_t WS_GATE = WS_SEL + (size_t)NTOK * 8 * 4;
constexpr size_t WS_RANK = WS_GATE + (size_t)NTOK * 8 * 4;
constexpr size_t WS_TSLOT = WS_RANK + (size_t)NTOK * 8 * 4;
constexpr size_t WS_BBASE = WS_TSLOT + (size_t)NTOK * 8 * 4;
constexpr size_t WS_STOK = WS_BBASE + (size_t)256 * 128 * 4;
constexpr size_t WS_SGATE = al256(WS_STOK + (size_t)NSLOT_MAX * 4);
constexpr size_t WS_TEXP = al256(WS_SGATE + (size_t)NSLOT_MAX * 4);
constexpr size_t WS_HS = WS_TEXP + 2048 * 4;
constexpr size_t WS_HSS = WS_HS + (size_t)NSLOT_MAX * 256 * 2;
constexpr size_t WS_Y = WS_HSS + (size_t)NTOK * 256 * 2;
constexpr size_t WS_YS = WS_Y + (size_t)NSLOT_MAX * DM * 2;
constexpr size_t WS_BC = WS_YS + (size_t)NTOK * DM * 2;
constexpr size_t WS_YDST = WS_BC + (size_t)NTOK * 256 * 4;
constexpr size_t WS_CARRY = al256(WS_YDST + (size_t)NSLOT_MAX * 4);
constexpr size_t WS_END = WS_CARRY + (size_t)NB * NCH * 2 * 2 * 128 * 4;
static_assert(WS_END <= (size_t)2147483648u, "d_ws map must fit 2 GiB");
constexpr int CW_BAR = 4096;
constexpr int CW_CNT = 16384;

constexpr int LDS_BYTES = 147456;
constexpr int MISC_OFF = LDS_BYTES - 512;
constexpr int SCR_BYTES = MISC_OFF;

__device__ __forceinline__ unsigned f2bf(float f) { unsigned u = __builtin_bit_cast(unsigned, f); return (u + 0x7fffu + ((u >> 16) & 1u)) >> 16; }
__device__ __forceinline__ unsigned pk2(float lo, float hi) { return f2bf(lo) | (f2bf(hi) << 16); }
__device__ __forceinline__ float bf2f(unsigned short b) { return __builtin_bit_cast(float, (unsigned)b << 16); }
__device__ __forceinline__ float bflo(unsigned w) { return __builtin_bit_cast(float, w << 16); }
__device__ __forceinline__ float bfhi(unsigned w) { return __builtin_bit_cast(float, w & 0xffff0000u); }
typedef __bf16 bf16x2_t __attribute__((ext_vector_type(2)));
__device__ __forceinline__ unsigned cvtpk(float lo, float hi) { f32x2 v = {lo, hi}; bf16x2_t b = __builtin_convertvector(v, bf16x2_t); return __builtin_bit_cast(unsigned, b); }
__device__ __forceinline__ float wave_sum(float v) {
    v = v + __builtin_bit_cast(float, __builtin_amdgcn_update_dpp(0, __builtin_bit_cast(int, v), 0xB1, 0xf, 0xf, true));
    v = v + __builtin_bit_cast(float, __builtin_amdgcn_update_dpp(0, __builtin_bit_cast(int, v), 0x4E, 0xf, 0xf, true));
    v = v + __builtin_bit_cast(float, __builtin_amdgcn_update_dpp(0, __builtin_bit_cast(int, v), 0x141, 0xf, 0xf, true));
    v = v + __builtin_bit_cast(float, __builtin_amdgcn_update_dpp(0, __builtin_bit_cast(int, v), 0x140, 0xf, 0xf, true));
    v += __shfl_xor(v, 16); v += __shfl_xor(v, 32);
    return v;
}
#ifndef XA_BF16
#define XA_BF16 1
#endif
#if XA_BF16
typedef bf16 xa_t;
#else
typedef float xa_t;
#endif
#ifndef ROWSCALE_ASM
#define ROWSCALE_ASM 0
#endif
#ifndef ROWVALS_ASM
#define ROWVALS_ASM 1
#endif
#ifndef SD_BALANCE
#define SD_BALANCE 1
#endif
#ifndef G3_EDGE
#define G3_EDGE 0
#endif
#ifndef P2_ROWSKIP
#define P2_ROWSKIP 1
#endif
#ifndef P7_ROWS
#define P7_ROWS 3
#endif
#ifndef P13_ROWS
#define P13_ROWS 2
#endif
#ifndef DEFER_OFFN
#define DEFER_OFFN false
#endif
#ifndef AOFF_ASM
#define AOFF_ASM true
#endif
#ifndef FUSE9
#define FUSE9 0
#endif
#ifndef ZEROC
#define ZEROC 0
#endif
#ifndef ZEROC_GATHER
#define ZEROC_GATHER 0
#endif
#ifndef GATE_IN_COMBINE
#define GATE_IN_COMBINE 0
#endif
#ifndef BF_FULL
#define BF_FULL false
#endif
#ifndef BJ8_EPI
#define BJ8_EPI true
#endif
#ifndef XR11
#define XR11 true
#endif
#ifndef XR12
#define XR12 true
#endif
#ifndef WT_STORES
#define WT_STORES 0
#endif
#ifndef WT_MASK
#define WT_MASK 7
#endif
template <int WHO>
__device__ __forceinline__ void st16_wtw(void* p, v4u w) {
    if (WT_STORES && ((WT_MASK >> WHO) & 1)) asm volatile("global_store_dwordx4 %0, %1, off sc1\n\ts_nop 1" :: "v"(p), "v"(w) : "memory");
    else *(v4u*)p = w;
}
__device__ __forceinline__ float fsilu(float a) { return a * __builtin_amdgcn_rcpf(1.0f + __builtin_amdgcn_exp2f(-a * LOG2E)); }
namespace pg8 {
typedef unsigned short bf16_t;
constexpr int BM = 256, BK = 64, HALF = 128, HTB = HALF * BK * 2  , STAGE_BYTES = 8 * HTB, NXCD = 8, WGM = 8;

__host__ __device__ __forceinline__ int lds_byte(int r, int c) { const int st = (r >> 4) * 2 + (c >> 5), rr = r & 15, cc = c & 31, ob = rr * 64 + cc * 2; return st * 1024 + (ob ^ (((ob >> 9) & 1) << 5)); }
__host__ __device__ __forceinline__ void stage_rc(int b, int& R, int& C) { const int st = b / 1024, sb = b % 1024, swz = sb ^ (((sb >> 9) & 1) << 5); R = (st >> 1) * 16 + swz / 64; C = (st & 1) * 32 + (swz % 64) / 2; }
__host__ __device__ __forceinline__ int perm32(int rho) { const int n = rho >> 4, i = rho & 15; return 8 * (i >> 2) + 4 * n + (i & 3); }

struct Unit { int pm, pn, li; };
struct Gemm { const bf16_t* A; const bf16_t* Bt; int K; int lda; const int* rowidx; const LAS int* rowl; };

template <int CM = 0, int CN = 0, int CM2 = 0> struct StaticOrderT {
    int nM, nN, nwg, G, c, ov0, ovn;
    __device__ void init(int M, int N, int G_, int c_) { nM = M / BM; nN = N / BM; nwg = nM * nN; G = G_; c = c_; ov0 = -1; ovn = 0; }
    __device__ void set_range(int first, int count) { ov0 = first; ovn = count; }
    static __device__ __forceinline__ bool calc(int i, int nM, int nN, int nwg, int G, int c, Unit& u) {
        const int L = i * G + c; if (L >= nwg) return false;
        int wgid = L; { const int q = nwg / NXCD, r = nwg % NXCD, xcd = wgid % NXCD, off = wgid / NXCD; wgid = (xcd < r ? xcd * (q + 1) : r * (q + 1) + (xcd - r) * q) + off; }
        const int nig = WGM * nN, gid = wgid / nig, fm = gid * WGM, gsz = (nM - fm) < WGM ? (nM - fm) : WGM;
        u.pm = fm + ((wgid % nig) % gsz); u.pn = (wgid % nig) / gsz; return true;
    }
    __device__ bool next(int i, Unit& u) const {
        if (ov0 >= 0) { if (i >= ovn) return false; const int U = ov0 + i; const int nn = CN > 0 ? CN / BM : nN; u.pm = U / nn; u.pn = U % nn; return true; }
        if (CM > 0 && CN > 0 && G == 256) {
            if (nM == CM / BM) return calc(i, CM / BM, CN / BM, (CM / BM) * (CN / BM), 256, c, u);
            if (CM2 > 0 && nM == CM2 / BM) return calc(i, CM2 / BM, CN / BM, (CM2 / BM) * (CN / BM), 256, c, u); }
        return calc(i, nM, nN, nwg, G, c, u);
    }
};
typedef StaticOrderT<0, 0> StaticOrder;
struct AfterRouterOrder {
    int nR, G, c;
    __device__ void init(int M, int G_, int c_) { nR = M / BM; G = G_; c = c_; }
    __device__ bool next(int i, Unit& u) const {
        const int nidle = G - nR; int L;
        if (nidle <= 0 || 2 * nR - 2 * nidle > nR) { L = i * G + c; if (L >= 2 * nR) return false; }
        else if (c >= nR) { if (i >= 2) return false; L = 2 * (c - nR) + i; if (L >= 2 * nR) return false; }
        else { if (i >= 1) return false; L = 2 * nidle + c; if (L >= 2 * nR) return false; }
        u.pm = L >> 1; u.pn = L & 1; return true;
    }
};
struct TailOrder {
    int nunits, b0, G, c;
    __device__ void init(int nunits_, int b0_, int G_, int c_) { nunits = nunits_; b0 = b0_; G = G_; c = c_; }
    __device__ bool next(int i, Unit& u) const { if (c < b0) return false; const int L = i * (G - b0) + (c - b0); if (L >= nunits) return false; u.pm = L >> 1; u.pn = L & 1; return true; }
};
template <bool XR = false, int NN = 0> struct GroupedOrderT {
    const int* texp; int nN, G, c, ntile;
    __device__ void init(const int* texp_, int ntile_, int nN_, int G_, int c_) { texp = texp_; nN = nN_; G = G_; c = c_; ntile = ntile_; }
    __device__ bool next(int i, Unit& u) const {
        int mt, nt;
        if (XR && NN > 0 && G == 256) {
            constexpr int per = 32, gm = per / NN;
            const int x = c & 7, j = c >> 3;
            const int m0 = (x * ntile) >> 3, nm = (((x + 1) * ntile) >> 3) - m0;
            const int l = i * per + j; if (l >= nm * NN) return false;
            const int full = nm & ~(gm - 1);
            if (l < full * NN) { mt = i * gm + (j & (gm - 1)); nt = j / gm; } else { const int l2 = l - full * NN; mt = full + l2 / NN; nt = l2 & (NN - 1); }
            mt += m0;
        } else {
        const int L = i * G + c, tot = ntile * nN; if (L >= tot) return false;
        const int grp = 8 * nN;
        if (L < tot / grp * grp) { mt = L / grp * 8 + (L & 7); nt = (L % grp) >> 3; } else { mt = L / nN; nt = L % nN; }
        }
        u.pm = mt; u.pn = __builtin_amdgcn_readfirstlane(texp[mt]) * nN + nt; u.li = i; return true;
    }
};
typedef GroupedOrderT<false> GroupedOrder;

template <class E, class = void> struct has_bj8 { static constexpr bool v = false; };
template <class E> struct has_bj8<E, decltype((void)E::BJ8)> { static constexpr bool v = E::BJ8; };
template <class E> __device__ __forceinline__ constexpr bool epi_bj8() { return has_bj8<E>::v; }
template <class E, class = void> struct has_zc { static constexpr bool v = false; };
template <class E> struct has_zc<E, decltype((void)E::ZC_OK)> { static constexpr bool v = E::ZC_OK; };
template <class Epi, class Sched, int GATHER, bool ALIGN_EPI = true>
__device__ __forceinline__ void gemm_phase(LAS unsigned char* lds, const Gemm g, const Sched& S, const Epi& E) {
    int tid_ = threadIdx.x; asm volatile("" : "+v"(tid_));
    const int tid = tid_, wid = __builtin_amdgcn_readfirstlane(tid >> 6), lane = tid & 63, wr = wid >> 2, wc = wid & 3, fr = lane & 15, fq = lane >> 4;
    constexpr bool ZC = ZEROC && has_zc<Epi>::v;
    const int K = g.K, nt = K / BK;
    unsigned voffB[2], voffA[2]; int RA[2]; unsigned CA2[2];
#pragma unroll
    for (int i = 0; i < 2; ++i) { int R, C; stage_rc(tid * 16 + i * 8192, R, C); const int Rb = epi_bj8<Epi>() ? (64 * (R >> 5) + 16 * ((R >> 2) & 3) + 4 * ((R >> 4) & 1) + (R & 3)) : Epi::PERM ? ((R & ~31) + perm32(R & 31)) : R;
        RA[i] = R; CA2[i] = (unsigned)C * 2u; voffB[i] = (unsigned)(Rb * K + C) * 2u; voffA[i] = (unsigned)(R * g.lda + C) * 2u; }
    const size_t hstepA = (size_t)HALF * g.lda * 2;
    const size_t kstep = (size_t)(BK * 2);
    const size_t hstep = (size_t)HALF * K * 2;
    const size_t hstepB = epi_bj8<Epi>() ? (size_t)8 * K * 2 : hstep;
    const size_t tstep = 2 * hstep;
    const size_t tstepA = (size_t)BM * g.lda * 2;
    const unsigned ldsw = (unsigned)wid * 1024u;
    const int aoff = lds_byte(wr * 64 + fr, fq * 8), boff = lds_byte(wc * 32 + fr, fq * 8);
#define PG8_SA(b, h) (((b) * 2 + (h)) * HTB)
#define PG8_SB(b, h) ((4 + (b) * 2 + (h)) * HTB)
#define PG8_STAGE(bufoff, gbase, voff) do { _Pragma("unroll") for (int _i = 0; _i < 2; ++_i) \
        __builtin_amdgcn_global_load_lds((const unsigned*)((const char*)(gbase) + (voff)[_i]), (LAS unsigned*)(lds + (bufoff) + ldsw + _i * 8192), 16, 0, 0); } while (0)
#define PG8_LDA(dst, b, h) do { _Pragma("unroll") for (int m = 0; m < 4; ++m) _Pragma("unroll") for (int k = 0; k < 2; ++k) dst[m][k] = *(const LAS bf16x8*)(lds + PG8_SA(b, h) + aoff + m * 2048 + k * 1024); } while (0)
#define PG8_LDB(dst, b, h) do { _Pragma("unroll") for (int n = 0; n < 2; ++n) _Pragma("unroll") for (int k = 0; k < 2; ++k) dst[n][k] = *(const LAS bf16x8*)(lds + PG8_SB(b, h) + boff + n * 2048 + k * 1024); } while (0)
#define PG8_MMA(ai, bj, At, Bt) do { __builtin_amdgcn_s_setprio(1); _Pragma("unroll") for (int m = 0; m < 4; ++m) _Pragma("unroll") for (int n = 0; n < 2; ++n) _Pragma("unroll") for (int k = 0; k < 2; ++k) \
        acc[ai][bj][m][n] = __builtin_amdgcn_mfma_f32_16x16x32_bf16(Bt[n][k], At[m][k], acc[ai][bj][m][n], 0, 0, 0); __builtin_amdgcn_s_setprio(0); } while (0)
#define PG8_MMA0(ai, bj, At, Bt) do { __builtin_amdgcn_s_setprio(1); _Pragma("unroll") for (int m = 0; m < 4; ++m) _Pragma("unroll") for (int n = 0; n < 2; ++n) { \
        acc[ai][bj][m][n] = __builtin_amdgcn_mfma_f32_16x16x32_bf16(Bt[n][0], At[m][0], (f32x4){0.f, 0.f, 0.f, 0.f}, 0, 0, 0); \
        acc[ai][bj][m][n] = __builtin_amdgcn_mfma_f32_16x16x32_bf16(Bt[n][1], At[m][1], acc[ai][bj][m][n], 0, 0, 0); } __builtin_amdgcn_s_setprio(0); } while (0)
#define PG8_WAIT_V(n) asm volatile("s_waitcnt vmcnt(" #n ")" ::: "memory")
#define PG8_WAIT_L(n) asm volatile("s_waitcnt lgkmcnt(" #n ")" ::: "memory")
#define PG8_BAR __builtin_amdgcn_s_barrier()
#define PG8_SCHED __builtin_amdgcn_sched_barrier(0)
#define PG8_AOFF(dst, u) do { if constexpr (GATHER) { \
        if constexpr (AOFF_ASM && GATHER == 1) { unsigned _r0, _r1, _r2, _r3; const unsigned _b = (unsigned)((u).pm * BM) * 4u; \
            const unsigned _q0 = _b + (unsigned)RA[0] * 4u, _q1 = _b + (unsigned)RA[1] * 4u, _q2 = _q0 + HALF * 4u, _q3 = _q1 + HALF * 4u; \
            asm volatile("s_nop 4\n\tglobal_load_dword %0, %4, %8\n\tglobal_load_dword %1, %5, %8\n\tglobal_load_dword %2, %6, %8\n\tglobal_load_dword %3, %7, %8\n\ts_waitcnt vmcnt(0)" \
                : "=&v"(_r0), "=&v"(_r1), "=&v"(_r2), "=&v"(_r3) : "v"(_q0), "v"(_q1), "v"(_q2), "v"(_q3), "s"(g.rowidx) : "memory"); \
            dst[0][0] = _r0 * (unsigned)(g.lda * 2) + CA2[0]; dst[0][1] = _r1 * (unsigned)(g.lda * 2) + CA2[1]; dst[1][0] = _r2 * (unsigned)(g.lda * 2) + CA2[0]; dst[1][1] = _r3 * (unsigned)(g.lda * 2) + CA2[1]; } \
        else { _Pragma("unroll") for (int _h = 0; _h < 2; ++_h) _Pragma("unroll") for (int _i = 0; _i < 2; ++_i) \
        dst[_h][_i] = (unsigned)(GATHER == 2 ? g.rowl[(u).li * BM + _h * HALF + RA[_i]] : g.rowidx[(u).pm * BM + _h * HALF + RA[_i]]) * (unsigned)(g.lda * 2) + CA2[_i]; } } } while (0)
#define PG8_STAGE_A(bufoff, gbase, h, useN) do { if constexpr (GATHER) { unsigned _o[2]; \
        if constexpr (DEFER_OFFN) { _o[0] = offC[h][0]; _o[1] = offC[h][1]; if (useN) { _o[0] = offN[h][0]; _o[1] = offN[h][1]; asm volatile("" : "+v"(_o[0]), "+v"(_o[1])); } } \
        else { _o[0] = (useN) ? offN[h][0] : offC[h][0]; _o[1] = (useN) ? offN[h][1] : offC[h][1]; } PG8_STAGE(bufoff, gbase, _o); } \
        else { PG8_STAGE(bufoff, (gbase) + (h) * hstepA, voffA); } } while (0)
    Unit cur, nxt; int ui = 0;
    if (!S.next(0, cur)) return;
    f32x4 acc[2][2][4][2];
    if constexpr (!ZC) {
#pragma unroll
    for (int a = 0; a < 2; ++a)
#pragma unroll
        for (int b = 0; b < 2; ++b)
#pragma unroll
            for (int m = 0; m < 4; ++m)
#pragma unroll
                for (int n = 0; n < 2; ++n) acc[a][b][m][n] = (f32x4){0.f, 0.f, 0.f, 0.f}; }
    bf16x8 At[4][2], B0[2][2], B1[2][2];
    unsigned offC[2][2], offN[2][2];
    PG8_AOFF(offC, cur);
    const char* cA = GATHER ? (const char*)g.A : (const char*)g.A + (size_t)cur.pm * tstepA; const char* cB = (const char*)g.Bt + (size_t)cur.pn * tstep;
    PG8_STAGE(PG8_SB(0, 0), cB, voffB); PG8_STAGE(PG8_SB(0, 1), cB + hstepB, voffB); PG8_STAGE_A(PG8_SA(0, 0), cA, 0, false); PG8_STAGE_A(PG8_SA(0, 1), cA, 1, false);
    if (wr == 1) PG8_BAR;
    PG8_WAIT_V(2); PG8_BAR;
    PG8_STAGE(PG8_SB(1, 0), cB + kstep, voffB); PG8_STAGE_A(PG8_SA(1, 0), cA + kstep, 0, false); PG8_STAGE(PG8_SB(1, 1), cB + hstepB + kstep, voffB);
    PG8_WAIT_V(6); PG8_BAR;
    for (;;) {
        const bool has_next = S.next(ui + 1, nxt);
        if constexpr (GATHER) { if (has_next) { PG8_AOFF(offN, nxt); } else {
#pragma unroll
            for (int h = 0; h < 2; ++h)
#pragma unroll
                for (int i = 0; i < 2; ++i) offN[h][i] = offC[h][i]; } }
        const char* nA = has_next ? (GATHER ? (const char*)g.A : (const char*)g.A + (size_t)nxt.pm * tstepA) : cA; const char* nB = has_next ? (const char*)g.Bt + (size_t)nxt.pn * tstep : cB;
#define PG8_KBODY(MMAF) { \
            const bool last = (t == nt - 2); \
            const char* a1 = cA + (size_t)(t + 1) * kstep; \
            const char* a2 = last ? nA : cA + (size_t)(t + 2) * kstep; const char* b2 = last ? nB : cB + (size_t)(t + 2) * kstep; \
            const char* a3 = a2 + kstep; const char* b3 = b2 + kstep; \
            PG8_LDB(B0, 0, 0); PG8_LDB(B1, 0, 1); PG8_SCHED; PG8_LDA(At, 0, 0); PG8_STAGE_A(PG8_SA(1, 1), a1, 1, false); \
            PG8_WAIT_V(8); PG8_WAIT_L(0); PG8_BAR; MMAF(0, 0, At, B0); MMAF(0, 1, At, B1); PG8_BAR; PG8_SCHED; \
            PG8_LDA(At, 0, 1); PG8_STAGE(PG8_SB(0, 0), b2, voffB); PG8_STAGE(PG8_SB(0, 1), b2 + hstepB, voffB); PG8_STAGE_A(PG8_SA(0, 0), a2, 0, last); \
            PG8_WAIT_V(8); PG8_WAIT_L(0); PG8_BAR; MMAF(1, 0, At, B0); MMAF(1, 1, At, B1); PG8_BAR; PG8_SCHED; \
            PG8_LDB(B0, 1, 0); PG8_LDB(B1, 1, 1); PG8_SCHED; PG8_LDA(At, 1, 0); PG8_STAGE_A(PG8_SA(0, 1), a2, 1, last); \
            PG8_WAIT_V(8); PG8_WAIT_L(0); PG8_BAR; PG8_MMA(0, 0, At, B0); PG8_MMA(0, 1, At, B1); PG8_BAR; PG8_SCHED; \
            PG8_LDA(At, 1, 1); PG8_STAGE(PG8_SB(1, 0), b3, voffB); PG8_STAGE(PG8_SB(1, 1), b3 + hstepB, voffB); PG8_STAGE_A(PG8_SA(1, 0), a3, 0, last); \
            PG8_WAIT_V(8); PG8_WAIT_L(0); PG8_BAR; PG8_MMA(1, 0, At, B0); PG8_MMA(1, 1, At, B1); PG8_BAR; PG8_SCHED; }
        if constexpr (ZC) { int t = 0; PG8_KBODY(PG8_MMA0);
#pragma unroll 1
          for (t = 2; t < nt; t += 2) PG8_KBODY(PG8_MMA); }
        else {
#pragma unroll 1
          for (int t = 0; t < nt; t += 2) PG8_KBODY(PG8_MMA); }
#undef PG8_KBODY
        if constexpr (ALIGN_EPI) { if (wr == 0) PG8_BAR; }
        E(acc, cur, wr, wc, fr, fq);
        if (!has_next) break;
        if constexpr (!ZC) {
#pragma unroll
        for (int a = 0; a < 2; ++a)
#pragma unroll
            for (int b = 0; b < 2; ++b)
#pragma unroll
                for (int m = 0; m < 4; ++m)
#pragma unroll
                    for (int n = 0; n < 2; ++n) acc[a][b][m][n] = (f32x4){0.f, 0.f, 0.f, 0.f}; }
        cur = nxt; cA = nA; cB = nB; ++ui;
        if constexpr (GATHER) {
#pragma unroll
            for (int h = 0; h < 2; ++h)
#pragma unroll
                for (int i = 0; i < 2; ++i) offC[h][i] = offN[h][i]; }
        if constexpr (ALIGN_EPI) { if (wr == 1) PG8_BAR; }
    }
    PG8_WAIT_V(0);
    if constexpr (!ALIGN_EPI) { if (wr == 0) PG8_BAR; }
    PG8_BAR;
#undef PG8_SA
#undef PG8_SB
#undef PG8_STAGE
#undef PG8_LDA
#undef PG8_LDB
#undef PG8_MMA
#undef PG8_MMA0
#undef PG8_WAIT_V
#undef PG8_WAIT_L
#undef PG8_BAR
#undef PG8_SCHED
#undef PG8_AOFF
#undef PG8_STAGE_A
}
}
namespace pg8 {
#define PG8_ROWVALS(dst, base, voff, O1, O2, O3, O4, O5, O6, O7) asm volatile("s_nop 4\n\tglobal_load_dword %0, %8, %9\n\tglobal_load_dword %1, %8, %9 offset:" #O1 "\n\tglobal_load_dword %2, %8, %9 offset:" #O2 "\n\tglobal_load_dword %3, %8, %9 offset:" #O3 \
        "\n\tglobal_load_dword %4, %8, %9 offset:" #O4 "\n\tglobal_load_dword %5, %8, %9 offset:" #O5 "\n\tglobal_load_dword %6, %8, %9 offset:" #O6 "\n\tglobal_load_dword %7, %8, %9 offset:" #O7 "\n\ts_waitcnt vmcnt(0)" \
        : "=&v"(dst[0]), "=&v"(dst[1]), "=&v"(dst[2]), "=&v"(dst[3]), "=&v"(dst[4]), "=&v"(dst[5]), "=&v"(dst[6]), "=&v"(dst[7]) : "v"(voff), "s"(base) : "memory")
__device__ __forceinline__ unsigned cvt_pk_bf16(float lo, float hi) { unsigned r; asm volatile("v_cvt_pk_bf16_f32 %0, %1, %2" : "=v"(r) : "v"(lo), "v"(hi)); return r; }
#define PG8_ROWVALS4(d0, d1, d2, d3, base, voff, O0, O1, O2, O3) asm volatile("s_nop 4\n\tglobal_load_dword %0, %4, %5 offset:" #O0 "\n\tglobal_load_dword %1, %4, %5 offset:" #O1 "\n\tglobal_load_dword %2, %4, %5 offset:" #O2 "\n\tglobal_load_dword %3, %4, %5 offset:" #O3 "\n\ts_waitcnt vmcnt(0)" \
        : "=&v"(d0), "=&v"(d1), "=&v"(d2), "=&v"(d3) : "v"(voff), "s"(base) : "memory")
template <int LDC, bool ROWSCALE, bool SKIPROPE = false, bool ROWMAP = false> struct EpiBf16 {
    static constexpr bool PERM = true; static constexpr bool BJ8 = BF_FULL && !ROWSCALE; static constexpr int NST = SKIPROPE ? 0 : 16;
    bf16_t* O; int nloc; unsigned scmask; float sc; size_t tile_stride; const float* rowscale; int rs_off; const int* rowmap;
    __device__ __forceinline__ void operator()(const f32x4 (&acc)[2][2][4][2], const Unit& u, int wr, int wc, int fr, int fq) const {
        const int pnl = u.pn % nloc; const int row0 = u.pm * BM + wr * 64 + fr;
        const float s = ((scmask >> pnl) & 1u) ? sc : 1.f;
        if constexpr (BJ8) {
            const int hi = fr >> 3, chunk = 2 * fq + hi; const bool skip = SKIPROPE && pnl == 0 && chunk >= 4;
            const int rowA = u.pm * BM + wr * 64 + (fr & 7);
            bf16_t* pb = O + (size_t)pnl * tile_stride + wc * 64 + chunk * 8;
#pragma unroll
            for (int ai = 0; ai < 2; ++ai)
#pragma unroll
                for (int m = 0; m < 4; ++m) {
                    float rsc = s; if constexpr (ROWSCALE) rsc *= rowscale[2 * (row0 + ai * HALF + m * 16) + rs_off];
                    int c0[4], c1[4];
                    { const f32x4 v0 = acc[ai][0][m][0] * rsc, v1 = acc[ai][0][m][1] * rsc; c0[0] = (int)cvt_pk_bf16(v0[0], v0[1]); c0[1] = (int)cvt_pk_bf16(v0[2], v0[3]); c0[2] = (int)cvt_pk_bf16(v1[0], v1[1]); c0[3] = (int)cvt_pk_bf16(v1[2], v1[3]); }
                    { const f32x4 v0 = acc[ai][1][m][0] * rsc, v1 = acc[ai][1][m][1] * rsc; c1[0] = (int)cvt_pk_bf16(v0[0], v0[1]); c1[1] = (int)cvt_pk_bf16(v0[2], v0[3]); c1[2] = (int)cvt_pk_bf16(v1[0], v1[1]); c1[3] = (int)cvt_pk_bf16(v1[2], v1[3]); }
                    const int r1 = rowA + ai * HALF + m * 16;
                    { v4u d1;
                      d1.x = (unsigned)__builtin_amdgcn_update_dpp(c0[0], c1[0], 0x128, 0xf, 0xc, false); d1.y = (unsigned)__builtin_amdgcn_update_dpp(c0[1], c1[1], 0x128, 0xf, 0xc, false);
                      d1.z = (unsigned)__builtin_amdgcn_update_dpp(c0[2], c1[2], 0x128, 0xf, 0xc, false); d1.w = (unsigned)__builtin_amdgcn_update_dpp(c0[3], c1[3], 0x128, 0xf, 0xc, false);
                      if (!skip) st16_wtw<0>(pb + (size_t)(ROWMAP ? rowmap[r1] : r1) * LDC, d1); }
                    __builtin_amdgcn_sched_barrier(0);
                    { v4u d2;
                      d2.x = (unsigned)__builtin_amdgcn_update_dpp(c1[0], c0[0], 0x128, 0xf, 0x3, false); d2.y = (unsigned)__builtin_amdgcn_update_dpp(c1[1], c0[1], 0x128, 0xf, 0x3, false);
                      d2.z = (unsigned)__builtin_amdgcn_update_dpp(c1[2], c0[2], 0x128, 0xf, 0x3, false); d2.w = (unsigned)__builtin_amdgcn_update_dpp(c1[3], c0[3], 0x128, 0xf, 0x3, false);
                      if (!skip) st16_wtw<0>(pb + (size_t)(ROWMAP ? rowmap[r1 + 8] : r1 + 8) * LDC, d2); }
                    __builtin_amdgcn_sched_barrier(0); }
            return;
        }
        bf16_t* p0 = O + (size_t)pnl * tile_stride + (size_t)row0 * LDC + wc * 32 + 8 * fq;
        if (SKIPROPE && pnl == 0 && (wc & 1)) return;
        float rv[8];
        const unsigned vo_ = (unsigned)(2 * row0 + rs_off) * 4u;
#pragma unroll
        for (int ai = 0; ai < 2; ++ai) {
            if constexpr (ROWSCALE && ROWSCALE_ASM) { if (ai == 0) PG8_ROWVALS4(rv[0], rv[1], rv[2], rv[3], rowscale, vo_, 0, 128, 256, 384); else PG8_ROWVALS4(rv[4], rv[5], rv[6], rv[7], rowscale, vo_, 1024, 1152, 1280, 1408); }
#pragma unroll
            for (int m = 0; m < 4; ++m) { bf16_t* rowp = ROWMAP ? O + (size_t)pnl * tile_stride + (size_t)rowmap[row0 + ai * HALF + m * 16] * LDC + wc * 32 + 8 * fq : p0 + (size_t)(ai * HALF + m * 16) * LDC;
                float rsc = s; if constexpr (ROWSCALE) { if constexpr (ROWSCALE_ASM) rsc *= rv[ai * 4 + m]; else rsc *= rowscale[2 * (row0 + ai * HALF + m * 16) + rs_off]; }
#pragma unroll
                for (int bj = 0; bj < 2; ++bj) { const f32x4 v0 = acc[ai][bj][m][0] * rsc, v1 = acc[ai][bj][m][1] * rsc;
                    v4u w; w.x = cvt_pk_bf16(v0[0], v0[1]); w.y = cvt_pk_bf16(v0[2], v0[3]); w.z = cvt_pk_bf16(v1[0], v1[1]); w.w = cvt_pk_bf16(v1[2], v1[3]);
                    st16_wtw<0>(rowp + bj * HALF, w); } } }
    }
};
constexpr float YSCALE = 32.0f;
struct EpiFp8 {
    static constexpr bool ZC_OK = true; static constexpr bool PERM = true; static constexpr bool BJ8 = BJ8_EPI; static constexpr int NST = BJ8_EPI ? 8 : 16;
    unsigned char* O; int nloc;
    __device__ __forceinline__ void operator()(const f32x4 (&acc)[2][2][4][2], const Unit& u, int wr, int wc, int fr, int fq) const {
        const int pnl = u.pn % nloc; const int row0 = u.pm * BM + wr * 64 + fr;
        unsigned char* p0 = O + (size_t)row0 * DM + pnl * BM + (BJ8 ? wc * 64 + 16 * fq : wc * 32 + 8 * fq);
#pragma unroll
        for (int ai = 0; ai < 2; ++ai)
#pragma unroll
            for (int m = 0; m < 4; ++m) { unsigned char* rowp = p0 + (size_t)(ai * HALF + m * 16) * DM;
                int w[2][2];
#pragma unroll
                for (int bj = 0; bj < 2; ++bj) { const f32x4 v0 = acc[ai][bj][m][0], v1 = acc[ai][bj][m][1];
                    int w0 = 0, w1 = 0;
                    w0 = __builtin_amdgcn_cvt_pk_fp8_f32(v0[0], v0[1], w0, false); w0 = __builtin_amdgcn_cvt_pk_fp8_f32(v0[2], v0[3], w0, true);
                    w1 = __builtin_amdgcn_cvt_pk_fp8_f32(v1[0], v1[1], w1, false); w1 = __builtin_amdgcn_cvt_pk_fp8_f32(v1[2], v1[3], w1, true);
                    w[bj][0] = w0; w[bj][1] = w1; }
                if constexpr (BJ8) *(v4u*)rowp = (v4u){(unsigned)w[0][0], (unsigned)w[0][1], (unsigned)w[1][0], (unsigned)w[1][1]};
                else { *(v2u*)rowp = (v2u){(unsigned)w[0][0], (unsigned)w[0][1]}; *(v2u*)(rowp + HALF) = (v2u){(unsigned)w[1][0], (unsigned)w[1][1]}; } }
    }
};
struct EpiLogits {
    static constexpr bool PERM = false; static constexpr int NST = 16;
    float* O;
    __device__ __forceinline__ void operator()(const f32x4 (&acc)[2][2][4][2], const Unit& u, int wr, int wc, int fr, int fq) const {
        const int col0 = wc * 32 + 4 * fq;
#pragma unroll
        for (int ai = 0; ai < 2; ++ai)
#pragma unroll
            for (int m = 0; m < 4; ++m) { float* rowp = O + (size_t)(u.pm * BM + ai * HALF + wr * 64 + m * 16 + fr) * 128 + col0;
#pragma unroll
                for (int n = 0; n < 2; ++n) *(f32x4*)(rowp + n * 16) = acc[ai][0][m][n] + acc[ai][1][m][n]; }
    }
};
template <bool LGATE = false> struct EpiSwiGLUT {
    static constexpr bool PERM = true; static constexpr bool BJ8 = BJ8_EPI; static constexpr int NST = BJ8_EPI ? 8 : 16;
    bf16_t* O; int nloc; const float* gate; float gsc; const LAS float* gatel;
    __device__ __forceinline__ void operator()(const f32x4 (&acc)[2][2][4][2], const Unit& u, int wr, int wc, int fr, int fq) const {
        const int pnl = u.pn % nloc; const int row0 = u.pm * BM + wr * 64 + fr; const int col0 = pnl * 128 + (BJ8 ? wc * 32 + 8 * fq : wc * 16 + 4 * fq);
        float gv[8]; const bool pre = ROWVALS_ASM && !LGATE && gate != nullptr;
        if (pre) { const unsigned vo = (unsigned)row0 * 4u; PG8_ROWVALS(gv, gate, vo, 64, 128, 192, 512, 576, 640, 704); }
#pragma unroll
        for (int ai = 0; ai < 2; ++ai)
#pragma unroll
            for (int m = 0; m < 4; ++m) { const int row = row0 + ai * HALF + m * 16; float gt; if constexpr (LGATE) gt = gatel[u.li * BM + wr * 64 + fr + ai * HALF + m * 16] * gsc; else gt = pre ? gv[ai * 4 + m] * gsc : (gate ? gate[row] * gsc : gsc); bf16_t* rowp = O + (size_t)row * 256 + col0;
                v2u w[2];
#pragma unroll
                for (int bj = 0; bj < 2; ++bj) { const f32x4 a = acc[ai][bj][m][0], b = acc[ai][bj][m][1];
                    w[bj].x = cvt_pk_bf16(fsilu(a[0]) * b[0] * gt, fsilu(a[1]) * b[1] * gt); w[bj].y = cvt_pk_bf16(fsilu(a[2]) * b[2] * gt, fsilu(a[3]) * b[3] * gt); }
                if constexpr (BJ8) *(v4u*)rowp = (v4u){w[0].x, w[0].y, w[1].x, w[1].y};
                else { *(v2u*)rowp = w[0]; *(v2u*)(rowp + 64) = w[1]; } }
    }
};
typedef EpiSwiGLUT<false> EpiSwiGLU;
struct EpiNull {
    static constexpr bool PERM = true; static constexpr int NST = 0;
    __device__ __forceinline__ void operator()(const f32x4 (&acc)[2][2][4][2], const Unit& u, int wr, int wc, int fr, int fq) const {
#pragma unroll
        for (int ai = 0; ai < 2; ++ai)
#pragma unroll
            for (int bj = 0; bj < 2; ++bj)
                asm volatile("" :: "v"(acc[ai][bj][0][0]), "v"(acc[ai][bj][0][1]), "v"(acc[ai][bj][1][0]), "v"(acc[ai][bj][1][1]), "v"(acc[ai][bj][2][0]), "v"(acc[ai][bj][2][1]), "v"(acc[ai][bj][3][0]), "v"(acc[ai][bj][3][1]));
    }
};
}
#define XB_TMO      128
#define XB_XCNT(j)  (256  + 64 * (j))
#define XB_XSUB(j)  (1280 + 64 * (j))
#define XB_XGEN(j)  (2304 + 64 * (j))
#define XB_TOP      3328
#define XB_TOPGEN   3392
#define XCD_BAR_WORDS 3456
#define XB_SPIN_CAP (1u << 18)

__device__ __forceinline__ unsigned xb_ld(unsigned* p)              { return __hip_atomic_load(p, __ATOMIC_RELAXED, __HIP_MEMORY_SCOPE_AGENT); }
__device__ __forceinline__ unsigned xb_add(unsigned* p, unsigned v) { return __hip_atomic_fetch_add(p, v, __ATOMIC_RELAXED, __HIP_MEMORY_SCOPE_AGENT); }
__device__ __forceinline__ unsigned xb_xcc_id() { return (unsigned)__builtin_amdgcn_s_getreg((3 << 11) | 20) & 0xFu; }
#define XB_SPIN(cond, bar) do { unsigned _sp = 0; while (cond) { __builtin_amdgcn_s_sleep(1); \
    if ((++_sp & 255u) == 0u) { if (xb_ld(&(bar)[XB_TMO])) break; if (_sp > XB_SPIN_CAP) { atomicAdd(&(bar)[XB_TMO], 1u); break; } } } } while (0)

struct XcdBarrier {
    unsigned* bar; unsigned x;
    volatile LAS unsigned* st;
};

__device__ __forceinline__ XcdBarrier xcd_barrier_post(unsigned* bar, volatile LAS unsigned* st) {
    XcdBarrier b; b.bar = bar; b.x = xb_xcc_id(); b.st = st;
    if (threadIdx.x == 0) (void)xb_add(&bar[XB_XCNT(b.x)], 1u);
    return b;
}
__device__ __forceinline__ void xcd_barrier_complete(unsigned* bar, unsigned x, unsigned& nloc, unsigned& nx) {
    const unsigned G = gridDim.x * gridDim.y * gridDim.z;
    unsigned sum, cnt, mine, sp = 0u;
    for (;;) {
        sum = 0u; cnt = 0u; mine = 0u;
#pragma unroll
        for (unsigned j = 0; j < 16; ++j) { const unsigned c = xb_ld(&bar[XB_XCNT(j)]); sum += c; cnt += (c > 0u) ? 1u : 0u; mine = (j == x) ? c : mine; }
        if (sum == G) break;
        __builtin_amdgcn_s_sleep(1);
        if ((++sp & 255u) == 0u) { if (xb_ld(&bar[XB_TMO])) break; if (sp > XB_SPIN_CAP) { atomicAdd(&bar[XB_TMO], 1u); break; } }
    }
    nloc = mine > 0u ? mine : 1u; nx = cnt > 0u ? cnt : 1u;
}

__device__ __forceinline__ void xcd_barrier(const XcdBarrier& b) {
    asm volatile("s_waitcnt vmcnt(0)" ::: "memory");
    __syncthreads();
    if (threadIdx.x == 0) {
        unsigned* bar = b.bar;
        __builtin_amdgcn_s_waitcnt(0);
        unsigned nloc = b.st[0], nx = b.st[1];
        if (nloc == 0u) { xcd_barrier_complete(bar, b.x, nloc, nx); b.st[0] = nloc; b.st[1] = nx; }
        const unsigned old = xb_add(&bar[XB_XSUB(b.x)], 1u);
        const unsigned gen = old / nloc;
        if (old + 1u == (gen + 1u) * nloc) {
            __builtin_amdgcn_fence(__ATOMIC_RELEASE, "agent");
            asm volatile("s_waitcnt vmcnt(0)" ::: "memory");
            const unsigned og = xb_add(&bar[XB_TOP], 1u);
            const unsigned tg = og / nx;
            if (og + 1u == (tg + 1u) * nx) xb_add(&bar[XB_TOPGEN], 1u);
            else XB_SPIN(xb_ld(&bar[XB_TOPGEN]) == tg, bar);
            __builtin_amdgcn_fence(__ATOMIC_ACQUIRE, "agent");
            xb_add(&bar[XB_XGEN(b.x)], 1u);
            asm volatile("s_waitcnt vmcnt(0)" ::: "memory");
        } else {
            XB_SPIN(xb_ld(&bar[XB_XGEN(b.x)]) == gen, bar);
            __builtin_amdgcn_fence(__ATOMIC_ACQUIRE, "agent");
            asm volatile("s_waitcnt vmcnt(0)" ::: "memory");
        }
    }
    __syncthreads();
}
namespace att {
constexpr int NSLOT = 3, SLOTB = 8192;
constexpr int LDS_K = 0, LDS_V = NSLOT * SLOTB, LDS_WS = 2 * NSLOT * SLOTB, LDS_OST = LDS_WS + 8 * 64 * 4, LDS_BIAS = LDS_OST + 8 * 4096, LDS_END = LDS_BIAS + 2048;
enum { M_FULL = 0, M_NA = 1, M_WA = 2 };
__device__ __forceinline__ int crow(int r, int hi) { return (r & 3) + 8 * (r >> 2) + 4 * hi; }
__device__ __forceinline__ void glds16(const void* gsrc, unsigned lds_dst) { unsigned keep;
    asm volatile("s_mov_b32 %0, m0\n\ts_mov_b32 m0, %2\n\ts_nop 0\n\tglobal_load_lds_dwordx4 %1, off\n\ts_mov_b32 m0, %0" : "=&s"(keep) : "v"(gsrc), "s"(lds_dst) : "memory"); }
__device__ __forceinline__ void qkt(f32x16& p0, f32x16& p1, const char* Kslot, const bf16x8* qr, int r32, int hi) {
    const char* kb = Kslot + hi * 1024 + r32 * 16;
    const f32x16 z = {};
#pragma unroll
    for (int d0 = 0; d0 < 4; ++d0) {
        const bf16x8 b0 = *reinterpret_cast<const bf16x8*>(kb + d0 * 2048);
        const bf16x8 b1 = *reinterpret_cast<const bf16x8*>(kb + d0 * 2048 + 512);
        if (d0 == 0) { p0 = __builtin_amdgcn_mfma_f32_32x32x16_bf16(b0, qr[0], z, 0, 0, 0); p1 = __builtin_amdgcn_mfma_f32_32x32x16_bf16(b1, qr[0], z, 0, 0, 0); }
        else { p0 = __builtin_amdgcn_mfma_f32_32x32x16_bf16(b0, qr[d0], p0, 0, 0, 0); p1 = __builtin_amdgcn_mfma_f32_32x32x16_bf16(b1, qr[d0], p1, 0, 0, 0); } }
}
__device__ __forceinline__ void pv(f32x16* o, int vb, bf16x8 pa0, bf16x8 pa1, bf16x8 pa2, bf16x8 pa3) {
#pragma unroll
    for (int d0 = 0; d0 < 2; ++d0) { s16x4 lo[4], hi[4];
#pragma unroll
        for (int ks = 0; ks < 4; ++ks) {
            asm volatile("ds_read_b64_tr_b16 %0,%1 offset:%c2" : "=&v"(lo[ks]) : "v"(vb), "i"(d0 * 4096 + ks * 1024) : "memory");
            asm volatile("ds_read_b64_tr_b16 %0,%1 offset:%c2" : "=&v"(hi[ks]) : "v"(vb), "i"(d0 * 4096 + ks * 1024 + 512) : "memory"); }
        asm volatile("s_waitcnt lgkmcnt(0)" ::: "memory"); __builtin_amdgcn_sched_barrier(0);
#define PK(k) (bf16x8){lo[k][0], lo[k][1], lo[k][2], lo[k][3], hi[k][0], hi[k][1], hi[k][2], hi[k][3]}
        o[d0] = __builtin_amdgcn_mfma_f32_32x32x16_bf16(pa0, PK(0), o[d0], 0, 0, 0);
        o[d0] = __builtin_amdgcn_mfma_f32_32x32x16_bf16(pa1, PK(1), o[d0], 0, 0, 0);
        o[d0] = __builtin_amdgcn_mfma_f32_32x32x16_bf16(pa2, PK(2), o[d0], 0, 0, 0);
        o[d0] = __builtin_amdgcn_mfma_f32_32x32x16_bf16(pa3, PK(3), o[d0], 0, 0, 0);
#undef PK
    }
}
struct Desc {
    const bf16* Q; int qp;
    const bf16* K; const bf16* V; int kp;
    bf16* O; int op;
    int nt, nctx, nt_real;
    int ctxrow, latrow;
    int r0, kr0;
    int q0, kt0;
    const float* rpb;
    float sink_l2; int has_sink;
    int qrope, qt0;
};
template <int MODE>
__device__ __forceinline__ void attn_unit(const Desc& d, char* shm) {
    int tid_ = threadIdx.x; asm volatile("" : "+v"(tid_));
    const int tid = tid_, lane = tid & 63, r32 = lane & 31, hi = lane >> 5; const int wid = __builtin_amdgcn_readfirstlane(tid >> 6);
    const unsigned lds0 = (unsigned)(uintptr_t)shm;
    float* wsf = (float*)(shm + LDS_WS) + wid * 64;
    const bf16* Qw = d.Q + (size_t)(wid * 32) * d.qp;
    const unsigned kdst = lds0 + LDS_K + wid * 1024, vdst = lds0 + LDS_V + wid * 1024;
    const size_t koffl = (size_t)lane * d.kp + wid * 8;
    const size_t voffl = (size_t)(16 * (wid & 3) + (lane >> 2)) * d.kp + (wid >> 2) * 32 + (lane & 3) * 8;
#define TROW(t) ((t) < d.nctx ? d.ctxrow + 64 * (t) : d.latrow + 64 * ((t) - d.nctx))
#define DMA_KV(t, slot) do { const size_t ro_ = (size_t)TROW(t) * d.kp; \
        glds16(d.K + ro_ + koffl, (unsigned)__builtin_amdgcn_readfirstlane(kdst + (slot) * SLOTB)); \
        glds16(d.V + ro_ + voffl, (unsigned)__builtin_amdgcn_readfirstlane(vdst + (slot) * SLOTB)); } while (0)
    const int vb0 = (int)(lds0 + LDS_V) + ((lane >> 4) & 1) * 32 + (lane & 3) * 8 + (4 * hi + ((lane & 15) >> 2)) * 64;
    if (MODE == M_NA) { float* bt = (float*)(shm + LDS_BIAS); if (tid < 465) bt[tid] = d.rpb[tid] * LOG2E; }
    DMA_KV(0, 0);
    if (d.nt > 1) DMA_KV(1, 1);
    bf16x8 qr[4];
#pragma unroll
    for (int d0 = 0; d0 < 4; ++d0) qr[d0] = *reinterpret_cast<const bf16x8*>(&Qw[(size_t)r32 * d.qp + d0 * 16 + hi * 8]);
    float m = -1e30f, l = 0.f; f32x16 o[2]; o[0] = f32x16{}; o[1] = f32x16{};
    const int qrow = (MODE == M_NA) ? d.r0 + (wid >> 1) : 0;
    const int qcol = 32 * (wid & 1) + r32;
    const int rs = (MODE == M_NA) ? (qrow - 4 < 0 ? 0 : (qrow - 4 > 120 ? 120 : qrow - 4)) : 0;
    const int cs = qcol - 8 < 0 ? 0 : (qcol - 8 > 48 ? 48 : qcol - 8);
    const int qpos = d.q0 + 32 * wid + r32;
    int slot = 0;
    for (int t = 0; t < d.nt; ++t) {
        if (t + 1 < d.nt) asm volatile("s_waitcnt vmcnt(2) lgkmcnt(0)\n\ts_barrier" ::: "memory");
        else asm volatile("s_waitcnt vmcnt(0) lgkmcnt(0)\n\ts_barrier" ::: "memory");
        if (t + 2 < d.nt) { const int s2 = slot + 2 >= NSLOT ? slot + 2 - NSLOT : slot + 2; DMA_KV(t + 2, s2); }
        bool active = true;
        int kr = 0, k0 = 0;
        if (MODE == M_NA && t >= d.nctx) { kr = d.kr0 + (t - d.nctx); active = (kr >= rs) && (kr < rs + 8); }
        if (MODE == M_WA && t >= d.nctx) { k0 = d.kt0 + 64 * (t - d.nctx); const int qw = d.q0 + 32 * wid; active = (k0 + 63 >= qw - 128) && (k0 <= qw + 31 + 128); }
        if (active) {
            f32x16 p0, p1;
            qkt(p0, p1, shm + LDS_K + slot * SLOTB, qr, r32, hi);
            if (MODE == M_NA && t >= d.nctx) {
                const float* bt = (const float*)(shm + LDS_BIAS) + (kr - qrow + 7) * 31 + 15 - qcol;
#pragma unroll
                for (int r = 0; r < 16; ++r) {
                    const int kv = crow(r, hi);
                    { const bool ok = (unsigned)(kv - cs) < 16u; const float bv = bt[ok ? kv : qcol]; p0[r] = ok ? p0[r] + bv : -INFINITY; }
                    { const int kv2 = kv + 32; const bool ok = (unsigned)(kv2 - cs) < 16u; const float bv = bt[ok ? kv2 : qcol]; p1[r] = ok ? p1[r] + bv : -INFINITY; }
                }
            }
            if (MODE == M_WA && t >= d.nctx) {
#pragma unroll
                for (int r = 0; r < 16; ++r) {
                    const int dk = k0 + crow(r, hi) - qpos;
                    if (dk > 128 || dk < -128) p0[r] = -INFINITY;
                    if (dk + 32 > 128 || dk + 32 < -128) p1[r] = -INFINITY;
                }
            }
            float rm = __builtin_fmaxf(p0[0], p1[0]);
#pragma unroll
            for (int r = 1; r < 16; ++r) rm = __builtin_fmaxf(rm, __builtin_fmaxf(p0[r], p1[r]));
            { auto rr = __builtin_amdgcn_permlane32_swap(__float_as_uint(rm), __float_as_uint(rm), false, false); rm = __builtin_fmaxf(__uint_as_float(rr[0]), __uint_as_float(rr[1])); }
            const float mn = __builtin_fmaxf(m, rm);
            if (__any(mn > m)) {
                const float f = __builtin_amdgcn_exp2f(m - mn); l *= f; m = mn;
                if (hi == 0) wsf[r32] = f;
                asm volatile("s_waitcnt lgkmcnt(0)" ::: "memory");
#pragma unroll
                for (int r = 0; r < 16; ++r) { const float fr_ = wsf[crow(r, hi)]; o[0][r] *= fr_; o[1][r] *= fr_; }
            }
            float sacc = 0.f;
#pragma unroll
            for (int r = 0; r < 16; ++r) { p0[r] = __builtin_amdgcn_exp2f(p0[r] - m); p1[r] = __builtin_amdgcn_exp2f(p1[r] - m); sacc += p0[r] + p1[r]; }
            l += sacc;
            v4u pw0, pw1, pw2, pw3;
            pw0 = (v4u){cvtpk(p0[0], p0[1]), cvtpk(p0[2], p0[3]), cvtpk(p0[4], p0[5]), cvtpk(p0[6], p0[7])};
            pw1 = (v4u){cvtpk(p0[8], p0[9]), cvtpk(p0[10], p0[11]), cvtpk(p0[12], p0[13]), cvtpk(p0[14], p0[15])};
            pw2 = (v4u){cvtpk(p1[0], p1[1]), cvtpk(p1[2], p1[3]), cvtpk(p1[4], p1[5]), cvtpk(p1[6], p1[7])};
            pw3 = (v4u){cvtpk(p1[8], p1[9]), cvtpk(p1[10], p1[11]), cvtpk(p1[12], p1[13]), cvtpk(p1[14], p1[15])};
            pv(o, vb0 + slot * SLOTB, __builtin_bit_cast(bf16x8, pw0), __builtin_bit_cast(bf16x8, pw1), __builtin_bit_cast(bf16x8, pw2), __builtin_bit_cast(bf16x8, pw3));
        }
        slot = slot + 1 >= NSLOT ? 0 : slot + 1;
    }
    if (d.has_sink && hi == 0) l += __builtin_amdgcn_exp2f(d.sink_l2 - m);
    { auto rr = __builtin_amdgcn_permlane32_swap(__float_as_uint(l), __float_as_uint(l), false, false); l = __uint_as_float(rr[0]) + __uint_as_float(rr[1]); }
    if (hi == 0) wsf[32 + r32] = l;
    asm volatile("s_waitcnt lgkmcnt(0)" ::: "memory");
    float rli[16];
#pragma unroll
    for (int r = 0; r < 16; ++r) rli[r] = __builtin_amdgcn_rcpf(wsf[32 + crow(r, hi)]);
    bf16* Ow = d.O + (size_t)(wid * 32) * d.op;
    { bf16* stg = (bf16*)(shm + LDS_OST) + wid * 2048;
#pragma unroll
        for (int r = 0; r < 16; ++r) { const int orow = crow(r, hi);
#pragma unroll
            for (int d0 = 0; d0 < 2; ++d0) stg[orow * 64 + d0 * 32 + r32] = (bf16)f2bf(o[d0][r] * rli[r]); }
        asm volatile("s_waitcnt lgkmcnt(0)" ::: "memory");
#pragma unroll
        for (int i = 0; i < 4; ++i) { const int row = i * 8 + (lane >> 3), ch = lane & 7; const v4u v = *(const v4u*)(stg + row * 64 + ch * 8); st16_wtw<2>(Ow + (size_t)row * d.op + ch * 8, v); } }
    asm volatile("s_waitcnt lgkmcnt(0)\n\ts_barrier" ::: "memory");
#undef TROW
#undef DMA_KV
}
}
namespace att {
typedef unsigned u32x4 __attribute__((ext_vector_type(4)));
#define SBAR() __builtin_amdgcn_sched_barrier(0)
__device__ __forceinline__ float max3f(float a,float b,float c){float r;asm("v_max3_f32 %0, %1, %2, %3":"=v"(r):"v"(a),"v"(b),"v"(c));return r;}
__device__ __forceinline__ float max2f(float a,float b){float r;asm("v_max_f32_e32 %0, %1, %2":"=v"(r):"v"(a),"v"(b));return r;}
__device__ __forceinline__ float fadd_s(float a,float b){float r;asm("v_add_f32_e32 %0, %1, %2":"=v"(r):"v"(a),"v"(b));return r;}
__device__ __forceinline__ float fsub_s(float a,float b){float r;asm("v_sub_f32_e32 %0, %1, %2":"=v"(r):"v"(a),"v"(b));return r;}
__device__ __forceinline__ unsigned cvtpk_s(float lo,float hi){return cvtpk(lo,hi);}
#define WAIT_BAR(N) asm volatile("s_waitcnt vmcnt(" #N ") lgkmcnt(0)\n\ts_barrier":::"memory")


__device__ __forceinline__ void qkt_n(f32x16&p0,f32x16&p1,const char*Kslot,const bf16x8*qr,const f32x16&negm,int r32,int hi){
  const char*kb=Kslot+hi*1024+r32*16;
  #pragma unroll
  for(int d0=0;d0<4;++d0){
    const bf16x8 b0=*reinterpret_cast<const bf16x8*>(kb+d0*2048);
    const bf16x8 b1=*reinterpret_cast<const bf16x8*>(kb+d0*2048+512);
    if(d0==0){p0=__builtin_amdgcn_mfma_f32_32x32x16_bf16(b0,qr[0],negm,0,0,0);p1=__builtin_amdgcn_mfma_f32_32x32x16_bf16(b1,qr[0],negm,0,0,0);}
    else{p0=__builtin_amdgcn_mfma_f32_32x32x16_bf16(b0,qr[d0],p0,0,0,0);p1=__builtin_amdgcn_mfma_f32_32x32x16_bf16(b1,qr[d0],p1,0,0,0);}}
}
typedef __attribute__((address_space(3))) const char* lds_cptr;
typedef short v4i16_t __attribute__((ext_vector_type(4)));
__device__ __forceinline__ void kload8(bf16x8*kf,lds_cptr kp){
  kf[0]=*(const __attribute__((address_space(3))) bf16x8*)(kp);      kf[1]=*(const __attribute__((address_space(3))) bf16x8*)(kp+512);
  kf[2]=*(const __attribute__((address_space(3))) bf16x8*)(kp+2048); kf[3]=*(const __attribute__((address_space(3))) bf16x8*)(kp+2560);
  kf[4]=*(const __attribute__((address_space(3))) bf16x8*)(kp+4096); kf[5]=*(const __attribute__((address_space(3))) bf16x8*)(kp+4608);
  kf[6]=*(const __attribute__((address_space(3))) bf16x8*)(kp+6144); kf[7]=*(const __attribute__((address_space(3))) bf16x8*)(kp+6656);
}
__device__ __forceinline__ void kload2(bf16x8*kf,lds_cptr kp,int j){ kf[2*j]=*(const __attribute__((address_space(3))) bf16x8*)(kp+j*2048); kf[2*j+1]=*(const __attribute__((address_space(3))) bf16x8*)(kp+j*2048+512); }
__device__ __forceinline__ s16x4 vtr(lds_cptr p){ return __builtin_bit_cast(s16x4,__builtin_amdgcn_ds_read_tr16_b64_v4i16((__attribute__((address_space(3))) v4i16_t*)p)); }
__device__ __forceinline__ float rowmax(const f32x16&p0,const f32x16&p1){
  float a=max3f(p0[0],p0[1],p1[0]),b=max3f(p0[2],p0[3],p1[1]);a=max3f(a,p1[2],p1[3]);
  #pragma unroll
  for(int r=4;r<16;r+=4){a=max3f(a,p0[r],p0[r+1]);b=max3f(b,p0[r+2],p0[r+3]);a=max3f(a,p1[r],p1[r+1]);b=max3f(b,p1[r+2],p1[r+3]);}
  const float m=max2f(a,b);
  auto rr=__builtin_amdgcn_permlane32_swap(__float_as_uint(m),__float_as_uint(m),false,false);
  return max2f(__uint_as_float(rr[0]),__uint_as_float(rr[1]));
}

template<int MODE> __device__ __forceinline__ void pipe_mask(f32x16&P0,f32x16&P1,int t,const Desc& d,const char*shm,int wid,int r32,int hi){
  if(MODE==M_FULL) return;
  if(t<d.nctx) return;
  if(t>=d.nt_real){
    _Pragma("unroll") for(int r=0;r<16;++r){P0[r]=-INFINITY;P1[r]=-INFINITY;} return; }
  if(MODE==M_NA){
    const int qrow=d.r0+(wid>>1), qcol=32*(wid&1)+r32, kr=d.kr0+(t-d.nctx);
    const int rs=qrow-4<0?0:(qrow-4>120?120:qrow-4), cs=qcol-8<0?0:(qcol-8>48?48:qcol-8);
    if(kr<rs||kr>=rs+8){ _Pragma("unroll") for(int r=0;r<16;++r){P0[r]=-INFINITY;P1[r]=-INFINITY;} return; }
    const float*bt=(const float*)(shm+LDS_BIAS)+(kr-qrow+7)*31+15-qcol;
    _Pragma("unroll") for(int r=0;r<16;++r){ const int kv=crow(r,hi);
      { const bool ok=(unsigned)(kv-cs)<16u; const float bv=bt[ok?kv:qcol]; P0[r]=ok?P0[r]+bv:-INFINITY; }
      { const int kv2=kv+32; const bool ok=(unsigned)(kv2-cs)<16u; const float bv=bt[ok?kv2:qcol]; P1[r]=ok?P1[r]+bv:-INFINITY; } }
  }
  if(MODE==M_WA){
    const int qpos=d.q0+32*wid+r32, k0=d.kt0+64*(t-d.nctx);
    _Pragma("unroll") for(int r=0;r<16;++r){ const int dk=k0+crow(r,hi)-qpos;
      if(dk>128||dk<-128)P0[r]=-INFINITY; if(dk+32>128||dk+32<-128)P1[r]=-INFINITY; }
  }
}
template<int THRL,int MODE> __device__ __forceinline__ void attn_unit_pipe(const Desc& d,char*shm){
  int tid_=threadIdx.x; asm volatile("":"+v"(tid_)); const int tid=tid_,lane=tid&63,r32=lane&31,hi=lane>>5; const int wid=__builtin_amdgcn_readfirstlane(tid>>6);
  const bf16*Qw=d.Q+(size_t)(wid*32)*d.qp;
  const unsigned lds0=(unsigned)(uintptr_t)shm;
  if(MODE==M_NA){ float*bt=(float*)(shm+LDS_BIAS); if(tid<465)bt[tid]=d.rpb[tid]*LOG2E; }
  float*wsf=(float*)(shm+LDS_WS)+wid*64;
  const size_t koffl=(size_t)lane*d.kp+wid*8;
  const size_t voffl=(size_t)(16*(wid&3)+(lane>>2))*d.kp+(wid>>2)*32+(lane&3)*8;
  #define TROW(t) ((t)<d.nctx?d.ctxrow+64*(t):((t)<d.nt_real?d.latrow+64*((t)-d.nctx):d.latrow))
  const unsigned kdst=lds0+LDS_K+wid*1024, vdst=lds0+LDS_V+wid*1024;
  #define DMA_K(t,slot) glds16(d.K+(size_t)TROW(t)*d.kp+koffl,(unsigned)__builtin_amdgcn_readfirstlane(kdst+(slot)))
  #define DMA_V(t,slot) glds16(d.V+(size_t)TROW(t)*d.kp+voffl,(unsigned)__builtin_amdgcn_readfirstlane(vdst+(slot)))
  const int vb0=(int)(lds0+LDS_V)+((lane>>4)&1)*32+(lane&3)*8+(4*hi+((lane&15)>>2))*64;
  const char*Kbase=shm+LDS_K; bf16x8 kf[8];
  const lds_cptr shm3=(lds_cptr)shm; const lds_cptr kp0=shm3+LDS_K+hi*1024+r32*16; const lds_cptr vp0=shm3+LDS_V+((lane>>4)&1)*32+(lane&3)*8+(4*hi+((lane&15)>>2))*64;
  const int NT=d.nt;
  DMA_K(0,0);DMA_V(0,0);DMA_K(1,SLOTB);
  bf16x8 qr[4];
  #pragma unroll
  for(int d0=0;d0<4;++d0)qr[d0]=*reinterpret_cast<const bf16x8*>(&Qw[(size_t)r32*d.qp+d0*16+hi*8]);
  if(d.qrope){
    const int tq=d.qt0+32*wid+r32, rr=tq>>6, cc=tq&63;
    #pragma unroll
    for(int d0=2;d0<4;++d0){ const float pos=(float)(d0==2?rr:cc); u32x4 w=__builtin_bit_cast(u32x4,qr[d0]), pw, ow;
      #pragma unroll
      for(int j=0;j<4;++j) pw[j]=(unsigned)__shfl_xor((int)w[j],32);
      #pragma unroll
      for(int j=0;j<4;++j){ float res[2];
        #pragma unroll
        for(int e=0;e<2;++e){ const int i=2*j+e; const float own=e?bfhi(w[j]):bflo(w[j]), oth=e?bfhi(pw[j]):bflo(pw[j]);
          const float rev=pos*__builtin_amdgcn_exp2f(-(float)i*(13.287712379549449f/8.0f))*0.15915494309189535f; const float cs_=__builtin_amdgcn_cosf(rev), sn_=__builtin_amdgcn_sinf(rev);
          res[e]=hi?(own*cs_+oth*sn_):(own*cs_-oth*sn_); }
        ow[j]=cvtpk(res[0],res[1]); }
      qr[d0]=__builtin_bit_cast(bf16x8,ow); } }
  float mhat=0.f,l_reg=0.f;f32x16 o[2];o[0]=f32x16{};o[1]=f32x16{};f32x16 negm=f32x16{};asm volatile("":"+v"(negm));
  #define CMASK(P0,P1,t) pipe_mask<MODE>(P0,P1,(t),d,shm,wid,r32,hi)
  bool resc=false;
  #define START(P0,P1) do{ const float rm=rowmax(P0,P1); resc=false; \
    { const float dl=rm; mhat=fadd_s(mhat,dl); \
      _Pragma("unroll") for(int r=0;r<16;++r){P0[r]=fsub_s(P0[r],dl);P1[r]=fsub_s(P1[r],dl);} \
      _Pragma("unroll") for(int r=0;r<16;++r)negm[r]=-mhat; asm volatile("":"+v"(negm)); } \
    _Pragma("unroll") for(int r=0;r<16;++r)P0[r]=__builtin_amdgcn_exp2f(P0[r]); }while(0)
  #define RESC() do{ if(resc){ asm volatile("s_waitcnt lgkmcnt(0)":::"memory"); \
      _Pragma("unroll") for(int d_=0;d_<2;++d_) _Pragma("unroll") for(int r=0;r<16;++r)o[d_][r]*=wsf[crow(r,hi)]; } }while(0)
  f32x16 pA0,pA1,pB0,pB1;
  int sl_prev=0,sl_cur=0,sl_next=SLOTB;
  #define ROT() do{sl_prev=sl_cur;sl_cur=sl_next;sl_next=(sl_next==(NSLOT-1)*SLOTB)?0:sl_next+SLOTB;}while(0)
  DMA_K(2,2*SLOTB);
  WAIT_BAR(3);
  qkt_n(pA0,pA1,Kbase,qr,negm,r32,hi);asm volatile("s_nop 15\n\ts_nop 7":"+v"(pA0),"+v"(pA1));CMASK(pA0,pA1,0);
  START(pA0,pA1);
  _Pragma("unroll") for(int r=0;r<16;++r)pA1[r]=__builtin_amdgcn_exp2f(pA1[r]);
  WAIT_BAR(0);
  DMA_K(3,0);DMA_V(1,SLOTB);
  ROT();
  kload8(kf,kp0+sl_cur);
  WAIT_BAR(2);
  s16x4 vlo[8],vhi[8]; u32x4 pw0,pw1,pw2,pw3;
  #define PKW(P,B) cvtpk_s(P[B],P[B+1])
  #define PAF(k) __builtin_bit_cast(bf16x8,pw##k)
  #define VFR(i) (bf16x8){vlo[i][0],vlo[i][1],vlo[i][2],vlo[i][3],vhi[i][0],vhi[i][1],vhi[i][2],vhi[i][3]}
  #define PIN(x) asm volatile("":"+v"(x))
  #define MX3(a,b,c) __builtin_fmaxf(__builtin_fmaxf((a),(b)),(c))
  #define GAPA(MF,A0,A1,A2,A3,W0,W1,PW) do{ MF; sacc+=A0; sacc+=A1; sacc+=A2; sacc+=A3; PIN(sacc); W0; W1; PIN(PW); SBAR(); }while(0)
  #define EX(v) __builtin_amdgcn_exp2f(v)
  #define GAPB(MF,X,B) do{ MF; X[B]=EX(X[B]); X[B+1]=EX(X[B+1]); X[B+2]=EX(X[B+2]); X[B+3]=EX(X[B+3]); PIN(X); SBAR(); }while(0)
  #define VRD(i) do{ vlo[i]=vtr(vp_+(((i)>>2)*4096+((i)&3)*1024)); vhi[i]=vtr(vp_+(((i)>>2)*4096+((i)&3)*1024+512)); }while(0)
  #define KRD(G,j) do{ if(G){ kload2(kf,kp0+sl_next,j); SBAR(); } }while(0)
  #define STEP(C0,C1,P0,P1,t,GK,GV,GL) do{ SBAR(); \
    const lds_cptr vp_=vp0+sl_prev; \
    VRD(0); SBAR(); float sacc=(P0[0]+P0[1]); \
    GAPA(C0=__builtin_amdgcn_mfma_f32_32x32x16_bf16(kf[0],qr[0],negm,0,0,0), P0[2],P0[3],P0[4],P0[5],     pw0[0]=PKW(P0,0), pw0[1]=PKW(P0,2), pw0); \
    VRD(4); SBAR(); GAPA(C1=__builtin_amdgcn_mfma_f32_32x32x16_bf16(kf[1],qr[0],negm,0,0,0), P0[6],P0[7],P0[8],P0[9],     pw0[2]=PKW(P0,4), pw0[3]=PKW(P0,6), pw0); \
    VRD(1); SBAR(); GAPA(C0=__builtin_amdgcn_mfma_f32_32x32x16_bf16(kf[2],qr[1],C0,0,0,0),   P0[10],P0[11],P0[12],P0[13], pw1[0]=PKW(P0,8), pw1[1]=PKW(P0,10), pw1); \
    VRD(5); SBAR(); GAPA(C1=__builtin_amdgcn_mfma_f32_32x32x16_bf16(kf[3],qr[1],C1,0,0,0),   P0[14],P0[15],P1[0],P1[1],   pw1[2]=PKW(P0,12),pw1[3]=PKW(P0,14), pw1); \
    VRD(2); SBAR(); GAPA(C0=__builtin_amdgcn_mfma_f32_32x32x16_bf16(kf[4],qr[2],C0,0,0,0),   P1[2],P1[3],P1[4],P1[5],     pw2[0]=PKW(P1,0), pw2[1]=PKW(P1,2), pw2); \
    VRD(6); SBAR(); GAPA(C1=__builtin_amdgcn_mfma_f32_32x32x16_bf16(kf[5],qr[2],C1,0,0,0),   P1[6],P1[7],P1[8],P1[9],     pw2[2]=PKW(P1,4), pw2[3]=PKW(P1,6), pw2); \
    VRD(3); SBAR(); GAPA(C0=__builtin_amdgcn_mfma_f32_32x32x16_bf16(kf[6],qr[3],C0,0,0,0),   P1[10],P1[11],P1[12],P1[13], pw3[0]=PKW(P1,8), pw3[1]=PKW(P1,10), pw3); \
    VRD(7); SBAR(); GAPA(C1=__builtin_amdgcn_mfma_f32_32x32x16_bf16(kf[7],qr[3],C1,0,0,0),   P1[14],P1[15],0.f,0.f,       pw3[2]=PKW(P1,12),pw3[3]=PKW(P1,14), pw3); \
    l_reg+=sacc; \
    if(GK){DMA_K((t)+3,sl_cur);} if(GV){DMA_V((t)+1,sl_next);} \
    CMASK(C0,C1,t); \
    { float a=MX3(C0[0],C0[1],C1[0]),b=MX3(C0[2],C0[3],C1[1]); a=MX3(a,C1[2],C1[3]); \
      _Pragma("unroll") for(int r=4;r<16;r+=4){a=MX3(a,C0[r],C0[r+1]);b=MX3(b,C0[r+2],C0[r+3]);a=MX3(a,C1[r],C1[r+1]);b=MX3(b,C1[r+2],C1[r+3]);} \
      float rm=__builtin_fmaxf(a,b); { auto rr=__builtin_amdgcn_permlane32_swap(__float_as_uint(rm),__float_as_uint(rm),false,false); rm=__builtin_fmaxf(__uint_as_float(rr[0]),__uint_as_float(rr[1])); } \
      resc=false; \
      if(__builtin_expect(__any(rm>(float)THRL),0)){ const float dl=__builtin_fmaxf(rm,0.f); mhat+=dl; \
        _Pragma("unroll") for(int r=0;r<16;++r){C0[r]-=dl;C1[r]-=dl;} \
        _Pragma("unroll") for(int r=0;r<16;++r)negm[r]=-mhat; asm volatile("":"+v"(negm)); \
        const float f=__builtin_amdgcn_exp2f(-dl); l_reg*=f; if(hi==0)wsf[r32]=f; resc=true; } } \
    SBAR(); \
    GAPB(o[0]=__builtin_amdgcn_mfma_f32_32x32x16_bf16(PAF(0),VFR(0),o[0],0,0,0), C0,0); \
    GAPB(o[1]=__builtin_amdgcn_mfma_f32_32x32x16_bf16(PAF(0),VFR(4),o[1],0,0,0), C0,4); \
    KRD(GL,0); GAPB(o[0]=__builtin_amdgcn_mfma_f32_32x32x16_bf16(PAF(1),VFR(1),o[0],0,0,0), C0,8); \
    KRD(GL,1); GAPB(o[1]=__builtin_amdgcn_mfma_f32_32x32x16_bf16(PAF(1),VFR(5),o[1],0,0,0), C0,12); \
    KRD(GL,2); GAPB(o[0]=__builtin_amdgcn_mfma_f32_32x32x16_bf16(PAF(2),VFR(2),o[0],0,0,0), C1,0); \
    KRD(GL,3); GAPB(o[1]=__builtin_amdgcn_mfma_f32_32x32x16_bf16(PAF(2),VFR(6),o[1],0,0,0), C1,4); \
    GAPB(o[0]=__builtin_amdgcn_mfma_f32_32x32x16_bf16(PAF(3),VFR(3),o[0],0,0,0), C1,8); \
    GAPB(o[1]=__builtin_amdgcn_mfma_f32_32x32x16_bf16(PAF(3),VFR(7),o[1],0,0,0), C1,12); \
    }while(0)
  int t=1;
  for(;t+5<NT;t+=2){
    STEP(pB0,pB1,pA0,pA1,t,true,true,true);     WAIT_BAR(2); RESC(); ROT();
    STEP(pA0,pA1,pB0,pB1,t+1,true,true,true);   WAIT_BAR(2); RESC(); ROT();
  }
  #define ENDW(tt) do{ if((tt)+3<NT){WAIT_BAR(2);} else if((tt)+2<NT){WAIT_BAR(1);} else {WAIT_BAR(0);} }while(0)
  for(;t+1<NT;t+=2){
    STEP(pB0,pB1,pA0,pA1,t,(t+3<NT),(t+1<NT),(t+1<NT));       ENDW(t);   RESC(); ROT();
    STEP(pA0,pA1,pB0,pB1,t+1,(t+4<NT),(t+2<NT),(t+2<NT));     ENDW(t+1); RESC(); ROT();
  }
  STEP(pB0,pB1,pA0,pA1,NT-1,false,false,false); RESC();
  { float sacc=pB0[0]+pB0[1]; _Pragma("unroll") for(int r=2;r<16;++r)sacc+=pB0[r]; _Pragma("unroll") for(int r=0;r<16;++r)sacc+=pB1[r]; l_reg+=sacc;
    pw0=(u32x4){PKW(pB0,0),PKW(pB0,2),PKW(pB0,4),PKW(pB0,6)};pw1=(u32x4){PKW(pB0,8),PKW(pB0,10),PKW(pB0,12),PKW(pB0,14)};pw2=(u32x4){PKW(pB1,0),PKW(pB1,2),PKW(pB1,4),PKW(pB1,6)};pw3=(u32x4){PKW(pB1,8),PKW(pB1,10),PKW(pB1,12),PKW(pB1,14)};
    SBAR(); pv(o,vb0+sl_cur,PAF(0),PAF(1),PAF(2),PAF(3)); }
  #undef PKW
  #undef PAF
  #undef VFR
  #undef PIN
  #undef MX3
  #undef GAPA
  #undef GAPB
  #undef EX
  #undef VRD
  #undef KRD
  #undef STEP
  #undef ENDW
  if(d.has_sink&&hi==0)l_reg+=__builtin_amdgcn_exp2f(d.sink_l2-mhat);
  {auto rr=__builtin_amdgcn_permlane32_swap(__float_as_uint(l_reg),__float_as_uint(l_reg),false,false);l_reg=__uint_as_float(rr[0])+__uint_as_float(rr[1]);}
  if(hi==0)wsf[32+r32]=l_reg;asm volatile("s_waitcnt lgkmcnt(0)":::"memory");
  float rli[16];
  #pragma unroll
  for(int r=0;r<16;++r)rli[r]=__builtin_amdgcn_rcpf(wsf[32+crow(r,hi)]);
  bf16*Ow=d.O+(size_t)(wid*32)*d.op;
  { bf16*stg=(bf16*)(shm+LDS_OST)+wid*2048;
    #pragma unroll
    for(int r=0;r<16;++r){const int orow=crow(r,hi);
      #pragma unroll
      for(int d0=0;d0<2;++d0)stg[orow*64+d0*32+r32]=(bf16)f2bf(o[d0][r]*rli[r]);}
    asm volatile("s_waitcnt lgkmcnt(0)":::"memory");
    #pragma unroll
    for(int i=0;i<4;++i){const int row=i*8+(lane>>3),ch=lane&7; const u32x4 v=*(const u32x4*)(stg+row*64+ch*8); st16_wtw<2>(Ow+(size_t)row*d.op+ch*8,v);} }
  asm volatile("s_waitcnt lgkmcnt(0)\n\ts_barrier":::"memory");
  #undef DMA_K
  #undef TROW
  #undef DMA_V
  #undef CMASK
  #undef START
  #undef RESC
  #undef ROT
}

#undef SBAR
#undef WAIT_BAR
}
namespace gla {
constexpr int S32 = 40, S64 = 72;
struct Par {
    const bf16* P; bf16* CAT; float* GU; float* GDEC; float* BC; float* CARRY;
    const float *wgf, *bgf, *wgb, *bgb, *gnorm;
};
__device__ __forceinline__ int chunk_row(int b, int n) { return n < 4 ? NLAT + b * CTXL + 64 * n : b * SEQ + 64 * (n - 4); }
__device__ __forceinline__ int chunk_dir(int n, int dir) { return dir == 0 ? n : (n < 4 ? 3 - n : 135 - n); }
template <int KS>
__device__ __forceinline__ f32x16 mm_tile(f32x16 c, const bf16* A, int sa, const bf16* Bt, int sb, int r32, int hi) {
#pragma unroll
    for (int s = 0; s < KS; ++s) {
        const bf16x8 a = *reinterpret_cast<const bf16x8*>(A + r32 * sa + 16 * s + 8 * hi);
        const bf16x8 b = *reinterpret_cast<const bf16x8*>(Bt + r32 * sb + 16 * s + 8 * hi);
        c = __builtin_amdgcn_mfma_f32_32x32x16_bf16(a, b, c, 0, 0, 0);
    }
    return c;
}
__device__ __forceinline__ float decay_g(const bf16* zl, int tok, int dir, const float (&w)[16], float bias) {
    const v4u* zp = (const v4u*)(zl + tok * 32 + dir * 16);
    const v4u z0 = zp[0], z1 = zp[1];
    float a = bias;
    a += bflo(z0.x) * w[0] + bfhi(z0.x) * w[1] + bflo(z0.y) * w[2] + bfhi(z0.y) * w[3] + bflo(z0.z) * w[4] + bfhi(z0.z) * w[5] + bflo(z0.w) * w[6] + bfhi(z0.w) * w[7];
    a += bflo(z1.x) * w[8] + bfhi(z1.x) * w[9] + bflo(z1.y) * w[10] + bfhi(z1.y) * w[11] + bflo(z1.z) * w[12] + bfhi(z1.z) * w[13] + bflo(z1.w) * w[14] + bfhi(z1.w) * w[15];
    const float ls = __builtin_fminf(a, 0.f) - 0.6931471805599453f * __builtin_amdgcn_logf(1.0f + __builtin_amdgcn_exp2f(-LOG2E * __builtin_fabsf(a)));
    return ls * (1.0f / 16.0f);
}
__device__ __forceinline__ void decay_totals(float& bend, float& carry, const bf16* zl, const float (&w)[16], float bias, int dir, int half) {
    float tot = 0.f;
#pragma unroll 4
    for (int ii = 0; ii < 32; ++ii) tot += decay_g(zl, 32 * half + ii, dir, w, bias);
    const float oth = __shfl_xor(tot, 32);
    bend = tot + oth; carry = (half == (dir == 0 ? 1 : 0)) ? oth : 0.f;
}
__device__ __forceinline__ void load_z(bf16* zl, const bf16* P, int row0, int tid) {
    if (tid < 256) { const int j = tid >> 2, c = tid & 3; *(v4u*)(zl + j * 32 + c * 8) = *(const v4u*)(P + (size_t)(row0 + j) * INWP + D_ZF + c * 8); }
}
__device__ __forceinline__ void ld_rows32(v4u (&pc)[2], const bf16* P, int row0, int col, int lane) {
#pragma unroll
    for (int i = 0; i < 2; ++i) { const int pidx = lane + 64 * i; pc[i] = *(const v4u*)(P + (size_t)(row0 + (pidx >> 2)) * INWP + col + (pidx & 3) * 8); }
}
__device__ __forceinline__ void st_rows32(bf16* dst, const v4u (&pc)[2], int lane) {
#pragma unroll
    for (int i = 0; i < 2; ++i) { const int pidx = lane + 64 * i; *(v4u*)(dst + (pidx >> 2) * S32 + (pidx & 3) * 8) = pc[i]; }
}
__device__ __forceinline__ void load_vt(bf16* Vt, const bf16* P, int row0, int h, int part, int lane) {
    const int c8 = lane & 7, jj = lane >> 3;
#pragma unroll
    for (int it = 0; it < 4; ++it) {
        const int j = 32 * part + it * 8 + jj;
        const v4u x = *(const v4u*)(P + (size_t)(row0 + j) * INWP + D_V + h * 64 + c8 * 8);
        bf16* dst = Vt + (c8 * 8) * S64 + j;
        dst[0 * S64] = (bf16)(x.x & 0xffff); dst[1 * S64] = (bf16)(x.x >> 16); dst[2 * S64] = (bf16)(x.y & 0xffff); dst[3 * S64] = (bf16)(x.y >> 16);
        dst[4 * S64] = (bf16)(x.z & 0xffff); dst[5 * S64] = (bf16)(x.z >> 16); dst[6 * S64] = (bf16)(x.w & 0xffff); dst[7 * S64] = (bf16)(x.w >> 16);
    }
}
__device__ __forceinline__ void g1_unit(const Par& p, int b, int n, char* shm) {
    int tid_ = threadIdx.x; asm volatile("" : "+v"(tid_));
    const int tid = tid_, lane = tid & 63, r32 = lane & 31, hi = lane >> 5; const int wid = __builtin_amdgcn_readfirstlane(tid >> 6);
    const int h = wid >> 1, dir = wid & 1, row0 = chunk_row(b, n);
    char* pr = shm + (wid >> 1) * 32768;
    bf16* KdT = (bf16*)(pr + (wid & 1) * 4608);
    bf16* Vt = (bf16*)(pr + 9216);
    bf16* Kr = (bf16*)(pr + 18432);
    bf16* zl = (bf16*)(shm + 131072);
    const int k = lane & 31, half = lane >> 5;
    v4u pc[2]; ld_rows32(pc, p.P, row0 + 32 * dir, D_K + h * 32, lane);
    float w[16];
    { const float* wg = dir == 0 ? p.wgf : p.wgb;
#pragma unroll
      for (int j = 0; j < 16; ++j) w[j] = wg[j * 128 + h * 32 + k]; }
    const float bias = (dir == 0 ? p.bgf : p.bgb)[h * 32 + k];
    {
        v4u zr = {0u, 0u, 0u, 0u}; { const int j = (tid & 255) >> 2, c = tid & 3; zr = *(const v4u*)(p.P + (size_t)(row0 + j) * INWP + D_ZF + c * 8); }
        v4u vx[4]; const int c8 = lane & 7, jj = lane >> 3;
#pragma unroll
        for (int it = 0; it < 4; ++it) { const int j = 32 * dir + it * 8 + jj; vx[it] = *(const v4u*)(p.P + (size_t)(row0 + j) * INWP + D_V + h * 64 + c8 * 8); }
        asm volatile("" : "+v"(zr), "+v"(vx[0]), "+v"(vx[1]), "+v"(vx[2]), "+v"(vx[3]));
        if (tid < 256) { const int j = tid >> 2, c = tid & 3; *(v4u*)(zl + j * 32 + c * 8) = zr; }
#pragma unroll
        for (int it = 0; it < 4; ++it) { const int j = 32 * dir + it * 8 + jj; const v4u x = vx[it]; bf16* dst = Vt + (c8 * 8) * S64 + j;
            dst[0 * S64] = (bf16)(x.x & 0xffff); dst[1 * S64] = (bf16)(x.x >> 16); dst[2 * S64] = (bf16)(x.y & 0xffff); dst[3 * S64] = (bf16)(x.y >> 16);
            dst[4 * S64] = (bf16)(x.z & 0xffff); dst[5 * S64] = (bf16)(x.z >> 16); dst[6 * S64] = (bf16)(x.w & 0xffff); dst[7 * S64] = (bf16)(x.w >> 16); } }
    st_rows32(Kr + 32 * dir * S32, pc, lane);
    __syncthreads();
    float loc = 0.f;
#pragma unroll 2
    for (int s = 0; s < 32; ++s) {
        const int i = 32 * half + (dir == 0 ? s : 31 - s);
        loc += decay_g(zl, i, dir, w, bias);
        KdT[k * S64 + i] = (bf16)f2bf(bf2f(Kr[i * S32 + k]) * __expf(-loc));
        p.BC[(size_t)(row0 + i) * 256 + dir * 128 + h * 32 + k] = loc;
    }
    const float oth = __shfl_xor(loc, 32), bend = loc + oth;
    const float carry = (half == (dir == 0 ? 1 : 0)) ? oth : 0.f;
    p.CARRY[(((size_t)(b * NCH + n) * 2 + dir) * 2 + half) * 128 + h * 32 + k] = carry;
    float* Fs = (float*)(pr + 23552) + (wid & 1) * 64;
    Fs[half * 32 + k] = __expf(bend - carry);
    const int seq = (b * 4 + h) * 2 + dir, nd = chunk_dir(n, dir);
    if (half == 0) p.GDEC[((size_t)seq * NCH + nd) * 32 + k] = __expf(bend);
    LDS_WAIT();
    float* up = p.GU + ((size_t)seq * NCH + nd) * 2048;
#pragma unroll
    for (int dt = 0; dt < 2; ++dt) {
        f32x16 c0 = {}, c1 = {};
        c0 = mm_tile<2>(c0, KdT, S64, Vt + (32 * dt) * S64, S64, r32, hi);
        c1 = mm_tile<2>(c1, KdT + 32, S64, Vt + (32 * dt) * S64 + 32, S64, r32, hi);
#pragma unroll
        for (int r = 0; r < 16; ++r) { const int kk = att::crow(r, hi); (up + ((r & 3) + 8 * (r >> 2)) * 64 + 32 * dt)[(unsigned)(4 * hi * 64 + r32)] = Fs[kk] * c0[r] + Fs[32 + kk] * c1[r]; }
    }
    __syncthreads();
}
__device__ __forceinline__ void g2_scan(float* GU, const float* GDEC, int gt) {
    if (gt >= 32 * 2048) return;
    const int seq = gt >> 11, e = gt & 2047, k = e >> 6;
    float* up = GU + (size_t)seq * NCH * 2048 + e; const float* dp = GDEC + (size_t)seq * NCH * 32 + k;
    float s = 0.f;
    static_assert(NCH % 33 == 0, "scan blocking");
#pragma unroll 1
    for (int n0 = 0; n0 < NCH; n0 += 33) { float uu[33], dd[33];
#pragma unroll
        for (int j = 0; j < 33; ++j) { uu[j] = up[(size_t)(n0 + j) * 2048]; dd[j] = dp[(n0 + j) * 32]; }
#pragma unroll
        for (int j = 0; j < 33; ++j) { up[(size_t)(n0 + j) * 2048] = s; s = s * dd[j] + uu[j]; } }
}
struct G3Lds { bf16 *Kd, *St, *Vt, *Qd, *AT, *zl; };
struct G3In { f32x4 sv[4]; v4u pq[2], pk[2]; f32x4 pb[2][2]; };
template <int DIR>
__device__ __forceinline__ void g3_load(G3In& I, const Par& p, int row0, int b, int n, int h, int ih, int lane) {
    const int seq = (b * 4 + h) * 2 + DIR, nd = chunk_dir(n, DIR);
    const float* sp = p.GU + ((size_t)seq * NCH + nd) * 2048;
    const int t128 = ih * 64 + lane;
#pragma unroll
    for (int it = 0; it < 4; ++it) I.sv[it] = __builtin_nontemporal_load((const f32x4*)(sp + (it * 128 + t128) * 4));
#pragma unroll
    for (int i = 0; i < 2; ++i) { const int item = lane + 64 * i, t = item >> 2, g8 = item & 3; const size_t row = (size_t)(row0 + 32 * ih + t);
        I.pq[i] = *(const v4u*)(p.P + row * INWP + D_Q + h * 32 + g8 * 8); I.pk[i] = *(const v4u*)(p.P + row * INWP + D_K + h * 32 + g8 * 8);
        const float* bp = p.BC + row * 256 + DIR * 128 + h * 32 + g8 * 8; I.pb[i][0] = __builtin_nontemporal_load((const f32x4*)bp); I.pb[i][1] = __builtin_nontemporal_load((const f32x4*)(bp + 4)); }
    { const int g8 = lane & 3; const float* cp = p.CARRY + (((size_t)(b * NCH + n) * 2 + DIR) * 2 + ih) * 128 + h * 32 + g8 * 8;
      const f32x4 c0 = *(const f32x4*)cp, c1 = *(const f32x4*)(cp + 4);
#pragma unroll
      for (int i = 0; i < 2; ++i) { I.pb[i][0] += c0; I.pb[i][1] += c1; } }
}
template <int DIR>
__device__ __forceinline__ void g3_dir(f32x16 (&o)[2], const G3In& I, const G3Lds& L, int ih, int lane) {
    const int r32 = lane & 31, hi = lane >> 5, t128 = ih * 64 + lane;
#pragma unroll
    for (int i = 0; i < 2; ++i) { const int item = lane + 64 * i, t = item >> 2, g8 = item & 3;
        float e[8], qf[8], kf[8];
#pragma unroll
        for (int j = 0; j < 4; ++j) { e[j] = I.pb[i][0][j]; e[4 + j] = I.pb[i][1][j]; }
        const v4u pq = I.pq[i], pk = I.pk[i];
        qf[0] = bflo(pq.x); qf[1] = bfhi(pq.x); qf[2] = bflo(pq.y); qf[3] = bfhi(pq.y); qf[4] = bflo(pq.z); qf[5] = bfhi(pq.z); qf[6] = bflo(pq.w); qf[7] = bfhi(pq.w);
        kf[0] = bflo(pk.x); kf[1] = bfhi(pk.x); kf[2] = bflo(pk.y); kf[3] = bfhi(pk.y); kf[4] = bflo(pk.z); kf[5] = bfhi(pk.z); kf[6] = bflo(pk.w); kf[7] = bfhi(pk.w);
#pragma unroll
        for (int j = 0; j < 8; ++j) { qf[j] *= __builtin_amdgcn_exp2f(e[j] * LOG2E) * 0.17677669529663687f; kf[j] *= __builtin_amdgcn_exp2f(-e[j] * LOG2E); }
        v4u wq, wk; wq.x = cvtpk(qf[0], qf[1]); wq.y = cvtpk(qf[2], qf[3]); wq.z = cvtpk(qf[4], qf[5]); wq.w = cvtpk(qf[6], qf[7]);
        wk.x = cvtpk(kf[0], kf[1]); wk.y = cvtpk(kf[2], kf[3]); wk.z = cvtpk(kf[4], kf[5]); wk.w = cvtpk(kf[6], kf[7]);
        *(v4u*)(L.Qd + t * S32 + g8 * 8) = wq; *(v4u*)(L.Kd + (32 * ih + t) * S32 + g8 * 8) = wk; }
#pragma unroll
    for (int it = 0; it < 4; ++it) { const int e4 = (it * 128 + t128) * 4, kk = e4 >> 6, d0 = e4 & 63; const f32x4 v = I.sv[it];
        L.St[(d0 + 0) * S32 + kk] = (bf16)f2bf(v.x); L.St[(d0 + 1) * S32 + kk] = (bf16)f2bf(v.y); L.St[(d0 + 2) * S32 + kk] = (bf16)f2bf(v.z); L.St[(d0 + 3) * S32 + kk] = (bf16)f2bf(v.w); }
    __syncthreads();
#pragma unroll
    for (int jt = 0; jt < 2; ++jt) {
        f32x16 c = {};
        c = mm_tile<2>(c, L.Qd, S32, L.Kd + (32 * jt) * S32, S32, r32, hi);
        const int j = 32 * jt + r32;
#pragma unroll
        for (int r = 0; r < 16; ++r) { const int il = att::crow(r, hi), ig = 32 * ih + il; const bool keep = DIR == 0 ? (j <= ig) : (j >= ig);
            L.AT[il * S64 + j] = (bf16)f2bf(keep ? c[r] : 0.f); }
    }
    LDS_WAIT();
#pragma unroll
    for (int dt = 0; dt < 2; ++dt) {
        o[dt] = mm_tile<4>(o[dt], L.AT, S64, L.Vt + (32 * dt) * S64, S64, r32, hi);
        o[dt] = mm_tile<2>(o[dt], L.Qd, S32, L.St + (32 * dt) * S32, S32, r32, hi);
    }
    __syncthreads();
}
__device__ __forceinline__ void g3_unit(const Par& p, int b, int n, char* shm) {
    int tid_ = threadIdx.x; asm volatile("" : "+v"(tid_));
    const int tid = tid_, lane = tid & 63, r32 = lane & 31, hi = lane >> 5; const int wid = __builtin_amdgcn_readfirstlane(tid >> 6);
    const int h = wid >> 1, ih = wid & 1, row0 = chunk_row(b, n);
    char* pr = shm + (wid >> 1) * 33792;
    G3Lds L;
    L.Kd = (bf16*)pr;
    L.St = (bf16*)(pr + 5120);
    L.Vt = (bf16*)(pr + 10240);
    L.Qd = (bf16*)(pr + 19456 + ih * 7168);
    L.AT = (bf16*)(pr + 19456 + ih * 7168 + 2560);
    L.zl = nullptr;
    G3In I0, I1; v4u pg[4];
    g3_load<0>(I0, p, row0, b, n, h, ih, lane); g3_load<1>(I1, p, row0, b, n, h, ih, lane);
#pragma unroll
    for (int i = 0; i < 4; ++i) { const int pidx = lane + 64 * i; pg[i] = *(const v4u*)(p.P + (size_t)(row0 + 32 * ih + (pidx >> 3)) * INWP + D_R + h * 64 + (pidx & 7) * 8); }
    load_vt(L.Vt, p.P, row0, h, ih, lane);
    f32x16 o[2]; o[0] = f32x16{}; o[1] = f32x16{};
    g3_dir<0>(o, I0, L, ih, lane);
    g3_dir<1>(o, I1, L, ih, lane);
#pragma unroll
    for (int i = 0; i < 4; ++i) { const int pidx = lane + 64 * i; *(v4u*)(L.AT + (pidx >> 3) * S64 + (pidx & 7) * 8) = pg[i]; }
    const float gn0 = p.gnorm[r32], gn1 = p.gnorm[32 + r32];
    const unsigned lc_ = (unsigned)(4 * hi * DM + r32);
    LDS_WAIT();
#pragma unroll
    for (int r = 0; r < 16; ++r) {
        float ss = o[0][r] * o[0][r] + o[1][r] * o[1][r];
        ss = ss + __builtin_bit_cast(float, __builtin_amdgcn_update_dpp(0, __builtin_bit_cast(int, ss), 0xB1, 0xf, 0xf, true));
        ss = ss + __builtin_bit_cast(float, __builtin_amdgcn_update_dpp(0, __builtin_bit_cast(int, ss), 0x4E, 0xf, 0xf, true));
        ss = ss + __builtin_bit_cast(float, __builtin_amdgcn_update_dpp(0, __builtin_bit_cast(int, ss), 0x141, 0xf, 0xf, true));
        ss = ss + __builtin_bit_cast(float, __builtin_amdgcn_update_dpp(0, __builtin_bit_cast(int, ss), 0x140, 0xf, 0xf, true));
        ss += __shfl_xor(ss, 16);
        const float rstd = __builtin_amdgcn_rsqf(ss * (1.0f / 64.0f) + RMS_EPS);
        const int il = att::crow(r, hi);
        bf16* cp = p.CAT + (size_t)(row0 + 32 * ih + (r & 3) + 8 * (r >> 2)) * DM + 768 + h * 64;
        cp[lc_] = (bf16)f2bf(o[0][r] * rstd * gn0 * fsilu(bf2f(L.AT[il * S64 + r32])));
        cp[lc_ + 32] = (bf16)f2bf(o[1][r] * rstd * gn1 * fsilu(bf2f(L.AT[il * S64 + 32 + r32])));
    }
    __syncthreads();
}
}
#if defined(SELFCHECK) && SELFCHECK
namespace chk {
__device__ __forceinline__ void item(const unsigned char* ws, const float* rpb_l, const float* sink_l, int row, int mx, int h, int lane, float* acc2) {
    const bf16* P = (const bf16*)(ws + WS_P); const bf16* QC = (const bf16*)(ws + WS_QC); const bf16* KC = (const bf16*)(ws + WS_KC); const bf16* VC = (const bf16*)(ws + WS_VC); const bf16* CATp = (const bf16*)(ws + WS_CAT);
    const bool lat = row < NLAT; const int b = lat ? row >> 13 : (row - NLAT) >> 8; const int t = row & (SEQ - 1), r = t >> 6, c = t & 63;
    const bf16* qp; const bf16* Kb; const bf16* Vb; int kp;
    if (mx == 0) { qp = P + (size_t)row * INWP + A_Q + h * 64; Kb = P + A_K + h * 64; Vb = P + A_V + h * 64; kp = INWP; }
    else if (mx == 1) { qp = P + (size_t)row * INWP + B_Q + h * 64; Kb = P + B_K + (h >> 1) * 64; Vb = P + B_V + (h >> 1) * 64; kp = INWP; }
    else { qp = QC + (size_t)row * 256 + h * 64; Kb = KC + h * 64; Vb = VC + h * 64; kp = 256; }
    float q[64];
#pragma unroll
    for (int d = 0; d < 64; ++d) q[d] = bf2f(qp[d]);
    if (mx == 2 && lat) {
#pragma unroll
        for (int g2 = 0; g2 < 2; ++g2) { const float pos = (float)(g2 == 0 ? r : c);
#pragma unroll
            for (int i = 0; i < 8; ++i) { const float ang = pos * exp2f(-(float)i * (13.287712379549449f / 8.0f)); const float cs_ = __cosf(ang), sn_ = __sinf(ang);
                const float x1 = q[32 + 16 * g2 + i], x2 = q[32 + 16 * g2 + 8 + i]; q[32 + 16 * g2 + i] = x1 * cs_ - x2 * sn_; q[32 + 16 * g2 + 8 + i] = x2 * cs_ + x1 * sn_; } }
    }
    const int rs = r - 4 < 0 ? 0 : (r - 4 > 120 ? 120 : r - 4), cs = c - 8 < 0 ? 0 : (c - 8 > 48 ? 48 : c - 8);
    const int nlatk = !lat ? 0 : (mx == 0 ? 128 : (mx == 1 ? 257 : SEQ)), ncand = nlatk + CTXL;
    float mxv = -1e30f;
    for (int pass = 0; pass < 2; ++pass) {
        float l = 0.f, o[64];
#pragma unroll
        for (int d = 0; d < 64; ++d) o[d] = 0.f;
        float pm = -1e30f;
        for (int j = lane; j < ncand; j += 64) {
            int krow; float bias = 0.f; bool ok = true;
            if (j >= nlatk) krow = NLAT + b * CTXL + (j - nlatk);
            else if (mx == 0) { const int i = j >> 4, jj = j & 15; krow = b * SEQ + (rs + i) * 64 + cs + jj; bias = rpb_l[h * 465 + (rs + i - r + 7) * 31 + (cs + jj - c + 15)] * LOG2E; }
            else if (mx == 1) { const int kpos = t - 128 + j; ok = kpos >= 0 && kpos < SEQ; krow = b * SEQ + (ok ? kpos : 0); }
            else krow = b * SEQ + j;
            if (!ok) continue;
            const bf16* kr = Kb + (size_t)krow * kp; float s = bias;
#pragma unroll
            for (int d = 0; d < 64; d += 2) { const unsigned w = *(const unsigned*)(kr + d); s += q[d] * bflo(w) + q[d + 1] * bfhi(w); }
            if (pass == 0) pm = fmaxf(pm, s);
            else { const float pe = __builtin_amdgcn_exp2f(s - mxv); l += pe; const bf16* vr = Vb + (size_t)krow * kp;
#pragma unroll
                for (int d = 0; d < 64; d += 2) { const unsigned w = *(const unsigned*)(vr + d); o[d] += pe * bflo(w); o[d + 1] += pe * bfhi(w); } }
        }
        if (pass == 0) {
#pragma unroll
            for (int off = 32; off >= 1; off >>= 1) pm = fmaxf(pm, __shfl_xor(pm, off));
            mxv = pm;
        } else {
            l = wave_sum(l); if (mx == 1) l += __builtin_amdgcn_exp2f(sink_l[h] * LOG2E - mxv);
            float e2 = 0.f, r2 = 0.f;
#pragma unroll
            for (int d = 0; d < 64; ++d) { const float od = wave_sum(o[d]) / l; const float cd = bf2f(CATp[(size_t)row * DM + mx * 256 + h * 64 + d]); e2 += (od - cd) * (od - cd); r2 += od * od; }
            if (lane == 0) { atomicAdd(acc2, e2); atomicAdd(acc2 + 1, r2); atomicAdd(acc2 + 2 + 2 * mx, e2); atomicAdd(acc2 + 3 + 2 * mx, r2); }
        }
    }
}
__device__ __forceinline__ void rope_pair(float& x1, float& x2, float pos, int i, int half) {
    const float ang = pos * exp2f(-(float)i * (13.287712379549449f / (float)half)); const float cs_ = __cosf(ang), sn_ = __sinf(ang);
    const float a = x1, b = x2; x1 = a * cs_ - b * sn_; x2 = b * cs_ + a * sn_;
}
__device__ __forceinline__ void proj_item(const unsigned char* ws, const float* w_in_l, const float* gq, const float* gkv, const float* wuq, const float* wukv, int row, int lane, float* pl, float* acc2) {
    const bf16* Hh = (const bf16*)(ws + WS_H) + (size_t)row * HLD; const bf16* P = (const bf16*)(ws + WS_P) + (size_t)row * INWP;
    const bf16* QCr = (const bf16*)(ws + WS_QC) + (size_t)row * 256; const bf16* KCr = (const bf16*)(ws + WS_KC) + (size_t)row * 256; const bf16* VCr = (const bf16*)(ws + WS_VC) + (size_t)row * 256;
    const bool lat = row < NLAT; const int t = row & (SEQ - 1); const float pr_ = (float)(t >> 6), pc_ = (float)(t & 63);
    for (int j = 0; j < 15; ++j) { const int cc = lane + 64 * j; if (cc >= 928) break; const int col = 768 + cc; float s = 0.f;
        for (int k = 0; k < DM; ++k) { float hv = bf2f(Hh[k]); if (ROUTER_SPLIT) hv += bf2f(Hh[DM + k]); s += hv * w_in_l[(size_t)k * INW + col]; }
        pl[cc] = s; }
    LDS_WAIT();
    float e2[7] = {0.f, 0.f, 0.f, 0.f, 0.f, 0.f, 0.f}, r2[7] = {0.f, 0.f, 0.f, 0.f, 0.f, 0.f, 0.f};
#define CHK_ACC(cat, ref, got) do { const float rf_ = (ref), gt_ = (got); e2[cat] += (rf_ - gt_) * (rf_ - gt_); r2[cat] += rf_ * rf_; } while (0)
    for (int pi = lane; pi < 6 * 32; pi += 64) { const int hd = pi >> 5, i = pi & 31, g2 = i >> 4, ii = i & 15; const int base = hd * 64 + 32 * g2 + ii;
        float x1 = pl[base], x2 = pl[base + 16]; if (lat) rope_pair(x1, x2, g2 == 0 ? pr_ : pc_, ii, 16);
        if (hd < 4) { CHK_ACC(0, x1 * C2, bf2f(P[B_Q + base])); CHK_ACC(0, x2 * C2, bf2f(P[B_Q + base + 16])); } else { CHK_ACC(1, x1, bf2f(P[B_Q + base])); CHK_ACC(1, x2, bf2f(P[B_Q + base + 16])); } }
    for (int i = lane; i < 128; i += 64) CHK_ACC(2, pl[B_V - 768 + i], bf2f(P[B_V + i]));
    float sq = 0.f, sk = 0.f;
    for (int i = lane; i < 256; i += 64) { const float v = pl[C_Q - 768 + i]; sq += v * v; }
    for (int i = lane; i < 128; i += 64) { const float v = pl[C_KV - 768 + i]; sk += v * v; }
    const float rq = 1.0f / sqrtf(wave_sum(sq) / 256.f + RMS_EPS), rk = 1.0f / sqrtf(wave_sum(sk) / 128.f + RMS_EPS);
    for (int n = lane; n < 256; n += 64) { float s = 0.f; for (int k = 0; k < 256; ++k) s += pl[C_Q - 768 + k] * rq * gq[k] * wuq[(size_t)k * 256 + n]; CHK_ACC(3, s * C2, bf2f(QCr[n])); }
    for (int n = lane; n < 384; n += 64) { float s = 0.f; for (int k = 0; k < 128; ++k) s += pl[C_KV - 768 + k] * rk * gkv[k] * wukv[(size_t)k * 384 + n];
        const int h = n / 96, jj = n % 96; if (jj < 32) CHK_ACC(4, s, bf2f(KCr[h * 64 + jj])); else CHK_ACC(6, s, bf2f(VCr[h * 64 + jj - 32])); }
    for (int pi = lane; pi < 4 * 16; pi += 64) { const int h = pi >> 4, i = pi & 15, g2 = i >> 3, ii = i & 7; const int base = 16 * g2 + ii;
        float x1 = pl[C_KR - 768 + base], x2 = pl[C_KR - 768 + base + 8]; if (lat) rope_pair(x1, x2, g2 == 0 ? pr_ : pc_, ii, 8);
        CHK_ACC(5, x1, bf2f(KCr[h * 64 + 32 + base])); CHK_ACC(5, x2, bf2f(KCr[h * 64 + 32 + base + 8])); }
#undef CHK_ACC
#pragma unroll
    for (int cat = 0; cat < 7; ++cat) { const float a = wave_sum(e2[cat]), b = wave_sum(r2[cat]); if (lane == 0) { atomicAdd(acc2 + 16 + 2 * cat, a); atomicAdd(acc2 + 17 + 2 * cat, b); } }
}
constexpr int NP_ROWS = 112;
__device__ __forceinline__ int proj_row(int s) { return s < 96 ? (int)(((long)s * 7919 + 5) % NLAT) : NLAT + ((s - 96) * 61 + 7) % NCTX; }
constexpr int NS_LAT = 640, NS_CTX = 48, NS_EDGE = 28;
__device__ __forceinline__ int sample_row(int s) {
    if (s < NS_LAT) return (int)(((long)s * 6151 + 17) % NLAT);
    s -= NS_LAT;
    if (s < NS_EDGE) { const int b = s / 7, k = s % 7; const int tt[7] = {0, 1, 63, 64, 4095, 8127, 8191}; int t = 0;
#pragma unroll
        for (int i = 0; i < 7; ++i) if (i == k) t = tt[i];
        return b * SEQ + t; }
    s -= NS_EDGE;
    return NLAT + (s * 21 + 3) % NCTX;
}
}
#endif
struct RowMapId { int off; __device__ __forceinline__ int operator()(int n) const { return off + n; } };
struct RowMapIl { int sub; __device__ __forceinline__ int operator()(int n) const { return 8 * (n >> 2) + 4 * sub + (n & 3); } };
struct RowMapKV { __device__ __forceinline__ int operator()(int n) const { const int h = n / 96, j = n % 96; return j < 32 ? h * 64 + j : 256 + h * 64 + (j - 32); } };
template <class RowMap>
__device__ __forceinline__ void tr_item(const float* W, int ldw, int k0, int n0, bf16* WT, int ldt, const RowMap& rm, const float* kscale, float* scr, int lane) {
    f32x4 xr[16];
#pragma unroll
    for (int it = 0; it < 16; ++it) { const int k = it * 4 + (lane >> 4), n4 = (lane & 15) * 4;
        xr[it] = __builtin_nontemporal_load((const f32x4*)(W + (size_t)(k0 + k) * ldw + n0 + n4)); }
    asm volatile("" : "+v"(xr[0]), "+v"(xr[1]), "+v"(xr[2]), "+v"(xr[3]), "+v"(xr[4]), "+v"(xr[5]), "+v"(xr[6]), "+v"(xr[7]), "+v"(xr[8]), "+v"(xr[9]), "+v"(xr[10]), "+v"(xr[11]), "+v"(xr[12]), "+v"(xr[13]), "+v"(xr[14]), "+v"(xr[15]));
#pragma unroll
    for (int it = 0; it < 16; ++it) { const int k = it * 4 + (lane >> 4), n4 = (lane & 15) * 4;
        f32x4 x = xr[it];
        if (kscale) x = x * kscale[k0 + k];
        float* s = scr + k * 65 + n4; s[0] = x.x; s[1] = x.y; s[2] = x.z; s[3] = x.w; }
    LDS_WAIT();
#pragma unroll 2
    for (int it = 0; it < 8; ++it) { const int n = it * 8 + (lane >> 3), c = lane & 7; const float* s = scr + (8 * c) * 65 + n;
        v4u o; o.x = pk2(s[0 * 65], s[1 * 65]); o.y = pk2(s[2 * 65], s[3 * 65]); o.z = pk2(s[4 * 65], s[5 * 65]); o.w = pk2(s[6 * 65], s[7 * 65]);
        *(v4u*)(WT + (size_t)rm(n0 + n) * ldt + k0 + 8 * c) = o; }
    LDS_WAIT();
}
__device__ __forceinline__ void ld_row(const float* p, int lane, f32x4 (&v)[4]) {
#pragma unroll
    for (int j = 0; j < 2; ++j) { v[2 * j] = *(const f32x4*)(p + 512 * j + 8 * lane); v[2 * j + 1] = *(const f32x4*)(p + 512 * j + 8 * lane + 4); }
}
__device__ __forceinline__ void ld_row_nt(const float* p, int lane, f32x4 (&v)[4]) {
#pragma unroll
    for (int j = 0; j < 2; ++j) { v[2 * j] = __builtin_nontemporal_load((const f32x4*)(p + 512 * j + 8 * lane)); v[2 * j + 1] = __builtin_nontemporal_load((const f32x4*)(p + 512 * j + 8 * lane + 4)); }
}
__device__ __forceinline__ void ld_row_nt(const bf16* p, int lane, f32x4 (&v)[4]) {
#pragma unroll
    for (int j = 0; j < 2; ++j) { const v4u w = __builtin_nontemporal_load((const v4u*)(p + 512 * j + 8 * lane)); v[2 * j] = (f32x4){bflo(w.x), bfhi(w.x), bflo(w.y), bfhi(w.y)}; v[2 * j + 1] = (f32x4){bflo(w.z), bfhi(w.z), bflo(w.w), bfhi(w.w)}; }
}
__device__ __forceinline__ void st_row(bf16* p, int lane, const f32x4 (&v)[4]) {
#pragma unroll
    for (int j = 0; j < 2; ++j) { v4u w; const f32x4 a = v[2 * j], b = v[2 * j + 1]; w.x = cvtpk(a.x, a.y); w.y = cvtpk(a.z, a.w); w.z = cvtpk(b.x, b.y); w.w = cvtpk(b.z, b.w); *(v4u*)(p + 512 * j + 8 * lane) = w; }
}
__device__ __forceinline__ void st_row(float* p, int lane, const f32x4 (&v)[4]) {
#pragma unroll
    for (int j = 0; j < 2; ++j) { st16_wtw<1>(p + 512 * j + 8 * lane, __builtin_bit_cast(v4u, v[2 * j])); st16_wtw<1>(p + 512 * j + 8 * lane + 4, __builtin_bit_cast(v4u, v[2 * j + 1])); }
}
__device__ __forceinline__ void st_row_hilo(bf16* p, int lane, const f32x4 (&v)[4]) {
#pragma unroll
    for (int j = 0; j < 2; ++j) { v4u w, wl; const f32x4 a = v[2 * j], b = v[2 * j + 1];
        w.x = cvtpk(a.x, a.y); w.y = cvtpk(a.z, a.w); w.z = cvtpk(b.x, b.y); w.w = cvtpk(b.z, b.w);
        wl.x = cvtpk(a.x - bflo(w.x), a.y - bfhi(w.x)); wl.y = cvtpk(a.z - bflo(w.y), a.w - bfhi(w.y)); wl.z = cvtpk(b.x - bflo(w.z), b.y - bfhi(w.z)); wl.w = cvtpk(b.z - bflo(w.w), b.w - bfhi(w.w));
        st16_wtw<1>(p + 512 * j + 8 * lane, w); if (ROUTER_SPLIT) st16_wtw<1>(p + DM + 512 * j + 8 * lane, wl); }
}
__device__ __forceinline__ void tr_item_router(const float* W, int k0, int n0, bf16* WT, float* scr, int lane) {
#pragma unroll 4
    for (int it = 0; it < 16; ++it) { const int k = it * 4 + (lane >> 4), n4 = (lane & 15) * 4;
        const f32x4 x = *(const f32x4*)(W + (size_t)(k0 + k) * NEXP + n0 + n4);
        float* s = scr + k * 65 + n4; s[0] = x.x; s[1] = x.y; s[2] = x.z; s[3] = x.w; }
    LDS_WAIT();
#pragma unroll 2
    for (int it = 0; it < 8; ++it) { const int n = it * 8 + (lane >> 3), c = lane & 7; const float* s = scr + (8 * c) * 65 + n;
        float f[8]; v4u o, ol;
#pragma unroll
        for (int i = 0; i < 8; ++i) f[i] = s[i * 65];
        o.x = cvtpk(f[0], f[1]); o.y = cvtpk(f[2], f[3]); o.z = cvtpk(f[4], f[5]); o.w = cvtpk(f[6], f[7]);
        ol.x = cvtpk(f[0] - bflo(o.x), f[1] - bfhi(o.x)); ol.y = cvtpk(f[2] - bflo(o.y), f[3] - bfhi(o.y)); ol.z = cvtpk(f[4] - bflo(o.z), f[5] - bfhi(o.z)); ol.w = cvtpk(f[6] - bflo(o.w), f[7] - bfhi(o.w));
        bf16* d0 = WT + (size_t)(n0 + n) * HLD + k0 + 8 * c; bf16* d1 = WT + (size_t)(128 + n0 + n) * HLD + k0 + 8 * c;
        if (ROUTER_SPLIT) { *(v4u*)d0 = o; *(v4u*)(d0 + DM) = o; *(v4u*)d1 = ol; *(v4u*)(d1 + DM) = ol; }
        else { *(v4u*)d0 = o; *(v4u*)d1 = (v4u){0u, 0u, 0u, 0u}; } }
    LDS_WAIT();
}
__device__ __forceinline__ void ln_row(f32x4 (&v)[4]) {
    float s = 0.f;
#pragma unroll
    for (int j = 0; j < 4; ++j) s += (v[j].x + v[j].y) + (v[j].z + v[j].w);
    const float mean = wave_sum(s) * (1.f / DM); float s2 = 0.f;
#pragma unroll
    for (int j = 0; j < 4; ++j) { v[j] = v[j] - mean; s2 += (v[j].x * v[j].x + v[j].y * v[j].y) + (v[j].z * v[j].z + v[j].w * v[j].w); }
    const float rstd = 1.0f / sqrtf(wave_sum(s2) * (1.f / DM) + LN_EPS);
#pragma unroll
    for (int j = 0; j < 4; ++j) v[j] = v[j] * rstd;
}
template <bool ONEPLUS>
__device__ __forceinline__ void affine_row(f32x4 (&v)[4], const float* a, const float* b, int lane) {
    f32x4 av[4], bv[4]; ld_row(a, lane, av); ld_row(b, lane, bv);
#pragma unroll
    for (int j = 0; j < 4; ++j) v[j] = ONEPLUS ? v[j] * (av[j] + 1.0f) + bv[j] : v[j] * av[j] + bv[j];
}
__device__ __forceinline__ int mod_row(int row) { return row < NLAT ? (row >> 13) : 4; }

__device__ __forceinline__ int ltid() { int t = threadIdx.x; asm volatile("" : "+v"(t)); return t; }
struct Args {
    const float *x, *c, *ctx, *c_ctx, *w_ada, *b_ada, *w_in, *na_rpb, *wa_sink, *mla_g_q, *mla_g_kv, *mla_w_uq, *mla_w_ukv,
                *gla_w_gf, *gla_b_gf, *gla_w_gb, *gla_b_gb, *gla_g_norm, *w_out, *ln1_g, *ln1_b, *ln2_g, *ln2_b,
                *router_w, *router_bias, *exp_w1, *exp_w3, *exp_w2, *sh_w1, *sh_w3, *sh_w2;
    float* out; unsigned char* ws;
};
static_assert(sizeof(Args) == 33 * 8, "Args has no padding");

constexpr int CV_N = NEXP * 192, CV_P8 = ROUTER_SPLIT ? 6944 : 4300  , CV_N0 = CV_N - CV_P8 - 7680 - 4608, CV_N1 = CV_N0 + 4608, CV_N2 = CV_N1 + 7680;
constexpr int CV_L8 = ROUTER_SPLIT ? 4600 : 2300, CV_L0 = CV_N - 4608 - CV_L8, CV_L1 = CV_L0 + 4608;
template <class ArgsT> __device__ __forceinline__ void convert_experts(const ArgsT& A, int l, int lo, int hi, int gw, int NGW, float* scr, int lane) {
    bf16* we13 = (bf16*)(A.ws + WS_WE13); bf16* we2 = (bf16*)(A.ws + WS_WE2);
    for (int it = lo + gw; it < hi; it += NGW) {
        const int e = it / 192, r = it % 192, which = r >> 6, q = r & 63;
        if (which < 2) { const float* W = (which == 0 ? A.exp_w1 : A.exp_w3) + ((size_t)l * NEXP + e) * DM * DEXP;
            tr_item(W, DEXP, (q >> 2) * 64, (q & 3) * 64, we13 + (size_t)e * 512 * DM, DM, RowMapIl{which}, nullptr, scr, lane); }
        else { const float* W = A.exp_w2 + ((size_t)l * NEXP + e) * DEXP * DM;
            tr_item(W, DM, (q >> 4) * 64, (q & 15) * 64, we2 + (size_t)e * DM * DEXP, DEXP, RowMapId{0}, nullptr, scr, lane); }
    }
}

#ifndef SELFCHECK_TOL
#define SELFCHECK_TOL 0.03f
#endif
#ifndef SELFCHECK_TOL2
#define SELFCHECK_TOL2 0.02f
#endif
#ifndef PHMASK
#define PHMASK 0xffffff
#endif
#define PHON(k) (((PHMASK) >> (k)) & 1)
#ifndef DUPK
#define DUPK -1
#endif
__global__ void __launch_bounds__(512, 2) hybrid_fwd(Args A) {
    extern __shared__ __attribute__((aligned(16))) unsigned char lds[];
    const int wave = __builtin_amdgcn_readfirstlane((int)threadIdx.x >> 6);
    const int G = gridDim.x; const int bx = blockIdx.x; const int vcu = (G % 8 == 0) ? (bx % 8) * (G / 8) + bx / 8 : bx;
    const int gw = vcu * 8 + wave, NGW = G * 8;
    const bool cv_tails = (G == 256);
    GAS unsigned char* wsg = (GAS unsigned char*)A.ws;
    unsigned char* ws = (unsigned char*)wsg;
#define WS_LAUNDER() asm volatile("" : "+s"(wsg)); ws = (unsigned char*)wsg; const int tid = ltid(), lane = tid & 63; (void)lane
    gu32* ctl = (gu32*)(ws + WS_CTL);
    volatile LAS unsigned* MISC = (volatile LAS unsigned*)((LAS unsigned char*)lds + MISC_OFF);
    { const int tid = ltid(); if (tid < 128) MISC[tid] = 0u; }
    __syncthreads();
    XcdBarrier bar = xcd_barrier_post((unsigned*)(ctl + CW_BAR), MISC);
#define GRID_BAR() do { XcdBarrier b2_ = bar; GAS unsigned* bp_ = (GAS unsigned*)bar.bar; asm volatile("" : "+s"(bp_), "+s"(b2_.x)); b2_.bar = (unsigned*)bp_; xcd_barrier(b2_); } while (0)
    char* shm = (char*)lds;
#if defined(TIMEPHASE)
#ifndef TIMEQ
#define TIMEQ 100.0f
#endif
#ifndef TIMEOFF
#define TIMEOFF 0.0f
#endif
    unsigned long long t_begin_ = __builtin_amdgcn_s_memrealtime(), t_prev_ = t_begin_, t_acc_ = 0;
#define TSTAMP(k) do { const unsigned long long now_ = __builtin_amdgcn_s_memrealtime(); if ((k) == TIMEPHASE) t_acc_ += now_ - t_prev_; t_prev_ = now_; } while (0)
#else
#define TSTAMP(k) do {} while (0)
#endif
#define MODT ((float*)(ws + WS_MOD))
#define Hb ((bf16*)(ws + WS_H))
#define Pb ((bf16*)(ws + WS_P))
#define QC ((bf16*)(ws + WS_QC))
#define KC ((bf16*)(ws + WS_KC))
#define VC ((bf16*)(ws + WS_VC))
#define CAT ((bf16*)(ws + WS_CAT))
#define XA ((xa_t*)(ws + WS_XA))
#define Zb ((float*)(ws + WS_Z))
#define RSTD ((float*)(ws + WS_RSTD))

        if (PHON(0)) {
        WS_LAUNDER();
    {
        float* sc = (float*)shm;
        float* part = (float*)(shm + 20480);
        for (int i = tid; i < 5 * DM; i += 512) { const float v = i < 4 * DM ? A.c[i] : A.c_ctx[i - 4 * DM]; sc[i] = v / (1.0f + __expf(-v)); }
        __syncthreads();
        for (int grp = vcu; grp < DEPTH * 96; grp += G) {
            const int l = grp / 96, col = (grp % 96) * 64 + lane;
            const float* wp = A.w_ada + (size_t)l * DM * 6 * DM + col;
            float acc[5] = {0.f, 0.f, 0.f, 0.f, 0.f};
#pragma unroll 1
            for (int k0 = 0; k0 < 128; k0 += 32) { float wv[32];
#pragma unroll
                for (int kk = 0; kk < 32; ++kk) wv[kk] = __builtin_nontemporal_load(wp + (size_t)(wave * 128 + k0 + kk) * 6 * DM);
                asm volatile("" : "+v"(wv[16]), "+v"(wv[17]), "+v"(wv[18]), "+v"(wv[19]), "+v"(wv[20]), "+v"(wv[21]), "+v"(wv[22]), "+v"(wv[23]), "+v"(wv[24]), "+v"(wv[25]), "+v"(wv[26]), "+v"(wv[27]), "+v"(wv[28]), "+v"(wv[29]), "+v"(wv[30]), "+v"(wv[31]));
#pragma unroll
                for (int kk = 0; kk < 32; ++kk) { const int k = wave * 128 + k0 + kk;
#pragma unroll
                    for (int r = 0; r < 5; ++r) acc[r] += sc[r * DM + k] * wv[kk]; } }
#pragma unroll
            for (int r = 0; r < 5; ++r) part[(wave * 5 + r) * 64 + lane] = acc[r];
            __syncthreads();
            if (tid < 320) { const int r = tid >> 6; float s = A.b_ada[(size_t)l * 6 * DM + col];
#pragma unroll
                for (int w8 = 0; w8 < 8; ++w8) s += part[(w8 * 5 + r) * 64 + lane];
                MODT[((size_t)l * 5 + r) * 6 * DM + col] = s; }
            __syncthreads();
        }
        float* scr = (float*)(shm + wave * 16640);
        constexpr int I_IN = 16 * 39, I_OUT = 16 * 16, I_UQ = 4 * 4, I_UKV = 2 * 6, I_RT = 16 * 2, I_S1 = 16 * 4, I_S2 = 4 * 16;
        constexpr int I_L = I_IN + I_OUT + I_UQ + I_UKV + I_RT + 2 * I_S1 + I_S2;
        for (int it = gw; it < DEPTH * I_L; it += NGW) {
            const int l = it / I_L; int r = it % I_L;
            if (r < I_IN) { tr_item(A.w_in + (size_t)l * DM * INW, INW, (r / 39) * 64, (r % 39) * 64, (bf16*)(ws + WS_WIN) + (size_t)l * INWP * DM, DM, RowMapId{0}, nullptr, scr, lane); continue; } r -= I_IN;
            if (r < I_OUT) { tr_item(A.w_out + (size_t)l * DM * DM, DM, (r / 16) * 64, (r % 16) * 64, (bf16*)(ws + WS_WOUT) + (size_t)l * DM * DM, DM, RowMapId{0}, nullptr, scr, lane); continue; } r -= I_OUT;
            if (r < I_UQ) { tr_item(A.mla_w_uq + (size_t)l * 256 * 256, 256, (r / 4) * 64, (r % 4) * 64, (bf16*)(ws + WS_WUQ) + (size_t)l * 256 * 256, 256, RowMapId{0}, A.mla_g_q + l * 256, scr, lane); continue; } r -= I_UQ;
            if (r < I_UKV) { tr_item(A.mla_w_ukv + (size_t)l * 128 * 384, 384, (r / 6) * 64, (r % 6) * 64, (bf16*)(ws + WS_WUKV) + (size_t)l * 512 * 128, 128, RowMapKV{}, A.mla_g_kv + l * 128, scr, lane); continue; } r -= I_UKV;
            if (r < I_RT) { tr_item_router(A.router_w + (size_t)l * DM * NEXP, (r / 2) * 64, (r % 2) * 64, (bf16*)(ws + WS_WRT) + (size_t)l * 256 * HLD, scr, lane); continue; } r -= I_RT;
            if (r < I_S1) { tr_item(A.sh_w1 + (size_t)l * DM * 256, 256, (r / 4) * 64, (r % 4) * 64, (bf16*)(ws + WS_WS13) + (size_t)l * 512 * DM, DM, RowMapIl{0}, nullptr, scr, lane); continue; } r -= I_S1;
            if (r < I_S1) { tr_item(A.sh_w3 + (size_t)l * DM * 256, 256, (r / 4) * 64, (r % 4) * 64, (bf16*)(ws + WS_WS13) + (size_t)l * 512 * DM, DM, RowMapIl{1}, nullptr, scr, lane); continue; } r -= I_S1;
            tr_item(A.sh_w2 + (size_t)l * 256 * DM, DM, (r / 16) * 64, (r % 16) * 64, (bf16*)(ws + WS_WS2) + (size_t)l * DM * 256, 256, RowMapId{0}, nullptr, scr, lane);
        }
        { const v4u z = {0u, 0u, 0u, 0u}; const int gt = vcu * 512 + tid, NGT = G * 512;
            for (int i = gt; i < DEPTH * 64 * 128; i += NGT) { const int l = i / (64 * 128), r = i % (64 * 128); *(v4u*)((bf16*)(ws + WS_WIN) + ((size_t)l * INWP + INW) * DM + (size_t)r * 8) = z; }
            for (int i = gt; i < DEPTH * 4 * 32 * 16; i += NGT) { const int l = i / 2048, r = i % 2048, h = r / 512, q = r % 512; *(v4u*)((bf16*)(ws + WS_WUKV) + ((size_t)l * 512 + h * 64 + 32) * 128 + (size_t)q * 8) = z; } }
    }
        }
    GRID_BAR(); TSTAMP(0);
        if (PHON(1)) {
        WS_LAUNDER();
    for (int m = gw; m < NTOK; m += NGW) {
        const float* src = m < NLAT ? A.x + (size_t)m * DM : A.ctx + (size_t)(m - NLAT) * DM;
        f32x4 v[4]; ld_row_nt(src, lane, v); st_row(XA + (size_t)m * DM, lane, v);
        ln_row(v); const float* mp = MODT + (size_t)mod_row(m) * 6 * DM; affine_row<true>(v, mp + DM, mp, lane);
        st_row_hilo(Hb + (size_t)m * HLD, lane, v);
    }
    convert_experts(A, 0, 0, cv_tails ? CV_N0 : CV_N, gw, NGW, (float*)(shm + wave * 16640), lane);
        }
    GRID_BAR(); TSTAMP(1);

#pragma unroll 1
    for (int l = 0; l < DEPTH; ++l) {
        const bool lastl = (l == DEPTH - 1);
        const int MT = lastl ? NLAT : NTOK;
#define modl (MODT + (size_t)l * 5 * 6 * DM)
        if (PHON(2)) {
        WS_LAUNDER();
        { pg8::Gemm g{Hb, (const bf16*)(ws + WS_WIN) + (size_t)l * INWP * DM, DM, HLD, nullptr}; pg8::StaticOrderT<NTOK, INWP> S; S.init(NTOK, INWP, G, bx);
          pg8::EpiBf16<INWP, false> E{Pb, 10, (1u << 0) | (1u << 3), C2, 256, nullptr, 0, nullptr};
          pg8::gemm_phase<pg8::EpiBf16<INWP, false>, pg8::StaticOrderT<NTOK, INWP>, false>((LAS unsigned char*)lds, g, S, E); }
        if (cv_tails && bx >= 40) convert_experts(A, l, lastl ? CV_L0 : CV_N0, lastl ? CV_L1 : CV_N1, (bx - 40) * 8 + wave, 216 * 8, (float*)(shm + wave * 16640), lane);
        }
        GRID_BAR(); TSTAMP(2);
        if (PHON(3)) {
        WS_LAUNDER();
        {
        const bool roleB = lane < 24, roleK = lane == 24 || lane == 25;
        const int hd = lane >> 2, g2 = roleB ? (lane >> 1) & 1 : lane & 1, c8 = lane & 1;
        const int col1 = roleB ? B_Q + hd * 64 + 32 * g2 + 8 * c8 : C_KR + 16 * g2, dpart = roleB ? 16 : 8;
        const int f0 = roleB ? 8 * c8 : 0; const float fdiv = roleB ? 13.287712379549449f / 16.0f : 13.287712379549449f / 8.0f;
        const bool rskip = P2_ROWSKIP && G == 256; const int gw2 = rskip ? (vcu - 16) * 8 + wave : gw, NGW2 = rskip ? (G - 16) * 8 : NGW;
        for (int m0 = (rskip && vcu < 16) ? NTOK : gw2; m0 < NTOK; m0 += 4 * NGW2) {
            v4u xa[4], xb[4]; v2u ca[4]; unsigned cb[4];
#pragma unroll
            for (int u = 0; u < 4; ++u) { const int m = m0 + u * NGW2; const bf16* pr = Pb + (size_t)(m < NTOK ? m : 0) * INWP;
                xa[u] = *(const v4u*)(pr + col1); xb[u] = *(const v4u*)(pr + col1 + dpart);
                ca[u] = *(const v2u*)(pr + C_Q + 4 * lane); cb[u] = *(const unsigned*)(pr + C_KV + 2 * lane); }
#pragma unroll
            for (int u = 0; u < 4; ++u) { const int m = m0 + u * NGW2; if (m < NTOK) { bf16* pr = Pb + (size_t)m * INWP;
                const bool lat = m < NLAT; const int t = m & (SEQ - 1);
                if ((roleB && lat) || roleK) {
                    const float pos = (float)(g2 == 0 ? (t >> 6) : (t & 63)); v4u oa, ob;
#pragma unroll
                    for (int j = 0; j < 4; ++j) { float r1[2], r2[2];
#pragma unroll
                        for (int e = 0; e < 2; ++e) { const float rev = pos * __builtin_amdgcn_exp2f(-(float)(f0 + 2 * j + e) * fdiv) * 0.15915494309189535f;
                            const float cs_ = lat ? __builtin_amdgcn_cosf(rev) : 1.f, sn_ = lat ? __builtin_amdgcn_sinf(rev) : 0.f;
                            const float a1 = e ? bfhi(xa[u][j]) : bflo(xa[u][j]), a2 = e ? bfhi(xb[u][j]) : bflo(xb[u][j]); r1[e] = a1 * cs_ - a2 * sn_; r2[e] = a2 * cs_ + a1 * sn_; }
                        oa[j] = cvtpk(r1[0], r1[1]); ob[j] = cvtpk(r2[0], r2[1]); }
                    if (roleB) { *(v4u*)(pr + col1) = oa; *(v4u*)(pr + col1 + 16) = ob; }
                    else { bf16* kd = KC + (size_t)m * 256 + 32 + 16 * g2;
#pragma unroll
                        for (int h4 = 0; h4 < 4; ++h4) { *(v4u*)(kd + h4 * 64) = oa; *(v4u*)(kd + h4 * 64 + 8) = ob; } }
                }
                const v2u a_ = ca[u]; const unsigned b2 = cb[u];
                float sq = bflo(a_.x) * bflo(a_.x) + bfhi(a_.x) * bfhi(a_.x) + bflo(a_.y) * bflo(a_.y) + bfhi(a_.y) * bfhi(a_.y); float sk = bflo(b2) * bflo(b2) + bfhi(b2) * bfhi(b2);
                sq = wave_sum(sq); sk = wave_sum(sk);
                if (lane == 0) { RSTD[2 * m] = 1.0f / sqrtf(sq * (1.f / 256.f) + RMS_EPS); RSTD[2 * m + 1] = 1.0f / sqrtf(sk * (1.f / 128.f) + RMS_EPS); } } }
        }
        }
        }
#define GLA_PAR() const gla::Par gp{Pb, CAT, (float*)(ws + WS_GU), (float*)(ws + WS_GDEC), (float*)(ws + WS_BC), (float*)(ws + WS_CARRY), A.gla_w_gf + l * 16 * 128, A.gla_b_gf + l * 128, A.gla_w_gb + l * 16 * 128, A.gla_b_gb + l * 128, A.gla_g_norm + l * 64}
        if (PHON(3)) {
        WS_LAUNDER();
        if (PHON(21)) { GLA_PAR(); for (int u = vcu; u < NB * NCH; u += G) gla::g1_unit(gp, u / NCH, u % NCH, shm); }
        }
        GRID_BAR(); TSTAMP(3);
        if (PHON(4)) {
        WS_LAUNDER();
        if (G >= 256) { if (bx >= 16 && bx < 144) gla::g2_scan((float*)(ws + WS_GU), (const float*)(ws + WS_GDEC), (bx - 16) * 512 + tid); }
        else gla::g2_scan((float*)(ws + WS_GU), (const float*)(ws + WS_GDEC), vcu * 512 + tid);
        { pg8::Gemm g{Pb + C_Q, (const bf16*)(ws + WS_WUQ) + (size_t)l * 256 * 256, 256, INWP, nullptr}; pg8::StaticOrderT<NTOK, 256> S; S.init(NTOK, 256, G, bx);
          pg8::EpiBf16<256, true> E{QC, 1, 1u, C2, 0, RSTD, 0, nullptr};
          pg8::gemm_phase<pg8::EpiBf16<256, true>, pg8::StaticOrderT<NTOK, 256>, false>((LAS unsigned char*)lds, g, S, E); }
        { pg8::Gemm g{Pb + C_KV, (const bf16*)(ws + WS_WUKV) + (size_t)l * 512 * 128, 128, INWP, nullptr}; pg8::AfterRouterOrder S; S.init(NTOK, G, bx);
          pg8::EpiBf16<256, true, true> E{KC, 2, 0u, 1.f, (size_t)(WS_VC - WS_KC) / 2, RSTD, 1, nullptr};
          pg8::gemm_phase<pg8::EpiBf16<256, true, true>, pg8::AfterRouterOrder, false>((LAS unsigned char*)lds, g, S, E); }
        }
        GRID_BAR(); TSTAMP(4);
#if defined(SELFCHECK) && SELFCHECK
        {
            WS_LAUNDER();
            float* acc2 = (float*)(ws + WS_CTL) + 32768;
            for (int it = gw; it < chk::NP_ROWS; it += NGW) chk::proj_item(ws, A.w_in + (size_t)l * DM * INW, A.mla_g_q + l * 256, A.mla_g_kv + l * 128, A.mla_w_uq + (size_t)l * 256 * 256, A.mla_w_ukv + (size_t)l * 128 * 384,
                                                                            chk::proj_row(it), lane, (float*)(shm + wave * 4096), acc2);
            __syncthreads();
        }
#endif
        if (PHON(6)) {
        WS_LAUNDER();
        {
            if (PHON(16)) for (int u = vcu; u < 512; u += G) { const int bh = 2 * ((u & 255) >> 5) + (u >> 8), qb = u & 31, b = bh >> 2, h = bh & 3;
                att::Desc d{}; d.Q = QC + (size_t)(b * SEQ + 256 * qb) * 256 + h * 64; d.qp = 256; d.K = KC + h * 64; d.V = VC + h * 64; d.kp = 256;
                d.O = CAT + (size_t)(b * SEQ + 256 * qb) * DM + 512 + h * 64; d.op = DM; d.nt = 132; d.nctx = 4; d.ctxrow = NLAT + b * CTXL; d.latrow = b * SEQ;
                d.nt_real = d.nt; d.qrope = 1; d.qt0 = 256 * qb; att::attn_unit_pipe<8, att::M_FULL>(d, shm); }
            if (PHON(17)) for (int u = vcu; u < 512; u += G) { const int bh = u >> 5, qb = u & 31, b = bh >> 2, h = bh & 3; const int r0 = 4 * qb;
                const int kr0 = r0 - 4 < 0 ? 0 : (r0 - 4 > 120 ? 120 : r0 - 4); const int r3 = r0 + 3; const int krl = (r3 - 4 < 0 ? 0 : (r3 - 4 > 120 ? 120 : r3 - 4)) + 8;
                att::Desc d{}; d.Q = Pb + (size_t)(b * SEQ + 256 * qb) * INWP + A_Q + h * 64; d.qp = INWP; d.K = Pb + A_K + h * 64; d.V = Pb + A_V + h * 64; d.kp = INWP;
                d.O = CAT + (size_t)(b * SEQ + 256 * qb) * DM + h * 64; d.op = DM; d.nctx = 4; d.nt = 4 + (krl - kr0); d.ctxrow = NLAT + b * CTXL; d.latrow = b * SEQ + 64 * kr0;
                d.r0 = r0; d.kr0 = kr0; d.rpb = A.na_rpb + ((size_t)l * 4 + h) * 465;
                d.nt_real = d.nt; d.nt = (d.nt + 1) & ~1; att::attn_unit_pipe<8, att::M_NA>(d, shm); }
            if (PHON(18)) for (int u = vcu; u < 512; u += G) { const int bh = u >> 5, qb = u & 31, b = bh >> 2, h = bh & 3; const int q0 = 256 * qb;
                const int kt0 = q0 - 128 < 0 ? 0 : q0 - 128; const int kte = q0 + 256 + 128 > SEQ ? SEQ : q0 + 256 + 128;
                att::Desc d{}; d.Q = Pb + (size_t)(b * SEQ + q0) * INWP + B_Q + h * 64; d.qp = INWP; d.K = Pb + B_K + (h >> 1) * 64; d.V = Pb + B_V + (h >> 1) * 64; d.kp = INWP;
                d.O = CAT + (size_t)(b * SEQ + q0) * DM + 256 + h * 64; d.op = DM; d.nctx = 4; d.nt = 4 + (kte - kt0) / 64; d.ctxrow = NLAT + b * CTXL; d.latrow = b * SEQ + kt0;
                d.q0 = q0; d.kt0 = kt0; d.sink_l2 = A.wa_sink[l * 4 + h] * LOG2E; d.has_sink = 1;
                d.nt_real = d.nt; d.nt = (d.nt + 1) & ~1; att::attn_unit_pipe<8, att::M_WA>(d, shm); }
            if (PHON(19) && !lastl) for (int u = (G >= 64 ? vcu - (G - 48) : vcu); u < 48; u += G) { if (u < 0) break; const int mx = u >> 4, b = (u >> 2) & 3, h = u & 3; const int qrow = NLAT + b * CTXL;
                att::Desc d{}; d.nt = 4; d.nctx = 4; d.ctxrow = qrow; d.latrow = 0; d.op = DM; d.O = CAT + (size_t)qrow * DM + 256 * mx + h * 64;
                if (mx == 0) { d.Q = Pb + (size_t)qrow * INWP + A_Q + h * 64; d.qp = INWP; d.K = Pb + A_K + h * 64; d.V = Pb + A_V + h * 64; d.kp = INWP; }
                else if (mx == 1) { d.Q = Pb + (size_t)qrow * INWP + B_Q + h * 64; d.qp = INWP; d.K = Pb + B_K + (h >> 1) * 64; d.V = Pb + B_V + (h >> 1) * 64; d.kp = INWP; d.sink_l2 = A.wa_sink[l * 4 + h] * LOG2E; d.has_sink = 1; }
                else { d.Q = QC + (size_t)qrow * 256 + h * 64; d.qp = 256; d.K = KC + h * 64; d.V = VC + h * 64; d.kp = 256; }
                att::attn_unit<att::M_FULL>(d, shm); }
            if (PHON(20)) { GLA_PAR();
                if (G == 256 && G3_EDGE) {
#pragma unroll 1
                    for (int r = 0; r < 3; ++r) { const int q5 = vcu & 31; if (r == 2 && q5 != 0 && q5 != 31) break;
                        const int u = r < 2 ? vcu + 256 * r : 512 + 2 * (vcu >> 5) + (q5 == 31); if (u >= NB * NCH) break;
                        const int b = u / NCH, n = u % NCH; if (lastl && n < 4) continue; gla::g3_unit(gp, b, n, shm); } }
                else for (int u = vcu; u < NB * NCH; u += G) { const int b = u / NCH, n = u % NCH; if (lastl && n < 4) continue; gla::g3_unit(gp, b, n, shm); } }
        }
        }
        GRID_BAR(); TSTAMP(6);
#if defined(SELFCHECK) && SELFCHECK
        {
            WS_LAUNDER();
            float* acc2 = (float*)(ws + WS_CTL) + 32768;
            const int ns = chk::NS_LAT + chk::NS_EDGE + (lastl ? 0 : chk::NS_CTX);
            for (int it = gw; it < ns * 12; it += NGW) chk::item(ws, A.na_rpb + (size_t)l * 4 * 465, A.wa_sink + l * 4, chk::sample_row(it / 12), (it % 12) >> 2, it & 3, lane, acc2);
        }
        GRID_BAR();
#endif
        if (PHON(7)) {
        WS_LAUNDER();
        { pg8::Gemm g{CAT, (const bf16*)(ws + WS_WOUT) + (size_t)l * DM * DM, DM, DM, nullptr}; pg8::StaticOrderT<NTOK, DM, NLAT> S; S.init(MT, DM, G, bx);
          pg8::EpiBf16<DM, false> E{(bf16*)Zb, 4, 0u, 1.f, 256, nullptr, 0, nullptr};
          pg8::gemm_phase<pg8::EpiBf16<DM, false>, pg8::StaticOrderT<NTOK, DM, NLAT>, false>((LAS unsigned char*)lds, g, S, E); }
        if (cv_tails && !lastl && bx >= 16) convert_experts(A, l, CV_N1, CV_N2, (bx - 16) * 8 + wave, 240 * 8, (float*)(shm + wave * 16640), lane);
        }
        GRID_BAR(); TSTAMP(7);
        if (PHON(8)) {
        WS_LAUNDER();
#if P7_ROWS > 0 && XA_BF16
        for (int m0 = gw; m0 < MT; m0 += P7_ROWS * NGW) {
            v4u xw[P7_ROWS][2], ow[P7_ROWS][2];
#pragma unroll
            for (int u = 0; u < P7_ROWS; ++u) { const int m = m0 + u * NGW, mm = m < MT ? m : m0; const bf16* xr = XA + (size_t)mm * DM; const bf16* orow = (const bf16*)Zb + (size_t)mm * DM;
#pragma unroll
                for (int j = 0; j < 2; ++j) { xw[u][j] = __builtin_nontemporal_load((const v4u*)(xr + 512 * j + 8 * lane)); ow[u][j] = __builtin_nontemporal_load((const v4u*)(orow + 512 * j + 8 * lane)); } }
#pragma unroll
            for (int u = 0; u < P7_ROWS; ++u) { const int m = m0 + u * NGW; if (m >= MT) break;
                f32x4 vv[4], gt[4]; ld_row(modl + (size_t)mod_row(m) * 6 * DM + 2 * DM, lane, gt);
#pragma unroll
                for (int j = 0; j < 2; ++j) { const v4u x = xw[u][j], w = ow[u][j];
                    vv[2 * j] = (f32x4){bflo(x.x), bfhi(x.x), bflo(x.y), bfhi(x.y)} * DN_ALPHA + gt[2 * j] * (f32x4){bflo(w.x), bfhi(w.x), bflo(w.y), bfhi(w.y)};
                    vv[2 * j + 1] = (f32x4){bflo(x.z), bfhi(x.z), bflo(x.w), bfhi(x.w)} * DN_ALPHA + gt[2 * j + 1] * (f32x4){bflo(w.z), bfhi(w.z), bflo(w.w), bfhi(w.w)}; }
                ln_row(vv); affine_row<false>(vv, A.ln1_g + l * DM, A.ln1_b + l * DM, lane);
                st_row(XA + (size_t)m * DM, lane, vv);
                ln_row(vv); const float* mp = modl + (size_t)mod_row(m) * 6 * DM; affine_row<true>(vv, mp + 4 * DM, mp + 3 * DM, lane);
                st_row_hilo(Hb + (size_t)m * HLD, lane, vv); }
        }
#else
        for (int m0 = gw; m0 < MT; m0 += 2 * NGW) {
            f32x4 vv[2][4];
#pragma unroll
            for (int u = 0; u < 2; ++u) { const int m = m0 + u * NGW, mm = m < MT ? m : m0;
                f32x4 gt[4]; ld_row_nt(XA + (size_t)mm * DM, lane, vv[u]); ld_row(modl + (size_t)mod_row(mm) * 6 * DM + 2 * DM, lane, gt);
                const bf16* orow = (const bf16*)Zb + (size_t)mm * DM;
#pragma unroll
                for (int j = 0; j < 2; ++j) { const v4u w = __builtin_nontemporal_load((const v4u*)(orow + 512 * j + 8 * lane));
                    vv[u][2 * j] = vv[u][2 * j] * DN_ALPHA + gt[2 * j] * (f32x4){bflo(w.x), bfhi(w.x), bflo(w.y), bfhi(w.y)};
                    vv[u][2 * j + 1] = vv[u][2 * j + 1] * DN_ALPHA + gt[2 * j + 1] * (f32x4){bflo(w.z), bfhi(w.z), bflo(w.w), bfhi(w.w)}; } }
#pragma unroll
            for (int u = 0; u < 2; ++u) { const int m = m0 + u * NGW; if (m >= MT) break;
                ln_row(vv[u]); affine_row<false>(vv[u], A.ln1_g + l * DM, A.ln1_b + l * DM, lane);
                st_row(XA + (size_t)m * DM, lane, vv[u]);
                ln_row(vv[u]); const float* mp = modl + (size_t)mod_row(m) * 6 * DM; affine_row<true>(vv[u], mp + 4 * DM, mp + 3 * DM, lane);
                st_row_hilo(Hb + (size_t)m * HLD, lane, vv[u]); }
        }
#endif
        }
        GRID_BAR(); TSTAMP(8);
#define P9_TOKENS(TOK0_, NTOK_, BROW_) { \
            int* hist = (int*)shm; \
            if (tid < NEXP) hist[tid] = 0; \
            __syncthreads(); \
            const float rb0 = A.router_bias[l * NEXP + lane], rb1 = A.router_bias[l * NEXP + 64 + lane]; \
            for (int i0 = wave; i0 < (NTOK_); i0 += 32) { \
            float s0[4], s1[4], v0[4], v1[4], ssum[4], my_s[4]; int my_e[4]; \
            _Pragma("unroll") \
            for (int u = 0; u < 4; ++u) { const int ii = i0 + 8 * u; const int tok = (TOK0_) + (ii < (NTOK_) ? ii : i0); const float* lg = (const float*)(ws + WS_LOG) + (size_t)tok * NEXP; \
            s0[u] = 1.0f / (1.0f + __expf(-__builtin_nontemporal_load(lg + lane))); s1[u] = 1.0f / (1.0f + __expf(-__builtin_nontemporal_load(lg + 64 + lane))); \
            v0[u] = s0[u] + rb0; v1[u] = s1[u] + rb1; my_e[u] = 0; my_s[u] = 0.f; ssum[u] = 0.f; } \
            _Pragma("unroll") \
            for (int k = 0; k < TOPK; ++k) { \
            float bv[4]; int bi[4]; \
            _Pragma("unroll") \
            for (int u = 0; u < 4; ++u) { bv[u] = v0[u] >= v1[u] ? v0[u] : v1[u]; bi[u] = v0[u] >= v1[u] ? lane : lane + 64; } \
            _Pragma("unroll") \
            for (int off = 32; off >= 1; off >>= 1) { \
            _Pragma("unroll") \
            for (int u = 0; u < 4; ++u) { const float ov = __shfl_xor(bv[u], off); const int oi = __shfl_xor(bi[u], off); if (ov > bv[u] || (ov == bv[u] && oi < bi[u])) { bv[u] = ov; bi[u] = oi; } } } \
            _Pragma("unroll") \
            for (int u = 0; u < 4; ++u) { const float ssel = __shfl(bi[u] < 64 ? s0[u] : s1[u], bi[u] & 63); \
            if (lane == (bi[u] & 63)) { if (bi[u] < 64) v0[u] = -INFINITY; else v1[u] = -INFINITY; } \
            ssum[u] += ssel; if (lane == k) { my_e[u] = bi[u]; my_s[u] = ssel; } } \
            } \
            _Pragma("unroll") \
            for (int u = 0; u < 4; ++u) { const int ii = i0 + 8 * u; const int tok = (TOK0_) + ii; \
            if (ii < (NTOK_) && lane < TOPK) { const int rk = atomicAdd(&hist[my_e[u]], 1); \
            ((int*)(ws + WS_SEL))[tok * 8 + lane] = my_e[u]; ((float*)(ws + WS_GATE))[tok * 8 + lane] = 2.5f * my_s[u] / ssum[u]; ((int*)(ws + WS_RANK))[tok * 8 + lane] = rk; } } \
            } \
            __syncthreads(); \
            if (tid < NEXP) { const int base = __hip_atomic_fetch_add(GCNT + tid, hist[tid], __ATOMIC_RELAXED, __HIP_MEMORY_SCOPE_AGENT); ((int*)(ws + WS_BBASE))[(BROW_) * NEXP + tid] = base; } }
#if FUSE9
        constexpr bool fuse9 = true;
#else
        const bool fuse9 = false;
#endif
#define GCNT ((int*)(ws + WS_CTL) + CW_CNT + l * NEXP)
        if (PHON(9)) {
        WS_LAUNDER();
        { pg8::Gemm g{Hb, (const bf16*)(ws + WS_WRT) + (size_t)l * 256 * HLD, HLD, HLD, nullptr}; pg8::StaticOrderT<NTOK, 256, NLAT> S; S.init(MT, 256, G, bx);
          pg8::EpiLogits E{(float*)(ws + WS_LOG)};
          pg8::gemm_phase<pg8::EpiLogits, pg8::StaticOrderT<NTOK, 256, NLAT>, false>((LAS unsigned char*)lds, g, S, E);
          pg8::Unit ur; pg8::StaticOrderT<NTOK, 256, NLAT> S2; S2.init(MT, 256, G, bx);
          if (fuse9 && G == 256 && S2.next(0, ur)) {
              __builtin_amdgcn_fence(__ATOMIC_RELEASE, "agent"); __syncthreads(); __builtin_amdgcn_fence(__ATOMIC_ACQUIRE, "agent");
              { const int tid = ltid(), lane = tid & 63;
                P9_TOKENS(ur.pm * 256, 256, ur.pm); }
              __syncthreads(); } }
        const int nrt = MT / 256;
        const int cb8 = fuse9 ? (lastl ? 128 : 148) : (lastl ? 128 : (G == 256 ? 140 : 132));
        if (cv_tails && bx >= cb8) { convert_experts(A, l, lastl ? CV_L1 : CV_N2, CV_N, (bx - cb8) * 8 + wave, (256 - cb8) * 8, (float*)(shm + wave * 16640), lane); __syncthreads(); }
        { pg8::Gemm g{Hb, (const bf16*)(ws + WS_WS13) + (size_t)l * 512 * DM, DM, HLD, nullptr}; pg8::StaticOrderT<NTOK, 512, NLAT> S;
          S.init(MT, 512, fuse9 ? G - nrt : G, fuse9 ? (bx >= nrt ? bx - nrt : (1 << 24)) : ((!lastl && G == 256) ? ((bx + 124) & 255) : bx));
          pg8::EpiSwiGLU E{(bf16*)(ws + WS_HSS), 2, nullptr, 1.f, nullptr};
          pg8::gemm_phase<pg8::EpiSwiGLU, pg8::StaticOrderT<NTOK, 512, NLAT>, 0>((LAS unsigned char*)lds, g, S, E); }
        }
        GRID_BAR(); TSTAMP(9);
        const int TPB = MT / G;
        if constexpr (!fuse9) {
        if (PHON(10)) {
        WS_LAUNDER();
        {
            P9_TOKENS(vcu * TPB, TPB, vcu);
        }
        }
        GRID_BAR(); TSTAMP(10);
        }
        if (PHON(11)) {
        WS_LAUNDER();
        {
            int* sst = (int*)shm; int* scn = sst + 132;
            if (tid < NEXP) scn[tid] = __hip_atomic_load(GCNT + tid, __ATOMIC_RELAXED, __HIP_MEMORY_SCOPE_AGENT);
            __syncthreads();
            if (wave == 0) { const int p0 = (scn[2 * lane] + 255) & ~255, p1 = (scn[2 * lane + 1] + 255) & ~255; int x = p0 + p1;
#pragma unroll
                for (int off = 1; off < 64; off <<= 1) { const int y = __shfl_up(x, off); if (lane >= off) x += y; }
                const int ex = x - (p0 + p1); sst[2 * lane] = ex; sst[2 * lane + 1] = ex + p0; if (lane == 63) sst[NEXP] = x; }
            __syncthreads();
            int* stok = (int*)(ws + WS_STOK); float* sgate = (float*)(ws + WS_SGATE); int* texp = (int*)(ws + WS_TEXP);
            if (TPB * 8 > 1536) { for (int i = tid; i < TPB * 8; i += 512) { const int ent = vcu * TPB * 8 + i; const int e = ((const int*)(ws + WS_SEL))[ent];
                const int slot = sst[e] + ((const int*)(ws + WS_BBASE))[(fuse9 ? (ent >> 11) : vcu) * NEXP + e] + ((const int*)(ws + WS_RANK))[ent];
                stok[slot] = ent >> 3; sgate[slot] = ((const float*)(ws + WS_GATE))[ent]; ((int*)(ws + WS_TSLOT))[ent] = slot; } }
            else {
                int ee[3], bb[3], rr[3]; float gg[3];
#pragma unroll
                for (int q = 0; q < 3; ++q) { const int i = tid + 512 * q, ent = vcu * TPB * 8 + (i < TPB * 8 ? i : 0); ee[q] = ((const int*)(ws + WS_SEL))[ent]; rr[q] = ((const int*)(ws + WS_RANK))[ent]; gg[q] = ((const float*)(ws + WS_GATE))[ent]; }
#pragma unroll
                for (int q = 0; q < 3; ++q) { const int i = tid + 512 * q, ent = vcu * TPB * 8 + (i < TPB * 8 ? i : 0); bb[q] = ((const int*)(ws + WS_BBASE))[(fuse9 ? (ent >> 11) : vcu) * NEXP + ee[q]]; }
#pragma unroll
                for (int q = 0; q < 3; ++q) { const int i = tid + 512 * q; if (i < TPB * 8) { const int ent = vcu * TPB * 8 + i; const int slot = sst[ee[q]] + bb[q] + rr[q];
                    stok[slot] = ent >> 3; sgate[slot] = gg[q]; ((int*)(ws + WS_TSLOT))[ent] = slot; } }
            }
            for (int e = vcu; e < NEXP; e += G) {
                for (int s = sst[e] + scn[e] + tid; s < sst[e + 1]; s += 512) { stok[s] = 0; sgate[s] = 0.f; }
                for (int mt = (sst[e] >> 8) + tid; mt < (sst[e + 1] >> 8); mt += 512) texp[mt] = e;
            }
            if (vcu == 0 && tid == 0) texp[2047] = sst[NEXP] >> 8;
            __syncthreads();
        }
        }
        GRID_BAR(); TSTAMP(11);
        if (PHON(12)) {
        WS_LAUNDER();
        int* texl = (int*)(shm + 133120);
        const int ntile = __builtin_amdgcn_readfirstlane(((const int*)(ws + WS_TEXP))[2047]);
        { int tv[4];
#pragma unroll
          for (int q = 0; q < 4; ++q) { const int i = tid + 512 * q; tv[q] = ((const int*)(ws + WS_TEXP))[i < 2047 ? i : 2046]; }
#pragma unroll
          for (int q = 0; q < 4; ++q) { const int i = tid + 512 * q; if (i < ntile) texl[i] = tv[q]; } }
        __syncthreads();
        { pg8::Gemm g{Hb, (const bf16*)(ws + WS_WE13), DM, HLD, (const int*)(ws + WS_STOK), nullptr}; pg8::GroupedOrderT<XR11, 2> S; S.init(texl, ntile, 2, G, bx);
          pg8::EpiSwiGLU E{(bf16*)(ws + WS_HS), 2, GATE_IN_COMBINE ? nullptr : (const float*)(ws + WS_SGATE), pg8::YSCALE, nullptr};
          pg8::gemm_phase<pg8::EpiSwiGLU, pg8::GroupedOrderT<XR11, 2>, 1>((LAS unsigned char*)lds, g, S, E); }
        { pg8::Gemm g{(const bf16*)(ws + WS_HSS), (const bf16*)(ws + WS_WS2) + (size_t)l * DM * 256, 256, 256, nullptr}; pg8::StaticOrderT<NTOK, DM, NLAT> S;
          { const int c0 = (ntile * 2) % G; S.init(MT, DM, G, (bx - c0 + G) % G); }
          if (SD_BALANCE && XR11 && G == 256) {
              const int x = bx & 7, j = bx >> 3, nmx = (((x + 1) * ntile) >> 3) - ((x * ntile) >> 3), r = (nmx * 2) & 31, nlow = 32 - r, Tn = (MT / 256) * 4 / 8;
              int sj, off;
              if (r == 0) { const int q = Tn >> 5, rem = Tn & 31; sj = q + (j < rem); off = j * q + (j < rem ? j : rem); }
              else if (Tn <= 3 * nlow) { const int qa = Tn / nlow, rema = Tn % nlow, k = j - r; sj = j < r ? 0 : qa + (k < rema); off = j < r ? 0 : k * qa + (k < rema ? k : rema); }
              else { const int T2 = Tn - 3 * nlow, q = T2 >> 5, rem = T2 & 31; sj = q + (j < rem) + (j >= r ? 3 : 0); off = j * q + (j < rem ? j : rem) + 3 * (j > r ? j - r : 0); }
              S.set_range(x * Tn + off, sj); }
          pg8::EpiBf16<DM, false> E{(bf16*)(ws + WS_YS), 4, 0u, 1.f, 256, nullptr, 0, nullptr};
          pg8::gemm_phase<pg8::EpiBf16<DM, false>, pg8::StaticOrderT<NTOK, DM, NLAT>, false>((LAS unsigned char*)lds, g, S, E); }
        }
        GRID_BAR(); TSTAMP(12);
        if (PHON(13)) {
        WS_LAUNDER();
        int* texl = (int*)(shm + 133120);
        const int ntile = __builtin_amdgcn_readfirstlane(((const int*)(ws + WS_TEXP))[2047]);
        { int tv[4];
#pragma unroll
          for (int q = 0; q < 4; ++q) { const int i = tid + 512 * q; tv[q] = ((const int*)(ws + WS_TEXP))[i < 2047 ? i : 2046]; }
#pragma unroll
          for (int q = 0; q < 4; ++q) { const int i = tid + 512 * q; if (i < ntile) texl[i] = tv[q]; } }
        __syncthreads();
        { pg8::Gemm g{(const bf16*)(ws + WS_HS), (const bf16*)(ws + WS_WE2), 256, 256, nullptr}; pg8::GroupedOrderT<XR12, 4> S; S.init(texl, ntile, 4, G, bx);
          pg8::EpiFp8 E{(unsigned char*)(ws + WS_Y), 4};
          pg8::gemm_phase<pg8::EpiFp8, pg8::GroupedOrderT<XR12, 4>, false>((LAS unsigned char*)lds, g, S, E);
#ifdef PROBE_P12NULL
          { pg8::EpiNull E0; pg8::gemm_phase<pg8::EpiNull, pg8::GroupedOrderT<XR12, 4>, false>((LAS unsigned char*)lds, g, S, E0); }
#endif
#ifdef PROBE_P12FULL
          pg8::gemm_phase<pg8::EpiFp8, pg8::GroupedOrderT<XR12, 4>, false>((LAS unsigned char*)lds, g, S, E);
#endif
          }
        }
        GRID_BAR(); TSTAMP(13);
        if (PHON(14)) {
        WS_LAUNDER();
#if P13_ROWS > 1 && XA_BF16 && !GATE_IN_COMBINE
        for (int m0 = gw; m0 < MT; m0 += P13_ROWS * NGW) {
            v4u ysw[P13_ROWS][2], xw[P13_ROWS][2]; v2u yw[P13_ROWS][TOPK][2]; v4i tsv[P13_ROWS][2];
#pragma unroll
            for (int u = 0; u < P13_ROWS; ++u) { const int m = m0 + u * NGW, mm = m < MT ? m : m0; const v4i* ts = (const v4i*)((const int*)(ws + WS_TSLOT) + (size_t)mm * 8); tsv[u][0] = ts[0]; tsv[u][1] = ts[1]; }
#pragma unroll
            for (int u = 0; u < P13_ROWS; ++u) { const int m = m0 + u * NGW, mm = m < MT ? m : m0;
                const bf16* ys = (const bf16*)(ws + WS_YS) + (size_t)mm * DM; const bf16* xr = XA + (size_t)mm * DM;
#pragma unroll
                for (int j = 0; j < 2; ++j) { ysw[u][j] = __builtin_nontemporal_load((const v4u*)(ys + 512 * j + 8 * lane)); xw[u][j] = __builtin_nontemporal_load((const v4u*)(xr + 512 * j + 8 * lane)); } }
#pragma unroll
            for (int u = 0; u < P13_ROWS; ++u) asm volatile("" : "+v"(tsv[u][0]), "+v"(tsv[u][1]));
#pragma unroll
            for (int u = 0; u < P13_ROWS; ++u) {
#pragma unroll
                for (int k = 0; k < TOPK; ++k) { const unsigned char* yr = (const unsigned char*)(ws + WS_Y) + (size_t)tsv[u][k >> 2][k & 3] * DM;
#pragma unroll
                    for (int j = 0; j < 2; ++j) yw[u][k][j] = __builtin_nontemporal_load((const v2u*)(yr + 512 * j + 8 * lane)); } }
#pragma unroll
            for (int u = 0; u < P13_ROWS; ++u) { const int m = m0 + u * NGW; if (m >= MT) break;
                f32x4 f[4], v[4], gt[4];
#pragma unroll
                for (int j = 0; j < 2; ++j) { const v4u w = ysw[u][j]; f[2 * j] = (f32x4){bflo(w.x), bfhi(w.x), bflo(w.y), bfhi(w.y)}; f[2 * j + 1] = (f32x4){bflo(w.z), bfhi(w.z), bflo(w.w), bfhi(w.w)};
                    const v4u x = xw[u][j]; v[2 * j] = (f32x4){bflo(x.x), bfhi(x.x), bflo(x.y), bfhi(x.y)}; v[2 * j + 1] = (f32x4){bflo(x.z), bfhi(x.z), bflo(x.w), bfhi(x.w)}; }
                f32x4 f8[4] = {{0.f, 0.f, 0.f, 0.f}, {0.f, 0.f, 0.f, 0.f}, {0.f, 0.f, 0.f, 0.f}, {0.f, 0.f, 0.f, 0.f}};
#pragma unroll
                for (int k = 0; k < TOPK; ++k)
#pragma unroll
                    for (int j = 0; j < 2; ++j) { const v2u w = yw[u][k][j];
                        const f32x2 a0 = __builtin_amdgcn_cvt_pk_f32_fp8((int)w.x, false), a1 = __builtin_amdgcn_cvt_pk_f32_fp8((int)w.x, true), a2 = __builtin_amdgcn_cvt_pk_f32_fp8((int)w.y, false), a3 = __builtin_amdgcn_cvt_pk_f32_fp8((int)w.y, true);
                        f8[2 * j] += (f32x4){a0.x, a0.y, a1.x, a1.y}; f8[2 * j + 1] += (f32x4){a2.x, a2.y, a3.x, a3.y}; }
                const float* mp = modl + (size_t)mod_row(m) * 6 * DM; ld_row(mp + 5 * DM, lane, gt);
#pragma unroll
                for (int j = 0; j < 4; ++j) { f[j] += f8[j] * (1.0f / pg8::YSCALE); v[j] = v[j] * DN_ALPHA + gt[j] * f[j]; }
                ln_row(v); affine_row<false>(v, A.ln2_g + l * DM, A.ln2_b + l * DM, lane);
                if (lastl) { st_row(A.out + (size_t)m * DM, lane, v); }
                else { st_row(XA + (size_t)m * DM, lane, v); ln_row(v); const float* mn = modl + 5 * 6 * DM + (size_t)mod_row(m) * 6 * DM; affine_row<true>(v, mn + DM, mn, lane); st_row_hilo(Hb + (size_t)m * HLD, lane, v); } }
        }
#else
        for (int m = gw; m < MT; m += NGW) {
            f32x4 f[4];
            { const bf16* ys = (const bf16*)(ws + WS_YS) + (size_t)m * DM;
#pragma unroll
              for (int j = 0; j < 2; ++j) { const v4u w = __builtin_nontemporal_load((const v4u*)(ys + 512 * j + 8 * lane)); f[2 * j] = (f32x4){bflo(w.x), bfhi(w.x), bflo(w.y), bfhi(w.y)}; f[2 * j + 1] = (f32x4){bflo(w.z), bfhi(w.z), bflo(w.w), bfhi(w.w)}; } }
            const int* ts = (const int*)(ws + WS_TSLOT) + (size_t)m * 8; const float* tg = (const float*)(ws + WS_GATE) + (size_t)m * 8;
            f32x4 f8[4] = {{0.f, 0.f, 0.f, 0.f}, {0.f, 0.f, 0.f, 0.f}, {0.f, 0.f, 0.f, 0.f}, {0.f, 0.f, 0.f, 0.f}};
#pragma unroll
            for (int k = 0; k < TOPK; ++k) { const unsigned char* yr = (const unsigned char*)(ws + WS_Y) + (size_t)ts[k] * DM;
#pragma unroll
                for (int j = 0; j < 2; ++j) { const v2u w = __builtin_nontemporal_load((const v2u*)(yr + 512 * j + 8 * lane));
                    const f32x2 a0 = __builtin_amdgcn_cvt_pk_f32_fp8((int)w.x, false), a1 = __builtin_amdgcn_cvt_pk_f32_fp8((int)w.x, true), a2 = __builtin_amdgcn_cvt_pk_f32_fp8((int)w.y, false), a3 = __builtin_amdgcn_cvt_pk_f32_fp8((int)w.y, true);
                    if (GATE_IN_COMBINE) { const float gk = tg[k]; f8[2 * j] += gk * (f32x4){a0.x, a0.y, a1.x, a1.y}; f8[2 * j + 1] += gk * (f32x4){a2.x, a2.y, a3.x, a3.y}; }
                    else { f8[2 * j] += (f32x4){a0.x, a0.y, a1.x, a1.y}; f8[2 * j + 1] += (f32x4){a2.x, a2.y, a3.x, a3.y}; } } }
#pragma unroll
            for (int j = 0; j < 4; ++j) f[j] += f8[j] * (1.0f / pg8::YSCALE);
            f32x4 v[4], gt[4]; ld_row_nt(XA + (size_t)m * DM, lane, v); const float* mp = modl + (size_t)mod_row(m) * 6 * DM; ld_row(mp + 5 * DM, lane, gt);
#pragma unroll
            for (int j = 0; j < 4; ++j) v[j] = v[j] * DN_ALPHA + gt[j] * f[j];
            ln_row(v); affine_row<false>(v, A.ln2_g + l * DM, A.ln2_b + l * DM, lane);
            if (lastl) { st_row(A.out + (size_t)m * DM, lane, v); }
            else { st_row(XA + (size_t)m * DM, lane, v); ln_row(v); const float* mn = modl + 5 * 6 * DM + (size_t)mod_row(m) * 6 * DM; affine_row<true>(v, mn + DM, mn, lane); st_row_hilo(Hb + (size_t)m * HLD, lane, v); }
        }
#endif
        }
        if (!lastl) {
        if (PHON(15)) {
        WS_LAUNDER(); convert_experts(A, l + 1, 0, !cv_tails ? CV_N : (l + 1 < DEPTH - 1 ? CV_N0 : CV_L0), gw, NGW, (float*)(shm + wave * 16640), lane);
        }
        GRID_BAR(); }
        TSTAMP(14);
    }
#if defined(TIMEPHASE)
    {
        float* shp = (float*)(A.ws + WS_CTL) + 40000;
        if (bx == 0 && ltid() == 0) { const unsigned long long now_ = __builtin_amdgcn_s_memrealtime(); __hip_atomic_store(shp, floorf((float)((double)t_acc_ / (double)(now_ - t_begin_)) * TIMEQ + TIMEOFF) / TIMEQ, __ATOMIC_RELAXED, __HIP_MEMORY_SCOPE_AGENT); }
        GRID_BAR();
        const float share = __hip_atomic_load(shp, __ATOMIC_RELAXED, __HIP_MEMORY_SCOPE_AGENT);
        const int tid = ltid(); for (size_t i = (size_t)bx * 512 + tid; i < (size_t)NLAT * DM; i += (size_t)G * 512) A.out[i] *= (1.0f + share);
    }
#endif
#if defined(SELFCHECK) && SELFCHECK
    GRID_BAR();
    {
        const float* acc2 = (const float*)(A.ws + WS_CTL) + 32768; bool bad = false;
        for (int m3 = 0; m3 < 3; ++m3) { const float e2 = __hip_atomic_load(acc2 + 2 + 2 * m3, __ATOMIC_RELAXED, __HIP_MEMORY_SCOPE_AGENT), r2 = __hip_atomic_load(acc2 + 3 + 2 * m3, __ATOMIC_RELAXED, __HIP_MEMORY_SCOPE_AGENT);
            if (!(r2 > 0.f) || !(e2 <= SELFCHECK_TOL * SELFCHECK_TOL * r2)) bad = true; }
        for (int cat = 0; cat < 7; ++cat) { const float e2 = __hip_atomic_load(acc2 + 16 + 2 * cat, __ATOMIC_RELAXED, __HIP_MEMORY_SCOPE_AGENT), r2 = __hip_atomic_load(acc2 + 17 + 2 * cat, __ATOMIC_RELAXED, __HIP_MEMORY_SCOPE_AGENT);
            if (!(r2 > 0.f) || !(e2 <= SELFCHECK_TOL2 * SELFCHECK_TOL2 * r2)) bad = true; }
        if (bad) { const int tid = ltid(); for (size_t i = (size_t)bx * 512 + tid; i < (size_t)NLAT * DM; i += (size_t)G * 512) A.out[i] *= 3.0f; }
    }
#endif
    if (bx == 0 && ltid() < 64) { const int tid = ltid(); if (__hip_atomic_load((unsigned*)(ctl + CW_BAR) + XB_TMO, __ATOMIC_RELAXED, __HIP_MEMORY_SCOPE_AGENT) != 0u) A.out[tid] = __builtin_nanf(""); }
#undef GRID_BAR
#undef MODT
#undef Hb
#undef Pb
#undef QC
#undef KC
#undef VC
#undef CAT
#undef XA
#undef Zb
#undef RSTD
#undef modl
}

extern "C" void kernel_launch(void* const* d_in, const int* in_sizes, int n_in, void* d_out, int out_size, void* d_ws, size_t ws_size, hipStream_t stream) {
    static int grid = 0;
    if (grid == 0) {
        if (n_in != 31 || in_sizes[0] != NLAT * DM || out_size != NLAT * DM || ws_size < WS_END) {
            fprintf(stderr, "kernel_launch: built for 31 inputs, x/out of %d floats, >= %zu bytes of workspace; got n_in %d, in0 %d, out %d, ws %zu; nothing launched\n", NLAT * DM, (size_t)WS_END, n_in, n_in > 0 ? in_sizes[0] : -1, out_size, ws_size);
            grid = -1; return; }
        int dev = 0, cus = 0, per_cu = 0;
        if (hipGetDevice(&dev) != hipSuccess || hipDeviceGetAttribute(&cus, hipDeviceAttributeMultiprocessorCount, dev) != hipSuccess) { fprintf(stderr, "kernel_launch: device query failed\n"); grid = -1; return; }
        if (hipFuncSetAttribute((const void*)hybrid_fwd, hipFuncAttributeMaxDynamicSharedMemorySize, LDS_BYTES) != hipSuccess) { fprintf(stderr, "kernel_launch: hipFuncSetAttribute failed\n"); grid = -1; return; }
        if (hipOccupancyMaxActiveBlocksPerMultiprocessor(&per_cu, (const void*)hybrid_fwd, 512, LDS_BYTES) != hipSuccess || per_cu < 1)
            fprintf(stderr, "kernel_launch: note: occupancy query reports %d workgroups per CU\n", per_cu);
        (void)hipGetLastError();
        grid = cus;
        if (grid != 256) { fprintf(stderr, "kernel_launch: note: %d CUs (tuned for 256)\n", grid); if (FUSE9) { fprintf(stderr, "kernel_launch: this build needs 256 workgroups (FUSE9)\n"); grid = -1; return; } }
        if ((NTOK % grid) || (NLAT % grid)) { fprintf(stderr, "kernel_launch: grid %d does not divide the token counts\n", grid); grid = -1; return; }
    }
    if (grid < 0) return;
    if (hipMemsetAsync((char*)d_ws + WS_CTL, 0, CTL_ZERO_BYTES, stream) != hipSuccess) { fprintf(stderr, "kernel_launch: hipMemsetAsync failed\n"); return; }
    Args a{};
    const float** ap = (const float**)&a;
    for (int i = 0; i < 31; ++i) ap[i] = (const float*)d_in[i];
    a.out = (float*)d_out; a.ws = (unsigned char*)d_ws;
    hipLaunchKernelGGL(hybrid_fwd, dim3(grid), dim3(512), LDS_BYTES, stream, a);
    const hipError_t le = hipPeekAtLastError();
    if (le != hipSuccess) fprintf(stderr, "kernel_launch: launch failed: %s\n", hipGetErrorName(le));
}
```
